# Optimizing an MI355X kernel written in HIP

```python
import jax, jax.numpy as jnp
from jax import lax
import numpy as np

D_MODEL = 2048
BATCH = 4
SEQ = 4096
DEPTH = 1

CHUNK = 64
N_MEM = 256
EPS = 1e-6
D_MIX = D_MODEL
D_POOL = D_MIX // 2
POOL_WINDOWS = (2, 4, 8, 16)
N_POOL_GROUPS = len(POOL_WINDOWS)
POOL_GROUP_DIM = D_POOL // N_POOL_GROUPS
D_SGU = D_MIX - D_POOL
SGU_BLOCK = 128
N_SGU_HEADS = 8
SGU_HEAD_DIM = D_SGU // N_SGU_HEADS
D_IN = D_POOL + 2 * D_SGU
N_XATTN_HEADS = 4
XATTN_HEAD_DIM = D_MODEL // N_XATTN_HEADS
D_FF = ((8 * D_MODEL // 3 + 255) // 256) * 256

kernel_name = "hybrid_pool_sgu_memxattn_block"


def rmsnorm(x, g):
    x32 = x.astype(jnp.float32)
    y = x32 * lax.rsqrt(jnp.mean(x32 * x32, axis=-1, keepdims=True) + EPS)
    return (y * g.astype(jnp.float32)).astype(x.dtype)


def multiscale_pool(a, pool_w, pool_scale):
    B, S, _ = a.shape
    a32 = a.astype(jnp.float32)
    csum = jnp.cumsum(a32, axis=1)
    pos = jnp.arange(1, S + 1, dtype=jnp.float32)[None, :, None]
    outs = []
    for g, w in enumerate(POOL_WINDOWS):
        sl = slice(g * POOL_GROUP_DIM, (g + 1) * POOL_GROUP_DIM)
        c = csum[..., sl]
        prev = jnp.pad(c, ((0, 0), (w, 0), (0, 0)))[:, :S]
        mean = (c - prev) / jnp.minimum(pos, float(w))
        outs.append(mean - a32[..., sl])
    p = jnp.stack(outs, axis=2).astype(a.dtype)
    y = jnp.einsum('bsgc,gcd->bsgd', p, pool_w)
    return y.reshape(B, S, D_POOL) * pool_scale


def spatial_gating(uv, sgu_norm_g, w_spatial, b_spatial):
    B, S, _ = uv.shape
    u, v = uv[..., :D_SGU], uv[..., D_SGU:]
    v = rmsnorm(v, sgu_norm_g)
    v = v.reshape(B, S // SGU_BLOCK, SGU_BLOCK, N_SGU_HEADS, SGU_HEAD_DIM)
    t = jnp.arange(SGU_BLOCK)
    mask = (t[None, :] // CHUNK) <= (t[:, None] // CHUNK)
    ws = jnp.where(mask[None], w_spatial, 0.0)
    mixed = jnp.einsum('hts,bnshc->bnthc', ws, v)
    mixed = mixed + b_spatial.T[None, None, :, :, None]
    return u * mixed.reshape(B, S, D_SGU)


def memory_cross_attention(h, m, w_q, w_k, w_v, w_o):
    B, S, _ = h.shape
    M = m.shape[1]
    q = (h @ w_q).reshape(B, S, N_XATTN_HEADS, XATTN_HEAD_DIM)
    k = (m @ w_k).reshape(B, M, N_XATTN_HEADS, XATTN_HEAD_DIM)
    v = (m @ w_v).reshape(B, M, N_XATTN_HEADS, XATTN_HEAD_DIM)
    s = jnp.einsum('bshd,bmhd->bhsm', q, k).astype(jnp.float32) * (XATTN_HEAD_DIM ** -0.5)
    p = jax.nn.softmax(s, axis=-1).astype(v.dtype)
    o = jnp.einsum('bhsm,bmhd->bshd', p, v).reshape(B, S, D_MODEL)
    return o @ w_o


def swiglu(h, w_gate, w_up, w_down):
    return (jax.nn.silu(h @ w_gate) * (h @ w_up)) @ w_down


def setup_inputs(seed: int = 0) -> dict:
    key = jax.random.key(seed)
    ks = jax.random.split(key, 24)
    L = DEPTH
    f32 = jnp.float32

    def nrm(k, shape, scale):
        return jax.random.normal(k, shape, f32) * scale

    def gain(k, shape):
        return 1.0 + 0.02 * jax.random.normal(k, shape, f32)

    return {
        "x": jax.random.normal(ks[0], (BATCH, SEQ, D_MODEL), f32),
        "mem": jax.random.normal(ks[1], (BATCH, N_MEM, D_MODEL), f32),
        "norm_mix_g": gain(ks[2], (L, D_MODEL)),
        "w_in": nrm(ks[3], (L, D_MODEL, D_IN), D_MODEL ** -0.5),
        "pool_w": nrm(ks[4], (L, N_POOL_GROUPS, POOL_GROUP_DIM, POOL_GROUP_DIM), POOL_GROUP_DIM ** -0.5),
        "pool_scale": 1.0 + 0.1 * jax.random.normal(ks[5], (L, D_POOL), f32),
        "sgu_norm_g": gain(ks[6], (L, D_SGU)),
        "w_spatial": nrm(ks[7], (L, N_SGU_HEADS, SGU_BLOCK, SGU_BLOCK), SGU_BLOCK ** -0.5),
        "b_spatial": 1.0 + 0.1 * jax.random.normal(ks[8], (L, N_SGU_HEADS, SGU_BLOCK), f32),
        "w_out": nrm(ks[9], (L, D_MIX, D_MODEL), D_MIX ** -0.5),
        "norm_xattn_g": gain(ks[10], (L, D_MODEL)),
        "norm_mem_g": gain(ks[11], (L, D_MODEL)),
        "w_q": nrm(ks[12], (L, D_MODEL, D_MODEL), D_MODEL ** -0.5),
        "w_k": nrm(ks[13], (L, D_MODEL, D_MODEL), D_MODEL ** -0.5),
        "w_v": nrm(ks[14], (L, D_MODEL, D_MODEL), D_MODEL ** -0.5),
        "w_o": nrm(ks[15], (L, D_MODEL, D_MODEL), D_MODEL ** -0.5),
        "norm_ffn_g": gain(ks[16], (L, D_MODEL)),
        "w_gate": nrm(ks[17], (L, D_MODEL, D_FF), D_MODEL ** -0.5),
        "w_up": nrm(ks[18], (L, D_MODEL, D_FF), D_MODEL ** -0.5),
        "w_down": nrm(ks[19], (L, D_FF, D_MODEL), D_FF ** -0.5),
        "final_norm_g": gain(ks[20], (D_MODEL,)),
    }


def reference(x, mem, norm_mix_g, w_in, pool_w, pool_scale, sgu_norm_g, w_spatial,
              b_spatial, w_out, norm_xattn_g, norm_mem_g, w_q, w_k, w_v, w_o,
              norm_ffn_g, w_gate, w_up, w_down, final_norm_g):
    for l in range(DEPTH):
        h = rmsnorm(x, norm_mix_g[l])
        proj = h @ w_in[l]
        y_pool = multiscale_pool(proj[..., :D_POOL], pool_w[l], pool_scale[l])
        y_sgu = spatial_gating(proj[..., D_POOL:], sgu_norm_g[l], w_spatial[l], b_spatial[l])
        x = x + jnp.concatenate([y_pool, y_sgu], axis=-1) @ w_out[l]
        h = rmsnorm(x, norm_xattn_g[l])
        m = rmsnorm(mem, norm_mem_g[l])
        x = x + memory_cross_attention(h, m, w_q[l], w_k[l], w_v[l], w_o[l])
        h = rmsnorm(x, norm_ffn_g[l])
        x = x + swiglu(h, w_gate[l], w_up[l], w_down[l])
    return rmsnorm(x, final_norm_g)
```

```cpp
#include <hip/hip_runtime.h>
#include <hip/hip_cooperative_groups.h>
#include <cstdio>
#include <cstdint>
namespace cg = cooperative_groups;
namespace pg8 {
#define PG8_LAS __attribute__((address_space(3)))
typedef unsigned short bf16_t;
typedef short bf16x8 __attribute__((ext_vector_type(8)));
typedef float f32x4 __attribute__((ext_vector_type(4)));
typedef unsigned u32x4 __attribute__((ext_vector_type(4)));
constexpr int BM = 256, BK = 64, HALF = 128, HTB = HALF * BK * 2  , STAGE_BYTES = 8 * HTB, NXCD = 8, WGM = 8;

__host__ __device__ __forceinline__ int lds_byte(int r, int c) { const int st = (r >> 4) * 2 + (c >> 5), rr = r & 15, cc = c & 31, ob = rr * 64 + cc * 2; return st * 1024 + (ob ^ (((ob >> 9) & 1) << 5)); }
__host__ __device__ __forceinline__ void stage_rc(int b, int& R, int& C) { const int st = b / 1024, sb = b % 1024, swz = sb ^ (((sb >> 9) & 1) << 5); R = (st >> 1) * 16 + swz / 64; C = (st & 1) * 32 + (swz % 64) / 2; }
__host__ __device__ __forceinline__ int perm32(int rho) { const int n = rho >> 4, i = rho & 15; return 8 * (i >> 2) + 4 * n + (i & 3); }

struct Unit { int pm, pn; };
struct Gemm { const bf16_t* A; const bf16_t* Bt; int M, N, K; };

struct StaticOrder {
    int nM, nN, nwg, G, c;
    __host__ __device__ void init(int M, int N, int G_, int c_) { nM = M / BM; nN = N / BM; nwg = nM * nN; G = G_; c = c_; }
    __host__ __device__ bool next(int i, Unit& u) const {
        const long L = (long)i * G + c; if (L >= nwg) return false;
        int wgid = (int)L; { const int q = nwg / NXCD, r = nwg % NXCD, xcd = wgid % NXCD, off = wgid / NXCD; wgid = (xcd < r ? xcd * (q + 1) : r * (q + 1) + (xcd - r) * q) + off; }
        const int nig = WGM * nN, gid = wgid / nig, fm = gid * WGM, gsz = (nM - fm) < WGM ? (nM - fm) : WGM;
        u.pm = fm + ((wgid % nig) % gsz); u.pn = (wgid % nig) / gsz; return true;
    }
    __device__ __forceinline__ void a_ready(const Unit&) const {}
    __device__ __forceinline__ void done(const Unit&) const {}
};

__device__ __forceinline__ unsigned cvt_pk_bf16(float lo, float hi) { unsigned r; asm volatile("v_cvt_pk_bf16_f32 %0, %1, %2" : "=v"(r) : "v"(lo), "v"(hi)); return r; }
typedef unsigned u32x2 __attribute__((ext_vector_type(2)));
constexpr float RMS_EPS = 1e-6f;

struct EpiPlain {
    static constexpr bool PERM = true, AFTER_DRAIN = false;
    bf16_t* O; int ldc;
    __device__ __forceinline__ void operator()(const f32x4 (&acc)[2][2][4][2], const Unit& u, int wr, int wc, int fr, int fq) const {
        const int row0 = u.pm * BM + wr * 64 + fr, col0 = u.pn * BM + wc * 32 + 8 * fq;
#pragma unroll
        for (int ai = 0; ai < 2; ++ai)
#pragma unroll
            for (int m = 0; m < 4; ++m) { bf16_t* rowp = O + (size_t)(row0 + ai * HALF + m * 16) * ldc + col0;
#pragma unroll
                for (int bj = 0; bj < 2; ++bj) { const f32x4 v0 = acc[ai][bj][m][0], v1 = acc[ai][bj][m][1];
                    u32x4 w; w.x = cvt_pk_bf16(v0[0], v0[1]); w.y = cvt_pk_bf16(v0[2], v0[3]); w.z = cvt_pk_bf16(v1[0], v1[1]); w.w = cvt_pk_bf16(v1[2], v1[3]);
                    *(u32x4*)(rowp + bj * HALF) = w; } }
    }
};
struct EpiRowScale {
    static constexpr bool PERM = true, AFTER_DRAIN = false;
    bf16_t* O; int ldc; const float* SS; float inv_n;
    __device__ __forceinline__ void operator()(const f32x4 (&acc)[2][2][4][2], const Unit& u, int wr, int wc, int fr, int fq) const {
        const int row0 = u.pm * BM + wr * 64 + fr, col0 = u.pn * BM + wc * 32 + 8 * fq;
#pragma unroll
        for (int ai = 0; ai < 2; ++ai)
#pragma unroll
            for (int m = 0; m < 4; ++m) { const int row = row0 + ai * HALF + m * 16; bf16_t* rowp = O + (size_t)row * ldc + col0;
                const float rs = 1.0f / sqrtf(SS[row] * inv_n + RMS_EPS);
#pragma unroll
                for (int bj = 0; bj < 2; ++bj) { const f32x4 v0 = acc[ai][bj][m][0] * rs, v1 = acc[ai][bj][m][1] * rs;
                    u32x4 w; w.x = cvt_pk_bf16(v0[0], v0[1]); w.y = cvt_pk_bf16(v0[2], v0[3]); w.z = cvt_pk_bf16(v1[0], v1[1]); w.w = cvt_pk_bf16(v1[2], v1[3]);
                    *(u32x4*)(rowp + bj * HALF) = w; } }
    }
};
__device__ __forceinline__ float silu_mul(float g, float u) { return g * u * __builtin_amdgcn_rcpf(1.0f + __expf(-g)); }
struct EpiSwiglu {
    static constexpr bool PERM = true, AFTER_DRAIN = false;
    bf16_t* O; int ldc; const float* SS; float inv_n;
    __device__ __forceinline__ void operator()(const f32x4 (&acc)[2][2][4][2], const Unit& u, int wr, int wc, int fr, int fq) const {
        const int row0 = u.pm * BM + wr * 64 + fr, col0 = u.pn * HALF + wc * 32 + 8 * fq;
#pragma unroll
        for (int ai = 0; ai < 2; ++ai)
#pragma unroll
            for (int m = 0; m < 4; ++m) { const int row = row0 + ai * HALF + m * 16;
                const float rs = 1.0f / sqrtf(SS[row] * inv_n + RMS_EPS);
                const f32x4 g0 = acc[ai][0][m][0] * rs, g1 = acc[ai][0][m][1] * rs, u0 = acc[ai][1][m][0] * rs, u1 = acc[ai][1][m][1] * rs;
                u32x4 w;
                w.x = cvt_pk_bf16(silu_mul(g0[0], u0[0]), silu_mul(g0[1], u0[1])); w.y = cvt_pk_bf16(silu_mul(g0[2], u0[2]), silu_mul(g0[3], u0[3]));
                w.z = cvt_pk_bf16(silu_mul(g1[0], u1[0]), silu_mul(g1[1], u1[1])); w.w = cvt_pk_bf16(silu_mul(g1[2], u1[2]), silu_mul(g1[3], u1[3]));
                *(u32x4*)(O + (size_t)row * ldc + col0) = w; }
    }
};
struct EpiResid {
    static constexpr bool PERM = false, AFTER_DRAIN = false;
    const float* res; float* out; bf16_t* xb; float* SS; int ldc;
    __device__ __forceinline__ void operator()(const f32x4 (&acc)[2][2][4][2], const Unit& u, int wr, int wc, int fr, int fq) const {
        const int col0 = u.pn * BM + wc * 32 + 4 * fq;
#pragma unroll
        for (int ai = 0; ai < 2; ++ai)
#pragma unroll
            for (int m = 0; m < 4; ++m) { const int row = u.pm * BM + ai * HALF + wr * 64 + m * 16 + fr; const size_t off = (size_t)row * ldc + col0; float s = 0.f;
#pragma unroll
                for (int bj = 0; bj < 2; ++bj)
#pragma unroll
                    for (int n = 0; n < 2; ++n) { const f32x4 r = *(const f32x4*)(res + off + bj * HALF + n * 16); const f32x4 v = r + acc[ai][bj][m][n];
                        *(f32x4*)(out + off + bj * HALF + n * 16) = v;
                        if (xb) { u32x2 w; w.x = cvt_pk_bf16(v[0], v[1]); w.y = cvt_pk_bf16(v[2], v[3]); *(u32x2*)(xb + off + bj * HALF + n * 16) = w; }
                        s += (v[0] * v[0] + v[1] * v[1]) + (v[2] * v[2] + v[3] * v[3]); }
                if (SS) { s += __shfl_xor(s, 16); s += __shfl_xor(s, 32); if (fq == 0) unsafeAtomicAdd(SS + row, s); }
                asm volatile("" ::: "memory"); }
    }
};
template <class Epi, class Sched, bool ALIGN_EPI = false, bool SP2 = false>
__device__ __forceinline__ void gemm_phase(PG8_LAS unsigned char* lds, const Gemm g, const Sched& S, const Epi& E) {
    int tid_ = threadIdx.x; asm volatile("" : "+v"(tid_));
    const int tid = tid_, wid = __builtin_amdgcn_readfirstlane(tid >> 6), lane = tid & 63, wr = wid >> 2, wc = wid & 3, fr = lane & 15, fq = lane >> 4;
    const int K = g.K, nt = K / BK;
    unsigned voffA[2], voffB[2];
#pragma unroll
    for (int i = 0; i < 2; ++i) { int R, C; stage_rc(tid * 16 + i * 8192, R, C); const int Rb = Epi::PERM ? ((R & ~31) + perm32(R & 31)) : R;
        voffA[i] = (unsigned)(R * K + C) * 2u; voffB[i] = (unsigned)(Rb * K + C) * 2u; }
    const size_t kstep = (size_t)(BK * 2);
    const size_t hstep = (size_t)HALF * K * 2;
    const size_t tstep = 2 * hstep;
    const unsigned ldsw = (unsigned)wid * 1024u;
    const int aoff = lds_byte(wr * 64 + fr, fq * 8), boff = lds_byte(wc * 32 + fr, fq * 8);
#define PG8_SA(b, h) (((b) * 2 + (h)) * HTB)
#define PG8_SB(b, h) ((4 + (b) * 2 + (h)) * HTB)
#define PG8_STAGE(bufoff, gbase, voff) do { _Pragma("unroll") for (int _i = 0; _i < 2; ++_i) \
        __builtin_amdgcn_global_load_lds((const unsigned*)((const char*)(gbase) + (voff)[_i]), (PG8_LAS unsigned*)(lds + (bufoff) + ldsw + _i * 8192), 16, 0, 0); } while (0)
#define PG8_LDA(dst, b, h) do { _Pragma("unroll") for (int m = 0; m < 4; ++m) _Pragma("unroll") for (int k = 0; k < 2; ++k) dst[m][k] = *(const PG8_LAS bf16x8*)(lds + PG8_SA(b, h) + aoff + m * 2048 + k * 1024); } while (0)
#define PG8_LDB(dst, b, h) do { _Pragma("unroll") for (int n = 0; n < 2; ++n) _Pragma("unroll") for (int k = 0; k < 2; ++k) dst[n][k] = *(const PG8_LAS bf16x8*)(lds + PG8_SB(b, h) + boff + n * 2048 + k * 1024); } while (0)
#define PG8_MMA(ai, bj, At, Bt) do { __builtin_amdgcn_s_setprio(1); _Pragma("unroll") for (int m = 0; m < 4; ++m) _Pragma("unroll") for (int n = 0; n < 2; ++n) _Pragma("unroll") for (int k = 0; k < 2; ++k) \
        acc[ai][bj][m][n] = __builtin_amdgcn_mfma_f32_16x16x32_bf16(Bt[n][k], At[m][k], acc[ai][bj][m][n], 0, 0, 0); __builtin_amdgcn_s_setprio(0); } while (0)
#define PG8_WAIT_V(n) asm volatile("s_waitcnt vmcnt(" #n ")" ::: "memory")
#define PG8_WAIT_L(n) asm volatile("s_waitcnt lgkmcnt(" #n ")" ::: "memory")
#define PG8_BAR __builtin_amdgcn_s_barrier()
#define PG8_SCHED __builtin_amdgcn_sched_barrier(0)
    Unit cur, nxt; int ui = 0;
    if (!S.next(0, cur)) return;
    f32x4 acc[2][2][4][2];
#pragma unroll
    for (int a = 0; a < 2; ++a)
#pragma unroll
        for (int b = 0; b < 2; ++b)
#pragma unroll
            for (int m = 0; m < 4; ++m)
#pragma unroll
                for (int n = 0; n < 2; ++n) acc[a][b][m][n] = (f32x4){0.f, 0.f, 0.f, 0.f};
    bf16x8 At[4][2], B0[2][2], B1[2][2];
    const char* cA = (const char*)g.A + (size_t)cur.pm * tstep; const char* cB = (const char*)g.Bt + (size_t)cur.pn * tstep;
    S.a_ready(cur);
    if constexpr (SP2) {
        PG8_STAGE(PG8_SB(0, 0), cB, voffB); PG8_STAGE(PG8_SB(0, 1), cB + hstep, voffB); PG8_STAGE(PG8_SA(0, 0), cA, voffA); PG8_STAGE(PG8_SA(0, 1), cA + hstep, voffA);
        if (wr == 1) PG8_BAR;
        PG8_WAIT_V(2); PG8_BAR;
        PG8_STAGE(PG8_SB(1, 0), cB + kstep, voffB); PG8_STAGE(PG8_SA(1, 0), cA + kstep, voffA); PG8_STAGE(PG8_SB(1, 1), cB + hstep + kstep, voffB);
        PG8_WAIT_V(6); PG8_BAR;
    } else {
        PG8_STAGE(PG8_SB(0, 0), cB, voffB); PG8_STAGE(PG8_SA(0, 0), cA, voffA); PG8_STAGE(PG8_SB(0, 1), cB + hstep, voffB); PG8_STAGE(PG8_SA(0, 1), cA + hstep, voffA);
        if (wr == 1) PG8_BAR;
        PG8_WAIT_V(4); PG8_BAR;
        PG8_STAGE(PG8_SB(1, 0), cB + kstep, voffB); PG8_STAGE(PG8_SA(1, 0), cA + kstep, voffA); PG8_STAGE(PG8_SB(1, 1), cB + hstep + kstep, voffB);
        PG8_WAIT_V(6); PG8_BAR;
    }
    for (;;) {
        const bool has_next = S.next(ui + 1, nxt);
        const char* nA = has_next ? (const char*)g.A + (size_t)nxt.pm * tstep : cA; const char* nB = has_next ? (const char*)g.Bt + (size_t)nxt.pn * tstep : cB;
        for (int t = 0; t < nt; t += 2) {
            const bool last = (t == nt - 2);
            const char* a1 = cA + (size_t)(t + 1) * kstep;
            const char* a2 = last ? nA : cA + (size_t)(t + 2) * kstep; const char* b2 = last ? nB : cB + (size_t)(t + 2) * kstep;
            const char* a3 = a2 + kstep; const char* b3 = b2 + kstep;
            if (last && has_next) S.a_ready(nxt);
            if constexpr (SP2) {
            PG8_LDB(B0, 0, 0); PG8_LDB(B1, 0, 1); PG8_SCHED; PG8_LDA(At, 0, 0); PG8_STAGE(PG8_SA(1, 1), a1 + hstep, voffA);
            PG8_WAIT_V(8); PG8_WAIT_L(0); PG8_BAR; PG8_MMA(0, 0, At, B0); PG8_MMA(0, 1, At, B1); PG8_BAR; PG8_SCHED;
            PG8_LDA(At, 0, 1); PG8_STAGE(PG8_SB(0, 0), b2, voffB); PG8_STAGE(PG8_SB(0, 1), b2 + hstep, voffB); PG8_STAGE(PG8_SA(0, 0), a2, voffA);
            PG8_WAIT_V(8); PG8_WAIT_L(0); PG8_BAR; PG8_MMA(1, 0, At, B0); PG8_MMA(1, 1, At, B1); PG8_BAR; PG8_SCHED;
            PG8_LDB(B0, 1, 0); PG8_LDB(B1, 1, 1); PG8_SCHED; PG8_LDA(At, 1, 0); PG8_STAGE(PG8_SA(0, 1), a2 + hstep, voffA);
            PG8_WAIT_V(8); PG8_WAIT_L(0); PG8_BAR; PG8_MMA(0, 0, At, B0); PG8_MMA(0, 1, At, B1); PG8_BAR; PG8_SCHED;
            PG8_LDA(At, 1, 1); PG8_STAGE(PG8_SB(1, 0), b3, voffB); PG8_STAGE(PG8_SB(1, 1), b3 + hstep, voffB); PG8_STAGE(PG8_SA(1, 0), a3, voffA);
            PG8_WAIT_V(8); PG8_WAIT_L(0); PG8_BAR; PG8_MMA(1, 0, At, B0); PG8_MMA(1, 1, At, B1); PG8_BAR; PG8_SCHED;
            } else {
            PG8_LDB(B0, 0, 0); PG8_SCHED; PG8_LDA(At, 0, 0); PG8_STAGE(PG8_SA(1, 1), a1 + hstep, voffA);
            PG8_WAIT_L(8); PG8_BAR; PG8_WAIT_L(0); PG8_MMA(0, 0, At, B0); PG8_BAR; PG8_SCHED;
            PG8_LDB(B1, 0, 1); PG8_STAGE(PG8_SB(0, 0), b2, voffB);
            PG8_BAR; PG8_WAIT_L(0); PG8_MMA(0, 1, At, B1); PG8_BAR;
            PG8_LDA(At, 0, 1); PG8_STAGE(PG8_SA(0, 0), a2, voffA);
            PG8_BAR; PG8_WAIT_L(0); PG8_MMA(1, 0, At, B0); PG8_BAR; PG8_SCHED;
            PG8_STAGE(PG8_SB(0, 1), b2 + hstep, voffB);
            PG8_WAIT_V(6); PG8_BAR; PG8_MMA(1, 1, At, B1); PG8_BAR;
            PG8_LDB(B0, 1, 0); PG8_SCHED; PG8_LDA(At, 1, 0); PG8_STAGE(PG8_SA(0, 1), a2 + hstep, voffA);
            PG8_WAIT_L(8); PG8_BAR; PG8_WAIT_L(0); PG8_MMA(0, 0, At, B0); PG8_BAR; PG8_SCHED;
            PG8_LDB(B1, 1, 1); PG8_STAGE(PG8_SB(1, 0), b3, voffB);
            PG8_BAR; PG8_WAIT_L(0); PG8_MMA(0, 1, At, B1); PG8_BAR;
            PG8_LDA(At, 1, 1); PG8_STAGE(PG8_SA(1, 0), a3, voffA);
            PG8_BAR; PG8_WAIT_L(0); PG8_MMA(1, 0, At, B0); PG8_BAR; PG8_SCHED;
            PG8_STAGE(PG8_SB(1, 1), b3 + hstep, voffB);
            PG8_WAIT_V(6); PG8_BAR; PG8_MMA(1, 1, At, B1); PG8_BAR;
            }
        }
        if constexpr (ALIGN_EPI) { if (wr == 0) PG8_BAR; }
        if constexpr (!Epi::AFTER_DRAIN) { E(acc, cur, wr, wc, fr, fq); S.done(cur); }
        if (!has_next) break;
#pragma unroll
        for (int a = 0; a < 2; ++a)
#pragma unroll
            for (int b = 0; b < 2; ++b)
#pragma unroll
                for (int m = 0; m < 4; ++m)
#pragma unroll
                    for (int n = 0; n < 2; ++n) acc[a][b][m][n] = (f32x4){0.f, 0.f, 0.f, 0.f};
        cur = nxt; cA = nA; cB = nB; ++ui;
        if constexpr (ALIGN_EPI) { if (wr == 1) PG8_BAR; }
    }
    PG8_WAIT_V(0);
    if constexpr (!ALIGN_EPI) { if (wr == 0) PG8_BAR; }
    PG8_BAR;
    if constexpr (Epi::AFTER_DRAIN) { E.fused(acc, cur, wr, wc, fr, fq, lds, wid, lane); S.done(cur); }
#undef PG8_SA
#undef PG8_SB
#undef PG8_STAGE
#undef PG8_LDA
#undef PG8_LDB
#undef PG8_MMA
#undef PG8_WAIT_V
#undef PG8_WAIT_L
#undef PG8_BAR
#undef PG8_SCHED
}
}
#define LAS __attribute__((address_space(3)))
using pg8::bf16_t; using pg8::bf16x8; using pg8::f32x4; using pg8::u32x4; using pg8::u32x2; using pg8::cvt_pk_bf16; using pg8::RMS_EPS;
constexpr int BATCH = 4, SEQ = 4096, D = 2048, M = BATCH * SEQ, NMEM = 256, MM = BATCH * NMEM, DFF = 5632, DPOOL = 1024, DSGU = 1024;
constexpr int NWAVES = 8, NTHR = NWAVES * 64;
constexpr int LDS_BYTES = 147456;
constexpr size_t MiB = 1u << 20;
constexpr size_t WS_SS1 = 0, WS_SS2 = 65536;
constexpr size_t WS_WIN = 1 * MiB, WS_WOUT = 13 * MiB, WS_WQ = 21 * MiB, WS_WK = 29 * MiB, WS_WV = 37 * MiB, WS_WO = 45 * MiB, WS_WGU = 53 * MiB, WS_WD = 97 * MiB;
constexpr size_t WS_PW = 119 * MiB, WS_WSP = 119 * MiB + 512 * 1024;
constexpr size_t WS_MN = 120 * MiB, WS_KB = 124 * MiB, WS_VTM = 128 * MiB;
constexpr size_t WS_XB = 132 * MiB;
constexpr size_t WS_HG = 196 * MiB;
constexpr size_t WS_PAU = 196 * MiB, WS_Q = 196 * MiB, WS_VT = 260 * MiB, WS_Y = 292 * MiB, WS_O = 292 * MiB;
constexpr size_t WS_END = 372 * MiB;

__device__ __forceinline__ float bf_lo(unsigned w) { return __uint_as_float(w << 16); }
__device__ __forceinline__ float bf_hi(unsigned w) { return __uint_as_float(w & 0xffff0000u); }
__device__ __forceinline__ float wave_sum(float v) {
#pragma unroll
    for (int o = 1; o < 64; o <<= 1) v += __shfl_xor(v, o);
    return v;
}
#define LDS_WAIT() asm volatile("s_waitcnt lgkmcnt(0)" ::: "memory")
#define MFMA16(a, b, c) __builtin_amdgcn_mfma_f32_16x16x32_bf16((a), (b), (c), 0, 0, 0)

__device__ __forceinline__ void tr_item(const float* W, int ldw, int k0, int n0, bf16_t* WT, int ldt, int orow0, const float* kgain, const float* nscale, LAS float* scr, int lane) {
#pragma unroll 4
    for (int i = 0; i < 16; ++i) { const int kk = 4 * i + (lane >> 4), nn = (lane & 15) * 4;
        f32x4 v = *(const f32x4*)(W + (size_t)(k0 + kk) * ldw + n0 + nn);
        if (kgain) v = v * kgain[k0 + kk];
        LAS float* s = scr + kk * 65 + nn; s[0] = v[0]; s[1] = v[1]; s[2] = v[2]; s[3] = v[3]; }
    LDS_WAIT();
    const int c = lane & 7;
#pragma unroll
    for (int j = 0; j < 8; ++j) { const int n = (lane >> 3) + 8 * j; const LAS float* s = scr + (8 * c) * 65 + n;
        const float sc = nscale ? nscale[n] : 1.0f;
        u32x4 o; o.x = cvt_pk_bf16(s[0 * 65] * sc, s[1 * 65] * sc); o.y = cvt_pk_bf16(s[2 * 65] * sc, s[3 * 65] * sc); o.z = cvt_pk_bf16(s[4 * 65] * sc, s[5 * 65] * sc); o.w = cvt_pk_bf16(s[6 * 65] * sc, s[7 * 65] * sc);
        *(u32x4*)(WT + (size_t)(orow0 + n) * ldt + k0 + 8 * c) = o; }
    LDS_WAIT();
}
__device__ __forceinline__ void norm_row_bf16(const float* xrow, const float* g, bf16_t* orow, int lane) {
    const f32x4* xr = (const f32x4*)xrow + lane; f32x4 v[8]; float s = 0.f;
#pragma unroll
    for (int j = 0; j < 8; ++j) { v[j] = xr[64 * j]; s += (v[j][0] * v[j][0] + v[j][1] * v[j][1]) + (v[j][2] * v[j][2] + v[j][3] * v[j][3]); }
    const float rstd = 1.0f / sqrtf(wave_sum(s) * (1.0f / D) + RMS_EPS);
    const f32x4* gr = (const f32x4*)g + lane; u32x2* o = (u32x2*)orow + lane;
#pragma unroll
    for (int j = 0; j < 8; ++j) { const f32x4 gg = gr[64 * j]; const f32x4 y = v[j] * rstd * gg; u32x2 w; w.x = cvt_pk_bf16(y[0], y[1]); w.y = cvt_pk_bf16(y[2], y[3]); o[64 * j] = w; }
}
__device__ __forceinline__ void norm_row_f32(float* xrow, const float* g, int lane) {
    f32x4* xr = (f32x4*)xrow + lane; f32x4 v[8]; float s = 0.f;
#pragma unroll
    for (int j = 0; j < 8; ++j) { v[j] = xr[64 * j]; s += (v[j][0] * v[j][0] + v[j][1] * v[j][1]) + (v[j][2] * v[j][2] + v[j][3] * v[j][3]); }
    const float rstd = 1.0f / sqrtf(wave_sum(s) * (1.0f / D) + RMS_EPS);
    const f32x4* gr = (const f32x4*)g + lane;
#pragma unroll
    for (int j = 0; j < 8; ++j) { const f32x4 gg = gr[64 * j]; xr[64 * j] = v[j] * rstd * gg; }
}

__device__ __forceinline__ void sgu_unit(LAS unsigned char* lds, int nb, const bf16_t* VT, const bf16_t* PAU, bf16_t* Y, const bf16_t* WSb, const float* sg, const float* bsp, int tid) {
    asm volatile("" : "+v"(tid));
    const int lane = tid & 63, wave = tid >> 6, fr = lane & 15, fq = lane >> 4;
    const int T0 = nb * 128;
    LAS float* red = (LAS float*)lds;
    LAS float* rstd = (LAS float*)(lds + 4096);
    LAS unsigned char* Bb = lds + 8192;
    {
        const int tg = tid & 15, rl = tid >> 4;
        float s[8];
#pragma unroll
        for (int e = 0; e < 8; ++e) s[e] = 0.f;
#pragma unroll 4
        for (int i = 0; i < 32; ++i) { const int c = rl + 32 * i; const u32x4 w = *(const u32x4*)(VT + (size_t)c * M + T0 + tg * 8);
#pragma unroll
            for (int e = 0; e < 4; ++e) { const float lo = bf_lo(w[e]), hi = bf_hi(w[e]); s[2 * e] += lo * lo; s[2 * e + 1] += hi * hi; } }
#pragma unroll
        for (int e = 0; e < 8; ++e) { s[e] += __shfl_xor(s[e], 16); s[e] += __shfl_xor(s[e], 32); }
        if (fq == 0) {
#pragma unroll
            for (int e = 0; e < 8; ++e) red[wave * 128 + tg * 8 + e] = s[e]; }
    }
    __syncthreads();
    if (tid < 128) { float t = 0.f;
#pragma unroll
        for (int w = 0; w < 8; ++w) t += red[w * 128 + tid];
        rstd[tid] = 1.0f / sqrtf(t * (1.0f / DSGU) + RMS_EPS); }
    __syncthreads();
    const int wr = wave >> 1, wc = wave & 1;
    for (int h = 0; h < 8; ++h) {
        LAS unsigned char* B = Bb + (h & 1) * 34816;
#pragma unroll
        for (int i = 0; i < 4; ++i) { const int p = tid + 512 * i, c = p >> 4, sgp = p & 15;
            const u32x4 w = *(const u32x4*)(VT + (size_t)(h * 128 + c) * M + T0 + sgp * 8);
            const float g = sg[h * 128 + c];
            const f32x4 r0 = *(const LAS f32x4*)(rstd + sgp * 8) * g, r1 = *(const LAS f32x4*)(rstd + sgp * 8 + 4) * g;
            u32x4 o; o.x = cvt_pk_bf16(bf_lo(w.x) * r0[0], bf_hi(w.x) * r0[1]); o.y = cvt_pk_bf16(bf_lo(w.y) * r0[2], bf_hi(w.y) * r0[3]);
            o.z = cvt_pk_bf16(bf_lo(w.z) * r1[0], bf_hi(w.z) * r1[1]); o.w = cvt_pk_bf16(bf_lo(w.w) * r1[2], bf_hi(w.w) * r1[3]);
            *(LAS u32x4*)(B + c * 272 + sgp * 16) = o; }
        __syncthreads();
        f32x4 acc[2][4];
#pragma unroll
        for (int m = 0; m < 2; ++m)
#pragma unroll
            for (int n = 0; n < 4; ++n) acc[m][n] = (f32x4){0.f, 0.f, 0.f, 0.f};
#pragma unroll
        for (int ks = 0; ks < 4; ++ks) { bf16x8 a[2], b[4];
#pragma unroll
            for (int m = 0; m < 2; ++m) a[m] = *(const bf16x8*)(WSb + (size_t)((h * 128 + wr * 32 + m * 16 + fr) * 128 + ks * 32 + fq * 8));
#pragma unroll
            for (int n = 0; n < 4; ++n) b[n] = *(const LAS bf16x8*)(B + (wc * 64 + n * 16 + fr) * 272 + (ks * 32 + fq * 8) * 2);
#pragma unroll
            for (int m = 0; m < 2; ++m)
#pragma unroll
                for (int n = 0; n < 4; ++n) acc[m][n] = MFMA16(b[n], a[m], acc[m][n]); }
#pragma unroll
        for (int m = 0; m < 2; ++m) { const int t = wr * 32 + m * 16 + fr; const float bias = bsp[h * 128 + t];
#pragma unroll
            for (int n = 0; n < 4; ++n) { const size_t off = (size_t)(T0 + t) * D + DPOOL + h * 128 + wc * 64 + n * 16 + fq * 4;
                const u32x2 uu = *(const u32x2*)(PAU + off); const f32x4 mx = acc[m][n] + bias;
                u32x2 o; o.x = cvt_pk_bf16(bf_lo(uu.x) * mx[0], bf_hi(uu.x) * mx[1]); o.y = cvt_pk_bf16(bf_lo(uu.y) * mx[2], bf_hi(uu.y) * mx[3]);
                *(u32x2*)(Y + off) = o; } }
    }
    __syncthreads();
}
__device__ __forceinline__ void pool_unit(LAS unsigned char* lds, int nb, const bf16_t* PAU, bf16_t* Y, const bf16_t* PWt, int tid) {
    asm volatile("" : "+v"(tid));
    const int lane = tid & 63, wave = tid >> 6, fr = lane & 15, fq = lane >> 4;
    const int T0 = nb * 128, tp0 = T0 & (SEQ - 1);
    LAS unsigned char* A = lds;
    for (int g = 0; g < 4; ++g) {
        const int w = 2 << g;
        {   const int cgp = tid & 31, ts = (tid >> 5) * 8; const bf16_t* base = PAU + g * 256 + cgp * 8;
            float S[8];
#pragma unroll
            for (int e = 0; e < 8; ++e) S[e] = 0.f;
            for (int j = 1; j < w; ++j) { if (tp0 + ts - j >= 0) { const u32x4 q = *(const u32x4*)(base + (size_t)(T0 + ts - j) * D);
#pragma unroll
                for (int e = 0; e < 4; ++e) { S[2 * e] += bf_lo(q[e]); S[2 * e + 1] += bf_hi(q[e]); } } }
#pragma unroll
            for (int i = 0; i < 8; ++i) { const int t = ts + i, tp = tp0 + t; const u32x4 q = *(const u32x4*)(base + (size_t)(T0 + t) * D);
                float cur[8], p[8];
#pragma unroll
                for (int e = 0; e < 4; ++e) { cur[2 * e] = bf_lo(q[e]); cur[2 * e + 1] = bf_hi(q[e]); }
                const float inv = 1.0f / (float)(tp + 1 < w ? tp + 1 : w);
#pragma unroll
                for (int e = 0; e < 8; ++e) { S[e] += cur[e]; p[e] = S[e] * inv - cur[e]; }
                u32x4 o; o.x = cvt_pk_bf16(p[0], p[1]); o.y = cvt_pk_bf16(p[2], p[3]); o.z = cvt_pk_bf16(p[4], p[5]); o.w = cvt_pk_bf16(p[6], p[7]);
                *(LAS u32x4*)(A + t * 528 + cgp * 16) = o;
                if (tp - w + 1 >= 0) { const u32x4 r = *(const u32x4*)(base + (size_t)(T0 + t - w + 1) * D);
#pragma unroll
                    for (int e = 0; e < 4; ++e) { S[2 * e] -= bf_lo(r[e]); S[2 * e + 1] -= bf_hi(r[e]); } } }
        }
        __syncthreads();
        f32x4 acc[8][2];
#pragma unroll
        for (int m = 0; m < 8; ++m)
#pragma unroll
            for (int n = 0; n < 2; ++n) acc[m][n] = (f32x4){0.f, 0.f, 0.f, 0.f};
#pragma unroll 2
        for (int ks = 0; ks < 8; ++ks) { bf16x8 b[2];
#pragma unroll
            for (int n = 0; n < 2; ++n) b[n] = *(const bf16x8*)(PWt + (size_t)((g * 256 + wave * 32 + n * 16 + fr) * 256 + ks * 32 + fq * 8));
#pragma unroll
            for (int m = 0; m < 8; ++m) { const bf16x8 a = *(const LAS bf16x8*)(A + (m * 16 + fr) * 528 + (ks * 32 + fq * 8) * 2);
#pragma unroll
                for (int n = 0; n < 2; ++n) acc[m][n] = MFMA16(b[n], a, acc[m][n]); } }
#pragma unroll
        for (int m = 0; m < 8; ++m)
#pragma unroll
            for (int n = 0; n < 2; ++n) { const size_t off = (size_t)(T0 + m * 16 + fr) * D + g * 256 + wave * 32 + n * 16 + fq * 4; const f32x4 v = acc[m][n];
                u32x2 o; o.x = cvt_pk_bf16(v[0], v[1]); o.y = cvt_pk_bf16(v[2], v[3]); *(u32x2*)(Y + off) = o; }
        __syncthreads();
    }
}
__device__ __forceinline__ void attn_unit(LAS unsigned char* lds, int unit, const bf16_t* Q, const bf16_t* KB, const bf16_t* VTM, bf16_t* O, int tid) {
    asm volatile("" : "+v"(tid));
    const int lane = tid & 63, wave = tid >> 6, fr = lane & 15, fq = lane >> 4, wr = wave >> 1, wc = wave & 1;
    const int qt = unit & 31, h = (unit >> 5) & 3, b = unit >> 7;
    const int R0 = b * SEQ + qt * 128;
    LAS unsigned char* P = lds;
    LAS float* xm = (LAS float*)(lds + 67584);
    LAS float* xs = xm + 256;
    f32x4 acc[2][8];
#pragma unroll
    for (int m = 0; m < 2; ++m)
#pragma unroll
        for (int n = 0; n < 8; ++n) acc[m][n] = (f32x4){0.f, 0.f, 0.f, 0.f};
    const bf16_t* qp = Q + (size_t)(R0 + wr * 32 + fr) * D + h * 512 + fq * 8;
    const bf16_t* kp = KB + (size_t)(b * NMEM + wc * 128 + fr) * D + h * 512 + fq * 8;
#pragma unroll 2
    for (int ks = 0; ks < 16; ++ks) { bf16x8 a[2], bb[8];
#pragma unroll
        for (int m = 0; m < 2; ++m) a[m] = *(const bf16x8*)(qp + (size_t)m * 16 * D + ks * 32);
#pragma unroll
        for (int n = 0; n < 8; ++n) bb[n] = *(const bf16x8*)(kp + (size_t)n * 16 * D + ks * 32);
#pragma unroll
        for (int m = 0; m < 2; ++m)
#pragma unroll
            for (int n = 0; n < 8; ++n) acc[m][n] = MFMA16(bb[n], a[m], acc[m][n]); }
    const float sc = 0.044194173824159216f;
#pragma unroll
    for (int m = 0; m < 2; ++m) { float v = -3.0e38f;
#pragma unroll
        for (int n = 0; n < 8; ++n) { acc[m][n] = acc[m][n] * sc; v = fmaxf(v, fmaxf(fmaxf(acc[m][n][0], acc[m][n][1]), fmaxf(acc[m][n][2], acc[m][n][3]))); }
        v = fmaxf(v, __shfl_xor(v, 16)); v = fmaxf(v, __shfl_xor(v, 32));
        if (fq == 0) xm[wc * 128 + wr * 32 + m * 16 + fr] = v; }
    __syncthreads();
#pragma unroll
    for (int m = 0; m < 2; ++m) { const int row = wr * 32 + m * 16 + fr; const float mx = fmaxf(xm[row], xm[128 + row]); float s = 0.f;
#pragma unroll
        for (int n = 0; n < 8; ++n) { const float p0 = __expf(acc[m][n][0] - mx), p1 = __expf(acc[m][n][1] - mx), p2 = __expf(acc[m][n][2] - mx), p3 = __expf(acc[m][n][3] - mx);
            s += (p0 + p1) + (p2 + p3);
            u32x2 o; o.x = cvt_pk_bf16(p0, p1); o.y = cvt_pk_bf16(p2, p3);
            *(LAS u32x2*)(P + row * 528 + (wc * 128 + n * 16 + fq * 4) * 2) = o; }
        s += __shfl_xor(s, 16); s += __shfl_xor(s, 32);
        if (fq == 0) xs[wc * 128 + row] = s; }
    __syncthreads();
    float inv[2];
#pragma unroll
    for (int m = 0; m < 2; ++m) { const int row = wr * 32 + m * 16 + fr; inv[m] = 1.0f / (xs[row] + xs[128 + row]); }
    f32x4 o[2][16];
#pragma unroll
    for (int m = 0; m < 2; ++m)
#pragma unroll
        for (int n = 0; n < 16; ++n) o[m][n] = (f32x4){0.f, 0.f, 0.f, 0.f};
    const bf16_t* vp = VTM + (size_t)(h * 512 + wc * 256 + fr) * MM + b * NMEM + fq * 8;
    for (int ks = 0; ks < 8; ++ks) { bf16x8 a[2];
#pragma unroll
        for (int m = 0; m < 2; ++m) a[m] = *(const LAS bf16x8*)(P + (wr * 32 + m * 16 + fr) * 528 + (ks * 32 + fq * 8) * 2);
#pragma unroll
        for (int n = 0; n < 16; ++n) { const bf16x8 bv = *(const bf16x8*)(vp + (size_t)n * 16 * MM + ks * 32);
#pragma unroll
            for (int m = 0; m < 2; ++m) o[m][n] = MFMA16(bv, a[m], o[m][n]); } }
#pragma unroll
    for (int m = 0; m < 2; ++m) { const size_t rowoff = (size_t)(R0 + wr * 32 + m * 16 + fr) * D + h * 512 + wc * 256 + fq * 4;
#pragma unroll
        for (int n = 0; n < 16; ++n) { const f32x4 v = o[m][n] * inv[m]; u32x2 w; w.x = cvt_pk_bf16(v[0], v[1]); w.y = cvt_pk_bf16(v[2], v[3]); *(u32x2*)(O + rowoff + n * 16) = w; } }
    __syncthreads();
}

struct Args { const float* in[21]; float* out; unsigned char* ws; };
#define GEMM_PHASE(EPI, g, S, E) pg8::gemm_phase<EPI, pg8::StaticOrder, true, true>(lds, g, S, E)
__global__ void __launch_bounds__(NTHR, 2) mk_fwd(Args a) {
    extern __shared__ __attribute__((aligned(16))) unsigned char lds_raw[];
    LAS unsigned char* lds = (LAS unsigned char*)lds_raw;
    cg::grid_group grid = cg::this_grid();
    const int G = gridDim.x, bx = blockIdx.x;
#define TID_FRESH() ({ int t_ = threadIdx.x; asm volatile("" : "+v"(t_)); t_; })
    const float *x = a.in[0], *mem = a.in[1], *norm_mix_g = a.in[2], *w_in = a.in[3], *pool_w = a.in[4], *pool_scale = a.in[5], *sgu_norm_g = a.in[6], *w_spatial = a.in[7], *b_spatial = a.in[8],
                *w_out = a.in[9], *norm_xattn_g = a.in[10], *norm_mem_g = a.in[11], *w_q = a.in[12], *w_k = a.in[13], *w_v = a.in[14], *w_o = a.in[15], *norm_ffn_g = a.in[16],
                *w_gate = a.in[17], *w_up = a.in[18], *w_down = a.in[19], *final_norm_g = a.in[20];
    float* out = a.out; unsigned char* ws = a.ws;
    float *SS1 = (float*)(ws + WS_SS1), *SS2 = (float*)(ws + WS_SS2);
    bf16_t *Win_t = (bf16_t*)(ws + WS_WIN), *Wout_t = (bf16_t*)(ws + WS_WOUT), *Wq_t = (bf16_t*)(ws + WS_WQ), *Wk_t = (bf16_t*)(ws + WS_WK), *Wv_t = (bf16_t*)(ws + WS_WV), *Wo_t = (bf16_t*)(ws + WS_WO),
           *Wgu_t = (bf16_t*)(ws + WS_WGU), *Wd_t = (bf16_t*)(ws + WS_WD), *PWt = (bf16_t*)(ws + WS_PW), *WSb = (bf16_t*)(ws + WS_WSP), *MN = (bf16_t*)(ws + WS_MN), *KB = (bf16_t*)(ws + WS_KB),
           *VTM = (bf16_t*)(ws + WS_VTM), *XB = (bf16_t*)(ws + WS_XB), *HG = (bf16_t*)(ws + WS_HG), *PAU = (bf16_t*)(ws + WS_PAU), *Qb = (bf16_t*)(ws + WS_Q), *VT = (bf16_t*)(ws + WS_VT),
           *Yb = (bf16_t*)(ws + WS_Y), *Ob = (bf16_t*)(ws + WS_O);

    {
        const int tid = TID_FRESH(), lane = tid & 63, wave = __builtin_amdgcn_readfirstlane(tid >> 6);
        LAS float* scr = (LAS float*)(lds + wave * 16640);
        const int gw = bx * NWAVES + wave, NGW = G * NWAVES;
        constexpr int I_IN = 32 * 48, I_SQ = 32 * 32, I_GU = 32 * 88, I_DN = 88 * 32, I_PW = 4 * 16;
        constexpr int NITEMS = I_IN + 5 * I_SQ + 2 * I_GU + I_DN + I_PW;
        for (int it = gw; it < NITEMS; it += NGW) {
            int r = it;
            if (r < I_IN) { tr_item(w_in, 3072, (r / 48) * 64, (r % 48) * 64, Win_t, D, (r % 48) * 64, nullptr, nullptr, scr, lane); continue; } r -= I_IN;
            if (r < I_SQ) { tr_item(w_out, D, (r / 32) * 64, (r % 32) * 64, Wout_t, D, (r % 32) * 64, nullptr, nullptr, scr, lane); continue; } r -= I_SQ;
            if (r < I_SQ) { tr_item(w_q, D, (r / 32) * 64, (r % 32) * 64, Wq_t, D, (r % 32) * 64, norm_xattn_g, nullptr, scr, lane); continue; } r -= I_SQ;
            if (r < I_SQ) { tr_item(w_k, D, (r / 32) * 64, (r % 32) * 64, Wk_t, D, (r % 32) * 64, nullptr, nullptr, scr, lane); continue; } r -= I_SQ;
            if (r < I_SQ) { tr_item(w_v, D, (r / 32) * 64, (r % 32) * 64, Wv_t, D, (r % 32) * 64, nullptr, nullptr, scr, lane); continue; } r -= I_SQ;
            if (r < I_SQ) { tr_item(w_o, D, (r / 32) * 64, (r % 32) * 64, Wo_t, D, (r % 32) * 64, nullptr, nullptr, scr, lane); continue; } r -= I_SQ;
            if (r < 2 * I_GU) { const int up = r >= I_GU; if (up) r -= I_GU; const int n0 = (r % 88) * 64;
                tr_item(up ? w_up : w_gate, DFF, (r / 88) * 64, n0, Wgu_t, D, (n0 >> 7) * 256 + (n0 & 127) + up * 128, norm_ffn_g, nullptr, scr, lane); continue; } r -= 2 * I_GU;
            if (r < I_DN) { tr_item(w_down, D, (r / 32) * 64, (r % 32) * 64, Wd_t, DFF, (r % 32) * 64, nullptr, nullptr, scr, lane); continue; } r -= I_DN;
            { const int g = r >> 4, q = r & 15; tr_item(pool_w + (size_t)g * 65536, 256, (q >> 2) * 64, (q & 3) * 64, PWt + (size_t)g * 65536, 256, (q & 3) * 64, nullptr, pool_scale + g * 256 + (q & 3) * 64, scr, lane); }
        }
        for (int i = bx * NTHR + tid; i < 8 * 128 * 128 / 4; i += G * NTHR) { const f32x4 v = *((const f32x4*)w_spatial + i); const int s = (i * 4) & 127, t = ((i * 4) >> 7) & 127;
            const bool keep = (s >> 6) <= (t >> 6); u32x2 o; o.x = keep ? cvt_pk_bf16(v[0], v[1]) : 0u; o.y = keep ? cvt_pk_bf16(v[2], v[3]) : 0u; *((u32x2*)WSb + i) = o; }
        for (int i = bx * NTHR + tid; i < M; i += G * NTHR) { SS1[i] = 0.f; SS2[i] = 0.f; }
        for (int m = gw; m < M; m += NGW) norm_row_bf16(x + (size_t)m * D, norm_mix_g, XB + (size_t)m * D, lane);
        for (int m = gw; m < MM; m += NGW) norm_row_bf16(mem + (size_t)m * D, norm_mem_g, MN + (size_t)m * D, lane);
    }
    grid.sync();
    {
        { pg8::Gemm g{XB, Win_t, M, 2048, D}; pg8::StaticOrder S; S.init(M, 2048, G, bx); pg8::EpiPlain E{PAU, D}; GEMM_PHASE(pg8::EpiPlain, g, S, E); }
        { pg8::Gemm g{Win_t + (size_t)2048 * D, XB, 1024, M, D}; pg8::StaticOrder S; S.init(1024, M, G, bx); pg8::EpiPlain E{VT, M}; GEMM_PHASE(pg8::EpiPlain, g, S, E); }
        { pg8::Gemm g{MN, Wk_t, MM, D, D}; pg8::StaticOrder S; S.init(MM, D, G, bx); pg8::EpiPlain E{KB, D}; GEMM_PHASE(pg8::EpiPlain, g, S, E); }
        { pg8::Gemm g{Wv_t, MN, D, MM, D}; pg8::StaticOrder S; S.init(D, MM, G, (bx + G - 32) % G); pg8::EpiPlain E{VTM, MM}; GEMM_PHASE(pg8::EpiPlain, g, S, E); }
    }
    grid.sync();
    for (int u = bx; u < 256; u += G) { if (u & 1) pool_unit(lds, u >> 1, PAU, Yb, PWt, (int)threadIdx.x); else sgu_unit(lds, u >> 1, VT, PAU, Yb, WSb, sgu_norm_g, b_spatial, (int)threadIdx.x); }
    grid.sync();
    { pg8::Gemm g{Yb, Wout_t, M, D, D}; pg8::StaticOrder S; S.init(M, D, G, bx); pg8::EpiResid E{x, out, XB, SS1, D}; GEMM_PHASE(pg8::EpiResid, g, S, E); }
    grid.sync();
    { pg8::Gemm g{XB, Wq_t, M, D, D}; pg8::StaticOrder S; S.init(M, D, G, bx); pg8::EpiRowScale E{Qb, D, SS1, 1.0f / D}; GEMM_PHASE(pg8::EpiRowScale, g, S, E); }
    grid.sync();
    for (int u = bx; u < 512; u += G) attn_unit(lds, u, Qb, KB, VTM, Ob, (int)threadIdx.x);
    grid.sync();
    { pg8::Gemm g{Ob, Wo_t, M, D, D}; pg8::StaticOrder S; S.init(M, D, G, bx); pg8::EpiResid E{out, out, XB, SS2, D}; GEMM_PHASE(pg8::EpiResid, g, S, E); }
    grid.sync();
    { pg8::Gemm g{XB, Wgu_t, M, 2 * DFF, D}; pg8::StaticOrder S; S.init(M, 2 * DFF, G, bx); pg8::EpiSwiglu E{HG, DFF, SS2, 1.0f / D}; GEMM_PHASE(pg8::EpiSwiglu, g, S, E); }
    grid.sync();
    { pg8::Gemm g{HG, Wd_t, M, D, DFF}; pg8::StaticOrder S; S.init(M, D, G, bx); pg8::EpiResid E{out, out, nullptr, nullptr, D}; GEMM_PHASE(pg8::EpiResid, g, S, E); }
    grid.sync();
    { const int tid = TID_FRESH(), lane = tid & 63, wave = __builtin_amdgcn_readfirstlane(tid >> 6); const int gw = bx * NWAVES + wave, NGW = G * NWAVES; for (int m = gw; m < M; m += NGW) norm_row_f32(out + (size_t)m * D, final_norm_g, lane); }
}

extern "C" void kernel_launch(void* const* d_in, const int* in_sizes, int n_in, void* d_out, int out_size, void* d_ws, size_t ws_size, hipStream_t stream) {
    static int grid = 0;
    if (grid == 0) {
        if (n_in != 21 || in_sizes[0] != M * D || out_size != M * D || ws_size < WS_END) { fprintf(stderr, "kernel_launch: unexpected shapes (n_in %d, in0 %d, out %d, ws %zu); nothing launched\n", n_in, n_in > 0 ? in_sizes[0] : -1, out_size, ws_size); grid = -1; return; }
        int dev = 0, cus = 0, per_cu = 0;
        if (hipGetDevice(&dev) != hipSuccess || hipDeviceGetAttribute(&cus, hipDeviceAttributeMultiprocessorCount, dev) != hipSuccess) { grid = -1; return; }
        if (hipFuncSetAttribute((const void*)mk_fwd, hipFuncAttributeMaxDynamicSharedMemorySize, LDS_BYTES) != hipSuccess) { fprintf(stderr, "kernel_launch: hipFuncSetAttribute failed\n"); grid = -1; return; }
        if (hipOccupancyMaxActiveBlocksPerMultiprocessor(&per_cu, (const void*)mk_fwd, NTHR, LDS_BYTES) != hipSuccess || per_cu < 1) { fprintf(stderr, "kernel_launch: occupancy query says %d blocks per CU\n", per_cu); (void)hipGetLastError(); grid = -1; return; }
        grid = cus * per_cu;
    }
    if (grid < 0) return;
    Args a{};
    for (int i = 0; i < 21; ++i) a.in[i] = (const float*)d_in[i];
    a.out = (float*)d_out; a.ws = (unsigned char*)d_ws;
    void* args[] = {&a};
    const hipError_t e = hipLaunchCooperativeKernel((const void*)mk_fwd, dim3(grid), dim3(NTHR), args, LDS_BYTES, stream);
    if (e != hipSuccess) fprintf(stderr, "kernel_launch: cooperative launch failed: %s (grid %d)\n", hipGetErrorString(e), grid);
}
```

```cpp
#include <hip/hip_runtime.h>
#include <hip/hip_cooperative_groups.h>
#include <cstdio>
#include <cstdint>
namespace cg = cooperative_groups;
namespace pg8 {
#define PG8_LAS __attribute__((address_space(3)))
typedef unsigned short bf16_t;
typedef short bf16x8 __attribute__((ext_vector_type(8)));
typedef float f32x4 __attribute__((ext_vector_type(4)));
typedef unsigned u32x4 __attribute__((ext_vector_type(4)));
constexpr int BM = 256, BK = 64, HALF = 128, HTB = HALF * BK * 2  , STAGE_BYTES = 8 * HTB, NXCD = 8, WGM = 8;

__host__ __device__ __forceinline__ int lds_byte(int r, int c) { const int st = (r >> 4) * 2 + (c >> 5), rr = r & 15, cc = c & 31, ob = rr * 64 + cc * 2; return st * 1024 + (ob ^ (((ob >> 9) & 1) << 5)); }
__host__ __device__ __forceinline__ void stage_rc(int b, int& R, int& C) { const int st = b / 1024, sb = b % 1024, swz = sb ^ (((sb >> 9) & 1) << 5); R = (st >> 1) * 16 + swz / 64; C = (st & 1) * 32 + (swz % 64) / 2; }
__host__ __device__ __forceinline__ int perm32(int rho) { const int n = rho >> 4, i = rho & 15; return 8 * (i >> 2) + 4 * n + (i & 3); }

struct Unit { int pm, pn; };
struct Gemm { const bf16_t* A; const bf16_t* Bt; int M, N, K; };

struct StaticOrder {
    int nM, nN, nwg, G, c;
    __host__ __device__ void init(int M, int N, int G_, int c_) { nM = M / BM; nN = N / BM; nwg = nM * nN; G = G_; c = c_; }
    __host__ __device__ bool next(int i, Unit& u) const {
        const long L = (long)i * G + c; if (L >= nwg) return false;
        int wgid = (int)L; { const int q = nwg / NXCD, r = nwg % NXCD, xcd = wgid % NXCD, off = wgid / NXCD; wgid = (xcd < r ? xcd * (q + 1) : r * (q + 1) + (xcd - r) * q) + off; }
        const int nig = WGM * nN, gid = wgid / nig, fm = gid * WGM, gsz = (nM - fm) < WGM ? (nM - fm) : WGM;
        u.pm = fm + ((wgid % nig) % gsz); u.pn = (wgid % nig) / gsz; return true;
    }
    __device__ __forceinline__ void a_ready(const Unit&) const {}
    __device__ __forceinline__ void done(const Unit&) const {}
};

__device__ __forceinline__ unsigned cvt_pk_bf16(float lo, float hi) { unsigned r; asm volatile("v_cvt_pk_bf16_f32 %0, %1, %2" : "=v"(r) : "v"(lo), "v"(hi)); return r; }
typedef unsigned u32x2 __attribute__((ext_vector_type(2)));
constexpr float RMS_EPS = 1e-6f;

struct EpiPlain {
    static constexpr bool PERM = true, AFTER_DRAIN = false;
    bf16_t* O; int ldc;
    __device__ __forceinline__ void operator()(const f32x4 (&acc)[2][2][4][2], const Unit& u, int wr, int wc, int fr, int fq) const {
        const int row0 = u.pm * BM + wr * 64 + fr, col0 = u.pn * BM + wc * 32 + 8 * fq;
#pragma unroll
        for (int ai = 0; ai < 2; ++ai)
#pragma unroll
            for (int m = 0; m < 4; ++m) { bf16_t* rowp = O + (size_t)(row0 + ai * HALF + m * 16) * ldc + col0;
#pragma unroll
                for (int bj = 0; bj < 2; ++bj) { const f32x4 v0 = acc[ai][bj][m][0], v1 = acc[ai][bj][m][1];
                    u32x4 w; w.x = cvt_pk_bf16(v0[0], v0[1]); w.y = cvt_pk_bf16(v0[2], v0[3]); w.z = cvt_pk_bf16(v1[0], v1[1]); w.w = cvt_pk_bf16(v1[2], v1[3]);
                    *(u32x4*)(rowp + bj * HALF) = w; } }
    }
};
struct EpiRowScale {
    static constexpr bool PERM = true, AFTER_DRAIN = false;
    bf16_t* O; int ldc; const float* SS; float inv_n;
    __device__ __forceinline__ void operator()(const f32x4 (&acc)[2][2][4][2], const Unit& u, int wr, int wc, int fr, int fq) const {
        const int row0 = u.pm * BM + wr * 64 + fr, col0 = u.pn * BM + wc * 32 + 8 * fq;
#pragma unroll
        for (int ai = 0; ai < 2; ++ai)
#pragma unroll
            for (int m = 0; m < 4; ++m) { const int row = row0 + ai * HALF + m * 16; bf16_t* rowp = O + (size_t)row * ldc + col0;
                const float rs = 1.0f / sqrtf(SS[row] * inv_n + RMS_EPS);
#pragma unroll
                for (int bj = 0; bj < 2; ++bj) { const f32x4 v0 = acc[ai][bj][m][0] * rs, v1 = acc[ai][bj][m][1] * rs;
                    u32x4 w; w.x = cvt_pk_bf16(v0[0], v0[1]); w.y = cvt_pk_bf16(v0[2], v0[3]); w.z = cvt_pk_bf16(v1[0], v1[1]); w.w = cvt_pk_bf16(v1[2], v1[3]);
                    *(u32x4*)(rowp + bj * HALF) = w; } }
    }
};
__device__ __forceinline__ float silu_mul(float g, float u) { return g * u * __builtin_amdgcn_rcpf(1.0f + __expf(-g)); }
struct EpiSwiglu {
    static constexpr bool PERM = true, AFTER_DRAIN = false;
    bf16_t* O; int ldc; const float* SS; float inv_n;
    __device__ __forceinline__ void operator()(const f32x4 (&acc)[2][2][4][2], const Unit& u, int wr, int wc, int fr, int fq) const {
        const int row0 = u.pm * BM + wr * 64 + fr, col0 = u.pn * HALF + wc * 32 + 8 * fq;
#pragma unroll
        for (int ai = 0; ai < 2; ++ai)
#pragma unroll
            for (int m = 0; m < 4; ++m) { const int row = row0 + ai * HALF + m * 16;
                const float rs = 1.0f / sqrtf(SS[row] * inv_n + RMS_EPS);
                const f32x4 g0 = acc[ai][0][m][0] * rs, g1 = acc[ai][0][m][1] * rs, u0 = acc[ai][1][m][0] * rs, u1 = acc[ai][1][m][1] * rs;
                u32x4 w;
                w.x = cvt_pk_bf16(silu_mul(g0[0], u0[0]), silu_mul(g0[1], u0[1])); w.y = cvt_pk_bf16(silu_mul(g0[2], u0[2]), silu_mul(g0[3], u0[3]));
                w.z = cvt_pk_bf16(silu_mul(g1[0], u1[0]), silu_mul(g1[1], u1[1])); w.w = cvt_pk_bf16(silu_mul(g1[2], u1[2]), silu_mul(g1[3], u1[3]));
                *(u32x4*)(O + (size_t)row * ldc + col0) = w; }
    }
};
struct EpiResid {
    static constexpr bool PERM = false, AFTER_DRAIN = false;
    const float* res; float* out; bf16_t* xb; float* SS; int ldc;
    __device__ __forceinline__ void operator()(const f32x4 (&acc)[2][2][4][2], const Unit& u, int wr, int wc, int fr, int fq) const {
        const int col0 = u.pn * BM + wc * 32 + 4 * fq;
#pragma unroll
        for (int ai = 0; ai < 2; ++ai)
#pragma unroll
            for (int m = 0; m < 4; ++m) { const int row = u.pm * BM + ai * HALF + wr * 64 + m * 16 + fr; const size_t off = (size_t)row * ldc + col0; float s = 0.f;
#pragma unroll
                for (int bj = 0; bj < 2; ++bj)
#pragma unroll
                    for (int n = 0; n < 2; ++n) { const f32x4 r = *(const f32x4*)(res + off + bj * HALF + n * 16); const f32x4 v = r + acc[ai][bj][m][n];
                        *(f32x4*)(out + off + bj * HALF + n * 16) = v;
                        if (xb) { u32x2 w; w.x = cvt_pk_bf16(v[0], v[1]); w.y = cvt_pk_bf16(v[2], v[3]); *(u32x2*)(xb + off + bj * HALF + n * 16) = w; }
                        s += (v[0] * v[0] + v[1] * v[1]) + (v[2] * v[2] + v[3] * v[3]); }
                if (SS) { s += __shfl_xor(s, 16); s += __shfl_xor(s, 32); if (fq == 0) unsafeAtomicAdd(SS + row, s); }
                asm volatile("" ::: "memory"); }
    }
};
template <class Epi, class Sched, bool ALIGN_EPI = false, bool SP2 = false>
__device__ __forceinline__ void gemm_phase(PG8_LAS unsigned char* lds, const Gemm g, const Sched& S, const Epi& E) {
    int tid_ = threadIdx.x; asm volatile("" : "+v"(tid_));
    const int tid = tid_, wid = __builtin_amdgcn_readfirstlane(tid >> 6), lane = tid & 63, wr = wid >> 2, wc = wid & 3, fr = lane & 15, fq = lane >> 4;
    const int K = g.K, nt = K / BK;
    unsigned voffA[2], voffB[2];
#pragma unroll
    for (int i = 0; i < 2; ++i) { int R, C; stage_rc(tid * 16 + i * 8192, R, C); const int Rb = Epi::PERM ? ((R & ~31) + perm32(R & 31)) : R;
        voffA[i] = (unsigned)(R * K + C) * 2u; voffB[i] = (unsigned)(Rb * K + C) * 2u; }
    const size_t kstep = (size_t)(BK * 2);
    const size_t hstep = (size_t)HALF * K * 2;
    const size_t tstep = 2 * hstep;
    const unsigned ldsw = (unsigned)wid * 1024u;
    const int aoff = lds_byte(wr * 64 + fr, fq * 8), boff = lds_byte(wc * 32 + fr, fq * 8);
#define PG8_SA(b, h) (((b) * 2 + (h)) * HTB)
#define PG8_SB(b, h) ((4 + (b) * 2 + (h)) * HTB)
#define PG8_STAGE(bufoff, gbase, voff) do { _Pragma("unroll") for (int _i = 0; _i < 2; ++_i) \
        __builtin_amdgcn_global_load_lds((const unsigned*)((const char*)(gbase) + (voff)[_i]), (PG8_LAS unsigned*)(lds + (bufoff) + ldsw + _i * 8192), 16, 0, 0); } while (0)
#define PG8_LDA(dst, b, h) do { _Pragma("unroll") for (int m = 0; m < 4; ++m) _Pragma("unroll") for (int k = 0; k < 2; ++k) dst[m][k] = *(const PG8_LAS bf16x8*)(lds + PG8_SA(b, h) + aoff + m * 2048 + k * 1024); } while (0)
#define PG8_LDB(dst, b, h) do { _Pragma("unroll") for (int n = 0; n < 2; ++n) _Pragma("unroll") for (int k = 0; k < 2; ++k) dst[n][k] = *(const PG8_LAS bf16x8*)(lds + PG8_SB(b, h) + boff + n * 2048 + k * 1024); } while (0)
#define PG8_MMA(ai, bj, At, Bt) do { __builtin_amdgcn_s_setprio(1); _Pragma("unroll") for (int m = 0; m < 4; ++m) _Pragma("unroll") for (int n = 0; n < 2; ++n) _Pragma("unroll") for (int k = 0; k < 2; ++k) \
        acc[ai][bj][m][n] = __builtin_amdgcn_mfma_f32_16x16x32_bf16(Bt[n][k], At[m][k], acc[ai][bj][m][n], 0, 0, 0); __builtin_amdgcn_s_setprio(0); } while (0)
#define PG8_WAIT_V(n) asm volatile("s_waitcnt vmcnt(" #n ")" ::: "memory")
#define PG8_WAIT_L(n) asm volatile("s_waitcnt lgkmcnt(" #n ")" ::: "memory")
#define PG8_BAR __builtin_amdgcn_s_barrier()
#define PG8_SCHED __builtin_amdgcn_sched_barrier(0)
    Unit cur, nxt; int ui = 0;
    if (!S.next(0, cur)) return;
    f32x4 acc[2][2][4][2];
#pragma unroll
    for (int a = 0; a < 2; ++a)
#pragma unroll
        for (int b = 0; b < 2; ++b)
#pragma unroll
            for (int m = 0; m < 4; ++m)
#pragma unroll
                for (int n = 0; n < 2; ++n) acc[a][b][m][n] = (f32x4){0.f, 0.f, 0.f, 0.f};
    bf16x8 At[4][2], B0[2][2], B1[2][2];
    const char* cA = (const char*)g.A + (size_t)cur.pm * tstep; const char* cB = (const char*)g.Bt + (size_t)cur.pn * tstep;
    S.a_ready(cur);
    if constexpr (SP2) {
        PG8_STAGE(PG8_SB(0, 0), cB, voffB); PG8_STAGE(PG8_SB(0, 1), cB + hstep, voffB); PG8_STAGE(PG8_SA(0, 0), cA, voffA); PG8_STAGE(PG8_SA(0, 1), cA + hstep, voffA);
        if (wr == 1) PG8_BAR;
        PG8_WAIT_V(2); PG8_BAR;
        PG8_STAGE(PG8_SB(1, 0), cB + kstep, voffB); PG8_STAGE(PG8_SA(1, 0), cA + kstep, voffA); PG8_STAGE(PG8_SB(1, 1), cB + hstep + kstep, voffB);
        PG8_WAIT_V(6); PG8_BAR;
    } else {
        PG8_STAGE(PG8_SB(0, 0), cB, voffB); PG8_STAGE(PG8_SA(0, 0), cA, voffA); PG8_STAGE(PG8_SB(0, 1), cB + hstep, voffB); PG8_STAGE(PG8_SA(0, 1), cA + hstep, voffA);
        if (wr == 1) PG8_BAR;
        PG8_WAIT_V(4); PG8_BAR;
        PG8_STAGE(PG8_SB(1, 0), cB + kstep, voffB); PG8_STAGE(PG8_SA(1, 0), cA + kstep, voffA); PG8_STAGE(PG8_SB(1, 1), cB + hstep + kstep, voffB);
        PG8_WAIT_V(6); PG8_BAR;
    }
    for (;;) {
        const bool has_next = S.next(ui + 1, nxt);
        const char* nA = has_next ? (const char*)g.A + (size_t)nxt.pm * tstep : cA; const char* nB = has_next ? (const char*)g.Bt + (size_t)nxt.pn * tstep : cB;
        for (int t = 0; t < nt; t += 2) {
            const bool last = (t == nt - 2);
            const char* a1 = cA + (size_t)(t + 1) * kstep;
            const char* a2 = last ? nA : cA + (size_t)(t + 2) * kstep; const char* b2 = last ? nB : cB + (size_t)(t + 2) * kstep;
            const char* a3 = a2 + kstep; const char* b3 = b2 + kstep;
            if (last && has_next) S.a_ready(nxt);
            if constexpr (SP2) {
            PG8_LDB(B0, 0, 0); PG8_LDB(B1, 0, 1); PG8_SCHED; PG8_LDA(At, 0, 0); PG8_STAGE(PG8_SA(1, 1), a1 + hstep, voffA);
            PG8_WAIT_V(8); PG8_WAIT_L(0); PG8_BAR; PG8_MMA(0, 0, At, B0); PG8_MMA(0, 1, At, B1); PG8_BAR; PG8_SCHED;
            PG8_LDA(At, 0, 1); PG8_STAGE(PG8_SB(0, 0), b2, voffB); PG8_STAGE(PG8_SB(0, 1), b2 + hstep, voffB); PG8_STAGE(PG8_SA(0, 0), a2, voffA);
            PG8_WAIT_V(8); PG8_WAIT_L(0); PG8_BAR; PG8_MMA(1, 0, At, B0); PG8_MMA(1, 1, At, B1); PG8_BAR; PG8_SCHED;
            PG8_LDB(B0, 1, 0); PG8_LDB(B1, 1, 1); PG8_SCHED; PG8_LDA(At, 1, 0); PG8_STAGE(PG8_SA(0, 1), a2 + hstep, voffA);
            PG8_WAIT_V(8); PG8_WAIT_L(0); PG8_BAR; PG8_MMA(0, 0, At, B0); PG8_MMA(0, 1, At, B1); PG8_BAR; PG8_SCHED;
            PG8_LDA(At, 1, 1); PG8_STAGE(PG8_SB(1, 0), b3, voffB); PG8_STAGE(PG8_SB(1, 1), b3 + hstep, voffB); PG8_STAGE(PG8_SA(1, 0), a3, voffA);
            PG8_WAIT_V(8); PG8_WAIT_L(0); PG8_BAR; PG8_MMA(1, 0, At, B0); PG8_MMA(1, 1, At, B1); PG8_BAR; PG8_SCHED;
            } else {
            PG8_LDB(B0, 0, 0); PG8_SCHED; PG8_LDA(At, 0, 0); PG8_STAGE(PG8_SA(1, 1), a1 + hstep, voffA);
            PG8_WAIT_L(8); PG8_BAR; PG8_WAIT_L(0); PG8_MMA(0, 0, At, B0); PG8_BAR; PG8_SCHED;
            PG8_LDB(B1, 0, 1); PG8_STAGE(PG8_SB(0, 0), b2, voffB);
            PG8_BAR; PG8_WAIT_L(0); PG8_MMA(0, 1, At, B1); PG8_BAR;
            PG8_LDA(At, 0, 1); PG8_STAGE(PG8_SA(0, 0), a2, voffA);
            PG8_BAR; PG8_WAIT_L(0); PG8_MMA(1, 0, At, B0); PG8_BAR; PG8_SCHED;
            PG8_STAGE(PG8_SB(0, 1), b2 + hstep, voffB);
            PG8_WAIT_V(6); PG8_BAR; PG8_MMA(1, 1, At, B1); PG8_BAR;
            PG8_LDB(B0, 1, 0); PG8_SCHED; PG8_LDA(At, 1, 0); PG8_STAGE(PG8_SA(0, 1), a2 + hstep, voffA);
            PG8_WAIT_L(8); PG8_BAR; PG8_WAIT_L(0); PG8_MMA(0, 0, At, B0); PG8_BAR; PG8_SCHED;
            PG8_LDB(B1, 1, 1); PG8_STAGE(PG8_SB(1, 0), b3, voffB);
            PG8_BAR; PG8_WAIT_L(0); PG8_MMA(0, 1, At, B1); PG8_BAR;
            PG8_LDA(At, 1, 1); PG8_STAGE(PG8_SA(1, 0), a3, voffA);
            PG8_BAR; PG8_WAIT_L(0); PG8_MMA(1, 0, At, B0); PG8_BAR; PG8_SCHED;
            PG8_STAGE(PG8_SB(1, 1), b3 + hstep, voffB);
            PG8_WAIT_V(6); PG8_BAR; PG8_MMA(1, 1, At, B1); PG8_BAR;
            }
        }
        if constexpr (ALIGN_EPI) { if (wr == 0) PG8_BAR; }
        if constexpr (!Epi::AFTER_DRAIN) { E(acc, cur, wr, wc, fr, fq); S.done(cur); }
        if (!has_next) break;
#pragma unroll
        for (int a = 0; a < 2; ++a)
#pragma unroll
            for (int b = 0; b < 2; ++b)
#pragma unroll
                for (int m = 0; m < 4; ++m)
#pragma unroll
                    for (int n = 0; n < 2; ++n) acc[a][b][m][n] = (f32x4){0.f, 0.f, 0.f, 0.f};
        cur = nxt; cA = nA; cB = nB; ++ui;
        if constexpr (ALIGN_EPI) { if (wr == 1) PG8_BAR; }
    }
    PG8_WAIT_V(0);
    if constexpr (!ALIGN_EPI) { if (wr == 0) PG8_BAR; }
    PG8_BAR;
    if constexpr (Epi::AFTER_DRAIN) { E.fused(acc, cur, wr, wc, fr, fq, lds, wid, lane); S.done(cur); }
#undef PG8_SA
#undef PG8_SB
#undef PG8_STAGE
#undef PG8_LDA
#undef PG8_LDB
#undef PG8_MMA
#undef PG8_WAIT_V
#undef PG8_WAIT_L
#undef PG8_BAR
#undef PG8_SCHED
}
}
#define LAS __attribute__((address_space(3)))
using pg8::bf16_t; using pg8::bf16x8; using pg8::f32x4; using pg8::u32x4; using pg8::u32x2; using pg8::cvt_pk_bf16; using pg8::RMS_EPS;
constexpr int BATCH = 4, SEQ = 4096, D = 2048, M = BATCH * SEQ, NMEM = 256, MM = BATCH * NMEM, DFF = 5632, DPOOL = 1024, DSGU = 1024;
constexpr int NWAVES = 8, NTHR = NWAVES * 64;
constexpr int LDS_BYTES = 147456;
constexpr size_t MiB = 1u << 20;
constexpr size_t WS_SS1 = 0, WS_SS2 = 65536, WS_BAR = 131072, WS_ZERO_BYTES = 262144;
constexpr size_t WS_WIN = 1 * MiB, WS_WOUT = 13 * MiB, WS_WQ = 21 * MiB, WS_WK = 29 * MiB, WS_WV = 37 * MiB, WS_WO = 45 * MiB, WS_WGU = 53 * MiB, WS_WD = 97 * MiB;
constexpr size_t WS_PW = 119 * MiB, WS_WSP = 119 * MiB + 512 * 1024;
constexpr size_t WS_MN = 120 * MiB, WS_KB = 124 * MiB, WS_VTM = 128 * MiB;
constexpr size_t WS_XB = 132 * MiB;
constexpr size_t WS_HG = 196 * MiB;
constexpr size_t WS_PAU = 196 * MiB, WS_Q = 196 * MiB, WS_VT = 260 * MiB, WS_Y = 292 * MiB, WS_O = 292 * MiB;
constexpr size_t WS_END = 372 * MiB;

__device__ __forceinline__ float bf_lo(unsigned w) { return __uint_as_float(w << 16); }
__device__ __forceinline__ float bf_hi(unsigned w) { return __uint_as_float(w & 0xffff0000u); }
__device__ __forceinline__ float wave_sum(float v) {
#pragma unroll
    for (int o = 1; o < 64; o <<= 1) v += __shfl_xor(v, o);
    return v;
}
#define LDS_WAIT() asm volatile("s_waitcnt lgkmcnt(0)" ::: "memory")
#define MFMA16(a, b, c) __builtin_amdgcn_mfma_f32_16x16x32_bf16((a), (b), (c), 0, 0, 0)

#define XB_TMO      128
#define XB_XCNT(j)  (256  + 64 * (j))
#define XB_XSUB(j)  (1280 + 64 * (j))
#define XB_XGEN(j)  (2304 + 64 * (j))
#define XB_TOP      3328
#define XB_TOPGEN   3392
#define XCD_BAR_WORDS 3456
#define XB_SPIN_CAP (1u << 18)

__device__ __forceinline__ unsigned xb_ld(unsigned* p)              { return __hip_atomic_load(p, __ATOMIC_RELAXED, __HIP_MEMORY_SCOPE_AGENT); }
__device__ __forceinline__ unsigned xb_add(unsigned* p, unsigned v) { return __hip_atomic_fetch_add(p, v, __ATOMIC_RELAXED, __HIP_MEMORY_SCOPE_AGENT); }
__device__ __forceinline__ unsigned xb_xcc_id() { return (unsigned)__builtin_amdgcn_s_getreg((3 << 11) | 20) & 0xFu; }
#define XB_SPIN(cond, bar) do { unsigned _sp = 0; while (cond) { __builtin_amdgcn_s_sleep(1); \
    if ((++_sp & 255u) == 0u) { if (xb_ld(&(bar)[XB_TMO])) break; if (_sp > XB_SPIN_CAP) { atomicAdd(&(bar)[XB_TMO], 1u); break; } } } } while (0)

struct XcdBarrier {
    unsigned* bar; unsigned x;
    volatile LAS unsigned* st;
};

__device__ __forceinline__ XcdBarrier xcd_barrier_post(unsigned* bar, volatile LAS unsigned* st) {
    XcdBarrier b; b.bar = bar; b.x = xb_xcc_id(); b.st = st;
    if (threadIdx.x == 0) (void)xb_add(&bar[XB_XCNT(b.x)], 1u);
    return b;
}
__device__ __forceinline__ void xcd_barrier_complete(unsigned* bar, unsigned x, unsigned& nloc, unsigned& nx) {
    const unsigned G = gridDim.x * gridDim.y * gridDim.z;
    unsigned sum, cnt, mine, sp = 0u;
    for (;;) {
        sum = 0u; cnt = 0u; mine = 0u;
#pragma unroll
        for (unsigned j = 0; j < 16; ++j) { const unsigned c = xb_ld(&bar[XB_XCNT(j)]); sum += c; cnt += (c > 0u) ? 1u : 0u; mine = (j == x) ? c : mine; }
        if (sum == G) break;
        __builtin_amdgcn_s_sleep(1);
        if ((++sp & 255u) == 0u) { if (xb_ld(&bar[XB_TMO])) break; if (sp > XB_SPIN_CAP) { atomicAdd(&bar[XB_TMO], 1u); break; } }
    }
    nloc = mine > 0u ? mine : 1u; nx = cnt > 0u ? cnt : 1u;
}

__device__ __forceinline__ void xcd_barrier(const XcdBarrier& b) {
    asm volatile("s_waitcnt vmcnt(0)" ::: "memory");
    __syncthreads();
    if (threadIdx.x == 0) {
        unsigned* bar = b.bar;
        __builtin_amdgcn_s_waitcnt(0);
        unsigned nloc = b.st[0], nx = b.st[1];
        if (nloc == 0u) { xcd_barrier_complete(bar, b.x, nloc, nx); b.st[0] = nloc; b.st[1] = nx; }
        const unsigned old = xb_add(&bar[XB_XSUB(b.x)], 1u);
        const unsigned gen = old / nloc;
        if (old + 1u == (gen + 1u) * nloc) {
            __builtin_amdgcn_fence(__ATOMIC_RELEASE, "agent");
            asm volatile("s_waitcnt vmcnt(0)" ::: "memory");
            const unsigned og = xb_add(&bar[XB_TOP], 1u);
            const unsigned tg = og / nx;
            if (og + 1u == (tg + 1u) * nx) xb_add(&bar[XB_TOPGEN], 1u);
            else XB_SPIN(xb_ld(&bar[XB_TOPGEN]) == tg, bar);
            __builtin_amdgcn_fence(__ATOMIC_ACQUIRE, "agent");
            xb_add(&bar[XB_XGEN(b.x)], 1u);
            asm volatile("s_waitcnt vmcnt(0)" ::: "memory");
        } else {
            XB_SPIN(xb_ld(&bar[XB_XGEN(b.x)]) == gen, bar);
            __builtin_amdgcn_fence(__ATOMIC_ACQUIRE, "agent");
            asm volatile("s_waitcnt vmcnt(0)" ::: "memory");
        }
    }
    __syncthreads();
}

__device__ __forceinline__ void tr_item(const float* W, int ldw, int k0, int n0, bf16_t* WT, int ldt, int orow0, const float* kgain, const float* nscale, LAS float* scr, int lane) {
#pragma unroll 4
    for (int i = 0; i < 16; ++i) { const int kk = 4 * i + (lane >> 4), nn = (lane & 15) * 4;
        f32x4 v = *(const f32x4*)(W + (size_t)(k0 + kk) * ldw + n0 + nn);
        if (kgain) v = v * kgain[k0 + kk];
        LAS float* s = scr + kk * 65 + nn; s[0] = v[0]; s[1] = v[1]; s[2] = v[2]; s[3] = v[3]; }
    LDS_WAIT();
    const int c = lane & 7;
#pragma unroll
    for (int j = 0; j < 8; ++j) { const int n = (lane >> 3) + 8 * j; const LAS float* s = scr + (8 * c) * 65 + n;
        const float sc = nscale ? nscale[n] : 1.0f;
        u32x4 o; o.x = cvt_pk_bf16(s[0 * 65] * sc, s[1 * 65] * sc); o.y = cvt_pk_bf16(s[2 * 65] * sc, s[3 * 65] * sc); o.z = cvt_pk_bf16(s[4 * 65] * sc, s[5 * 65] * sc); o.w = cvt_pk_bf16(s[6 * 65] * sc, s[7 * 65] * sc);
        *(u32x4*)(WT + (size_t)(orow0 + n) * ldt + k0 + 8 * c) = o; }
    LDS_WAIT();
}
__device__ __forceinline__ void norm_row_bf16(const float* xrow, const float* g, bf16_t* orow, int lane) {
    const f32x4* xr = (const f32x4*)xrow + lane; f32x4 v[8]; float s = 0.f;
#pragma unroll
    for (int j = 0; j < 8; ++j) { v[j] = xr[64 * j]; s += (v[j][0] * v[j][0] + v[j][1] * v[j][1]) + (v[j][2] * v[j][2] + v[j][3] * v[j][3]); }
    const float rstd = 1.0f / sqrtf(wave_sum(s) * (1.0f / D) + RMS_EPS);
    const f32x4* gr = (const f32x4*)g + lane; u32x2* o = (u32x2*)orow + lane;
#pragma unroll
    for (int j = 0; j < 8; ++j) { const f32x4 gg = gr[64 * j]; const f32x4 y = v[j] * rstd * gg; u32x2 w; w.x = cvt_pk_bf16(y[0], y[1]); w.y = cvt_pk_bf16(y[2], y[3]); o[64 * j] = w; }
}
__device__ __forceinline__ void norm_row_f32(float* xrow, const float* g, int lane) {
    f32x4* xr = (f32x4*)xrow + lane; f32x4 v[8]; float s = 0.f;
#pragma unroll
    for (int j = 0; j < 8; ++j) { v[j] = xr[64 * j]; s += (v[j][0] * v[j][0] + v[j][1] * v[j][1]) + (v[j][2] * v[j][2] + v[j][3] * v[j][3]); }
    const float rstd = 1.0f / sqrtf(wave_sum(s) * (1.0f / D) + RMS_EPS);
    const f32x4* gr = (const f32x4*)g + lane;
#pragma unroll
    for (int j = 0; j < 8; ++j) { const f32x4 gg = gr[64 * j]; xr[64 * j] = v[j] * rstd * gg; }
}

__device__ __forceinline__ void sgu_unit(LAS unsigned char* lds, int nb, const bf16_t* VT, const bf16_t* PAU, bf16_t* Y, const bf16_t* WSb, const float* sg, const float* bsp, int tid) {
    asm volatile("" : "+v"(tid));
    const int lane = tid & 63, wave = tid >> 6, fr = lane & 15, fq = lane >> 4;
    const int T0 = nb * 128;
    LAS float* red = (LAS float*)lds;
    LAS float* rstd = (LAS float*)(lds + 4096);
    LAS unsigned char* Bb = lds + 8192;
    {
        const int tg = tid & 15, rl = tid >> 4;
        float s[8];
#pragma unroll
        for (int e = 0; e < 8; ++e) s[e] = 0.f;
#pragma unroll 4
        for (int i = 0; i < 32; ++i) { const int c = rl + 32 * i; const u32x4 w = *(const u32x4*)(VT + (size_t)c * M + T0 + tg * 8);
#pragma unroll
            for (int e = 0; e < 4; ++e) { const float lo = bf_lo(w[e]), hi = bf_hi(w[e]); s[2 * e] += lo * lo; s[2 * e + 1] += hi * hi; } }
#pragma unroll
        for (int e = 0; e < 8; ++e) { s[e] += __shfl_xor(s[e], 16); s[e] += __shfl_xor(s[e], 32); }
        if (fq == 0) {
#pragma unroll
            for (int e = 0; e < 8; ++e) red[wave * 128 + tg * 8 + e] = s[e]; }
    }
    __syncthreads();
    if (tid < 128) { float t = 0.f;
#pragma unroll
        for (int w = 0; w < 8; ++w) t += red[w * 128 + tid];
        rstd[tid] = 1.0f / sqrtf(t * (1.0f / DSGU) + RMS_EPS); }
    __syncthreads();
    const int wr = wave >> 1, wc = wave & 1;
    for (int h = 0; h < 8; ++h) {
        LAS unsigned char* B = Bb + (h & 1) * 34816;
#pragma unroll
        for (int i = 0; i < 4; ++i) { const int p = tid + 512 * i, c = p >> 4, sgp = p & 15;
            const u32x4 w = *(const u32x4*)(VT + (size_t)(h * 128 + c) * M + T0 + sgp * 8);
            const float g = sg[h * 128 + c];
            const f32x4 r0 = *(const LAS f32x4*)(rstd + sgp * 8) * g, r1 = *(const LAS f32x4*)(rstd + sgp * 8 + 4) * g;
            u32x4 o; o.x = cvt_pk_bf16(bf_lo(w.x) * r0[0], bf_hi(w.x) * r0[1]); o.y = cvt_pk_bf16(bf_lo(w.y) * r0[2], bf_hi(w.y) * r0[3]);
            o.z = cvt_pk_bf16(bf_lo(w.z) * r1[0], bf_hi(w.z) * r1[1]); o.w = cvt_pk_bf16(bf_lo(w.w) * r1[2], bf_hi(w.w) * r1[3]);
            *(LAS u32x4*)(B + c * 272 + sgp * 16) = o; }
        __syncthreads();
        f32x4 acc[2][4];
#pragma unroll
        for (int m = 0; m < 2; ++m)
#pragma unroll
            for (int n = 0; n < 4; ++n) acc[m][n] = (f32x4){0.f, 0.f, 0.f, 0.f};
#pragma unroll
        for (int ks = 0; ks < 4; ++ks) { bf16x8 a[2], b[4];
#pragma unroll
            for (int m = 0; m < 2; ++m) a[m] = *(const bf16x8*)(WSb + (size_t)((h * 128 + wr * 32 + m * 16 + fr) * 128 + ks * 32 + fq * 8));
#pragma unroll
            for (int n = 0; n < 4; ++n) b[n] = *(const LAS bf16x8*)(B + (wc * 64 + n * 16 + fr) * 272 + (ks * 32 + fq * 8) * 2);
#pragma unroll
            for (int m = 0; m < 2; ++m)
#pragma unroll
                for (int n = 0; n < 4; ++n) acc[m][n] = MFMA16(b[n], a[m], acc[m][n]); }
#pragma unroll
        for (int m = 0; m < 2; ++m) { const int t = wr * 32 + m * 16 + fr; const float bias = bsp[h * 128 + t];
#pragma unroll
            for (int n = 0; n < 4; ++n) { const size_t off = (size_t)(T0 + t) * D + DPOOL + h * 128 + wc * 64 + n * 16 + fq * 4;
                const u32x2 uu = *(const u32x2*)(PAU + off); const f32x4 mx = acc[m][n] + bias;
                u32x2 o; o.x = cvt_pk_bf16(bf_lo(uu.x) * mx[0], bf_hi(uu.x) * mx[1]); o.y = cvt_pk_bf16(bf_lo(uu.y) * mx[2], bf_hi(uu.y) * mx[3]);
                *(u32x2*)(Y + off) = o; } }
    }
    __syncthreads();
}
__device__ __forceinline__ void pool_unit(LAS unsigned char* lds, int nb, const bf16_t* PAU, bf16_t* Y, const bf16_t* PWt, int tid) {
    asm volatile("" : "+v"(tid));
    const int lane = tid & 63, wave = tid >> 6, fr = lane & 15, fq = lane >> 4;
    const int T0 = nb * 128, tp0 = T0 & (SEQ - 1);
    LAS unsigned char* A = lds;
    for (int g = 0; g < 4; ++g) {
        const int w = 2 << g;
        {   const int cgp = tid & 31, ts = (tid >> 5) * 8; const bf16_t* base = PAU + g * 256 + cgp * 8;
            float S[8];
#pragma unroll
            for (int e = 0; e < 8; ++e) S[e] = 0.f;
            for (int j = 1; j < w; ++j) { if (tp0 + ts - j >= 0) { const u32x4 q = *(const u32x4*)(base + (size_t)(T0 + ts - j) * D);
#pragma unroll
                for (int e = 0; e < 4; ++e) { S[2 * e] += bf_lo(q[e]); S[2 * e + 1] += bf_hi(q[e]); } } }
#pragma unroll
            for (int i = 0; i < 8; ++i) { const int t = ts + i, tp = tp0 + t; const u32x4 q = *(const u32x4*)(base + (size_t)(T0 + t) * D);
                float cur[8], p[8];
#pragma unroll
                for (int e = 0; e < 4; ++e) { cur[2 * e] = bf_lo(q[e]); cur[2 * e + 1] = bf_hi(q[e]); }
                const float inv = 1.0f / (float)(tp + 1 < w ? tp + 1 : w);
#pragma unroll
                for (int e = 0; e < 8; ++e) { S[e] += cur[e]; p[e] = S[e] * inv - cur[e]; }
                u32x4 o; o.x = cvt_pk_bf16(p[0], p[1]); o.y = cvt_pk_bf16(p[2], p[3]); o.z = cvt_pk_bf16(p[4], p[5]); o.w = cvt_pk_bf16(p[6], p[7]);
                *(LAS u32x4*)(A + t * 528 + cgp * 16) = o;
                if (tp - w + 1 >= 0) { const u32x4 r = *(const u32x4*)(base + (size_t)(T0 + t - w + 1) * D);
#pragma unroll
                    for (int e = 0; e < 4; ++e) { S[2 * e] -= bf_lo(r[e]); S[2 * e + 1] -= bf_hi(r[e]); } } }
        }
        __syncthreads();
        f32x4 acc[8][2];
#pragma unroll
        for (int m = 0; m < 8; ++m)
#pragma unroll
            for (int n = 0; n < 2; ++n) acc[m][n] = (f32x4){0.f, 0.f, 0.f, 0.f};
#pragma unroll 2
        for (int ks = 0; ks < 8; ++ks) { bf16x8 b[2];
#pragma unroll
            for (int n = 0; n < 2; ++n) b[n] = *(const bf16x8*)(PWt + (size_t)((g * 256 + wave * 32 + n * 16 + fr) * 256 + ks * 32 + fq * 8));
#pragma unroll
            for (int m = 0; m < 8; ++m) { const bf16x8 a = *(const LAS bf16x8*)(A + (m * 16 + fr) * 528 + (ks * 32 + fq * 8) * 2);
#pragma unroll
                for (int n = 0; n < 2; ++n) acc[m][n] = MFMA16(b[n], a, acc[m][n]); } }
#pragma unroll
        for (int m = 0; m < 8; ++m)
#pragma unroll
            for (int n = 0; n < 2; ++n) { const size_t off = (size_t)(T0 + m * 16 + fr) * D + g * 256 + wave * 32 + n * 16 + fq * 4; const f32x4 v = acc[m][n];
                u32x2 o; o.x = cvt_pk_bf16(v[0], v[1]); o.y = cvt_pk_bf16(v[2], v[3]); *(u32x2*)(Y + off) = o; }
        __syncthreads();
    }
}
__device__ __forceinline__ void attn_unit(LAS unsigned char* lds, int unit, const bf16_t* Q, const bf16_t* KB, const bf16_t* VTM, bf16_t* O, int tid) {
    asm volatile("" : "+v"(tid));
    const int lane = tid & 63, wave = tid >> 6, fr = lane & 15, fq = lane >> 4, wr = wave >> 1, wc = wave & 1;
    const int qt = unit & 31, h = (unit >> 5) & 3, b = unit >> 7;
    const int R0 = b * SEQ + qt * 128;
    LAS unsigned char* P = lds;
    LAS float* xm = (LAS float*)(lds + 67584);
    LAS float* xs = xm + 256;
    f32x4 acc[2][8];
#pragma unroll
    for (int m = 0; m < 2; ++m)
#pragma unroll
        for (int n = 0; n < 8; ++n) acc[m][n] = (f32x4){0.f, 0.f, 0.f, 0.f};
    const bf16_t* qp = Q + (size_t)(R0 + wr * 32 + fr) * D + h * 512 + fq * 8;
    const bf16_t* kp = KB + (size_t)(b * NMEM + wc * 128 + fr) * D + h * 512 + fq * 8;
#pragma unroll 2
    for (int ks = 0; ks < 16; ++ks) { bf16x8 a[2], bb[8];
#pragma unroll
        for (int m = 0; m < 2; ++m) a[m] = *(const bf16x8*)(qp + (size_t)m * 16 * D + ks * 32);
#pragma unroll
        for (int n = 0; n < 8; ++n) bb[n] = *(const bf16x8*)(kp + (size_t)n * 16 * D + ks * 32);
#pragma unroll
        for (int m = 0; m < 2; ++m)
#pragma unroll
            for (int n = 0; n < 8; ++n) acc[m][n] = MFMA16(bb[n], a[m], acc[m][n]); }
    const float sc = 0.044194173824159216f;
#pragma unroll
    for (int m = 0; m < 2; ++m) { float v = -3.0e38f;
#pragma unroll
        for (int n = 0; n < 8; ++n) { acc[m][n] = acc[m][n] * sc; v = fmaxf(v, fmaxf(fmaxf(acc[m][n][0], acc[m][n][1]), fmaxf(acc[m][n][2], acc[m][n][3]))); }
        v = fmaxf(v, __shfl_xor(v, 16)); v = fmaxf(v, __shfl_xor(v, 32));
        if (fq == 0) xm[wc * 128 + wr * 32 + m * 16 + fr] = v; }
    __syncthreads();
#pragma unroll
    for (int m = 0; m < 2; ++m) { const int row = wr * 32 + m * 16 + fr; const float mx = fmaxf(xm[row], xm[128 + row]); float s = 0.f;
#pragma unroll
        for (int n = 0; n < 8; ++n) { const float p0 = __expf(acc[m][n][0] - mx), p1 = __expf(acc[m][n][1] - mx), p2 = __expf(acc[m][n][2] - mx), p3 = __expf(acc[m][n][3] - mx);
            s += (p0 + p1) + (p2 + p3);
            u32x2 o; o.x = cvt_pk_bf16(p0, p1); o.y = cvt_pk_bf16(p2, p3);
            *(LAS u32x2*)(P + row * 528 + (wc * 128 + n * 16 + fq * 4) * 2) = o; }
        s += __shfl_xor(s, 16); s += __shfl_xor(s, 32);
        if (fq == 0) xs[wc * 128 + row] = s; }
    __syncthreads();
    float inv[2];
#pragma unroll
    for (int m = 0; m < 2; ++m) { const int row = wr * 32 + m * 16 + fr; inv[m] = 1.0f / (xs[row] + xs[128 + row]); }
    f32x4 o[2][16];
#pragma unroll
    for (int m = 0; m < 2; ++m)
#pragma unroll
        for (int n = 0; n < 16; ++n) o[m][n] = (f32x4){0.f, 0.f, 0.f, 0.f};
    const bf16_t* vp = VTM + (size_t)(h * 512 + wc * 256 + fr) * MM + b * NMEM + fq * 8;
    for (int ks = 0; ks < 8; ++ks) { bf16x8 a[2];
#pragma unroll
        for (int m = 0; m < 2; ++m) a[m] = *(const LAS bf16x8*)(P + (wr * 32 + m * 16 + fr) * 528 + (ks * 32 + fq * 8) * 2);
#pragma unroll
        for (int n = 0; n < 16; ++n) { const bf16x8 bv = *(const bf16x8*)(vp + (size_t)n * 16 * MM + ks * 32);
#pragma unroll
            for (int m = 0; m < 2; ++m) o[m][n] = MFMA16(bv, a[m], o[m][n]); } }
#pragma unroll
    for (int m = 0; m < 2; ++m) { const size_t rowoff = (size_t)(R0 + wr * 32 + m * 16 + fr) * D + h * 512 + wc * 256 + fq * 4;
#pragma unroll
        for (int n = 0; n < 16; ++n) { const f32x4 v = o[m][n] * inv[m]; u32x2 w; w.x = cvt_pk_bf16(v[0], v[1]); w.y = cvt_pk_bf16(v[2], v[3]); *(u32x2*)(O + rowoff + n * 16) = w; } }
    __syncthreads();
}

#ifndef REP_P0
#define REP_P0 1
#endif
#ifndef REP_P2
#define REP_P2 1
#endif
#ifndef REP_P5
#define REP_P5 1
#endif
#ifndef REP_SYNC
#define REP_SYNC 1
#endif
#ifndef REP_P4
#define REP_P4 1
#endif
struct Args { const float* in[21]; float* out; unsigned char* ws; };
#define GEMM_PHASE(EPI, g, S, E) pg8::gemm_phase<EPI, pg8::StaticOrder, true, true>(lds, g, S, E)
__global__ void __launch_bounds__(NTHR, 2) mk_fwd(Args a) {
    extern __shared__ __attribute__((aligned(16))) unsigned char lds_raw[];
    LAS unsigned char* lds = (LAS unsigned char*)lds_raw;
    cg::grid_group grid = cg::this_grid();
    const int G = gridDim.x, bx = blockIdx.x;
    volatile LAS unsigned* bar_st = (volatile LAS unsigned*)(lds + LDS_BYTES - 64);
    if (threadIdx.x < 2) bar_st[threadIdx.x] = 0u;
    __syncthreads();
    const XcdBarrier xbar = xcd_barrier_post((unsigned*)(a.ws + WS_BAR), bar_st);
#define TID_FRESH() ({ int t_ = threadIdx.x; asm volatile("" : "+v"(t_)); t_; })
    const float *x = a.in[0], *mem = a.in[1], *norm_mix_g = a.in[2], *w_in = a.in[3], *pool_w = a.in[4], *pool_scale = a.in[5], *sgu_norm_g = a.in[6], *w_spatial = a.in[7], *b_spatial = a.in[8],
                *w_out = a.in[9], *norm_xattn_g = a.in[10], *norm_mem_g = a.in[11], *w_q = a.in[12], *w_k = a.in[13], *w_v = a.in[14], *w_o = a.in[15], *norm_ffn_g = a.in[16],
                *w_gate = a.in[17], *w_up = a.in[18], *w_down = a.in[19], *final_norm_g = a.in[20];
    float* out = a.out; unsigned char* ws = a.ws;
    float *SS1 = (float*)(ws + WS_SS1), *SS2 = (float*)(ws + WS_SS2);
    bf16_t *Win_t = (bf16_t*)(ws + WS_WIN), *Wout_t = (bf16_t*)(ws + WS_WOUT), *Wq_t = (bf16_t*)(ws + WS_WQ), *Wk_t = (bf16_t*)(ws + WS_WK), *Wv_t = (bf16_t*)(ws + WS_WV), *Wo_t = (bf16_t*)(ws + WS_WO),
           *Wgu_t = (bf16_t*)(ws + WS_WGU), *Wd_t = (bf16_t*)(ws + WS_WD), *PWt = (bf16_t*)(ws + WS_PW), *WSb = (bf16_t*)(ws + WS_WSP), *MN = (bf16_t*)(ws + WS_MN), *KB = (bf16_t*)(ws + WS_KB),
           *VTM = (bf16_t*)(ws + WS_VTM), *XB = (bf16_t*)(ws + WS_XB), *HG = (bf16_t*)(ws + WS_HG), *PAU = (bf16_t*)(ws + WS_PAU), *Qb = (bf16_t*)(ws + WS_Q), *VT = (bf16_t*)(ws + WS_VT),
           *Yb = (bf16_t*)(ws + WS_Y), *Ob = (bf16_t*)(ws + WS_O);

    for (int rep = 0; rep < REP_P0; ++rep) {
        const int tid = TID_FRESH(), lane = tid & 63, wave = __builtin_amdgcn_readfirstlane(tid >> 6);
        LAS float* scr = (LAS float*)(lds + wave * 16640);
        const int gw = bx * NWAVES + wave, NGW = G * NWAVES;
        constexpr int I_IN = 32 * 48, I_SQ = 32 * 32, I_GU = 32 * 88, I_DN = 88 * 32, I_PW = 4 * 16;
        constexpr int NITEMS = I_IN + 5 * I_SQ + 2 * I_GU + I_DN + I_PW;
        for (int it = gw; it < NITEMS; it += NGW) {
            int r = it;
            if (r < I_IN) { tr_item(w_in, 3072, (r / 48) * 64, (r % 48) * 64, Win_t, D, (r % 48) * 64, nullptr, nullptr, scr, lane); continue; } r -= I_IN;
            if (r < I_SQ) { tr_item(w_out, D, (r / 32) * 64, (r % 32) * 64, Wout_t, D, (r % 32) * 64, nullptr, nullptr, scr, lane); continue; } r -= I_SQ;
            if (r < I_SQ) { tr_item(w_q, D, (r / 32) * 64, (r % 32) * 64, Wq_t, D, (r % 32) * 64, norm_xattn_g, nullptr, scr, lane); continue; } r -= I_SQ;
            if (r < I_SQ) { tr_item(w_k, D, (r / 32) * 64, (r % 32) * 64, Wk_t, D, (r % 32) * 64, nullptr, nullptr, scr, lane); continue; } r -= I_SQ;
            if (r < I_SQ) { tr_item(w_v, D, (r / 32) * 64, (r % 32) * 64, Wv_t, D, (r % 32) * 64, nullptr, nullptr, scr, lane); continue; } r -= I_SQ;
            if (r < I_SQ) { tr_item(w_o, D, (r / 32) * 64, (r % 32) * 64, Wo_t, D, (r % 32) * 64, nullptr, nullptr, scr, lane); continue; } r -= I_SQ;
            if (r < 2 * I_GU) { const int up = r >= I_GU; if (up) r -= I_GU; const int n0 = (r % 88) * 64;
                tr_item(up ? w_up : w_gate, DFF, (r / 88) * 64, n0, Wgu_t, D, (n0 >> 7) * 256 + (n0 & 127) + up * 128, norm_ffn_g, nullptr, scr, lane); continue; } r -= 2 * I_GU;
            if (r < I_DN) { tr_item(w_down, D, (r / 32) * 64, (r % 32) * 64, Wd_t, DFF, (r % 32) * 64, nullptr, nullptr, scr, lane); continue; } r -= I_DN;
            { const int g = r >> 4, q = r & 15; tr_item(pool_w + (size_t)g * 65536, 256, (q >> 2) * 64, (q & 3) * 64, PWt + (size_t)g * 65536, 256, (q & 3) * 64, nullptr, pool_scale + g * 256 + (q & 3) * 64, scr, lane); }
        }
        for (int i = bx * NTHR + tid; i < 8 * 128 * 128 / 4; i += G * NTHR) { const f32x4 v = *((const f32x4*)w_spatial + i); const int s = (i * 4) & 127, t = ((i * 4) >> 7) & 127;
            const bool keep = (s >> 6) <= (t >> 6); u32x2 o; o.x = keep ? cvt_pk_bf16(v[0], v[1]) : 0u; o.y = keep ? cvt_pk_bf16(v[2], v[3]) : 0u; *((u32x2*)WSb + i) = o; }
        for (int i = bx * NTHR + tid; i < M; i += G * NTHR) { SS1[i] = 0.f; SS2[i] = 0.f; }
        for (int m = gw; m < M; m += NGW) norm_row_bf16(x + (size_t)m * D, norm_mix_g, XB + (size_t)m * D, lane);
        for (int m = gw; m < MM; m += NGW) norm_row_bf16(mem + (size_t)m * D, norm_mem_g, MN + (size_t)m * D, lane);
    }
    for (int rep = 0; rep < REP_SYNC; ++rep) grid.sync();
    {
        { pg8::Gemm g{XB, Win_t, M, 2048, D}; pg8::StaticOrder S; S.init(M, 2048, G, bx); pg8::EpiPlain E{PAU, D}; GEMM_PHASE(pg8::EpiPlain, g, S, E); }
        { pg8::Gemm g{Win_t + (size_t)2048 * D, XB, 1024, M, D}; pg8::StaticOrder S; S.init(1024, M, G, bx); pg8::EpiPlain E{VT, M}; GEMM_PHASE(pg8::EpiPlain, g, S, E); }
        { pg8::Gemm g{MN, Wk_t, MM, D, D}; pg8::StaticOrder S; S.init(MM, D, G, bx); pg8::EpiPlain E{KB, D}; GEMM_PHASE(pg8::EpiPlain, g, S, E); }
        { pg8::Gemm g{Wv_t, MN, D, MM, D}; pg8::StaticOrder S; S.init(D, MM, G, (bx + G - 32) % G); pg8::EpiPlain E{VTM, MM}; GEMM_PHASE(pg8::EpiPlain, g, S, E); }
    }
    xcd_barrier(xbar);
    for (int rep = 0; rep < REP_P2; ++rep) for (int u = bx; u < 256; u += G) { if (u & 1) pool_unit(lds, u >> 1, PAU, Yb, PWt, (int)threadIdx.x); else sgu_unit(lds, u >> 1, VT, PAU, Yb, WSb, sgu_norm_g, b_spatial, (int)threadIdx.x); }
    xcd_barrier(xbar);
    { pg8::Gemm g{Yb, Wout_t, M, D, D}; pg8::StaticOrder S; S.init(M, D, G, bx); pg8::EpiResid E{x, out, XB, SS1, D}; GEMM_PHASE(pg8::EpiResid, g, S, E); }
    xcd_barrier(xbar);
    for (int rep = 0; rep < REP_P4; ++rep) { pg8::Gemm g{XB, Wq_t, M, D, D}; pg8::StaticOrder S; S.init(M, D, G, bx); pg8::EpiRowScale E{Qb, D, SS1, 1.0f / D}; GEMM_PHASE(pg8::EpiRowScale, g, S, E); }
    xcd_barrier(xbar);
    for (int rep = 0; rep < REP_P5; ++rep) for (int u = bx; u < 512; u += G) attn_unit(lds, u, Qb, KB, VTM, Ob, (int)threadIdx.x);
    xcd_barrier(xbar);
    { pg8::Gemm g{Ob, Wo_t, M, D, D}; pg8::StaticOrder S; S.init(M, D, G, bx); pg8::EpiResid E{out, out, XB, SS2, D}; GEMM_PHASE(pg8::EpiResid, g, S, E); }
    xcd_barrier(xbar);
    { pg8::Gemm g{XB, Wgu_t, M, 2 * DFF, D}; pg8::StaticOrder S; S.init(M, 2 * DFF, G, bx); pg8::EpiSwiglu E{HG, DFF, SS2, 1.0f / D}; GEMM_PHASE(pg8::EpiSwiglu, g, S, E); }
    xcd_barrier(xbar);
    { pg8::Gemm g{HG, Wd_t, M, D, DFF}; pg8::StaticOrder S; S.init(M, D, G, bx); pg8::EpiResid E{out, out, nullptr, nullptr, D}; GEMM_PHASE(pg8::EpiResid, g, S, E); }
    xcd_barrier(xbar);
    { const int tid = TID_FRESH(), lane = tid & 63, wave = __builtin_amdgcn_readfirstlane(tid >> 6); const int gw = bx * NWAVES + wave, NGW = G * NWAVES; for (int m = gw; m < M; m += NGW) norm_row_f32(out + (size_t)m * D, final_norm_g, lane); }
}

extern "C" void kernel_launch(void* const* d_in, const int* in_sizes, int n_in, void* d_out, int out_size, void* d_ws, size_t ws_size, hipStream_t stream) {
    static int grid = 0;
    if (grid == 0) {
        if (n_in != 21 || in_sizes[0] != M * D || out_size != M * D || ws_size < WS_END) { fprintf(stderr, "kernel_launch: unexpected shapes (n_in %d, in0 %d, out %d, ws %zu); nothing launched\n", n_in, n_in > 0 ? in_sizes[0] : -1, out_size, ws_size); grid = -1; return; }
        int dev = 0, cus = 0, per_cu = 0;
        if (hipGetDevice(&dev) != hipSuccess || hipDeviceGetAttribute(&cus, hipDeviceAttributeMultiprocessorCount, dev) != hipSuccess) { grid = -1; return; }
        if (hipFuncSetAttribute((const void*)mk_fwd, hipFuncAttributeMaxDynamicSharedMemorySize, LDS_BYTES) != hipSuccess) { fprintf(stderr, "kernel_launch: hipFuncSetAttribute failed\n"); grid = -1; return; }
        if (hipOccupancyMaxActiveBlocksPerMultiprocessor(&per_cu, (const void*)mk_fwd, NTHR, LDS_BYTES) != hipSuccess || per_cu < 1) { fprintf(stderr, "kernel_launch: occupancy query says %d blocks per CU\n", per_cu); (void)hipGetLastError(); grid = -1; return; }
        grid = cus * per_cu;
    }
    if (grid < 0) return;
    if (hipMemsetAsync(d_ws, 0, WS_ZERO_BYTES, stream) != hipSuccess) { fprintf(stderr, "kernel_launch: hipMemsetAsync failed\n"); return; }
    Args a{};
    for (int i = 0; i < 21; ++i) a.in[i] = (const float*)d_in[i];
    a.out = (float*)d_out; a.ws = (unsigned char*)d_ws;
    void* args[] = {&a};
    const hipError_t e = hipLaunchCooperativeKernel((const void*)mk_fwd, dim3(grid), dim3(NTHR), args, LDS_BYTES, stream);
    if (e != hipSuccess) fprintf(stderr, "kernel_launch: cooperative launch failed: %s (grid %d)\n", hipGetErrorString(e), grid);
}
```

```cpp
#include <hip/hip_runtime.h>
#include <hip/hip_cooperative_groups.h>
#include <cstdio>
#include <cstdint>
namespace cg = cooperative_groups;
namespace pg8 {
#define PG8_LAS __attribute__((address_space(3)))
typedef unsigned short bf16_t;
typedef short bf16x8 __attribute__((ext_vector_type(8)));
typedef float f32x4 __attribute__((ext_vector_type(4)));
typedef unsigned u32x4 __attribute__((ext_vector_type(4)));
constexpr int BM = 256, BK = 64, HALF = 128, HTB = HALF * BK * 2  , STAGE_BYTES = 8 * HTB, NXCD = 8, WGM = 8;

__host__ __device__ __forceinline__ int lds_byte(int r, int c) { const int st = (r >> 4) * 2 + (c >> 5), rr = r & 15, cc = c & 31, ob = rr * 64 + cc * 2; return st * 1024 + (ob ^ (((ob >> 9) & 1) << 5)); }
__host__ __device__ __forceinline__ void stage_rc(int b, int& R, int& C) { const int st = b / 1024, sb = b % 1024, swz = sb ^ (((sb >> 9) & 1) << 5); R = (st >> 1) * 16 + swz / 64; C = (st & 1) * 32 + (swz % 64) / 2; }
__host__ __device__ __forceinline__ int perm32(int rho) { const int n = rho >> 4, i = rho & 15; return 8 * (i >> 2) + 4 * n + (i & 3); }

struct Unit { int pm, pn; };
struct Gemm { const bf16_t* A; const bf16_t* Bt; int M, N, K; };

struct StaticOrder {
    int nM, nN, nwg, G, c;
    __host__ __device__ void init(int M, int N, int G_, int c_) { nM = M / BM; nN = N / BM; nwg = nM * nN; G = G_; c = c_; }
    __host__ __device__ bool next(int i, Unit& u) const {
        const long L = (long)i * G + c; if (L >= nwg) return false;
        int wgid = (int)L; { const int q = nwg / NXCD, r = nwg % NXCD, xcd = wgid % NXCD, off = wgid / NXCD; wgid = (xcd < r ? xcd * (q + 1) : r * (q + 1) + (xcd - r) * q) + off; }
        const int nig = WGM * nN, gid = wgid / nig, fm = gid * WGM, gsz = (nM - fm) < WGM ? (nM - fm) : WGM;
        u.pm = fm + ((wgid % nig) % gsz); u.pn = (wgid % nig) / gsz; return true;
    }
    __device__ __forceinline__ void a_ready(const Unit&) const {}
    __device__ __forceinline__ void done(const Unit&) const {}
};

__device__ __forceinline__ unsigned cvt_pk_bf16(float lo, float hi) { unsigned r; asm volatile("v_cvt_pk_bf16_f32 %0, %1, %2" : "=v"(r) : "v"(lo), "v"(hi)); return r; }
typedef unsigned u32x2 __attribute__((ext_vector_type(2)));
constexpr float RMS_EPS = 1e-6f;

struct EpiPlain {
    static constexpr bool PERM = true, AFTER_DRAIN = false;
    bf16_t* O; int ldc;
    __device__ __forceinline__ void operator()(const f32x4 (&acc)[2][2][4][2], const Unit& u, int wr, int wc, int fr, int fq) const {
        const int row0 = u.pm * BM + wr * 64 + fr, col0 = u.pn * BM + wc * 32 + 8 * fq;
#pragma unroll
        for (int ai = 0; ai < 2; ++ai)
#pragma unroll
            for (int m = 0; m < 4; ++m) { bf16_t* rowp = O + (size_t)(row0 + ai * HALF + m * 16) * ldc + col0;
#pragma unroll
                for (int bj = 0; bj < 2; ++bj) { const f32x4 v0 = acc[ai][bj][m][0], v1 = acc[ai][bj][m][1];
                    u32x4 w; w.x = cvt_pk_bf16(v0[0], v0[1]); w.y = cvt_pk_bf16(v0[2], v0[3]); w.z = cvt_pk_bf16(v1[0], v1[1]); w.w = cvt_pk_bf16(v1[2], v1[3]);
                    *(u32x4*)(rowp + bj * HALF) = w; } }
    }
};
struct EpiRowScale {
    static constexpr bool PERM = true, AFTER_DRAIN = false;
    bf16_t* O; int ldc; const float* SS; float inv_n;
    __device__ __forceinline__ void operator()(const f32x4 (&acc)[2][2][4][2], const Unit& u, int wr, int wc, int fr, int fq) const {
        const int row0 = u.pm * BM + wr * 64 + fr, col0 = u.pn * BM + wc * 32 + 8 * fq;
#pragma unroll
        for (int ai = 0; ai < 2; ++ai)
#pragma unroll
            for (int m = 0; m < 4; ++m) { const int row = row0 + ai * HALF + m * 16; bf16_t* rowp = O + (size_t)row * ldc + col0;
                const float rs = 1.0f / sqrtf(SS[row] * inv_n + RMS_EPS);
#pragma unroll
                for (int bj = 0; bj < 2; ++bj) { const f32x4 v0 = acc[ai][bj][m][0] * rs, v1 = acc[ai][bj][m][1] * rs;
                    u32x4 w; w.x = cvt_pk_bf16(v0[0], v0[1]); w.y = cvt_pk_bf16(v0[2], v0[3]); w.z = cvt_pk_bf16(v1[0], v1[1]); w.w = cvt_pk_bf16(v1[2], v1[3]);
                    *(u32x4*)(rowp + bj * HALF) = w; } }
    }
};
__device__ __forceinline__ float silu_mul(float g, float u) { return g * u * __builtin_amdgcn_rcpf(1.0f + __expf(-g)); }
struct EpiSwiglu {
    static constexpr bool PERM = true, AFTER_DRAIN = false;
    bf16_t* O; int ldc; const float* SS; float inv_n;
    __device__ __forceinline__ void operator()(const f32x4 (&acc)[2][2][4][2], const Unit& u, int wr, int wc, int fr, int fq) const {
        const int row0 = u.pm * BM + wr * 64 + fr, col0 = u.pn * HALF + wc * 32 + 8 * fq;
#pragma unroll
        for (int ai = 0; ai < 2; ++ai)
#pragma unroll
            for (int m = 0; m < 4; ++m) { const int row = row0 + ai * HALF + m * 16;
                const float rs = 1.0f / sqrtf(SS[row] * inv_n + RMS_EPS);
                const f32x4 g0 = acc[ai][0][m][0] * rs, g1 = acc[ai][0][m][1] * rs, u0 = acc[ai][1][m][0] * rs, u1 = acc[ai][1][m][1] * rs;
                u32x4 w;
                w.x = cvt_pk_bf16(silu_mul(g0[0], u0[0]), silu_mul(g0[1], u0[1])); w.y = cvt_pk_bf16(silu_mul(g0[2], u0[2]), silu_mul(g0[3], u0[3]));
                w.z = cvt_pk_bf16(silu_mul(g1[0], u1[0]), silu_mul(g1[1], u1[1])); w.w = cvt_pk_bf16(silu_mul(g1[2], u1[2]), silu_mul(g1[3], u1[3]));
                *(u32x4*)(O + (size_t)row * ldc + col0) = w; }
    }
};
template <bool RES_F32> struct EpiResid {
    static constexpr bool PERM = true, AFTER_DRAIN = false;
    const float* res32; const bf16_t* res16; bf16_t* xb; float* SS; int ldc;
    __device__ __forceinline__ void operator()(const f32x4 (&acc)[2][2][4][2], const Unit& u, int wr, int wc, int fr, int fq) const {
        const int col0 = u.pn * BM + wc * 32 + 8 * fq;
#pragma unroll
        for (int ai = 0; ai < 2; ++ai)
#pragma unroll
            for (int m = 0; m < 4; ++m) { const int row = u.pm * BM + ai * HALF + wr * 64 + m * 16 + fr; const size_t off = (size_t)row * ldc + col0; float s = 0.f;
#pragma unroll
                for (int bj = 0; bj < 2; ++bj) { f32x4 r0, r1;
                    if (RES_F32) { r0 = *(const f32x4*)(res32 + off + bj * HALF); r1 = *(const f32x4*)(res32 + off + bj * HALF + 4); }
                    else { const u32x4 rb = *(const u32x4*)(res16 + off + bj * HALF);
                        r0 = (f32x4){__uint_as_float(rb.x << 16), __uint_as_float(rb.x & 0xffff0000u), __uint_as_float(rb.y << 16), __uint_as_float(rb.y & 0xffff0000u)};
                        r1 = (f32x4){__uint_as_float(rb.z << 16), __uint_as_float(rb.z & 0xffff0000u), __uint_as_float(rb.w << 16), __uint_as_float(rb.w & 0xffff0000u)}; }
                    const f32x4 v0 = r0 + acc[ai][bj][m][0], v1 = r1 + acc[ai][bj][m][1];
                    u32x4 w; w.x = cvt_pk_bf16(v0[0], v0[1]); w.y = cvt_pk_bf16(v0[2], v0[3]); w.z = cvt_pk_bf16(v1[0], v1[1]); w.w = cvt_pk_bf16(v1[2], v1[3]);
                    *(u32x4*)(xb + off + bj * HALF) = w;
                    s += ((v0[0] * v0[0] + v0[1] * v0[1]) + (v0[2] * v0[2] + v0[3] * v0[3])) + ((v1[0] * v1[0] + v1[1] * v1[1]) + (v1[2] * v1[2] + v1[3] * v1[3])); }
                s += __shfl_xor(s, 16); s += __shfl_xor(s, 32); if (fq == 0) unsafeAtomicAdd(SS + row, s);
                asm volatile("" ::: "memory"); }
    }
};
template <class Epi, class Sched, bool ALIGN_EPI = false, bool SP2 = false>
__device__ __forceinline__ void gemm_phase(PG8_LAS unsigned char* lds, const Gemm g, const Sched& S, const Epi& E) {
    int tid_ = threadIdx.x; asm volatile("" : "+v"(tid_));
    const int tid = tid_, wid = __builtin_amdgcn_readfirstlane(tid >> 6), lane = tid & 63, wr = wid >> 2, wc = wid & 3, fr = lane & 15, fq = lane >> 4;
    const int K = g.K, nt = K / BK;
    unsigned voffA[2], voffB[2];
#pragma unroll
    for (int i = 0; i < 2; ++i) { int R, C; stage_rc(tid * 16 + i * 8192, R, C); const int Rb = Epi::PERM ? ((R & ~31) + perm32(R & 31)) : R;
        voffA[i] = (unsigned)(R * K + C) * 2u; voffB[i] = (unsigned)(Rb * K + C) * 2u; }
    const size_t kstep = (size_t)(BK * 2);
    const size_t hstep = (size_t)HALF * K * 2;
    const size_t tstep = 2 * hstep;
    const unsigned ldsw = (unsigned)wid * 1024u;
    const int aoff = lds_byte(wr * 64 + fr, fq * 8), boff = lds_byte(wc * 32 + fr, fq * 8);
#define PG8_SA(b, h) (((b) * 2 + (h)) * HTB)
#define PG8_SB(b, h) ((4 + (b) * 2 + (h)) * HTB)
#define PG8_STAGE(bufoff, gbase, voff) do { _Pragma("unroll") for (int _i = 0; _i < 2; ++_i) \
        __builtin_amdgcn_global_load_lds((const unsigned*)((const char*)(gbase) + (voff)[_i]), (PG8_LAS unsigned*)(lds + (bufoff) + ldsw + _i * 8192), 16, 0, 0); } while (0)
#define PG8_LDA(dst, b, h) do { _Pragma("unroll") for (int m = 0; m < 4; ++m) _Pragma("unroll") for (int k = 0; k < 2; ++k) dst[m][k] = *(const PG8_LAS bf16x8*)(lds + PG8_SA(b, h) + aoff + m * 2048 + k * 1024); } while (0)
#define PG8_LDB(dst, b, h) do { _Pragma("unroll") for (int n = 0; n < 2; ++n) _Pragma("unroll") for (int k = 0; k < 2; ++k) dst[n][k] = *(const PG8_LAS bf16x8*)(lds + PG8_SB(b, h) + boff + n * 2048 + k * 1024); } while (0)
#define PG8_MMA(ai, bj, At, Bt) do { __builtin_amdgcn_s_setprio(1); _Pragma("unroll") for (int m = 0; m < 4; ++m) _Pragma("unroll") for (int n = 0; n < 2; ++n) _Pragma("unroll") for (int k = 0; k < 2; ++k) \
        acc[ai][bj][m][n] = __builtin_amdgcn_mfma_f32_16x16x32_bf16(Bt[n][k], At[m][k], acc[ai][bj][m][n], 0, 0, 0); __builtin_amdgcn_s_setprio(0); } while (0)
#define PG8_WAIT_V(n) asm volatile("s_waitcnt vmcnt(" #n ")" ::: "memory")
#define PG8_WAIT_L(n) asm volatile("s_waitcnt lgkmcnt(" #n ")" ::: "memory")
#define PG8_BAR __builtin_amdgcn_s_barrier()
#define PG8_SCHED __builtin_amdgcn_sched_barrier(0)
    Unit cur, nxt; int ui = 0;
    if (!S.next(0, cur)) return;
    f32x4 acc[2][2][4][2];
#pragma unroll
    for (int a = 0; a < 2; ++a)
#pragma unroll
        for (int b = 0; b < 2; ++b)
#pragma unroll
            for (int m = 0; m < 4; ++m)
#pragma unroll
                for (int n = 0; n < 2; ++n) acc[a][b][m][n] = (f32x4){0.f, 0.f, 0.f, 0.f};
    bf16x8 At[4][2], B0[2][2], B1[2][2];
    const char* cA = (const char*)g.A + (size_t)cur.pm * tstep; const char* cB = (const char*)g.Bt + (size_t)cur.pn * tstep;
    S.a_ready(cur);
    if constexpr (SP2) {
        PG8_STAGE(PG8_SB(0, 0), cB, voffB); PG8_STAGE(PG8_SB(0, 1), cB + hstep, voffB); PG8_STAGE(PG8_SA(0, 0), cA, voffA); PG8_STAGE(PG8_SA(0, 1), cA + hstep, voffA);
        if (wr == 1) PG8_BAR;
        PG8_WAIT_V(2); PG8_BAR;
        PG8_STAGE(PG8_SB(1, 0), cB + kstep, voffB); PG8_STAGE(PG8_SA(1, 0), cA + kstep, voffA); PG8_STAGE(PG8_SB(1, 1), cB + hstep + kstep, voffB);
        PG8_WAIT_V(6); PG8_BAR;
    } else {
        PG8_STAGE(PG8_SB(0, 0), cB, voffB); PG8_STAGE(PG8_SA(0, 0), cA, voffA); PG8_STAGE(PG8_SB(0, 1), cB + hstep, voffB); PG8_STAGE(PG8_SA(0, 1), cA + hstep, voffA);
        if (wr == 1) PG8_BAR;
        PG8_WAIT_V(4); PG8_BAR;
        PG8_STAGE(PG8_SB(1, 0), cB + kstep, voffB); PG8_STAGE(PG8_SA(1, 0), cA + kstep, voffA); PG8_STAGE(PG8_SB(1, 1), cB + hstep + kstep, voffB);
        PG8_WAIT_V(6); PG8_BAR;
    }
    for (;;) {
        const bool has_next = S.next(ui + 1, nxt);
        const char* nA = has_next ? (const char*)g.A + (size_t)nxt.pm * tstep : cA; const char* nB = has_next ? (const char*)g.Bt + (size_t)nxt.pn * tstep : cB;
        for (int t = 0; t < nt; t += 2) {
            const bool last = (t == nt - 2);
            const char* a1 = cA + (size_t)(t + 1) * kstep;
            const char* a2 = last ? nA : cA + (size_t)(t + 2) * kstep; const char* b2 = last ? nB : cB + (size_t)(t + 2) * kstep;
            const char* a3 = a2 + kstep; const char* b3 = b2 + kstep;
            if (last && has_next) S.a_ready(nxt);
            if constexpr (SP2) {
            PG8_LDB(B0, 0, 0); PG8_LDB(B1, 0, 1); PG8_SCHED; PG8_LDA(At, 0, 0); PG8_STAGE(PG8_SA(1, 1), a1 + hstep, voffA);
            PG8_WAIT_V(8); PG8_WAIT_L(0); PG8_BAR; PG8_MMA(0, 0, At, B0); PG8_MMA(0, 1, At, B1); PG8_BAR; PG8_SCHED;
            PG8_LDA(At, 0, 1); PG8_STAGE(PG8_SB(0, 0), b2, voffB); PG8_STAGE(PG8_SB(0, 1), b2 + hstep, voffB); PG8_STAGE(PG8_SA(0, 0), a2, voffA);
            PG8_WAIT_V(8); PG8_WAIT_L(0); PG8_BAR; PG8_MMA(1, 0, At, B0); PG8_MMA(1, 1, At, B1); PG8_BAR; PG8_SCHED;
            PG8_LDB(B0, 1, 0); PG8_LDB(B1, 1, 1); PG8_SCHED; PG8_LDA(At, 1, 0); PG8_STAGE(PG8_SA(0, 1), a2 + hstep, voffA);
            PG8_WAIT_V(8); PG8_WAIT_L(0); PG8_BAR; PG8_MMA(0, 0, At, B0); PG8_MMA(0, 1, At, B1); PG8_BAR; PG8_SCHED;
            PG8_LDA(At, 1, 1); PG8_STAGE(PG8_SB(1, 0), b3, voffB); PG8_STAGE(PG8_SB(1, 1), b3 + hstep, voffB); PG8_STAGE(PG8_SA(1, 0), a3, voffA);
            PG8_WAIT_V(8); PG8_WAIT_L(0); PG8_BAR; PG8_MMA(1, 0, At, B0); PG8_MMA(1, 1, At, B1); PG8_BAR; PG8_SCHED;
            } else {
            PG8_LDB(B0, 0, 0); PG8_SCHED; PG8_LDA(At, 0, 0); PG8_STAGE(PG8_SA(1, 1), a1 + hstep, voffA);
            PG8_WAIT_L(8); PG8_BAR; PG8_WAIT_L(0); PG8_MMA(0, 0, At, B0); PG8_BAR; PG8_SCHED;
            PG8_LDB(B1, 0, 1); PG8_STAGE(PG8_SB(0, 0), b2, voffB);
            PG8_BAR; PG8_WAIT_L(0); PG8_MMA(0, 1, At, B1); PG8_BAR;
            PG8_LDA(At, 0, 1); PG8_STAGE(PG8_SA(0, 0), a2, voffA);
            PG8_BAR; PG8_WAIT_L(0); PG8_MMA(1, 0, At, B0); PG8_BAR; PG8_SCHED;
            PG8_STAGE(PG8_SB(0, 1), b2 + hstep, voffB);
            PG8_WAIT_V(6); PG8_BAR; PG8_MMA(1, 1, At, B1); PG8_BAR;
            PG8_LDB(B0, 1, 0); PG8_SCHED; PG8_LDA(At, 1, 0); PG8_STAGE(PG8_SA(0, 1), a2 + hstep, voffA);
            PG8_WAIT_L(8); PG8_BAR; PG8_WAIT_L(0); PG8_MMA(0, 0, At, B0); PG8_BAR; PG8_SCHED;
            PG8_LDB(B1, 1, 1); PG8_STAGE(PG8_SB(1, 0), b3, voffB);
            PG8_BAR; PG8_WAIT_L(0); PG8_MMA(0, 1, At, B1); PG8_BAR;
            PG8_LDA(At, 1, 1); PG8_STAGE(PG8_SA(1, 0), a3, voffA);
            PG8_BAR; PG8_WAIT_L(0); PG8_MMA(1, 0, At, B0); PG8_BAR; PG8_SCHED;
            PG8_STAGE(PG8_SB(1, 1), b3 + hstep, voffB);
            PG8_WAIT_V(6); PG8_BAR; PG8_MMA(1, 1, At, B1); PG8_BAR;
            }
        }
        if constexpr (ALIGN_EPI) { if (wr == 0) PG8_BAR; }
        if constexpr (!Epi::AFTER_DRAIN) { E(acc, cur, wr, wc, fr, fq); S.done(cur); }
        if (!has_next) break;
#pragma unroll
        for (int a = 0; a < 2; ++a)
#pragma unroll
            for (int b = 0; b < 2; ++b)
#pragma unroll
                for (int m = 0; m < 4; ++m)
#pragma unroll
                    for (int n = 0; n < 2; ++n) acc[a][b][m][n] = (f32x4){0.f, 0.f, 0.f, 0.f};
        cur = nxt; cA = nA; cB = nB; ++ui;
        if constexpr (ALIGN_EPI) { if (wr == 1) PG8_BAR; }
    }
    PG8_WAIT_V(0);
    if constexpr (!ALIGN_EPI) { if (wr == 0) PG8_BAR; }
    PG8_BAR;
    if constexpr (Epi::AFTER_DRAIN) { E.fused(acc, cur, wr, wc, fr, fq, lds, wid, lane); S.done(cur); }
#undef PG8_SA
#undef PG8_SB
#undef PG8_STAGE
#undef PG8_LDA
#undef PG8_LDB
#undef PG8_MMA
#undef PG8_WAIT_V
#undef PG8_WAIT_L
#undef PG8_BAR
#undef PG8_SCHED
}
}
#define LAS __attribute__((address_space(3)))
using pg8::bf16_t; using pg8::bf16x8; using pg8::f32x4; using pg8::u32x4; using pg8::u32x2; using pg8::cvt_pk_bf16; using pg8::RMS_EPS;
constexpr int BATCH = 4, SEQ = 4096, D = 2048, M = BATCH * SEQ, NMEM = 256, MM = BATCH * NMEM, DFF = 5632, DPOOL = 1024, DSGU = 1024;
constexpr int NWAVES = 8, NTHR = NWAVES * 64;
constexpr int LDS_BYTES = 147456;
constexpr size_t MiB = 1u << 20;
constexpr size_t WS_SS1 = 0, WS_SS2 = 65536, WS_SS3 = 131072, WS_BAR = 196608, WS_ZERO_BYTES = 262144;
constexpr size_t WS_WIN = 1 * MiB, WS_WOUT = 13 * MiB, WS_WQ = 21 * MiB, WS_WK = 29 * MiB, WS_WV = 37 * MiB, WS_WO = 45 * MiB, WS_WGU = 53 * MiB, WS_WD = 97 * MiB;
constexpr size_t WS_PW = 119 * MiB, WS_WSP = 119 * MiB + 512 * 1024;
constexpr size_t WS_MN = 120 * MiB, WS_KB = 124 * MiB, WS_VTM = 128 * MiB;
constexpr size_t WS_XB = 132 * MiB;
constexpr size_t WS_HG = 196 * MiB;
constexpr size_t WS_PAU = 196 * MiB, WS_Q = 196 * MiB, WS_VT = 260 * MiB, WS_Y = 292 * MiB, WS_O = 292 * MiB;
constexpr size_t WS_END = 372 * MiB;

__device__ __forceinline__ float bf_lo(unsigned w) { return __uint_as_float(w << 16); }
__device__ __forceinline__ float bf_hi(unsigned w) { return __uint_as_float(w & 0xffff0000u); }
__device__ __forceinline__ float wave_sum(float v) {
#pragma unroll
    for (int o = 1; o < 64; o <<= 1) v += __shfl_xor(v, o);
    return v;
}
#define LDS_WAIT() asm volatile("s_waitcnt lgkmcnt(0)" ::: "memory")
#define MFMA16(a, b, c) __builtin_amdgcn_mfma_f32_16x16x32_bf16((a), (b), (c), 0, 0, 0)

#define XB_TMO      128
#define XB_XCNT(j)  (256  + 64 * (j))
#define XB_XSUB(j)  (1280 + 64 * (j))
#define XB_XGEN(j)  (2304 + 64 * (j))
#define XB_TOP      3328
#define XB_TOPGEN   3392
#define XCD_BAR_WORDS 3456
#define XB_SPIN_CAP (1u << 18)

__device__ __forceinline__ unsigned xb_ld(unsigned* p)              { return __hip_atomic_load(p, __ATOMIC_RELAXED, __HIP_MEMORY_SCOPE_AGENT); }
__device__ __forceinline__ unsigned xb_add(unsigned* p, unsigned v) { return __hip_atomic_fetch_add(p, v, __ATOMIC_RELAXED, __HIP_MEMORY_SCOPE_AGENT); }
__device__ __forceinline__ unsigned xb_xcc_id() { return (unsigned)__builtin_amdgcn_s_getreg((3 << 11) | 20) & 0xFu; }
#define XB_SPIN(cond, bar) do { unsigned _sp = 0; while (cond) { __builtin_amdgcn_s_sleep(1); \
    if ((++_sp & 255u) == 0u) { if (xb_ld(&(bar)[XB_TMO])) break; if (_sp > XB_SPIN_CAP) { atomicAdd(&(bar)[XB_TMO], 1u); break; } } } } while (0)

struct XcdBarrier {
    unsigned* bar; unsigned x;
    volatile LAS unsigned* st;
};

__device__ __forceinline__ XcdBarrier xcd_barrier_post(unsigned* bar, volatile LAS unsigned* st) {
    XcdBarrier b; b.bar = bar; b.x = xb_xcc_id(); b.st = st;
    if (threadIdx.x == 0) (void)xb_add(&bar[XB_XCNT(b.x)], 1u);
    return b;
}
__device__ __forceinline__ void xcd_barrier_complete(unsigned* bar, unsigned x, unsigned& nloc, unsigned& nx) {
    const unsigned G = gridDim.x * gridDim.y * gridDim.z;
    unsigned sum, cnt, mine, sp = 0u;
    for (;;) {
        sum = 0u; cnt = 0u; mine = 0u;
#pragma unroll
        for (unsigned j = 0; j < 16; ++j) { const unsigned c = xb_ld(&bar[XB_XCNT(j)]); sum += c; cnt += (c > 0u) ? 1u : 0u; mine = (j == x) ? c : mine; }
        if (sum == G) break;
        __builtin_amdgcn_s_sleep(1);
        if ((++sp & 255u) == 0u) { if (xb_ld(&bar[XB_TMO])) break; if (sp > XB_SPIN_CAP) { atomicAdd(&bar[XB_TMO], 1u); break; } }
    }
    nloc = mine > 0u ? mine : 1u; nx = cnt > 0u ? cnt : 1u;
}

__device__ __forceinline__ void xcd_barrier(const XcdBarrier& b) {
    asm volatile("s_waitcnt vmcnt(0)" ::: "memory");
    __syncthreads();
    if (threadIdx.x == 0) {
        unsigned* bar = b.bar;
        __builtin_amdgcn_s_waitcnt(0);
        unsigned nloc = b.st[0], nx = b.st[1];
        if (nloc == 0u) { xcd_barrier_complete(bar, b.x, nloc, nx); b.st[0] = nloc; b.st[1] = nx; }
        const unsigned old = xb_add(&bar[XB_XSUB(b.x)], 1u);
        const unsigned gen = old / nloc;
        if (old + 1u == (gen + 1u) * nloc) {
            __builtin_amdgcn_fence(__ATOMIC_RELEASE, "agent");
            asm volatile("s_waitcnt vmcnt(0)" ::: "memory");
            const unsigned og = xb_add(&bar[XB_TOP], 1u);
            const unsigned tg = og / nx;
            if (og + 1u == (tg + 1u) * nx) xb_add(&bar[XB_TOPGEN], 1u);
            else XB_SPIN(xb_ld(&bar[XB_TOPGEN]) == tg, bar);
            __builtin_amdgcn_fence(__ATOMIC_ACQUIRE, "agent");
            xb_add(&bar[XB_XGEN(b.x)], 1u);
            asm volatile("s_waitcnt vmcnt(0)" ::: "memory");
        } else {
            XB_SPIN(xb_ld(&bar[XB_XGEN(b.x)]) == gen, bar);
            __builtin_amdgcn_fence(__ATOMIC_ACQUIRE, "agent");
            asm volatile("s_waitcnt vmcnt(0)" ::: "memory");
        }
    }
    __syncthreads();
}

__device__ __forceinline__ void tr_item(const float* W, int ldw, int k0, int n0, bf16_t* WT, int ldt, int orow0, const float* kgain, const float* nscale, LAS float* scr, int lane) {
#pragma unroll 4
    for (int i = 0; i < 16; ++i) { const int kk = 4 * i + (lane >> 4), nn = (lane & 15) * 4;
        f32x4 v = *(const f32x4*)(W + (size_t)(k0 + kk) * ldw + n0 + nn);
        if (kgain) v = v * kgain[k0 + kk];
        LAS float* s = scr + kk * 65 + nn; s[0] = v[0]; s[1] = v[1]; s[2] = v[2]; s[3] = v[3]; }
    LDS_WAIT();
    const int c = lane & 7;
#pragma unroll
    for (int j = 0; j < 8; ++j) { const int n = (lane >> 3) + 8 * j; const LAS float* s = scr + (8 * c) * 65 + n;
        const float sc = nscale ? nscale[n] : 1.0f;
        u32x4 o; o.x = cvt_pk_bf16(s[0 * 65] * sc, s[1 * 65] * sc); o.y = cvt_pk_bf16(s[2 * 65] * sc, s[3 * 65] * sc); o.z = cvt_pk_bf16(s[4 * 65] * sc, s[5 * 65] * sc); o.w = cvt_pk_bf16(s[6 * 65] * sc, s[7 * 65] * sc);
        *(u32x4*)(WT + (size_t)(orow0 + n) * ldt + k0 + 8 * c) = o; }
    LDS_WAIT();
}
__device__ __forceinline__ void norm_row_bf16(const float* xrow, const float* g, bf16_t* orow, int lane) {
    const f32x4* xr = (const f32x4*)xrow + lane; f32x4 v[8]; float s = 0.f;
#pragma unroll
    for (int j = 0; j < 8; ++j) { v[j] = xr[64 * j]; s += (v[j][0] * v[j][0] + v[j][1] * v[j][1]) + (v[j][2] * v[j][2] + v[j][3] * v[j][3]); }
    const float rstd = 1.0f / sqrtf(wave_sum(s) * (1.0f / D) + RMS_EPS);
    const f32x4* gr = (const f32x4*)g + lane; u32x2* o = (u32x2*)orow + lane;
#pragma unroll
    for (int j = 0; j < 8; ++j) { const f32x4 gg = gr[64 * j]; const f32x4 y = v[j] * rstd * gg; u32x2 w; w.x = cvt_pk_bf16(y[0], y[1]); w.y = cvt_pk_bf16(y[2], y[3]); o[64 * j] = w; }
}
__device__ __forceinline__ void norm_row_out(const bf16_t* xrow, float ss, const float* g, float* orow, int lane) {
    const float rstd = 1.0f / sqrtf(ss * (1.0f / D) + RMS_EPS);
#pragma unroll
    for (int j = 0; j < 4; ++j) { const int c = (lane + 64 * j) * 8; const u32x4 w = *(const u32x4*)(xrow + c);
        const f32x4 g0 = *(const f32x4*)(g + c), g1 = *(const f32x4*)(g + c + 4);
        const f32x4 y0 = (f32x4){bf_lo(w.x), bf_hi(w.x), bf_lo(w.y), bf_hi(w.y)} * rstd * g0, y1 = (f32x4){bf_lo(w.z), bf_hi(w.z), bf_lo(w.w), bf_hi(w.w)} * rstd * g1;
        *(f32x4*)(orow + c) = y0; *(f32x4*)(orow + c + 4) = y1; }
}

__device__ __forceinline__ void sgu_unit(LAS unsigned char* lds, int nb, const bf16_t* VT, const bf16_t* PAU, bf16_t* Y, const bf16_t* WSb, const float* sg, const float* bsp, int tid) {
    asm volatile("" : "+v"(tid));
    const int lane = tid & 63, wave = tid >> 6, fr = lane & 15, fq = lane >> 4;
    const int T0 = nb * 128;
    LAS float* red = (LAS float*)lds;
    LAS float* rstd = (LAS float*)(lds + 4096);
    LAS unsigned char* Bb = lds + 8192;
    {
        const int tg = tid & 15, rl = tid >> 4;
        float s[8];
#pragma unroll
        for (int e = 0; e < 8; ++e) s[e] = 0.f;
#pragma unroll 4
        for (int i = 0; i < 32; ++i) { const int c = rl + 32 * i; const u32x4 w = *(const u32x4*)(VT + (size_t)c * M + T0 + tg * 8);
#pragma unroll
            for (int e = 0; e < 4; ++e) { const float lo = bf_lo(w[e]), hi = bf_hi(w[e]); s[2 * e] += lo * lo; s[2 * e + 1] += hi * hi; } }
#pragma unroll
        for (int e = 0; e < 8; ++e) { s[e] += __shfl_xor(s[e], 16); s[e] += __shfl_xor(s[e], 32); }
        if (fq == 0) {
#pragma unroll
            for (int e = 0; e < 8; ++e) red[wave * 128 + tg * 8 + e] = s[e]; }
    }
    __syncthreads();
    if (tid < 128) { float t = 0.f;
#pragma unroll
        for (int w = 0; w < 8; ++w) t += red[w * 128 + tid];
        rstd[tid] = 1.0f / sqrtf(t * (1.0f / DSGU) + RMS_EPS); }
    __syncthreads();
    const int wr = wave >> 1, wc = wave & 1;
    for (int h = 0; h < 8; ++h) {
        LAS unsigned char* B = Bb + (h & 1) * 34816;
#pragma unroll
        for (int i = 0; i < 4; ++i) { const int p = tid + 512 * i, c = p >> 4, sgp = p & 15;
            const u32x4 w = *(const u32x4*)(VT + (size_t)(h * 128 + c) * M + T0 + sgp * 8);
            const float g = sg[h * 128 + c];
            const f32x4 r0 = *(const LAS f32x4*)(rstd + sgp * 8) * g, r1 = *(const LAS f32x4*)(rstd + sgp * 8 + 4) * g;
            u32x4 o; o.x = cvt_pk_bf16(bf_lo(w.x) * r0[0], bf_hi(w.x) * r0[1]); o.y = cvt_pk_bf16(bf_lo(w.y) * r0[2], bf_hi(w.y) * r0[3]);
            o.z = cvt_pk_bf16(bf_lo(w.z) * r1[0], bf_hi(w.z) * r1[1]); o.w = cvt_pk_bf16(bf_lo(w.w) * r1[2], bf_hi(w.w) * r1[3]);
            *(LAS u32x4*)(B + c * 272 + sgp * 16) = o; }
        __syncthreads();
        f32x4 acc[2][4];
#pragma unroll
        for (int m = 0; m < 2; ++m)
#pragma unroll
            for (int n = 0; n < 4; ++n) acc[m][n] = (f32x4){0.f, 0.f, 0.f, 0.f};
#pragma unroll
        for (int ks = 0; ks < 4; ++ks) { bf16x8 a[2], b[4];
#pragma unroll
            for (int m = 0; m < 2; ++m) a[m] = *(const bf16x8*)(WSb + (size_t)((h * 128 + wr * 32 + m * 16 + fr) * 128 + ks * 32 + fq * 8));
#pragma unroll
            for (int n = 0; n < 4; ++n) b[n] = *(const LAS bf16x8*)(B + (wc * 64 + n * 16 + fr) * 272 + (ks * 32 + fq * 8) * 2);
#pragma unroll
            for (int m = 0; m < 2; ++m)
#pragma unroll
                for (int n = 0; n < 4; ++n) acc[m][n] = MFMA16(b[n], a[m], acc[m][n]); }
#pragma unroll
        for (int m = 0; m < 2; ++m) { const int t = wr * 32 + m * 16 + fr; const float bias = bsp[h * 128 + t];
#pragma unroll
            for (int n = 0; n < 4; ++n) { const size_t off = (size_t)(T0 + t) * D + DPOOL + h * 128 + wc * 64 + n * 16 + fq * 4;
                const u32x2 uu = *(const u32x2*)(PAU + off); const f32x4 mx = acc[m][n] + bias;
                u32x2 o; o.x = cvt_pk_bf16(bf_lo(uu.x) * mx[0], bf_hi(uu.x) * mx[1]); o.y = cvt_pk_bf16(bf_lo(uu.y) * mx[2], bf_hi(uu.y) * mx[3]);
                *(u32x2*)(Y + off) = o; } }
    }
    __syncthreads();
}
__device__ __forceinline__ void pool_unit(LAS unsigned char* lds, int nb, const bf16_t* PAU, bf16_t* Y, const bf16_t* PWt, int tid) {
    asm volatile("" : "+v"(tid));
    const int lane = tid & 63, wave = tid >> 6, fr = lane & 15, fq = lane >> 4;
    const int T0 = nb * 128, tp0 = T0 & (SEQ - 1);
    LAS unsigned char* A = lds;
    for (int g = 0; g < 4; ++g) {
        const int w = 2 << g;
        {   const int cgp = tid & 31, ts = (tid >> 5) * 8; const bf16_t* base = PAU + g * 256 + cgp * 8;
            float S[8];
#pragma unroll
            for (int e = 0; e < 8; ++e) S[e] = 0.f;
            for (int j = 1; j < w; ++j) { if (tp0 + ts - j >= 0) { const u32x4 q = *(const u32x4*)(base + (size_t)(T0 + ts - j) * D);
#pragma unroll
                for (int e = 0; e < 4; ++e) { S[2 * e] += bf_lo(q[e]); S[2 * e + 1] += bf_hi(q[e]); } } }
#pragma unroll
            for (int i = 0; i < 8; ++i) { const int t = ts + i, tp = tp0 + t; const u32x4 q = *(const u32x4*)(base + (size_t)(T0 + t) * D);
                float cur[8], p[8];
#pragma unroll
                for (int e = 0; e < 4; ++e) { cur[2 * e] = bf_lo(q[e]); cur[2 * e + 1] = bf_hi(q[e]); }
                const float inv = 1.0f / (float)(tp + 1 < w ? tp + 1 : w);
#pragma unroll
                for (int e = 0; e < 8; ++e) { S[e] += cur[e]; p[e] = S[e] * inv - cur[e]; }
                u32x4 o; o.x = cvt_pk_bf16(p[0], p[1]); o.y = cvt_pk_bf16(p[2], p[3]); o.z = cvt_pk_bf16(p[4], p[5]); o.w = cvt_pk_bf16(p[6], p[7]);
                *(LAS u32x4*)(A + t * 528 + cgp * 16) = o;
                if (tp - w + 1 >= 0) { const u32x4 r = *(const u32x4*)(base + (size_t)(T0 + t - w + 1) * D);
#pragma unroll
                    for (int e = 0; e < 4; ++e) { S[2 * e] -= bf_lo(r[e]); S[2 * e + 1] -= bf_hi(r[e]); } } }
        }
        __syncthreads();
        f32x4 acc[8][2];
#pragma unroll
        for (int m = 0; m < 8; ++m)
#pragma unroll
            for (int n = 0; n < 2; ++n) acc[m][n] = (f32x4){0.f, 0.f, 0.f, 0.f};
#pragma unroll 2
        for (int ks = 0; ks < 8; ++ks) { bf16x8 b[2];
#pragma unroll
            for (int n = 0; n < 2; ++n) b[n] = *(const bf16x8*)(PWt + (size_t)((g * 256 + wave * 32 + n * 16 + fr) * 256 + ks * 32 + fq * 8));
#pragma unroll
            for (int m = 0; m < 8; ++m) { const bf16x8 a = *(const LAS bf16x8*)(A + (m * 16 + fr) * 528 + (ks * 32 + fq * 8) * 2);
#pragma unroll
                for (int n = 0; n < 2; ++n) acc[m][n] = MFMA16(b[n], a, acc[m][n]); } }
#pragma unroll
        for (int m = 0; m < 8; ++m)
#pragma unroll
            for (int n = 0; n < 2; ++n) { const size_t off = (size_t)(T0 + m * 16 + fr) * D + g * 256 + wave * 32 + n * 16 + fq * 4; const f32x4 v = acc[m][n];
                u32x2 o; o.x = cvt_pk_bf16(v[0], v[1]); o.y = cvt_pk_bf16(v[2], v[3]); *(u32x2*)(Y + off) = o; }
        __syncthreads();
    }
}
__device__ __forceinline__ void attn_unit(LAS unsigned char* lds, int unit, const bf16_t* Q, const bf16_t* KB, const bf16_t* VTM, bf16_t* O, int tid) {
    asm volatile("" : "+v"(tid));
    const int lane = tid & 63, wave = tid >> 6, fr = lane & 15, fq = lane >> 4, wr = wave >> 1, wc = wave & 1;
    const int qt = unit & 31, h = (unit >> 5) & 3, b = unit >> 7;
    const int R0 = b * SEQ + qt * 128;
    LAS unsigned char* P = lds;
    LAS float* xm = (LAS float*)(lds + 67584);
    LAS float* xs = xm + 256;
    f32x4 acc[2][8];
#pragma unroll
    for (int m = 0; m < 2; ++m)
#pragma unroll
        for (int n = 0; n < 8; ++n) acc[m][n] = (f32x4){0.f, 0.f, 0.f, 0.f};
    const bf16_t* qp = Q + (size_t)(R0 + wr * 32 + fr) * D + h * 512 + fq * 8;
    const bf16_t* kp = KB + (size_t)(b * NMEM + wc * 128 + fr) * D + h * 512 + fq * 8;
#pragma unroll 2
    for (int ks = 0; ks < 16; ++ks) { bf16x8 a[2], bb[8];
#pragma unroll
        for (int m = 0; m < 2; ++m) a[m] = *(const bf16x8*)(qp + (size_t)m * 16 * D + ks * 32);
#pragma unroll
        for (int n = 0; n < 8; ++n) bb[n] = *(const bf16x8*)(kp + (size_t)n * 16 * D + ks * 32);
#pragma unroll
        for (int m = 0; m < 2; ++m)
#pragma unroll
            for (int n = 0; n < 8; ++n) acc[m][n] = MFMA16(bb[n], a[m], acc[m][n]); }
    const float sc = 0.044194173824159216f;
#pragma unroll
    for (int m = 0; m < 2; ++m) { float v = -3.0e38f;
#pragma unroll
        for (int n = 0; n < 8; ++n) { acc[m][n] = acc[m][n] * sc; v = fmaxf(v, fmaxf(fmaxf(acc[m][n][0], acc[m][n][1]), fmaxf(acc[m][n][2], acc[m][n][3]))); }
        v = fmaxf(v, __shfl_xor(v, 16)); v = fmaxf(v, __shfl_xor(v, 32));
        if (fq == 0) xm[wc * 128 + wr * 32 + m * 16 + fr] = v; }
    __syncthreads();
#pragma unroll
    for (int m = 0; m < 2; ++m) { const int row = wr * 32 + m * 16 + fr; const float mx = fmaxf(xm[row], xm[128 + row]); float s = 0.f;
#pragma unroll
        for (int n = 0; n < 8; ++n) { const float p0 = __expf(acc[m][n][0] - mx), p1 = __expf(acc[m][n][1] - mx), p2 = __expf(acc[m][n][2] - mx), p3 = __expf(acc[m][n][3] - mx);
            s += (p0 + p1) + (p2 + p3);
            u32x2 o; o.x = cvt_pk_bf16(p0, p1); o.y = cvt_pk_bf16(p2, p3);
            *(LAS u32x2*)(P + row * 528 + (wc * 128 + n * 16 + fq * 4) * 2) = o; }
        s += __shfl_xor(s, 16); s += __shfl_xor(s, 32);
        if (fq == 0) xs[wc * 128 + row] = s; }
    __syncthreads();
    float inv[2];
#pragma unroll
    for (int m = 0; m < 2; ++m) { const int row = wr * 32 + m * 16 + fr; inv[m] = 1.0f / (xs[row] + xs[128 + row]); }
    f32x4 o[2][16];
#pragma unroll
    for (int m = 0; m < 2; ++m)
#pragma unroll
        for (int n = 0; n < 16; ++n) o[m][n] = (f32x4){0.f, 0.f, 0.f, 0.f};
    const bf16_t* vp = VTM + (size_t)(h * 512 + wc * 256 + fr) * MM + b * NMEM + fq * 8;
    for (int ks = 0; ks < 8; ++ks) { bf16x8 a[2];
#pragma unroll
        for (int m = 0; m < 2; ++m) a[m] = *(const LAS bf16x8*)(P + (wr * 32 + m * 16 + fr) * 528 + (ks * 32 + fq * 8) * 2);
#pragma unroll
        for (int n = 0; n < 16; ++n) { const bf16x8 bv = *(const bf16x8*)(vp + (size_t)n * 16 * MM + ks * 32);
#pragma unroll
            for (int m = 0; m < 2; ++m) o[m][n] = MFMA16(bv, a[m], o[m][n]); } }
#pragma unroll
    for (int m = 0; m < 2; ++m) { const size_t rowoff = (size_t)(R0 + wr * 32 + m * 16 + fr) * D + h * 512 + wc * 256 + fq * 4;
#pragma unroll
        for (int n = 0; n < 16; ++n) { const f32x4 v = o[m][n] * inv[m]; u32x2 w; w.x = cvt_pk_bf16(v[0], v[1]); w.y = cvt_pk_bf16(v[2], v[3]); *(u32x2*)(O + rowoff + n * 16) = w; } }
    __syncthreads();
}

#ifndef REP_P0
#define REP_P0 1
#endif
#ifndef REP_P0N
#define REP_P0N 1
#endif
#ifndef REP_P1
#define REP_P1 1
#endif
#ifndef REP_P3
#define REP_P3 1
#endif
#ifndef REP_P7
#define REP_P7 1
#endif
#ifndef REP_P2
#define REP_P2 1
#endif
#ifndef REP_P5
#define REP_P5 1
#endif
#ifndef REP_SYNC
#define REP_SYNC 1
#endif
#ifndef REP_P4
#define REP_P4 1
#endif
struct Args { const float* in[21]; float* out; unsigned char* ws; };
#define GEMM_PHASE(EPI, g, S, E) pg8::gemm_phase<EPI, pg8::StaticOrder, true, true>(lds, g, S, E)
__global__ void __launch_bounds__(NTHR, 2) mk_fwd(Args a) {
    extern __shared__ __attribute__((aligned(16))) unsigned char lds_raw[];
    LAS unsigned char* lds = (LAS unsigned char*)lds_raw;
    cg::grid_group grid = cg::this_grid();
    const int G = gridDim.x, bx = blockIdx.x;
    volatile LAS unsigned* bar_st = (volatile LAS unsigned*)(lds + LDS_BYTES - 64);
    if (threadIdx.x < 2) bar_st[threadIdx.x] = 0u;
    __syncthreads();
    const XcdBarrier xbar = xcd_barrier_post((unsigned*)(a.ws + WS_BAR), bar_st);
#define TID_FRESH() ({ int t_ = threadIdx.x; asm volatile("" : "+v"(t_)); t_; })
    const float *x = a.in[0], *mem = a.in[1], *norm_mix_g = a.in[2], *w_in = a.in[3], *pool_w = a.in[4], *pool_scale = a.in[5], *sgu_norm_g = a.in[6], *w_spatial = a.in[7], *b_spatial = a.in[8],
                *w_out = a.in[9], *norm_xattn_g = a.in[10], *norm_mem_g = a.in[11], *w_q = a.in[12], *w_k = a.in[13], *w_v = a.in[14], *w_o = a.in[15], *norm_ffn_g = a.in[16],
                *w_gate = a.in[17], *w_up = a.in[18], *w_down = a.in[19], *final_norm_g = a.in[20];
    float* out = a.out; unsigned char* ws = a.ws;
    float *SS1 = (float*)(ws + WS_SS1), *SS2 = (float*)(ws + WS_SS2), *SS3 = (float*)(ws + WS_SS3);
    bf16_t *Win_t = (bf16_t*)(ws + WS_WIN), *Wout_t = (bf16_t*)(ws + WS_WOUT), *Wq_t = (bf16_t*)(ws + WS_WQ), *Wk_t = (bf16_t*)(ws + WS_WK), *Wv_t = (bf16_t*)(ws + WS_WV), *Wo_t = (bf16_t*)(ws + WS_WO),
           *Wgu_t = (bf16_t*)(ws + WS_WGU), *Wd_t = (bf16_t*)(ws + WS_WD), *PWt = (bf16_t*)(ws + WS_PW), *WSb = (bf16_t*)(ws + WS_WSP), *MN = (bf16_t*)(ws + WS_MN), *KB = (bf16_t*)(ws + WS_KB),
           *VTM = (bf16_t*)(ws + WS_VTM), *XB = (bf16_t*)(ws + WS_XB), *HG = (bf16_t*)(ws + WS_HG), *PAU = (bf16_t*)(ws + WS_PAU), *Qb = (bf16_t*)(ws + WS_Q), *VT = (bf16_t*)(ws + WS_VT),
           *Yb = (bf16_t*)(ws + WS_Y), *Ob = (bf16_t*)(ws + WS_O);

    {
        const int tid = TID_FRESH(), lane = tid & 63, wave = __builtin_amdgcn_readfirstlane(tid >> 6);
        LAS float* scr = (LAS float*)(lds + wave * 16640);
        const int gw = bx * NWAVES + wave, NGW = G * NWAVES;
        constexpr int I_IN = 32 * 48, I_SQ = 32 * 32, I_GU = 32 * 88, I_DN = 88 * 32, I_PW = 4 * 16;
        constexpr int NITEMS = I_IN + 5 * I_SQ + 2 * I_GU + I_DN + I_PW;
        for (int it = gw; it < NITEMS * REP_P0; it += NGW) {
            int r = it % NITEMS;
            if (r < I_IN) { tr_item(w_in, 3072, (r / 48) * 64, (r % 48) * 64, Win_t, D, (r % 48) * 64, nullptr, nullptr, scr, lane); continue; } r -= I_IN;
            if (r < I_SQ) { tr_item(w_out, D, (r / 32) * 64, (r % 32) * 64, Wout_t, D, (r % 32) * 64, nullptr, nullptr, scr, lane); continue; } r -= I_SQ;
            if (r < I_SQ) { tr_item(w_q, D, (r / 32) * 64, (r % 32) * 64, Wq_t, D, (r % 32) * 64, norm_xattn_g, nullptr, scr, lane); continue; } r -= I_SQ;
            if (r < I_SQ) { tr_item(w_k, D, (r / 32) * 64, (r % 32) * 64, Wk_t, D, (r % 32) * 64, nullptr, nullptr, scr, lane); continue; } r -= I_SQ;
            if (r < I_SQ) { tr_item(w_v, D, (r / 32) * 64, (r % 32) * 64, Wv_t, D, (r % 32) * 64, nullptr, nullptr, scr, lane); continue; } r -= I_SQ;
            if (r < I_SQ) { tr_item(w_o, D, (r / 32) * 64, (r % 32) * 64, Wo_t, D, (r % 32) * 64, nullptr, nullptr, scr, lane); continue; } r -= I_SQ;
            if (r < 2 * I_GU) { const int up = r >= I_GU; if (up) r -= I_GU; const int n0 = (r % 88) * 64;
                tr_item(up ? w_up : w_gate, DFF, (r / 88) * 64, n0, Wgu_t, D, (n0 >> 7) * 256 + (n0 & 127) + up * 128, norm_ffn_g, nullptr, scr, lane); continue; } r -= 2 * I_GU;
            if (r < I_DN) { tr_item(w_down, D, (r / 32) * 64, (r % 32) * 64, Wd_t, DFF, (r % 32) * 64, nullptr, nullptr, scr, lane); continue; } r -= I_DN;
            { const int g = r >> 4, q = r & 15; tr_item(pool_w + (size_t)g * 65536, 256, (q >> 2) * 64, (q & 3) * 64, PWt + (size_t)g * 65536, 256, (q & 3) * 64, nullptr, pool_scale + g * 256 + (q & 3) * 64, scr, lane); }
        }
        for (int i = bx * NTHR + tid; i < 8 * 128 * 128 / 4; i += G * NTHR) { const f32x4 v = *((const f32x4*)w_spatial + i); const int s = (i * 4) & 127, t = ((i * 4) >> 7) & 127;
            const bool keep = (s >> 6) <= (t >> 6); u32x2 o; o.x = keep ? cvt_pk_bf16(v[0], v[1]) : 0u; o.y = keep ? cvt_pk_bf16(v[2], v[3]) : 0u; *((u32x2*)WSb + i) = o; }
        for (int mm = gw; mm < M * REP_P0N; mm += NGW) { const int m = mm & (M - 1); norm_row_bf16(x + (size_t)m * D, norm_mix_g, XB + (size_t)m * D, lane); }
        for (int m = gw; m < MM; m += NGW) norm_row_bf16(mem + (size_t)m * D, norm_mem_g, MN + (size_t)m * D, lane);
    }
    for (int rep = 0; rep < REP_SYNC; ++rep) grid.sync();
    for (int rep = 0; rep < REP_P1; ++rep) {
        { pg8::Gemm g{XB, Win_t, M, 2048, D}; pg8::StaticOrder S; S.init(M, 2048, G, bx); pg8::EpiPlain E{PAU, D}; GEMM_PHASE(pg8::EpiPlain, g, S, E); }
        { pg8::Gemm g{Win_t + (size_t)2048 * D, XB, 1024, M, D}; pg8::StaticOrder S; S.init(1024, M, G, bx); pg8::EpiPlain E{VT, M}; GEMM_PHASE(pg8::EpiPlain, g, S, E); }
        { pg8::Gemm g{MN, Wk_t, MM, D, D}; pg8::StaticOrder S; S.init(MM, D, G, bx); pg8::EpiPlain E{KB, D}; GEMM_PHASE(pg8::EpiPlain, g, S, E); }
        { pg8::Gemm g{Wv_t, MN, D, MM, D}; pg8::StaticOrder S; S.init(D, MM, G, (bx + G - 32) % G); pg8::EpiPlain E{VTM, MM}; GEMM_PHASE(pg8::EpiPlain, g, S, E); }
    }
    xcd_barrier(xbar);
    for (int uu = bx; uu < 256 * REP_P2; uu += G) { const int u = uu & 255; if (u & 1) pool_unit(lds, u >> 1, PAU, Yb, PWt, (int)threadIdx.x); else sgu_unit(lds, u >> 1, VT, PAU, Yb, WSb, sgu_norm_g, b_spatial, (int)threadIdx.x); }
    xcd_barrier(xbar);
    for (int rep = 0; rep < REP_P3; ++rep) { pg8::Gemm g{Yb, Wout_t, M, D, D}; pg8::StaticOrder S; S.init(M, D, G, bx); pg8::EpiResid<true> E{x, nullptr, XB, rep ? (float*)(ws + WS_VT) : SS1, D}; GEMM_PHASE(pg8::EpiResid<true>, g, S, E); }
    xcd_barrier(xbar);
    for (int rep = 0; rep < REP_P4; ++rep) { pg8::Gemm g{XB, Wq_t, M, D, D}; pg8::StaticOrder S; S.init(M, D, G, bx); pg8::EpiRowScale E{Qb, D, SS1, 1.0f / D}; GEMM_PHASE(pg8::EpiRowScale, g, S, E); }
    xcd_barrier(xbar);
    for (int u = bx; u < 512 * REP_P5; u += G) attn_unit(lds, u & 511, Qb, KB, VTM, Ob, (int)threadIdx.x);
    xcd_barrier(xbar);
    { pg8::Gemm g{Ob, Wo_t, M, D, D}; pg8::StaticOrder S; S.init(M, D, G, bx); pg8::EpiResid<false> E{nullptr, XB, XB, SS2, D}; GEMM_PHASE(pg8::EpiResid<false>, g, S, E); }
    xcd_barrier(xbar);
    for (int rep = 0; rep < REP_P7; ++rep) { pg8::Gemm g{XB, Wgu_t, M, 2 * DFF, D}; pg8::StaticOrder S; S.init(M, 2 * DFF, G, bx); pg8::EpiSwiglu E{HG, DFF, SS2, 1.0f / D}; GEMM_PHASE(pg8::EpiSwiglu, g, S, E); }
    xcd_barrier(xbar);
    { pg8::Gemm g{HG, Wd_t, M, D, DFF}; pg8::StaticOrder S; S.init(M, D, G, bx); pg8::EpiResid<false> E{nullptr, XB, XB, SS3, D}; GEMM_PHASE(pg8::EpiResid<false>, g, S, E); }
    xcd_barrier(xbar);
    { const int tid = TID_FRESH(), lane = tid & 63, wave = __builtin_amdgcn_readfirstlane(tid >> 6); const int gw = bx * NWAVES + wave, NGW = G * NWAVES; for (int m = gw; m < M; m += NGW) norm_row_out(XB + (size_t)m * D, SS3[m], final_norm_g, out + (size_t)m * D, lane); }
}

extern "C" void kernel_launch(void* const* d_in, const int* in_sizes, int n_in, void* d_out, int out_size, void* d_ws, size_t ws_size, hipStream_t stream) {
    static int grid = 0;
    if (grid == 0) {
        if (n_in != 21 || in_sizes[0] != M * D || out_size != M * D || ws_size < WS_END) { fprintf(stderr, "kernel_launch: unexpected shapes (n_in %d, in0 %d, out %d, ws %zu); nothing launched\n", n_in, n_in > 0 ? in_sizes[0] : -1, out_size, ws_size); grid = -1; return; }
        int dev = 0, cus = 0, per_cu = 0;
        if (hipGetDevice(&dev) != hipSuccess || hipDeviceGetAttribute(&cus, hipDeviceAttributeMultiprocessorCount, dev) != hipSuccess) { grid = -1; return; }
        if (hipFuncSetAttribute((const void*)mk_fwd, hipFuncAttributeMaxDynamicSharedMemorySize, LDS_BYTES) != hipSuccess) { fprintf(stderr, "kernel_launch: hipFuncSetAttribute failed\n"); grid = -1; return; }
        if (hipOccupancyMaxActiveBlocksPerMultiprocessor(&per_cu, (const void*)mk_fwd, NTHR, LDS_BYTES) != hipSuccess || per_cu < 1) { fprintf(stderr, "kernel_launch: occupancy query says %d blocks per CU\n", per_cu); (void)hipGetLastError(); grid = -1; return; }
        grid = cus * per_cu;
    }
    if (grid < 0) return;
    if (hipMemsetAsync(d_ws, 0, WS_ZERO_BYTES, stream) != hipSuccess) { fprintf(stderr, "kernel_launch: hipMemsetAsync failed\n"); return; }
    Args a{};
    for (int i = 0; i < 21; ++i) a.in[i] = (const float*)d_in[i];
    a.out = (float*)d_out; a.ws = (unsigned char*)d_ws;
    void* args[] = {&a};
    const hipError_t e = hipLaunchCooperativeKernel((const void*)mk_fwd, dim3(grid), dim3(NTHR), args, LDS_BYTES, stream);
    if (e != hipSuccess) fprintf(stderr, "kernel_launch: cooperative launch failed: %s (grid %d)\n", hipGetErrorString(e), grid);
}
```

```cpp
#include <hip/hip_runtime.h>
#include <hip/hip_cooperative_groups.h>
#include <cstdio>
#include <cstdint>
namespace cg = cooperative_groups;
namespace pg8 {
#define PG8_LAS __attribute__((address_space(3)))
typedef unsigned short bf16_t;
typedef short bf16x8 __attribute__((ext_vector_type(8)));
typedef float f32x4 __attribute__((ext_vector_type(4)));
typedef unsigned u32x4 __attribute__((ext_vector_type(4)));
constexpr int BM = 256, BK = 64, HALF = 128, HTB = HALF * BK * 2  , STAGE_BYTES = 8 * HTB, NXCD = 8, WGM = 8;

__host__ __device__ __forceinline__ int lds_byte(int r, int c) { const int st = (r >> 4) * 2 + (c >> 5), rr = r & 15, cc = c & 31, ob = rr * 64 + cc * 2; return st * 1024 + (ob ^ (((ob >> 9) & 1) << 5)); }
__host__ __device__ __forceinline__ void stage_rc(int b, int& R, int& C) { const int st = b / 1024, sb = b % 1024, swz = sb ^ (((sb >> 9) & 1) << 5); R = (st >> 1) * 16 + swz / 64; C = (st & 1) * 32 + (swz % 64) / 2; }
__host__ __device__ __forceinline__ int perm32(int rho) { const int n = rho >> 4, i = rho & 15; return 8 * (i >> 2) + 4 * n + (i & 3); }

struct Unit { int pm, pn; };
struct Gemm { const bf16_t* A; const bf16_t* Bt; int M, N, K, ld; };

struct StaticOrder {
    int nM, nN, nwg, G, c;
    __host__ __device__ void init(int M, int N, int G_, int c_) { nM = M / BM; nN = N / BM; nwg = nM * nN; G = G_; c = c_; }
    __host__ __device__ bool next(int i, Unit& u) const {
        const long L = (long)i * G + c; if (L >= nwg) return false;
        int wgid = (int)L; { const int q = nwg / NXCD, r = nwg % NXCD, xcd = wgid % NXCD, off = wgid / NXCD; wgid = (xcd < r ? xcd * (q + 1) : r * (q + 1) + (xcd - r) * q) + off; }
        const int nig = WGM * nN, gid = wgid / nig, fm = gid * WGM, gsz = (nM - fm) < WGM ? (nM - fm) : WGM;
        u.pm = fm + ((wgid % nig) % gsz); u.pn = (wgid % nig) / gsz; return true;
    }
    __device__ __forceinline__ void a_ready(const Unit&) const {}
    __device__ __forceinline__ void done(const Unit&) const {}
    __device__ __forceinline__ const char* pA(const Gemm& g, const Unit& u) const { return (const char*)g.A + (size_t)u.pm * BM * g.ld * 2; }
    __device__ __forceinline__ const char* pB(const Gemm& g, const Unit& u) const { return (const char*)g.Bt + (size_t)u.pn * BM * g.ld * 2; }
};
struct AttnSOrder {
    int G, c;
    __device__ bool next(int i, Unit& u) const { const int L = i * G + c; if (L >= 256) return false; u.pm = L >> 2; u.pn = L & 3; return true; }
    __device__ __forceinline__ void a_ready(const Unit&) const {}
    __device__ __forceinline__ void done(const Unit&) const {}
    __device__ __forceinline__ const char* pA(const Gemm& g, const Unit& u) const { return (const char*)(g.A + (size_t)u.pm * BM * 2048 + u.pn * 512); }
    __device__ __forceinline__ const char* pB(const Gemm& g, const Unit& u) const { return (const char*)(g.Bt + (size_t)(u.pm >> 4) * 256 * 2048 + u.pn * 512); }
};
struct AttnPVOrder {
    int G, c;
    __device__ bool next(int i, Unit& u) const { const int L = i * G + c; if (L >= 512) return false; u.pm = L >> 3; u.pn = L & 7; return true; }
    __device__ __forceinline__ void a_ready(const Unit&) const {}
    __device__ __forceinline__ void done(const Unit&) const {}
    __device__ __forceinline__ const char* pA(const Gemm& g, const Unit& u) const { return (const char*)(g.A + (size_t)u.pm * BM * 1024 + (u.pn >> 1) * 256); }
    __device__ __forceinline__ const char* pB(const Gemm& g, const Unit& u) const { return (const char*)(g.Bt + (size_t)u.pn * BM * 1024 + (u.pm >> 4) * 256); }
};

__device__ __forceinline__ unsigned cvt_pk_bf16(float lo, float hi) { unsigned r; asm volatile("v_cvt_pk_bf16_f32 %0, %1, %2" : "=v"(r) : "v"(lo), "v"(hi)); return r; }
typedef unsigned u32x2 __attribute__((ext_vector_type(2)));
constexpr float RMS_EPS = 1e-6f;

struct EpiPlain {
    static constexpr bool PERM = true, AFTER_DRAIN = false;
    bf16_t* O; int ldc;
    __device__ __forceinline__ void operator()(const f32x4 (&acc)[2][2][4][2], const Unit& u, int wr, int wc, int fr, int fq) const {
        const int row0 = u.pm * BM + wr * 64 + fr, col0 = u.pn * BM + wc * 32 + 8 * fq;
#pragma unroll
        for (int ai = 0; ai < 2; ++ai)
#pragma unroll
            for (int m = 0; m < 4; ++m) { bf16_t* rowp = O + (size_t)(row0 + ai * HALF + m * 16) * ldc + col0;
#pragma unroll
                for (int bj = 0; bj < 2; ++bj) { const f32x4 v0 = acc[ai][bj][m][0], v1 = acc[ai][bj][m][1];
                    u32x4 w; w.x = cvt_pk_bf16(v0[0], v0[1]); w.y = cvt_pk_bf16(v0[2], v0[3]); w.z = cvt_pk_bf16(v1[0], v1[1]); w.w = cvt_pk_bf16(v1[2], v1[3]);
                    *(u32x4*)(rowp + bj * HALF) = w; } }
    }
};
struct EpiRowScale {
    static constexpr bool PERM = true, AFTER_DRAIN = false;
    bf16_t* O; int ldc; const float* SS; float inv_n;
    __device__ __forceinline__ void operator()(const f32x4 (&acc)[2][2][4][2], const Unit& u, int wr, int wc, int fr, int fq) const {
        const int row0 = u.pm * BM + wr * 64 + fr, col0 = u.pn * BM + wc * 32 + 8 * fq;
#pragma unroll
        for (int ai = 0; ai < 2; ++ai)
#pragma unroll
            for (int m = 0; m < 4; ++m) { const int row = row0 + ai * HALF + m * 16; bf16_t* rowp = O + (size_t)row * ldc + col0;
                const float rs = 1.0f / sqrtf(SS[row] * inv_n + RMS_EPS);
#pragma unroll
                for (int bj = 0; bj < 2; ++bj) { const f32x4 v0 = acc[ai][bj][m][0] * rs, v1 = acc[ai][bj][m][1] * rs;
                    u32x4 w; w.x = cvt_pk_bf16(v0[0], v0[1]); w.y = cvt_pk_bf16(v0[2], v0[3]); w.z = cvt_pk_bf16(v1[0], v1[1]); w.w = cvt_pk_bf16(v1[2], v1[3]);
                    *(u32x4*)(rowp + bj * HALF) = w; } }
    }
};
__device__ __forceinline__ float silu_mul(float g, float u) { return g * u * __builtin_amdgcn_rcpf(1.0f + __expf(-g)); }
struct EpiSwiglu {
    static constexpr bool PERM = true, AFTER_DRAIN = false;
    bf16_t* O; int ldc; const float* SS; float inv_n;
    __device__ __forceinline__ void operator()(const f32x4 (&acc)[2][2][4][2], const Unit& u, int wr, int wc, int fr, int fq) const {
        const int row0 = u.pm * BM + wr * 64 + fr, col0 = u.pn * HALF + wc * 32 + 8 * fq;
#pragma unroll
        for (int ai = 0; ai < 2; ++ai)
#pragma unroll
            for (int m = 0; m < 4; ++m) { const int row = row0 + ai * HALF + m * 16;
                const float rs = 1.0f / sqrtf(SS[row] * inv_n + RMS_EPS);
                const f32x4 g0 = acc[ai][0][m][0] * rs, g1 = acc[ai][0][m][1] * rs, u0 = acc[ai][1][m][0] * rs, u1 = acc[ai][1][m][1] * rs;
                u32x4 w;
                w.x = cvt_pk_bf16(silu_mul(g0[0], u0[0]), silu_mul(g0[1], u0[1])); w.y = cvt_pk_bf16(silu_mul(g0[2], u0[2]), silu_mul(g0[3], u0[3]));
                w.z = cvt_pk_bf16(silu_mul(g1[0], u1[0]), silu_mul(g1[1], u1[1])); w.w = cvt_pk_bf16(silu_mul(g1[2], u1[2]), silu_mul(g1[3], u1[3]));
                *(u32x4*)(O + (size_t)row * ldc + col0) = w; }
    }
};
struct EpiSoftmax {
    static constexpr bool PERM = true, AFTER_DRAIN = false;
    bf16_t* P; float* RSP; __attribute__((address_space(3))) float* xm; float sl2;
    __device__ __forceinline__ void operator()(const f32x4 (&acc)[2][2][4][2], const Unit& u, int wr, int wc, int fr, int fq) const {
        const int h = u.pn;
#pragma unroll
        for (int ai = 0; ai < 2; ++ai)
#pragma unroll
            for (int m = 0; m < 4; ++m) { float v = -3.0e38f;
#pragma unroll
                for (int bj = 0; bj < 2; ++bj)
#pragma unroll
                    for (int n = 0; n < 2; ++n) { const f32x4 x = acc[ai][bj][m][n]; v = fmaxf(v, fmaxf(fmaxf(x[0], x[1]), fmaxf(x[2], x[3]))); }
                v = fmaxf(v, __shfl_xor(v, 16)); v = fmaxf(v, __shfl_xor(v, 32));
                if (fq == 0) xm[(ai * HALF + wr * 64 + m * 16 + fr) * 4 + wc] = v; }
        asm volatile("s_waitcnt lgkmcnt(0)" ::: "memory"); __builtin_amdgcn_s_barrier(); asm volatile("" ::: "memory");
#pragma unroll
        for (int ai = 0; ai < 2; ++ai)
#pragma unroll
            for (int m = 0; m < 4; ++m) { const int r = ai * HALF + wr * 64 + m * 16 + fr; const int row = u.pm * BM + r;
                const f32x4 mm = *(const __attribute__((address_space(3))) f32x4*)(xm + r * 4); const float mx = fmaxf(fmaxf(mm[0], mm[1]), fmaxf(mm[2], mm[3])) * sl2; float s = 0.f;
#pragma unroll
                for (int bj = 0; bj < 2; ++bj) { f32x4 p0, p1;
#pragma unroll
                    for (int j = 0; j < 4; ++j) { p0[j] = __builtin_amdgcn_exp2f(acc[ai][bj][m][0][j] * sl2 - mx); p1[j] = __builtin_amdgcn_exp2f(acc[ai][bj][m][1][j] * sl2 - mx); }
                    s += ((p0[0] + p0[1]) + (p0[2] + p0[3])) + ((p1[0] + p1[1]) + (p1[2] + p1[3]));
                    u32x4 w; w.x = cvt_pk_bf16(p0[0], p0[1]); w.y = cvt_pk_bf16(p0[2], p0[3]); w.z = cvt_pk_bf16(p1[0], p1[1]); w.w = cvt_pk_bf16(p1[2], p1[3]);
                    *(u32x4*)(P + (size_t)row * 1024 + h * 256 + bj * HALF + wc * 32 + 8 * fq) = w; }
                s += __shfl_xor(s, 16); s += __shfl_xor(s, 32);
                if (fq == 0) RSP[(size_t)row * 16 + h * 4 + wc] = s; }
    }
};
struct EpiAttnOut {
    static constexpr bool PERM = true, AFTER_DRAIN = false;
    bf16_t* O; const float* RSP;
    __device__ __forceinline__ void operator()(const f32x4 (&acc)[2][2][4][2], const Unit& u, int wr, int wc, int fr, int fq) const {
        const int row0 = u.pm * BM + wr * 64 + fr, col0 = u.pn * BM + wc * 32 + 8 * fq, h = u.pn >> 1;
#pragma unroll
        for (int ai = 0; ai < 2; ++ai)
#pragma unroll
            for (int m = 0; m < 4; ++m) { const int row = row0 + ai * HALF + m * 16; bf16_t* rowp = O + (size_t)row * 2048 + col0;
                const f32x4 ps = *(const f32x4*)(RSP + (size_t)row * 16 + h * 4); const float rs = 1.0f / ((ps[0] + ps[1]) + (ps[2] + ps[3]));
#pragma unroll
                for (int bj = 0; bj < 2; ++bj) { const f32x4 v0 = acc[ai][bj][m][0] * rs, v1 = acc[ai][bj][m][1] * rs;
                    u32x4 w; w.x = cvt_pk_bf16(v0[0], v0[1]); w.y = cvt_pk_bf16(v0[2], v0[3]); w.z = cvt_pk_bf16(v1[0], v1[1]); w.w = cvt_pk_bf16(v1[2], v1[3]);
                    *(u32x4*)(rowp + bj * HALF) = w; } }
    }
};
template <bool RES_F32> struct EpiResid {
    static constexpr bool PERM = true, AFTER_DRAIN = false;
    const float* res32; const bf16_t* res16; bf16_t* xb; float* SS; int ldc;
    __device__ __forceinline__ void operator()(const f32x4 (&acc)[2][2][4][2], const Unit& u, int wr, int wc, int fr, int fq) const {
        const int col0 = u.pn * BM + wc * 32 + 8 * fq;
#pragma unroll
        for (int ai = 0; ai < 2; ++ai)
#pragma unroll
            for (int m = 0; m < 4; ++m) { const int row = u.pm * BM + ai * HALF + wr * 64 + m * 16 + fr; const size_t off = (size_t)row * ldc + col0; float s = 0.f;
#pragma unroll
                for (int bj = 0; bj < 2; ++bj) { f32x4 r0, r1;
                    if (RES_F32) { r0 = *(const f32x4*)(res32 + off + bj * HALF); r1 = *(const f32x4*)(res32 + off + bj * HALF + 4); }
                    else { const u32x4 rb = *(const u32x4*)(res16 + off + bj * HALF);
                        r0 = (f32x4){__uint_as_float(rb.x << 16), __uint_as_float(rb.x & 0xffff0000u), __uint_as_float(rb.y << 16), __uint_as_float(rb.y & 0xffff0000u)};
                        r1 = (f32x4){__uint_as_float(rb.z << 16), __uint_as_float(rb.z & 0xffff0000u), __uint_as_float(rb.w << 16), __uint_as_float(rb.w & 0xffff0000u)}; }
                    const f32x4 v0 = r0 + acc[ai][bj][m][0], v1 = r1 + acc[ai][bj][m][1];
                    u32x4 w; w.x = cvt_pk_bf16(v0[0], v0[1]); w.y = cvt_pk_bf16(v0[2], v0[3]); w.z = cvt_pk_bf16(v1[0], v1[1]); w.w = cvt_pk_bf16(v1[2], v1[3]);
                    *(u32x4*)(xb + off + bj * HALF) = w;
                    s += ((v0[0] * v0[0] + v0[1] * v0[1]) + (v0[2] * v0[2] + v0[3] * v0[3])) + ((v1[0] * v1[0] + v1[1] * v1[1]) + (v1[2] * v1[2] + v1[3] * v1[3])); }
                s += __shfl_xor(s, 16); s += __shfl_xor(s, 32); if (fq == 0) unsafeAtomicAdd(SS + row, s);
                asm volatile("" ::: "memory"); }
    }
};
template <class Epi, class Sched, bool ALIGN_EPI = false, bool SP2 = false>
__device__ __forceinline__ void gemm_phase(PG8_LAS unsigned char* lds, const Gemm g, const Sched& S, const Epi& E) {
    int tid_ = threadIdx.x; asm volatile("" : "+v"(tid_));
    const int tid = tid_, wid = __builtin_amdgcn_readfirstlane(tid >> 6), lane = tid & 63, wr = wid >> 2, wc = wid & 3, fr = lane & 15, fq = lane >> 4;
    const int K = g.ld, nt = g.K / BK;
    unsigned voffA[2], voffB[2];
#pragma unroll
    for (int i = 0; i < 2; ++i) { int R, C; stage_rc(tid * 16 + i * 8192, R, C); const int Rb = Epi::PERM ? ((R & ~31) + perm32(R & 31)) : R;
        voffA[i] = (unsigned)(R * K + C) * 2u; voffB[i] = (unsigned)(Rb * K + C) * 2u; }
    const size_t kstep = (size_t)(BK * 2);
    const size_t hstep = (size_t)HALF * K * 2;
    const unsigned ldsw = (unsigned)wid * 1024u;
    const int aoff = lds_byte(wr * 64 + fr, fq * 8), boff = lds_byte(wc * 32 + fr, fq * 8);
#define PG8_SA(b, h) (((b) * 2 + (h)) * HTB)
#define PG8_SB(b, h) ((4 + (b) * 2 + (h)) * HTB)
#define PG8_STAGE(bufoff, gbase, voff) do { _Pragma("unroll") for (int _i = 0; _i < 2; ++_i) \
        __builtin_amdgcn_global_load_lds((const unsigned*)((const char*)(gbase) + (voff)[_i]), (PG8_LAS unsigned*)(lds + (bufoff) + ldsw + _i * 8192), 16, 0, 0); } while (0)
#define PG8_LDA(dst, b, h) do { _Pragma("unroll") for (int m = 0; m < 4; ++m) _Pragma("unroll") for (int k = 0; k < 2; ++k) dst[m][k] = *(const PG8_LAS bf16x8*)(lds + PG8_SA(b, h) + aoff + m * 2048 + k * 1024); } while (0)
#define PG8_LDB(dst, b, h) do { _Pragma("unroll") for (int n = 0; n < 2; ++n) _Pragma("unroll") for (int k = 0; k < 2; ++k) dst[n][k] = *(const PG8_LAS bf16x8*)(lds + PG8_SB(b, h) + boff + n * 2048 + k * 1024); } while (0)
#define PG8_MMA(ai, bj, At, Bt) do { __builtin_amdgcn_s_setprio(1); _Pragma("unroll") for (int m = 0; m < 4; ++m) _Pragma("unroll") for (int n = 0; n < 2; ++n) _Pragma("unroll") for (int k = 0; k < 2; ++k) \
        acc[ai][bj][m][n] = __builtin_amdgcn_mfma_f32_16x16x32_bf16(Bt[n][k], At[m][k], acc[ai][bj][m][n], 0, 0, 0); __builtin_amdgcn_s_setprio(0); } while (0)
#define PG8_WAIT_V(n) asm volatile("s_waitcnt vmcnt(" #n ")" ::: "memory")
#define PG8_WAIT_L(n) asm volatile("s_waitcnt lgkmcnt(" #n ")" ::: "memory")
#define PG8_BAR __builtin_amdgcn_s_barrier()
#define PG8_SCHED __builtin_amdgcn_sched_barrier(0)
    Unit cur, nxt; int ui = 0;
    if (!S.next(0, cur)) return;
    f32x4 acc[2][2][4][2];
#pragma unroll
    for (int a = 0; a < 2; ++a)
#pragma unroll
        for (int b = 0; b < 2; ++b)
#pragma unroll
            for (int m = 0; m < 4; ++m)
#pragma unroll
                for (int n = 0; n < 2; ++n) acc[a][b][m][n] = (f32x4){0.f, 0.f, 0.f, 0.f};
    bf16x8 At[4][2], B0[2][2], B1[2][2];
    const char* cA = S.pA(g, cur); const char* cB = S.pB(g, cur);
    S.a_ready(cur);
    if constexpr (SP2) {
        PG8_STAGE(PG8_SB(0, 0), cB, voffB); PG8_STAGE(PG8_SB(0, 1), cB + hstep, voffB); PG8_STAGE(PG8_SA(0, 0), cA, voffA); PG8_STAGE(PG8_SA(0, 1), cA + hstep, voffA);
        if (wr == 1) PG8_BAR;
        PG8_WAIT_V(2); PG8_BAR;
        PG8_STAGE(PG8_SB(1, 0), cB + kstep, voffB); PG8_STAGE(PG8_SA(1, 0), cA + kstep, voffA); PG8_STAGE(PG8_SB(1, 1), cB + hstep + kstep, voffB);
        PG8_WAIT_V(6); PG8_BAR;
    } else {
        PG8_STAGE(PG8_SB(0, 0), cB, voffB); PG8_STAGE(PG8_SA(0, 0), cA, voffA); PG8_STAGE(PG8_SB(0, 1), cB + hstep, voffB); PG8_STAGE(PG8_SA(0, 1), cA + hstep, voffA);
        if (wr == 1) PG8_BAR;
        PG8_WAIT_V(4); PG8_BAR;
        PG8_STAGE(PG8_SB(1, 0), cB + kstep, voffB); PG8_STAGE(PG8_SA(1, 0), cA + kstep, voffA); PG8_STAGE(PG8_SB(1, 1), cB + hstep + kstep, voffB);
        PG8_WAIT_V(6); PG8_BAR;
    }
    for (;;) {
        const bool has_next = S.next(ui + 1, nxt);
        const char* nA = has_next ? S.pA(g, nxt) : cA; const char* nB = has_next ? S.pB(g, nxt) : cB;
        for (int t = 0; t < nt; t += 2) {
            const bool last = (t == nt - 2);
            const char* a1 = cA + (size_t)(t + 1) * kstep;
            const char* a2 = last ? nA : cA + (size_t)(t + 2) * kstep; const char* b2 = last ? nB : cB + (size_t)(t + 2) * kstep;
            const char* a3 = a2 + kstep; const char* b3 = b2 + kstep;
            if (last && has_next) S.a_ready(nxt);
            if constexpr (SP2) {
            PG8_LDB(B0, 0, 0); PG8_LDB(B1, 0, 1); PG8_SCHED; PG8_LDA(At, 0, 0); PG8_STAGE(PG8_SA(1, 1), a1 + hstep, voffA);
            PG8_WAIT_V(8); PG8_WAIT_L(0); PG8_BAR; PG8_MMA(0, 0, At, B0); PG8_MMA(0, 1, At, B1); PG8_BAR; PG8_SCHED;
            PG8_LDA(At, 0, 1); PG8_STAGE(PG8_SB(0, 0), b2, voffB); PG8_STAGE(PG8_SB(0, 1), b2 + hstep, voffB); PG8_STAGE(PG8_SA(0, 0), a2, voffA);
            PG8_WAIT_V(8); PG8_WAIT_L(0); PG8_BAR; PG8_MMA(1, 0, At, B0); PG8_MMA(1, 1, At, B1); PG8_BAR; PG8_SCHED;
            PG8_LDB(B0, 1, 0); PG8_LDB(B1, 1, 1); PG8_SCHED; PG8_LDA(At, 1, 0); PG8_STAGE(PG8_SA(0, 1), a2 + hstep, voffA);
            PG8_WAIT_V(8); PG8_WAIT_L(0); PG8_BAR; PG8_MMA(0, 0, At, B0); PG8_MMA(0, 1, At, B1); PG8_BAR; PG8_SCHED;
            PG8_LDA(At, 1, 1); PG8_STAGE(PG8_SB(1, 0), b3, voffB); PG8_STAGE(PG8_SB(1, 1), b3 + hstep, voffB); PG8_STAGE(PG8_SA(1, 0), a3, voffA);
            PG8_WAIT_V(8); PG8_WAIT_L(0); PG8_BAR; PG8_MMA(1, 0, At, B0); PG8_MMA(1, 1, At, B1); PG8_BAR; PG8_SCHED;
            } else {
            PG8_LDB(B0, 0, 0); PG8_SCHED; PG8_LDA(At, 0, 0); PG8_STAGE(PG8_SA(1, 1), a1 + hstep, voffA);
            PG8_WAIT_L(8); PG8_BAR; PG8_WAIT_L(0); PG8_MMA(0, 0, At, B0); PG8_BAR; PG8_SCHED;
            PG8_LDB(B1, 0, 1); PG8_STAGE(PG8_SB(0, 0), b2, voffB);
            PG8_BAR; PG8_WAIT_L(0); PG8_MMA(0, 1, At, B1); PG8_BAR;
            PG8_LDA(At, 0, 1); PG8_STAGE(PG8_SA(0, 0), a2, voffA);
            PG8_BAR; PG8_WAIT_L(0); PG8_MMA(1, 0, At, B0); PG8_BAR; PG8_SCHED;
            PG8_STAGE(PG8_SB(0, 1), b2 + hstep, voffB);
            PG8_WAIT_V(6); PG8_BAR; PG8_MMA(1, 1, At, B1); PG8_BAR;
            PG8_LDB(B0, 1, 0); PG8_SCHED; PG8_LDA(At, 1, 0); PG8_STAGE(PG8_SA(0, 1), a2 + hstep, voffA);
            PG8_WAIT_L(8); PG8_BAR; PG8_WAIT_L(0); PG8_MMA(0, 0, At, B0); PG8_BAR; PG8_SCHED;
            PG8_LDB(B1, 1, 1); PG8_STAGE(PG8_SB(1, 0), b3, voffB);
            PG8_BAR; PG8_WAIT_L(0); PG8_MMA(0, 1, At, B1); PG8_BAR;
            PG8_LDA(At, 1, 1); PG8_STAGE(PG8_SA(1, 0), a3, voffA);
            PG8_BAR; PG8_WAIT_L(0); PG8_MMA(1, 0, At, B0); PG8_BAR; PG8_SCHED;
            PG8_STAGE(PG8_SB(1, 1), b3 + hstep, voffB);
            PG8_WAIT_V(6); PG8_BAR; PG8_MMA(1, 1, At, B1); PG8_BAR;
            }
        }
        if constexpr (ALIGN_EPI) { if (wr == 0) PG8_BAR; }
        if constexpr (!Epi::AFTER_DRAIN) { E(acc, cur, wr, wc, fr, fq); S.done(cur); }
        if (!has_next) break;
#pragma unroll
        for (int a = 0; a < 2; ++a)
#pragma unroll
            for (int b = 0; b < 2; ++b)
#pragma unroll
                for (int m = 0; m < 4; ++m)
#pragma unroll
                    for (int n = 0; n < 2; ++n) acc[a][b][m][n] = (f32x4){0.f, 0.f, 0.f, 0.f};
        cur = nxt; cA = nA; cB = nB; ++ui;
        if constexpr (ALIGN_EPI) { if (wr == 1) PG8_BAR; }
    }
    PG8_WAIT_V(0);
    if constexpr (!ALIGN_EPI) { if (wr == 0) PG8_BAR; }
    PG8_BAR;
    if constexpr (Epi::AFTER_DRAIN) { E.fused(acc, cur, wr, wc, fr, fq, lds, wid, lane); S.done(cur); }
#undef PG8_SA
#undef PG8_SB
#undef PG8_STAGE
#undef PG8_LDA
#undef PG8_LDB
#undef PG8_MMA
#undef PG8_WAIT_V
#undef PG8_WAIT_L
#undef PG8_BAR
#undef PG8_SCHED
}
}
#define LAS __attribute__((address_space(3)))
using pg8::bf16_t; using pg8::bf16x8; using pg8::f32x4; using pg8::u32x4; using pg8::u32x2; using pg8::cvt_pk_bf16; using pg8::RMS_EPS;
constexpr int BATCH = 4, SEQ = 4096, D = 2048, M = BATCH * SEQ, NMEM = 256, MM = BATCH * NMEM, DFF = 5632, DPOOL = 1024, DSGU = 1024;
constexpr int NWAVES = 8, NTHR = NWAVES * 64;
constexpr int LDS_BYTES = 147456;
constexpr size_t MiB = 1u << 20;
constexpr size_t WS_SS1 = 0, WS_SS2 = 65536, WS_SS3 = 131072, WS_BAR = 196608, WS_ZERO_BYTES = 262144;
constexpr size_t WS_WIN = 1 * MiB, WS_WOUT = 13 * MiB, WS_WQ = 21 * MiB, WS_WK = 29 * MiB, WS_WV = 37 * MiB, WS_WO = 45 * MiB, WS_WGU = 53 * MiB, WS_WD = 97 * MiB;
constexpr size_t WS_PW = 119 * MiB, WS_WSP = 119 * MiB + 512 * 1024;
constexpr size_t WS_MN = 120 * MiB, WS_KB = 124 * MiB, WS_VTM = 128 * MiB;
constexpr size_t WS_XB = 132 * MiB;
constexpr size_t WS_HG = 196 * MiB;
constexpr size_t WS_PAU = 196 * MiB, WS_Q = 196 * MiB, WS_VT = 260 * MiB, WS_Y = 292 * MiB, WS_O = 292 * MiB;
constexpr size_t WS_PM = 260 * MiB;
constexpr size_t WS_RSP = 356 * MiB;
constexpr size_t WS_END = 372 * MiB;

__device__ __forceinline__ float bf_lo(unsigned w) { return __uint_as_float(w << 16); }
__device__ __forceinline__ float bf_hi(unsigned w) { return __uint_as_float(w & 0xffff0000u); }
__device__ __forceinline__ float wave_sum(float v) {
#pragma unroll
    for (int o = 1; o < 64; o <<= 1) v += __shfl_xor(v, o);
    return v;
}
#define LDS_WAIT() asm volatile("s_waitcnt lgkmcnt(0)" ::: "memory")
#define MFMA16(a, b, c) __builtin_amdgcn_mfma_f32_16x16x32_bf16((a), (b), (c), 0, 0, 0)

#define XB_TMO      128
#define XB_XCNT(j)  (256  + 64 * (j))
#define XB_XSUB(j)  (1280 + 64 * (j))
#define XB_XGEN(j)  (2304 + 64 * (j))
#define XB_TOP      3328
#define XB_TOPGEN   3392
#define XCD_BAR_WORDS 3456
#define XB_SPIN_CAP (1u << 18)

__device__ __forceinline__ unsigned xb_ld(unsigned* p)              { return __hip_atomic_load(p, __ATOMIC_RELAXED, __HIP_MEMORY_SCOPE_AGENT); }
__device__ __forceinline__ unsigned xb_add(unsigned* p, unsigned v) { return __hip_atomic_fetch_add(p, v, __ATOMIC_RELAXED, __HIP_MEMORY_SCOPE_AGENT); }
__device__ __forceinline__ unsigned xb_xcc_id() { return (unsigned)__builtin_amdgcn_s_getreg((3 << 11) | 20) & 0xFu; }
#define XB_SPIN(cond, bar) do { unsigned _sp = 0; while (cond) { __builtin_amdgcn_s_sleep(1); \
    if ((++_sp & 255u) == 0u) { if (xb_ld(&(bar)[XB_TMO])) break; if (_sp > XB_SPIN_CAP) { atomicAdd(&(bar)[XB_TMO], 1u); break; } } } } while (0)

struct XcdBarrier {
    unsigned* bar; unsigned x;
    volatile LAS unsigned* st;
};

__device__ __forceinline__ XcdBarrier xcd_barrier_post(unsigned* bar, volatile LAS unsigned* st) {
    XcdBarrier b; b.bar = bar; b.x = xb_xcc_id(); b.st = st;
    if (threadIdx.x == 0) (void)xb_add(&bar[XB_XCNT(b.x)], 1u);
    return b;
}
__device__ __forceinline__ void xcd_barrier_complete(unsigned* bar, unsigned x, unsigned& nloc, unsigned& nx) {
    const unsigned G = gridDim.x * gridDim.y * gridDim.z;
    unsigned sum, cnt, mine, sp = 0u;
    for (;;) {
        sum = 0u; cnt = 0u; mine = 0u;
#pragma unroll
        for (unsigned j = 0; j < 16; ++j) { const unsigned c = xb_ld(&bar[XB_XCNT(j)]); sum += c; cnt += (c > 0u) ? 1u : 0u; mine = (j == x) ? c : mine; }
        if (sum == G) break;
        __builtin_amdgcn_s_sleep(1);
        if ((++sp & 255u) == 0u) { if (xb_ld(&bar[XB_TMO])) break; if (sp > XB_SPIN_CAP) { atomicAdd(&bar[XB_TMO], 1u); break; } }
    }
    nloc = mine > 0u ? mine : 1u; nx = cnt > 0u ? cnt : 1u;
}

__device__ __forceinline__ void xcd_barrier(const XcdBarrier& b) {
    asm volatile("s_waitcnt vmcnt(0)" ::: "memory");
    __syncthreads();
    if (threadIdx.x == 0) {
        unsigned* bar = b.bar;
        __builtin_amdgcn_s_waitcnt(0);
        unsigned nloc = b.st[0], nx = b.st[1];
        if (nloc == 0u) { xcd_barrier_complete(bar, b.x, nloc, nx); b.st[0] = nloc; b.st[1] = nx; }
        const unsigned old = xb_add(&bar[XB_XSUB(b.x)], 1u);
        const unsigned gen = old / nloc;
        if (old + 1u == (gen + 1u) * nloc) {
            __builtin_amdgcn_fence(__ATOMIC_RELEASE, "agent");
            asm volatile("s_waitcnt vmcnt(0)" ::: "memory");
            const unsigned og = xb_add(&bar[XB_TOP], 1u);
            const unsigned tg = og / nx;
            if (og + 1u == (tg + 1u) * nx) xb_add(&bar[XB_TOPGEN], 1u);
            else XB_SPIN(xb_ld(&bar[XB_TOPGEN]) == tg, bar);
            __builtin_amdgcn_fence(__ATOMIC_ACQUIRE, "agent");
            xb_add(&bar[XB_XGEN(b.x)], 1u);
            asm volatile("s_waitcnt vmcnt(0)" ::: "memory");
        } else {
            XB_SPIN(xb_ld(&bar[XB_XGEN(b.x)]) == gen, bar);
            __builtin_amdgcn_fence(__ATOMIC_ACQUIRE, "agent");
            asm volatile("s_waitcnt vmcnt(0)" ::: "memory");
        }
    }
    __syncthreads();
}

__device__ __forceinline__ void tr_item(const float* W, int ldw, int k0, int n0, bf16_t* WT, int ldt, int orow0, const float* kgain, const float* nscale, LAS float* scr, int lane) {
#pragma unroll 4
    for (int i = 0; i < 16; ++i) { const int kk = 4 * i + (lane >> 4), nn = (lane & 15) * 4;
        f32x4 v = *(const f32x4*)(W + (size_t)(k0 + kk) * ldw + n0 + nn);
        if (kgain) v = v * kgain[k0 + kk];
        LAS float* s = scr + kk * 65 + nn; s[0] = v[0]; s[1] = v[1]; s[2] = v[2]; s[3] = v[3]; }
    LDS_WAIT();
    const int c = lane & 7;
#pragma unroll
    for (int j = 0; j < 8; ++j) { const int n = (lane >> 3) + 8 * j; const LAS float* s = scr + (8 * c) * 65 + n;
        const float sc = nscale ? nscale[n] : 1.0f;
        u32x4 o; o.x = cvt_pk_bf16(s[0 * 65] * sc, s[1 * 65] * sc); o.y = cvt_pk_bf16(s[2 * 65] * sc, s[3 * 65] * sc); o.z = cvt_pk_bf16(s[4 * 65] * sc, s[5 * 65] * sc); o.w = cvt_pk_bf16(s[6 * 65] * sc, s[7 * 65] * sc);
        *(u32x4*)(WT + (size_t)(orow0 + n) * ldt + k0 + 8 * c) = o; }
    LDS_WAIT();
}
__device__ __forceinline__ void norm_row_bf16(const float* xrow, const float* g, bf16_t* orow, int lane) {
    const f32x4* xr = (const f32x4*)xrow + lane; f32x4 v[8]; float s = 0.f;
#pragma unroll
    for (int j = 0; j < 8; ++j) { v[j] = xr[64 * j]; s += (v[j][0] * v[j][0] + v[j][1] * v[j][1]) + (v[j][2] * v[j][2] + v[j][3] * v[j][3]); }
    const float rstd = 1.0f / sqrtf(wave_sum(s) * (1.0f / D) + RMS_EPS);
    const f32x4* gr = (const f32x4*)g + lane; u32x2* o = (u32x2*)orow + lane;
#pragma unroll
    for (int j = 0; j < 8; ++j) { const f32x4 gg = gr[64 * j]; const f32x4 y = v[j] * rstd * gg; u32x2 w; w.x = cvt_pk_bf16(y[0], y[1]); w.y = cvt_pk_bf16(y[2], y[3]); o[64 * j] = w; }
}
__device__ __forceinline__ void norm_row_out(const bf16_t* xrow, float ss, const float* g, float* orow, int lane) {
    const float rstd = 1.0f / sqrtf(ss * (1.0f / D) + RMS_EPS);
#pragma unroll
    for (int j = 0; j < 4; ++j) { const int c = (lane + 64 * j) * 8; const u32x4 w = *(const u32x4*)(xrow + c);
        const f32x4 g0 = *(const f32x4*)(g + c), g1 = *(const f32x4*)(g + c + 4);
        const f32x4 y0 = (f32x4){bf_lo(w.x), bf_hi(w.x), bf_lo(w.y), bf_hi(w.y)} * rstd * g0, y1 = (f32x4){bf_lo(w.z), bf_hi(w.z), bf_lo(w.w), bf_hi(w.w)} * rstd * g1;
        *(f32x4*)(orow + c) = y0; *(f32x4*)(orow + c + 4) = y1; }
}

__device__ __forceinline__ void sgu_unit(LAS unsigned char* lds, int nb, const bf16_t* VT, const bf16_t* PAU, bf16_t* Y, const bf16_t* WSb, const float* sg, const float* bsp, int tid) {
    asm volatile("" : "+v"(tid));
    const int lane = tid & 63, wave = tid >> 6, fr = lane & 15, fq = lane >> 4;
    const int T0 = nb * 128;
    LAS float* red = (LAS float*)lds;
    LAS float* rstd = (LAS float*)(lds + 4096);
    LAS unsigned char* Bb = lds + 8192;
    {
        const int tg = tid & 15, rl = tid >> 4;
        float s[8];
#pragma unroll
        for (int e = 0; e < 8; ++e) s[e] = 0.f;
#pragma unroll 4
        for (int i = 0; i < 32; ++i) { const int c = rl + 32 * i; const u32x4 w = *(const u32x4*)(VT + (size_t)c * M + T0 + tg * 8);
#pragma unroll
            for (int e = 0; e < 4; ++e) { const float lo = bf_lo(w[e]), hi = bf_hi(w[e]); s[2 * e] += lo * lo; s[2 * e + 1] += hi * hi; } }
#pragma unroll
        for (int e = 0; e < 8; ++e) { s[e] += __shfl_xor(s[e], 16); s[e] += __shfl_xor(s[e], 32); }
        if (fq == 0) {
#pragma unroll
            for (int e = 0; e < 8; ++e) red[wave * 128 + tg * 8 + e] = s[e]; }
    }
    __syncthreads();
    if (tid < 128) { float t = 0.f;
#pragma unroll
        for (int w = 0; w < 8; ++w) t += red[w * 128 + tid];
        rstd[tid] = 1.0f / sqrtf(t * (1.0f / DSGU) + RMS_EPS); }
    __syncthreads();
    const int wr = wave >> 1, wc = wave & 1;
    for (int h = 0; h < 8; ++h) {
        LAS unsigned char* B = Bb + (h & 1) * 34816;
#pragma unroll
        for (int i = 0; i < 4; ++i) { const int p = tid + 512 * i, c = p >> 4, sgp = p & 15;
            const u32x4 w = *(const u32x4*)(VT + (size_t)(h * 128 + c) * M + T0 + sgp * 8);
            const float g = sg[h * 128 + c];
            const f32x4 r0 = *(const LAS f32x4*)(rstd + sgp * 8) * g, r1 = *(const LAS f32x4*)(rstd + sgp * 8 + 4) * g;
            u32x4 o; o.x = cvt_pk_bf16(bf_lo(w.x) * r0[0], bf_hi(w.x) * r0[1]); o.y = cvt_pk_bf16(bf_lo(w.y) * r0[2], bf_hi(w.y) * r0[3]);
            o.z = cvt_pk_bf16(bf_lo(w.z) * r1[0], bf_hi(w.z) * r1[1]); o.w = cvt_pk_bf16(bf_lo(w.w) * r1[2], bf_hi(w.w) * r1[3]);
            *(LAS u32x4*)(B + c * 272 + sgp * 16) = o; }
        __syncthreads();
        f32x4 acc[2][4];
#pragma unroll
        for (int m = 0; m < 2; ++m)
#pragma unroll
            for (int n = 0; n < 4; ++n) acc[m][n] = (f32x4){0.f, 0.f, 0.f, 0.f};
#pragma unroll
        for (int ks = 0; ks < 4; ++ks) { bf16x8 a[2], b[4];
#pragma unroll
            for (int m = 0; m < 2; ++m) a[m] = *(const bf16x8*)(WSb + (size_t)((h * 128 + wr * 32 + m * 16 + fr) * 128 + ks * 32 + fq * 8));
#pragma unroll
            for (int n = 0; n < 4; ++n) b[n] = *(const LAS bf16x8*)(B + (wc * 64 + n * 16 + fr) * 272 + (ks * 32 + fq * 8) * 2);
#pragma unroll
            for (int m = 0; m < 2; ++m)
#pragma unroll
                for (int n = 0; n < 4; ++n) acc[m][n] = MFMA16(b[n], a[m], acc[m][n]); }
#pragma unroll
        for (int m = 0; m < 2; ++m) { const int t = wr * 32 + m * 16 + fr; const float bias = bsp[h * 128 + t];
#pragma unroll
            for (int n = 0; n < 4; ++n) { const size_t off = (size_t)(T0 + t) * D + DPOOL + h * 128 + wc * 64 + n * 16 + fq * 4;
                const u32x2 uu = *(const u32x2*)(PAU + off); const f32x4 mx = acc[m][n] + bias;
                u32x2 o; o.x = cvt_pk_bf16(bf_lo(uu.x) * mx[0], bf_hi(uu.x) * mx[1]); o.y = cvt_pk_bf16(bf_lo(uu.y) * mx[2], bf_hi(uu.y) * mx[3]);
                *(u32x2*)(Y + off) = o; } }
    }
    __syncthreads();
}
__device__ __forceinline__ void pool_unit(LAS unsigned char* lds, int nb, const bf16_t* PAU, bf16_t* Y, const bf16_t* PWt, int tid) {
    asm volatile("" : "+v"(tid));
    const int lane = tid & 63, wave = tid >> 6, fr = lane & 15, fq = lane >> 4;
    const int T0 = nb * 128, tp0 = T0 & (SEQ - 1);
    LAS unsigned char* A = lds;
    for (int g = 0; g < 4; ++g) {
        const int w = 2 << g;
        {   const int cgp = tid & 31, ts = (tid >> 5) * 8; const bf16_t* base = PAU + g * 256 + cgp * 8;
            float S[8];
#pragma unroll
            for (int e = 0; e < 8; ++e) S[e] = 0.f;
            for (int j = 1; j < w; ++j) { if (tp0 + ts - j >= 0) { const u32x4 q = *(const u32x4*)(base + (size_t)(T0 + ts - j) * D);
#pragma unroll
                for (int e = 0; e < 4; ++e) { S[2 * e] += bf_lo(q[e]); S[2 * e + 1] += bf_hi(q[e]); } } }
#pragma unroll
            for (int i = 0; i < 8; ++i) { const int t = ts + i, tp = tp0 + t; const u32x4 q = *(const u32x4*)(base + (size_t)(T0 + t) * D);
                float cur[8], p[8];
#pragma unroll
                for (int e = 0; e < 4; ++e) { cur[2 * e] = bf_lo(q[e]); cur[2 * e + 1] = bf_hi(q[e]); }
                const float inv = 1.0f / (float)(tp + 1 < w ? tp + 1 : w);
#pragma unroll
                for (int e = 0; e < 8; ++e) { S[e] += cur[e]; p[e] = S[e] * inv - cur[e]; }
                u32x4 o; o.x = cvt_pk_bf16(p[0], p[1]); o.y = cvt_pk_bf16(p[2], p[3]); o.z = cvt_pk_bf16(p[4], p[5]); o.w = cvt_pk_bf16(p[6], p[7]);
                *(LAS u32x4*)(A + t * 528 + cgp * 16) = o;
                if (tp - w + 1 >= 0) { const u32x4 r = *(const u32x4*)(base + (size_t)(T0 + t - w + 1) * D);
#pragma unroll
                    for (int e = 0; e < 4; ++e) { S[2 * e] -= bf_lo(r[e]); S[2 * e + 1] -= bf_hi(r[e]); } } }
        }
        __syncthreads();
        f32x4 acc[8][2];
#pragma unroll
        for (int m = 0; m < 8; ++m)
#pragma unroll
            for (int n = 0; n < 2; ++n) acc[m][n] = (f32x4){0.f, 0.f, 0.f, 0.f};
#pragma unroll 2
        for (int ks = 0; ks < 8; ++ks) { bf16x8 b[2];
#pragma unroll
            for (int n = 0; n < 2; ++n) b[n] = *(const bf16x8*)(PWt + (size_t)((g * 256 + wave * 32 + n * 16 + fr) * 256 + ks * 32 + fq * 8));
#pragma unroll
            for (int m = 0; m < 8; ++m) { const bf16x8 a = *(const LAS bf16x8*)(A + (m * 16 + fr) * 528 + (ks * 32 + fq * 8) * 2);
#pragma unroll
                for (int n = 0; n < 2; ++n) acc[m][n] = MFMA16(b[n], a, acc[m][n]); } }
#pragma unroll
        for (int m = 0; m < 8; ++m)
#pragma unroll
            for (int n = 0; n < 2; ++n) { const size_t off = (size_t)(T0 + m * 16 + fr) * D + g * 256 + wave * 32 + n * 16 + fq * 4; const f32x4 v = acc[m][n];
                u32x2 o; o.x = cvt_pk_bf16(v[0], v[1]); o.y = cvt_pk_bf16(v[2], v[3]); *(u32x2*)(Y + off) = o; }
        __syncthreads();
    }
}
__device__ __forceinline__ void attn_unit(LAS unsigned char* lds, int unit, const bf16_t* Q, const bf16_t* KB, const bf16_t* VTM, bf16_t* O, int tid) {
    asm volatile("" : "+v"(tid));
    const int lane = tid & 63, wave = tid >> 6, fr = lane & 15, fq = lane >> 4, wr = wave >> 1, wc = wave & 1;
    const int qt = unit & 31, h = (unit >> 5) & 3, b = unit >> 7;
    const int R0 = b * SEQ + qt * 128;
    LAS unsigned char* P = lds;
    LAS float* xm = (LAS float*)(lds + 67584);
    LAS float* xs = xm + 256;
    f32x4 acc[2][8];
#pragma unroll
    for (int m = 0; m < 2; ++m)
#pragma unroll
        for (int n = 0; n < 8; ++n) acc[m][n] = (f32x4){0.f, 0.f, 0.f, 0.f};
    const bf16_t* qp = Q + (size_t)(R0 + wr * 32 + fr) * D + h * 512 + fq * 8;
    const bf16_t* kp = KB + (size_t)(b * NMEM + wc * 128 + fr) * D + h * 512 + fq * 8;
#pragma unroll 2
    for (int ks = 0; ks < 16; ++ks) { bf16x8 a[2], bb[8];
#pragma unroll
        for (int m = 0; m < 2; ++m) a[m] = *(const bf16x8*)(qp + (size_t)m * 16 * D + ks * 32);
#pragma unroll
        for (int n = 0; n < 8; ++n) bb[n] = *(const bf16x8*)(kp + (size_t)n * 16 * D + ks * 32);
#pragma unroll
        for (int m = 0; m < 2; ++m)
#pragma unroll
            for (int n = 0; n < 8; ++n) acc[m][n] = MFMA16(bb[n], a[m], acc[m][n]); }
    const float sc = 0.044194173824159216f;
#pragma unroll
    for (int m = 0; m < 2; ++m) { float v = -3.0e38f;
#pragma unroll
        for (int n = 0; n < 8; ++n) { acc[m][n] = acc[m][n] * sc; v = fmaxf(v, fmaxf(fmaxf(acc[m][n][0], acc[m][n][1]), fmaxf(acc[m][n][2], acc[m][n][3]))); }
        v = fmaxf(v, __shfl_xor(v, 16)); v = fmaxf(v, __shfl_xor(v, 32));
        if (fq == 0) xm[wc * 128 + wr * 32 + m * 16 + fr] = v; }
    __syncthreads();
#pragma unroll
    for (int m = 0; m < 2; ++m) { const int row = wr * 32 + m * 16 + fr; const float mx = fmaxf(xm[row], xm[128 + row]); float s = 0.f;
#pragma unroll
        for (int n = 0; n < 8; ++n) { const float p0 = __expf(acc[m][n][0] - mx), p1 = __expf(acc[m][n][1] - mx), p2 = __expf(acc[m][n][2] - mx), p3 = __expf(acc[m][n][3] - mx);
            s += (p0 + p1) + (p2 + p3);
            u32x2 o; o.x = cvt_pk_bf16(p0, p1); o.y = cvt_pk_bf16(p2, p3);
            *(LAS u32x2*)(P + row * 528 + (wc * 128 + n * 16 + fq * 4) * 2) = o; }
        s += __shfl_xor(s, 16); s += __shfl_xor(s, 32);
        if (fq == 0) xs[wc * 128 + row] = s; }
    __syncthreads();
    float inv[2];
#pragma unroll
    for (int m = 0; m < 2; ++m) { const int row = wr * 32 + m * 16 + fr; inv[m] = 1.0f / (xs[row] + xs[128 + row]); }
    f32x4 o[2][16];
#pragma unroll
    for (int m = 0; m < 2; ++m)
#pragma unroll
        for (int n = 0; n < 16; ++n) o[m][n] = (f32x4){0.f, 0.f, 0.f, 0.f};
    const bf16_t* vp = VTM + (size_t)(h * 512 + wc * 256 + fr) * MM + b * NMEM + fq * 8;
    for (int ks = 0; ks < 8; ++ks) { bf16x8 a[2];
#pragma unroll
        for (int m = 0; m < 2; ++m) a[m] = *(const LAS bf16x8*)(P + (wr * 32 + m * 16 + fr) * 528 + (ks * 32 + fq * 8) * 2);
#pragma unroll
        for (int n = 0; n < 16; ++n) { const bf16x8 bv = *(const bf16x8*)(vp + (size_t)n * 16 * MM + ks * 32);
#pragma unroll
            for (int m = 0; m < 2; ++m) o[m][n] = MFMA16(bv, a[m], o[m][n]); } }
#pragma unroll
    for (int m = 0; m < 2; ++m) { const size_t rowoff = (size_t)(R0 + wr * 32 + m * 16 + fr) * D + h * 512 + wc * 256 + fq * 4;
#pragma unroll
        for (int n = 0; n < 16; ++n) { const f32x4 v = o[m][n] * inv[m]; u32x2 w; w.x = cvt_pk_bf16(v[0], v[1]); w.y = cvt_pk_bf16(v[2], v[3]); *(u32x2*)(O + rowoff + n * 16) = w; } }
    __syncthreads();
}

#ifndef REP_P0
#define REP_P0 1
#endif
#ifndef REP_P0N
#define REP_P0N 1
#endif
#ifndef REP_P1
#define REP_P1 1
#endif
#ifndef REP_P3
#define REP_P3 1
#endif
#ifndef REP_P7
#define REP_P7 1
#endif
#ifndef OLD_ATTN
#define OLD_ATTN 0
#endif
#ifndef REP_P2
#define REP_P2 1
#endif
#ifndef REP_P5
#define REP_P5 1
#endif
#ifndef REP_SYNC
#define REP_SYNC 1
#endif
#ifndef REP_P4
#define REP_P4 1
#endif
struct Args { const float* in[21]; float* out; unsigned char* ws; };
#define GEMM_PHASE(EPI, g, S, E) pg8::gemm_phase<EPI, pg8::StaticOrder, true, true>(lds, g, S, E)
__global__ void __launch_bounds__(NTHR, 2) mk_fwd(Args a) {
    extern __shared__ __attribute__((aligned(16))) unsigned char lds_raw[];
    LAS unsigned char* lds = (LAS unsigned char*)lds_raw;
    cg::grid_group grid = cg::this_grid();
    const int G = gridDim.x, bx = blockIdx.x;
    volatile LAS unsigned* bar_st = (volatile LAS unsigned*)(lds + LDS_BYTES - 64);
    if (threadIdx.x < 2) bar_st[threadIdx.x] = 0u;
    __syncthreads();
    const XcdBarrier xbar = xcd_barrier_post((unsigned*)(a.ws + WS_BAR), bar_st);
#define TID_FRESH() ({ int t_ = threadIdx.x; asm volatile("" : "+v"(t_)); t_; })
    const float *x = a.in[0], *mem = a.in[1], *norm_mix_g = a.in[2], *w_in = a.in[3], *pool_w = a.in[4], *pool_scale = a.in[5], *sgu_norm_g = a.in[6], *w_spatial = a.in[7], *b_spatial = a.in[8],
                *w_out = a.in[9], *norm_xattn_g = a.in[10], *norm_mem_g = a.in[11], *w_q = a.in[12], *w_k = a.in[13], *w_v = a.in[14], *w_o = a.in[15], *norm_ffn_g = a.in[16],
                *w_gate = a.in[17], *w_up = a.in[18], *w_down = a.in[19], *final_norm_g = a.in[20];
    float* out = a.out; unsigned char* ws = a.ws;
    float *SS1 = (float*)(ws + WS_SS1), *SS2 = (float*)(ws + WS_SS2), *SS3 = (float*)(ws + WS_SS3);
    bf16_t *Win_t = (bf16_t*)(ws + WS_WIN), *Wout_t = (bf16_t*)(ws + WS_WOUT), *Wq_t = (bf16_t*)(ws + WS_WQ), *Wk_t = (bf16_t*)(ws + WS_WK), *Wv_t = (bf16_t*)(ws + WS_WV), *Wo_t = (bf16_t*)(ws + WS_WO),
           *Wgu_t = (bf16_t*)(ws + WS_WGU), *Wd_t = (bf16_t*)(ws + WS_WD), *PWt = (bf16_t*)(ws + WS_PW), *WSb = (bf16_t*)(ws + WS_WSP), *MN = (bf16_t*)(ws + WS_MN), *KB = (bf16_t*)(ws + WS_KB),
           *VTM = (bf16_t*)(ws + WS_VTM), *XB = (bf16_t*)(ws + WS_XB), *HG = (bf16_t*)(ws + WS_HG), *PAU = (bf16_t*)(ws + WS_PAU), *Qb = (bf16_t*)(ws + WS_Q), *VT = (bf16_t*)(ws + WS_VT),
           *Yb = (bf16_t*)(ws + WS_Y), *Ob = (bf16_t*)(ws + WS_O);

    {
        const int tid = TID_FRESH(), lane = tid & 63, wave = __builtin_amdgcn_readfirstlane(tid >> 6);
        LAS float* scr = (LAS float*)(lds + wave * 16640);
        const int gw = bx * NWAVES + wave, NGW = G * NWAVES;
        constexpr int I_IN = 32 * 48, I_SQ = 32 * 32, I_GU = 32 * 88, I_DN = 88 * 32, I_PW = 4 * 16;
        constexpr int NITEMS = I_IN + 5 * I_SQ + 2 * I_GU + I_DN + I_PW;
        for (int it = gw; it < NITEMS * REP_P0; it += NGW) {
            int r = it % NITEMS;
            if (r < I_IN) { tr_item(w_in, 3072, (r / 48) * 64, (r % 48) * 64, Win_t, D, (r % 48) * 64, nullptr, nullptr, scr, lane); continue; } r -= I_IN;
            if (r < I_SQ) { tr_item(w_out, D, (r / 32) * 64, (r % 32) * 64, Wout_t, D, (r % 32) * 64, nullptr, nullptr, scr, lane); continue; } r -= I_SQ;
            if (r < I_SQ) { tr_item(w_q, D, (r / 32) * 64, (r % 32) * 64, Wq_t, D, (r % 32) * 64, norm_xattn_g, nullptr, scr, lane); continue; } r -= I_SQ;
            if (r < I_SQ) { tr_item(w_k, D, (r / 32) * 64, (r % 32) * 64, Wk_t, D, (r % 32) * 64, nullptr, nullptr, scr, lane); continue; } r -= I_SQ;
            if (r < I_SQ) { tr_item(w_v, D, (r / 32) * 64, (r % 32) * 64, Wv_t, D, (r % 32) * 64, nullptr, nullptr, scr, lane); continue; } r -= I_SQ;
            if (r < I_SQ) { tr_item(w_o, D, (r / 32) * 64, (r % 32) * 64, Wo_t, D, (r % 32) * 64, nullptr, nullptr, scr, lane); continue; } r -= I_SQ;
            if (r < 2 * I_GU) { const int up = r >= I_GU; if (up) r -= I_GU; const int n0 = (r % 88) * 64;
                tr_item(up ? w_up : w_gate, DFF, (r / 88) * 64, n0, Wgu_t, D, (n0 >> 7) * 256 + (n0 & 127) + up * 128, norm_ffn_g, nullptr, scr, lane); continue; } r -= 2 * I_GU;
            if (r < I_DN) { tr_item(w_down, D, (r / 32) * 64, (r % 32) * 64, Wd_t, DFF, (r % 32) * 64, nullptr, nullptr, scr, lane); continue; } r -= I_DN;
            { const int g = r >> 4, q = r & 15; tr_item(pool_w + (size_t)g * 65536, 256, (q >> 2) * 64, (q & 3) * 64, PWt + (size_t)g * 65536, 256, (q & 3) * 64, nullptr, pool_scale + g * 256 + (q & 3) * 64, scr, lane); }
        }
        for (int i = bx * NTHR + tid; i < 8 * 128 * 128 / 4; i += G * NTHR) { const f32x4 v = *((const f32x4*)w_spatial + i); const int s = (i * 4) & 127, t = ((i * 4) >> 7) & 127;
            const bool keep = (s >> 6) <= (t >> 6); u32x2 o; o.x = keep ? cvt_pk_bf16(v[0], v[1]) : 0u; o.y = keep ? cvt_pk_bf16(v[2], v[3]) : 0u; *((u32x2*)WSb + i) = o; }
        for (int mm = gw; mm < M * REP_P0N; mm += NGW) { const int m = mm & (M - 1); norm_row_bf16(x + (size_t)m * D, norm_mix_g, XB + (size_t)m * D, lane); }
        for (int m = gw; m < MM; m += NGW) norm_row_bf16(mem + (size_t)m * D, norm_mem_g, MN + (size_t)m * D, lane);
    }
    for (int rep = 0; rep < REP_SYNC; ++rep) grid.sync();
    for (int rep = 0; rep < REP_P1; ++rep) {
        { pg8::Gemm g{XB, Win_t, M, 2048, D, D}; pg8::StaticOrder S; S.init(M, 2048, G, bx); pg8::EpiPlain E{PAU, D}; GEMM_PHASE(pg8::EpiPlain, g, S, E); }
        { pg8::Gemm g{Win_t + (size_t)2048 * D, XB, 1024, M, D, D}; pg8::StaticOrder S; S.init(1024, M, G, bx); pg8::EpiPlain E{VT, M}; GEMM_PHASE(pg8::EpiPlain, g, S, E); }
        { pg8::Gemm g{MN, Wk_t, MM, D, D, D}; pg8::StaticOrder S; S.init(MM, D, G, bx); pg8::EpiPlain E{KB, D}; GEMM_PHASE(pg8::EpiPlain, g, S, E); }
        { pg8::Gemm g{Wv_t, MN, D, MM, D, D}; pg8::StaticOrder S; S.init(D, MM, G, (bx + G - 32) % G); pg8::EpiPlain E{VTM, MM}; GEMM_PHASE(pg8::EpiPlain, g, S, E); }
    }
    xcd_barrier(xbar);
    for (int uu = bx; uu < 256 * REP_P2; uu += G) { const int u = uu & 255; if (u & 1) pool_unit(lds, u >> 1, PAU, Yb, PWt, (int)threadIdx.x); else sgu_unit(lds, u >> 1, VT, PAU, Yb, WSb, sgu_norm_g, b_spatial, (int)threadIdx.x); }
    xcd_barrier(xbar);
    for (int rep = 0; rep < REP_P3; ++rep) { pg8::Gemm g{Yb, Wout_t, M, D, D, D}; pg8::StaticOrder S; S.init(M, D, G, bx); pg8::EpiResid<true> E{x, nullptr, XB, rep ? (float*)(ws + WS_VT) : SS1, D}; GEMM_PHASE(pg8::EpiResid<true>, g, S, E); }
    xcd_barrier(xbar);
    for (int rep = 0; rep < REP_P4; ++rep) { pg8::Gemm g{XB, Wq_t, M, D, D, D}; pg8::StaticOrder S; S.init(M, D, G, bx); pg8::EpiRowScale E{Qb, D, SS1, 1.0f / D}; GEMM_PHASE(pg8::EpiRowScale, g, S, E); }
    xcd_barrier(xbar);
#if OLD_ATTN
    for (int u = bx; u < 512 * REP_P5; u += G) attn_unit(lds, u & 511, Qb, KB, VTM, Ob, (int)threadIdx.x);
    xcd_barrier(xbar);
#else
    for (int rep = 0; rep < REP_P5; ++rep) {
    { pg8::Gemm g{Qb, KB, M, 1024, 512, D}; pg8::AttnSOrder S{G, bx}; pg8::EpiSoftmax E{(bf16_t*)(ws + WS_PM), (float*)(ws + WS_RSP), (LAS float*)(lds + 131072), 0.044194173824159216f * 1.4426950408889634f};
      pg8::gemm_phase<pg8::EpiSoftmax, pg8::AttnSOrder, true, true>(lds, g, S, E); }
    xcd_barrier(xbar);
    { pg8::Gemm g{(const bf16_t*)(ws + WS_PM), VTM, M, 2048, 256, 1024}; pg8::AttnPVOrder S{G, bx}; pg8::EpiAttnOut E{Ob, (const float*)(ws + WS_RSP)};
      pg8::gemm_phase<pg8::EpiAttnOut, pg8::AttnPVOrder, true, true>(lds, g, S, E); }
    xcd_barrier(xbar);
    }
#endif
    { pg8::Gemm g{Ob, Wo_t, M, D, D, D}; pg8::StaticOrder S; S.init(M, D, G, bx); pg8::EpiResid<false> E{nullptr, XB, XB, SS2, D}; GEMM_PHASE(pg8::EpiResid<false>, g, S, E); }
    xcd_barrier(xbar);
    for (int rep = 0; rep < REP_P7; ++rep) { pg8::Gemm g{XB, Wgu_t, M, 2 * DFF, D, D}; pg8::StaticOrder S; S.init(M, 2 * DFF, G, bx); pg8::EpiSwiglu E{HG, DFF, SS2, 1.0f / D}; GEMM_PHASE(pg8::EpiSwiglu, g, S, E); }
    xcd_barrier(xbar);
    { pg8::Gemm g{HG, Wd_t, M, D, DFF, DFF}; pg8::StaticOrder S; S.init(M, D, G, bx); pg8::EpiResid<false> E{nullptr, XB, XB, SS3, D}; GEMM_PHASE(pg8::EpiResid<false>, g, S, E); }
    xcd_barrier(xbar);
    { const int tid = TID_FRESH(), lane = tid & 63, wave = __builtin_amdgcn_readfirstlane(tid >> 6); const int gw = bx * NWAVES + wave, NGW = G * NWAVES; for (int m = gw; m < M; m += NGW) norm_row_out(XB + (size_t)m * D, SS3[m], final_norm_g, out + (size_t)m * D, lane); }
}

extern "C" void kernel_launch(void* const* d_in, const int* in_sizes, int n_in, void* d_out, int out_size, void* d_ws, size_t ws_size, hipStream_t stream) {
    static int grid = 0;
    if (grid == 0) {
        if (n_in != 21 || in_sizes[0] != M * D || out_size != M * D || ws_size < WS_END) { fprintf(stderr, "kernel_launch: unexpected shapes (n_in %d, in0 %d, out %d, ws %zu); nothing launched\n", n_in, n_in > 0 ? in_sizes[0] : -1, out_size, ws_size); grid = -1; return; }
        int dev = 0, cus = 0, per_cu = 0;
        if (hipGetDevice(&dev) != hipSuccess || hipDeviceGetAttribute(&cus, hipDeviceAttributeMultiprocessorCount, dev) != hipSuccess) { grid = -1; return; }
        if (hipFuncSetAttribute((const void*)mk_fwd, hipFuncAttributeMaxDynamicSharedMemorySize, LDS_BYTES) != hipSuccess) { fprintf(stderr, "kernel_launch: hipFuncSetAttribute failed\n"); grid = -1; return; }
        if (hipOccupancyMaxActiveBlocksPerMultiprocessor(&per_cu, (const void*)mk_fwd, NTHR, LDS_BYTES) != hipSuccess || per_cu < 1) { fprintf(stderr, "kernel_launch: occupancy query says %d blocks per CU\n", per_cu); (void)hipGetLastError(); grid = -1; return; }
        grid = cus * per_cu;
    }
    if (grid < 0) return;
    if (hipMemsetAsync(d_ws, 0, WS_ZERO_BYTES, stream) != hipSuccess) { fprintf(stderr, "kernel_launch: hipMemsetAsync failed\n"); return; }
    Args a{};
    for (int i = 0; i < 21; ++i) a.in[i] = (const float*)d_in[i];
    a.out = (float*)d_out; a.ws = (unsigned char*)d_ws;
    void* args[] = {&a};
    const hipError_t e = hipLaunchCooperativeKernel((const void*)mk_fwd, dim3(grid), dim3(NTHR), args, LDS_BYTES, stream);
    if (e != hipSuccess) fprintf(stderr, "kernel_launch: cooperative launch failed: %s (grid %d)\n", hipGetErrorString(e), grid);
}
```

```cpp
#include <hip/hip_runtime.h>
#include <hip/hip_cooperative_groups.h>
#include <cstdio>
#include <cstdint>
namespace cg = cooperative_groups;
namespace pg8 {
#define PG8_LAS __attribute__((address_space(3)))
typedef unsigned short bf16_t;
typedef short bf16x8 __attribute__((ext_vector_type(8)));
typedef float f32x4 __attribute__((ext_vector_type(4)));
typedef unsigned u32x4 __attribute__((ext_vector_type(4)));
constexpr int BM = 256, BK = 64, HALF = 128, HTB = HALF * BK * 2  , STAGE_BYTES = 8 * HTB, NXCD = 8, WGM = 8;

__host__ __device__ __forceinline__ int lds_byte(int r, int c) { const int st = (r >> 4) * 2 + (c >> 5), rr = r & 15, cc = c & 31, ob = rr * 64 + cc * 2; return st * 1024 + (ob ^ (((ob >> 9) & 1) << 5)); }
__host__ __device__ __forceinline__ void stage_rc(int b, int& R, int& C) { const int st = b / 1024, sb = b % 1024, swz = sb ^ (((sb >> 9) & 1) << 5); R = (st >> 1) * 16 + swz / 64; C = (st & 1) * 32 + (swz % 64) / 2; }
__host__ __device__ __forceinline__ int perm32(int rho) { const int n = rho >> 4, i = rho & 15; return 8 * (i >> 2) + 4 * n + (i & 3); }

__device__ __forceinline__ const bf16_t* sel_ptr(bool c, const bf16_t* a, const bf16_t* b) { const unsigned long long m = 0ull - (unsigned long long)c; return (const bf16_t*)((((unsigned long long)a) & m) | (((unsigned long long)b) & ~m)); }
struct Unit { int pm, pn; };
struct Gemm { const bf16_t* A; const bf16_t* Bt; int M, N, K, ld; };

struct StaticOrder {
    int nM, nN, nwg, G, c;
    __host__ __device__ void init(int M, int N, int G_, int c_) { nM = M / BM; nN = N / BM; nwg = nM * nN; G = G_; c = c_; }
    __host__ __device__ bool next(int i, Unit& u) const {
        const long L = (long)i * G + c; if (L >= nwg) return false;
        int wgid = (int)L; { const int q = nwg / NXCD, r = nwg % NXCD, xcd = wgid % NXCD, off = wgid / NXCD; wgid = (xcd < r ? xcd * (q + 1) : r * (q + 1) + (xcd - r) * q) + off; }
        const int nig = WGM * nN, gid = wgid / nig, fm = gid * WGM, gsz = (nM - fm) < WGM ? (nM - fm) : WGM;
        u.pm = fm + ((wgid % nig) % gsz); u.pn = (wgid % nig) / gsz; return true;
    }
    __device__ __forceinline__ void a_ready(const Unit&) const {}
    __device__ __forceinline__ void done(const Unit&) const {}
    __device__ __forceinline__ const char* pA(const Gemm& g, const Unit& u) const { return (const char*)g.A + (size_t)u.pm * BM * g.ld * 2; }
    __device__ __forceinline__ const char* pB(const Gemm& g, const Unit& u) const { return (const char*)g.Bt + (size_t)u.pn * BM * g.ld * 2; }
};
struct DownOrder {
    int c;
    __device__ bool next(int i, Unit& u) const { if (i > 1) return false; const int xcd = c & 7, j = c >> 3; u.pm = i * 32 + xcd * 4 + (j >> 3); u.pn = j & 7; return true; }
    __device__ __forceinline__ void a_ready(const Unit&) const {}
    __device__ __forceinline__ void done(const Unit&) const {}
    __device__ __forceinline__ const char* pA(const Gemm& g, const Unit& u) const { return (const char*)g.A + (size_t)u.pm * BM * g.ld * 2; }
    __device__ __forceinline__ const char* pB(const Gemm& g, const Unit& u) const { return (const char*)g.Bt + (size_t)u.pn * BM * g.ld * 2; }
};
struct PreQKOrder {
    int G, c0, cmax; const bf16_t* Wout_t; const bf16_t* PWn;
    __device__ __forceinline__ bool next(int i, Unit& u) const { const int c = i * G + c0; if (c >= cmax) return false;
        if (c < 128) { u.pm = (c >> 5) * 4 + ((c >> 3) & 3); u.pn = c & 7; } else { const int q = c - 128; u.pm = 0x1000 | (q >> 2); u.pn = q & 3; } return true; }
    __device__ __forceinline__ void a_ready(const Unit&) const {}
    __device__ __forceinline__ void done(const Unit&) const {}
    __device__ __forceinline__ const char* pA(const Gemm& g, const Unit& u) const { const bool pw = (u.pm & 0x1000) != 0;
        const bf16_t* p = sel_ptr(pw, Wout_t + (size_t)(u.pm & 0xfff) * 256 * 2048 + u.pn * 256, g.A + (size_t)((u.pm & 0xfff) >> 2) * 256 * 2048 + (u.pm & 3) * 512); return (const char*)p; }
    __device__ __forceinline__ const char* pB(const Gemm& g, const Unit& u) const { const bool pw = (u.pm & 0x1000) != 0;
        const bf16_t* p = sel_ptr(pw, PWn + (size_t)u.pn * 256 * 2048, g.Bt + (size_t)u.pn * 256 * 2048 + (u.pm & 3) * 512); return (const char*)p; }
};
struct PreVOOrder {
    int G, c0;
    __device__ bool next(int i, Unit& u) const { const int c = i * G + c0; if (c >= 128) return false; u.pm = (c >> 5) * 8 + ((c >> 2) & 7); u.pn = c & 3; return true; }
    __device__ __forceinline__ void a_ready(const Unit&) const {}
    __device__ __forceinline__ void done(const Unit&) const {}
    __device__ __forceinline__ const char* pA(const Gemm& g, const Unit& u) const { return (const char*)(g.A + (size_t)(u.pm & 7) * 256 * 2048 + u.pn * 512); }
    __device__ __forceinline__ const char* pB(const Gemm& g, const Unit& u) const { return (const char*)(g.Bt + (size_t)(u.pm >> 3) * 256 * 2048 + u.pn * 512); }
};
struct ScoreOrder {
    int G, c;
    __device__ bool next(int i, Unit& u) const { if (G != 256) { const int L = i * G + c; if (L >= 256) return false; u.pm = L >> 2; u.pn = L & 3; return true; }
        if (i > 0) return false; const int xcd = c & 7, j = c >> 3; u.pm = xcd * 8 + (j >> 2); u.pn = j & 3; return true; }
    __device__ __forceinline__ void a_ready(const Unit&) const {}
    __device__ __forceinline__ void done(const Unit&) const {}
    __device__ __forceinline__ const char* pA(const Gemm& g, const Unit& u) const { return (const char*)(g.A + (size_t)u.pm * BM * 2048); }
    __device__ __forceinline__ const char* pB(const Gemm& g, const Unit& u) const { return (const char*)(g.Bt + (size_t)((u.pm >> 4) * 1024 + u.pn * 256) * 2048); }
};
struct AttnOutOrder {
    int G, c;
    __device__ bool next(int i, Unit& u) const { if (G != 256) { const int L = i * G + c; if (L >= 512) return false; u.pm = L >> 3; u.pn = L & 7; return true; }
        if (i > 1) return false; const int xcd = c & 7, j = c >> 3; u.pm = xcd * 8 + (j >> 2); u.pn = i * 4 + (j & 3); return true; }
    __device__ __forceinline__ void a_ready(const Unit&) const {}
    __device__ __forceinline__ void done(const Unit&) const {}
    __device__ __forceinline__ const char* pA(const Gemm& g, const Unit& u) const { return (const char*)(g.A + (size_t)u.pm * BM * 1024); }
    __device__ __forceinline__ const char* pB(const Gemm& g, const Unit& u) const { return (const char*)(g.Bt + (size_t)((u.pm >> 4) * 2048 + u.pn * 256) * 1024); }
};
struct AttnSOrder {
    int G, c;
    __device__ bool next(int i, Unit& u) const { const int L = i * G + c; if (L >= 256) return false; u.pm = L >> 2; u.pn = L & 3; return true; }
    __device__ __forceinline__ void a_ready(const Unit&) const {}
    __device__ __forceinline__ void done(const Unit&) const {}
    __device__ __forceinline__ const char* pA(const Gemm& g, const Unit& u) const { return (const char*)(g.A + (size_t)u.pm * BM * 2048 + u.pn * 512); }
    __device__ __forceinline__ const char* pB(const Gemm& g, const Unit& u) const { return (const char*)(g.Bt + (size_t)(u.pm >> 4) * 256 * 2048 + u.pn * 512); }
};
struct AttnPVOrder {
    int G, c;
    __device__ bool next(int i, Unit& u) const { const int L = i * G + c; if (L >= 512) return false; u.pm = L >> 3; u.pn = L & 7; return true; }
    __device__ __forceinline__ void a_ready(const Unit&) const {}
    __device__ __forceinline__ void done(const Unit&) const {}
    __device__ __forceinline__ const char* pA(const Gemm& g, const Unit& u) const { return (const char*)(g.A + (size_t)u.pm * BM * 1024 + (u.pn >> 1) * 256); }
    __device__ __forceinline__ const char* pB(const Gemm& g, const Unit& u) const { return (const char*)(g.Bt + (size_t)u.pn * BM * 1024 + (u.pm >> 4) * 256); }
};

typedef __bf16 bf16x2v_ __attribute__((ext_vector_type(2)));
typedef float f32x2v_ __attribute__((ext_vector_type(2)));
__device__ __forceinline__ unsigned cvt_pk_bf16(float lo, float hi) { const f32x2v_ f = {lo, hi}; const bf16x2v_ b = __builtin_convertvector(f, bf16x2v_); return __builtin_bit_cast(unsigned, b); }
typedef unsigned u32x2 __attribute__((ext_vector_type(2)));
constexpr float RMS_EPS = 1e-6f;

struct EpiPlain {
    static constexpr bool PERM = true, AFTER_DRAIN = false;
    bf16_t* O; int ldc;
    __device__ __forceinline__ void operator()(const f32x4 (&acc)[2][2][4][2], const Unit& u, int wr, int wc, int fr, int fq) const {
        { const int l_ = (int)__builtin_amdgcn_mbcnt_hi(~0u, __builtin_amdgcn_mbcnt_lo(~0u, 0u)); fr = l_ & 15; fq = l_ >> 4; }
        const int row0 = u.pm * BM + wr * 64 + fr, col0 = u.pn * BM + wc * 32 + 8 * fq;
#pragma unroll
        for (int ai = 0; ai < 2; ++ai)
#pragma unroll
            for (int m = 0; m < 4; ++m) { bf16_t* rowp = O + (size_t)(row0 + ai * HALF + m * 16) * ldc + col0;
#pragma unroll
                for (int bj = 0; bj < 2; ++bj) { const f32x4 v0 = acc[ai][bj][m][0], v1 = acc[ai][bj][m][1];
                    u32x4 w; w.x = cvt_pk_bf16(v0[0], v0[1]); w.y = cvt_pk_bf16(v0[2], v0[3]); w.z = cvt_pk_bf16(v1[0], v1[1]); w.w = cvt_pk_bf16(v1[2], v1[3]);
                    *(u32x4*)(rowp + bj * HALF) = w; } }
    }
};
struct EpiPre {
    static constexpr bool PERM = true, AFTER_DRAIN = false;
    bf16_t* WQK; bf16_t* Wout_t;
    __device__ __forceinline__ void operator()(const f32x4 (&acc)[2][2][4][2], const Unit& u, int wr, int wc, int fr, int fq) const {
        const bool pw = (u.pm & 0x1000) != 0; Unit t; t.pm = u.pm & 0xfff; t.pn = u.pn; const EpiPlain E{(bf16_t*)sel_ptr(pw, Wout_t, WQK), 2048}; E(acc, t, wr, wc, fr, fq);
    }
};
struct EpiRowScale {
    static constexpr bool PERM = true, AFTER_DRAIN = false;
    bf16_t* O; int ldc; const float* SS; float inv_n;
    __device__ __forceinline__ void operator()(const f32x4 (&acc)[2][2][4][2], const Unit& u, int wr, int wc, int fr, int fq) const {
        const int row0 = u.pm * BM + wr * 64 + fr, col0 = u.pn * BM + wc * 32 + 8 * fq;
#pragma unroll
        for (int ai = 0; ai < 2; ++ai)
#pragma unroll
            for (int m = 0; m < 4; ++m) { const int row = row0 + ai * HALF + m * 16; bf16_t* rowp = O + (size_t)row * ldc + col0;
                const f32x4 pa = *(const f32x4*)(SS + (size_t)row * 8), pb = *(const f32x4*)(SS + (size_t)row * 8 + 4); const float rs = __builtin_amdgcn_rsqf((((pa[0] + pa[1]) + (pa[2] + pa[3])) + ((pb[0] + pb[1]) + (pb[2] + pb[3]))) * inv_n + RMS_EPS);
#pragma unroll
                for (int bj = 0; bj < 2; ++bj) { const f32x4 v0 = acc[ai][bj][m][0] * rs, v1 = acc[ai][bj][m][1] * rs;
                    u32x4 w; w.x = cvt_pk_bf16(v0[0], v0[1]); w.y = cvt_pk_bf16(v0[2], v0[3]); w.z = cvt_pk_bf16(v1[0], v1[1]); w.w = cvt_pk_bf16(v1[2], v1[3]);
                    *(u32x4*)(rowp + bj * HALF) = w; } }
    }
};
struct EpiRowScaleC {
    static constexpr bool PERM = true, AFTER_DRAIN = false;
    bf16_t* O; int ldc; const float* RS;
    __device__ __forceinline__ void operator()(const f32x4 (&acc)[2][2][4][2], const Unit& u, int wr, int wc, int fr, int fq) const {
        const int row0 = u.pm * BM + wr * 64 + fr, col0 = u.pn * BM + wc * 32 + 8 * fq;
#pragma unroll
        for (int ai = 0; ai < 2; ++ai)
#pragma unroll
            for (int m = 0; m < 4; ++m) { const int row = row0 + ai * HALF + m * 16; bf16_t* rowp = O + (size_t)row * ldc + col0; const float rs = RS[row];
#pragma unroll
                for (int bj = 0; bj < 2; ++bj) { const f32x4 v0 = acc[ai][bj][m][0] * rs, v1 = acc[ai][bj][m][1] * rs;
                    u32x4 w; w.x = cvt_pk_bf16(v0[0], v0[1]); w.y = cvt_pk_bf16(v0[2], v0[3]); w.z = cvt_pk_bf16(v1[0], v1[1]); w.w = cvt_pk_bf16(v1[2], v1[3]);
                    *(u32x4*)(rowp + bj * HALF) = w; } }
    }
};
struct EpiColScale {
    static constexpr bool PERM = true, AFTER_DRAIN = false;
    bf16_t* O; int ldc; const float* RS;
    __device__ __forceinline__ void operator()(const f32x4 (&acc)[2][2][4][2], const Unit& u, int wr, int wc, int fr, int fq) const {
        const int row0 = u.pm * BM + wr * 64 + fr, col0 = u.pn * BM + wc * 32 + 8 * fq;
        f32x4 c0[2], c1[2];
#pragma unroll
        for (int bj = 0; bj < 2; ++bj) { c0[bj] = *(const f32x4*)(RS + col0 + bj * HALF); c1[bj] = *(const f32x4*)(RS + col0 + bj * HALF + 4); }
#pragma unroll
        for (int ai = 0; ai < 2; ++ai)
#pragma unroll
            for (int m = 0; m < 4; ++m) { bf16_t* rowp = O + (size_t)(row0 + ai * HALF + m * 16) * ldc + col0;
#pragma unroll
                for (int bj = 0; bj < 2; ++bj) { const f32x4 v0 = acc[ai][bj][m][0] * c0[bj], v1 = acc[ai][bj][m][1] * c1[bj];
                    u32x4 w; w.x = cvt_pk_bf16(v0[0], v0[1]); w.y = cvt_pk_bf16(v0[2], v0[3]); w.z = cvt_pk_bf16(v1[0], v1[1]); w.w = cvt_pk_bf16(v1[2], v1[3]);
                    *(u32x4*)(rowp + bj * HALF) = w; } }
    }
};
__device__ __forceinline__ float silu_mul(float g, float u) { return g * u * __builtin_amdgcn_rcpf(1.0f + __expf(-g)); }
struct EpiSwiglu {
    static constexpr bool PERM = true, AFTER_DRAIN = false;
    bf16_t* O; int ldc; const float* SS; float inv_n;
    __device__ __forceinline__ void operator()(const f32x4 (&acc)[2][2][4][2], const Unit& u, int wr, int wc, int fr, int fq) const {
        const int row0 = u.pm * BM + wr * 64 + fr, col0 = u.pn * HALF + wc * 32 + 8 * fq;
#pragma unroll
        for (int ai = 0; ai < 2; ++ai)
#pragma unroll
            for (int m = 0; m < 4; ++m) { const int row = row0 + ai * HALF + m * 16;
                const f32x4 pa = *(const f32x4*)(SS + (size_t)row * 8), pb = *(const f32x4*)(SS + (size_t)row * 8 + 4); const float rs = __builtin_amdgcn_rsqf((((pa[0] + pa[1]) + (pa[2] + pa[3])) + ((pb[0] + pb[1]) + (pb[2] + pb[3]))) * inv_n + RMS_EPS);
                const f32x4 g0 = acc[ai][0][m][0] * rs, g1 = acc[ai][0][m][1] * rs, u0 = acc[ai][1][m][0] * rs, u1 = acc[ai][1][m][1] * rs;
                u32x4 w;
                w.x = cvt_pk_bf16(silu_mul(g0[0], u0[0]), silu_mul(g0[1], u0[1])); w.y = cvt_pk_bf16(silu_mul(g0[2], u0[2]), silu_mul(g0[3], u0[3]));
                w.z = cvt_pk_bf16(silu_mul(g1[0], u1[0]), silu_mul(g1[1], u1[1])); w.w = cvt_pk_bf16(silu_mul(g1[2], u1[2]), silu_mul(g1[3], u1[3]));
                *(u32x4*)(O + (size_t)row * ldc + col0) = w; }
    }
};
struct EpiSoftmax {
    static constexpr bool PERM = true, AFTER_DRAIN = false;
    bf16_t* P; float* RSP; __attribute__((address_space(3))) float* xm; float sl2;
    __device__ __forceinline__ void operator()(const f32x4 (&acc)[2][2][4][2], const Unit& u, int wr, int wc, int fr, int fq) const {
        const int h = u.pn;
#pragma unroll
        for (int ai = 0; ai < 2; ++ai)
#pragma unroll
            for (int m = 0; m < 4; ++m) { float v = -3.0e38f;
#pragma unroll
                for (int bj = 0; bj < 2; ++bj)
#pragma unroll
                    for (int n = 0; n < 2; ++n) { const f32x4 x = acc[ai][bj][m][n]; v = fmaxf(v, fmaxf(fmaxf(x[0], x[1]), fmaxf(x[2], x[3]))); }
                v = fmaxf(v, __shfl_xor(v, 16)); v = fmaxf(v, __shfl_xor(v, 32));
                if (fq == 0) xm[(ai * HALF + wr * 64 + m * 16 + fr) * 4 + wc] = v; }
        asm volatile("s_waitcnt lgkmcnt(0)" ::: "memory"); __builtin_amdgcn_s_barrier(); asm volatile("" ::: "memory");
#pragma unroll
        for (int ai = 0; ai < 2; ++ai)
#pragma unroll
            for (int m = 0; m < 4; ++m) { const int r = ai * HALF + wr * 64 + m * 16 + fr; const int row = u.pm * BM + r;
                const f32x4 mm = *(const __attribute__((address_space(3))) f32x4*)(xm + r * 4); const float mx = fmaxf(fmaxf(mm[0], mm[1]), fmaxf(mm[2], mm[3])) * sl2; float s = 0.f;
#pragma unroll
                for (int bj = 0; bj < 2; ++bj) { f32x4 p0, p1;
#pragma unroll
                    for (int j = 0; j < 4; ++j) { p0[j] = __builtin_amdgcn_exp2f(acc[ai][bj][m][0][j] * sl2 - mx); p1[j] = __builtin_amdgcn_exp2f(acc[ai][bj][m][1][j] * sl2 - mx); }
                    s += ((p0[0] + p0[1]) + (p0[2] + p0[3])) + ((p1[0] + p1[1]) + (p1[2] + p1[3]));
                    u32x4 w; w.x = cvt_pk_bf16(p0[0], p0[1]); w.y = cvt_pk_bf16(p0[2], p0[3]); w.z = cvt_pk_bf16(p1[0], p1[1]); w.w = cvt_pk_bf16(p1[2], p1[3]);
                    *(u32x4*)(P + (size_t)row * 1024 + h * 256 + bj * HALF + wc * 32 + 8 * fq) = w; }
                s += __shfl_xor(s, 16); s += __shfl_xor(s, 32);
                if (fq == 0) RSP[(size_t)row * 16 + h * 4 + wc] = s; }
    }
};
struct EpiSoftmaxN {
    static constexpr bool PERM = true, AFTER_DRAIN = false;
    bf16_t* P; const float* SS; float inv_n; __attribute__((address_space(3))) float* xm; float sl2;
    __device__ __forceinline__ void operator()(f32x4 (&acc)[2][2][4][2], const Unit& u, int wr, int wc, int fr, int fq) const {
        { const int l_ = (int)__builtin_amdgcn_mbcnt_hi(~0u, __builtin_amdgcn_mbcnt_lo(~0u, 0u)); fr = l_ & 15; fq = l_ >> 4; }
        const int h = u.pn; __attribute__((address_space(3))) float* xs = xm + 1024;
#pragma unroll
        for (int ai = 0; ai < 2; ++ai)
#pragma unroll
            for (int m = 0; m < 4; ++m) { float v = -3.0e38f;
#pragma unroll
                for (int bj = 0; bj < 2; ++bj)
#pragma unroll
                    for (int n = 0; n < 2; ++n) { const f32x4 x = acc[ai][bj][m][n]; v = fmaxf(v, fmaxf(fmaxf(x[0], x[1]), fmaxf(x[2], x[3]))); }
                v = fmaxf(v, __shfl_xor(v, 16)); v = fmaxf(v, __shfl_xor(v, 32));
                if (fq == 0) xm[(ai * HALF + wr * 64 + m * 16 + fr) * 4 + wc] = v; }
        asm volatile("s_waitcnt lgkmcnt(0)" ::: "memory"); __builtin_amdgcn_s_barrier(); asm volatile("" ::: "memory");
#pragma unroll
        for (int ai = 0; ai < 2; ++ai)
#pragma unroll
            for (int m = 0; m < 4; ++m) { const int r = ai * HALF + wr * 64 + m * 16 + fr; const int row = u.pm * BM + r;
                const f32x4 pa = *(const f32x4*)(SS + (size_t)row * 8), pb = *(const f32x4*)(SS + (size_t)row * 8 + 4);
                const float f = sl2 * __builtin_amdgcn_rsqf((((pa[0] + pa[1]) + (pa[2] + pa[3])) + ((pb[0] + pb[1]) + (pb[2] + pb[3]))) * inv_n + RMS_EPS);
                const f32x4 mm = *(const __attribute__((address_space(3))) f32x4*)(xm + r * 4); const float mx = fmaxf(fmaxf(mm[0], mm[1]), fmaxf(mm[2], mm[3])) * f; float s = 0.f;
#pragma unroll
                for (int bj = 0; bj < 2; ++bj)
#pragma unroll
                    for (int n = 0; n < 2; ++n) { f32x4 p;
#pragma unroll
                        for (int j = 0; j < 4; ++j) p[j] = __builtin_amdgcn_exp2f(acc[ai][bj][m][n][j] * f - mx);
                        acc[ai][bj][m][n] = p; s += (p[0] + p[1]) + (p[2] + p[3]); }
                s += __shfl_xor(s, 16); s += __shfl_xor(s, 32);
                if (fq == 0) xs[r * 4 + wc] = s; }
        asm volatile("s_waitcnt lgkmcnt(0)" ::: "memory"); __builtin_amdgcn_s_barrier(); asm volatile("" ::: "memory");
#pragma unroll
        for (int ai = 0; ai < 2; ++ai)
#pragma unroll
            for (int m = 0; m < 4; ++m) { const int r = ai * HALF + wr * 64 + m * 16 + fr; const int row = u.pm * BM + r;
                const f32x4 ps = *(const __attribute__((address_space(3))) f32x4*)(xs + r * 4); const float inv = 1.0f / ((ps[0] + ps[1]) + (ps[2] + ps[3]));
#pragma unroll
                for (int bj = 0; bj < 2; ++bj) { const f32x4 v0 = acc[ai][bj][m][0] * inv, v1 = acc[ai][bj][m][1] * inv;
                    u32x4 w; w.x = cvt_pk_bf16(v0[0], v0[1]); w.y = cvt_pk_bf16(v0[2], v0[3]); w.z = cvt_pk_bf16(v1[0], v1[1]); w.w = cvt_pk_bf16(v1[2], v1[3]);
                    *(u32x4*)(P + (size_t)row * 1024 + h * 256 + bj * HALF + wc * 32 + 8 * fq) = w; } }
    }
};
struct EpiFinal {
    static constexpr bool PERM = true, AFTER_DRAIN = false;
    const bf16_t* res16; float* out; float* SS; unsigned* cnt; const float* gfin; __attribute__((address_space(3))) float* xs; int ldc;
    __device__ __forceinline__ void operator()(f32x4 (&acc)[2][2][4][2], const Unit& u, int wr, int wc, int fr, int fq) const {
        const int lane = (int)__builtin_amdgcn_mbcnt_hi(~0u, __builtin_amdgcn_mbcnt_lo(~0u, 0u)); fr = lane & 15; fq = lane >> 4;
        __attribute__((address_space(3))) float* rsl = xs + 1024;
        const int col0 = u.pn * BM + wc * 32 + 8 * fq;
#pragma unroll
        for (int ai = 0; ai < 2; ++ai) { u32x4 rh[4][2];
#pragma unroll
            for (int m = 0; m < 4; ++m) { const size_t off = (size_t)(u.pm * BM + ai * HALF + wr * 64 + m * 16 + fr) * ldc + col0;
#pragma unroll
                for (int bj = 0; bj < 2; ++bj) rh[m][bj] = *(const u32x4*)(res16 + off + bj * HALF); }
#pragma unroll
            for (int m = 0; m < 4; ++m) { float s = 0.f;
#pragma unroll
                for (int bj = 0; bj < 2; ++bj) { const u32x4 rb = rh[m][bj];
                    const f32x4 r0 = (f32x4){__uint_as_float(rb.x << 16), __uint_as_float(rb.x & 0xffff0000u), __uint_as_float(rb.y << 16), __uint_as_float(rb.y & 0xffff0000u)};
                    const f32x4 r1 = (f32x4){__uint_as_float(rb.z << 16), __uint_as_float(rb.z & 0xffff0000u), __uint_as_float(rb.w << 16), __uint_as_float(rb.w & 0xffff0000u)};
                    const f32x4 v0 = r0 + acc[ai][bj][m][0], v1 = r1 + acc[ai][bj][m][1]; acc[ai][bj][m][0] = v0; acc[ai][bj][m][1] = v1;
                    s += ((v0[0] * v0[0] + v0[1] * v0[1]) + (v0[2] * v0[2] + v0[3] * v0[3])) + ((v1[0] * v1[0] + v1[1] * v1[1]) + (v1[2] * v1[2] + v1[3] * v1[3])); }
                s += __shfl_xor(s, 16); s += __shfl_xor(s, 32); if (fq == 0) xs[(ai * HALF + wr * 64 + m * 16 + fr) * 4 + wc] = s; }
            asm volatile("" ::: "memory"); }
        asm volatile("s_waitcnt lgkmcnt(0)" ::: "memory"); __builtin_amdgcn_s_barrier(); asm volatile("" ::: "memory");
        if (fq == 0) {
#pragma unroll
            for (int ai = 0; ai < 2; ++ai) { const int r = ai * HALF + wr * 64 + wc * 16 + fr; const f32x4 p = *(const __attribute__((address_space(3))) f32x4*)(xs + r * 4);
                __hip_atomic_store(SS + (size_t)(u.pm * BM + r) * 8 + u.pn, (p[0] + p[1]) + (p[2] + p[3]), __ATOMIC_RELAXED, __HIP_MEMORY_SCOPE_AGENT); } }
        asm volatile("s_waitcnt vmcnt(0)" ::: "memory");
        if (lane == 0) __hip_atomic_fetch_add(cnt + 64 * u.pm, 1u, __ATOMIC_RELAXED, __HIP_MEMORY_SCOPE_AGENT);
        if (wr == 0 && wc == 0) {
            unsigned sp = 0u;
            while ((unsigned)__builtin_amdgcn_readfirstlane((int)__hip_atomic_load(cnt + 64 * u.pm, __ATOMIC_RELAXED, __HIP_MEMORY_SCOPE_AGENT)) < 64u) { __builtin_amdgcn_s_sleep(2); if (++sp > (1u << 22)) break; }
            __builtin_amdgcn_fence(__ATOMIC_ACQUIRE, "agent"); }
        asm volatile("s_waitcnt vmcnt(0) lgkmcnt(0)" ::: "memory"); __builtin_amdgcn_s_barrier(); asm volatile("" ::: "memory");
        if (wr == 0) {
            const int r = wc * 64 + lane; const unsigned long long* sp = (const unsigned long long*)(SS + (size_t)(u.pm * BM + r) * 8); float t = 0.f;
#pragma unroll
            for (int q = 0; q < 4; ++q) { const unsigned long long w = __hip_atomic_load(sp + q, __ATOMIC_RELAXED, __HIP_MEMORY_SCOPE_AGENT); t += __uint_as_float((unsigned)w) + __uint_as_float((unsigned)(w >> 32)); }
            rsl[r] = __builtin_amdgcn_rsqf(t * (1.0f / 2048.0f) + RMS_EPS); }
        asm volatile("s_waitcnt vmcnt(0) lgkmcnt(0)" ::: "memory"); __builtin_amdgcn_s_barrier(); asm volatile("" ::: "memory");
        f32x4 g0[2], g1[2];
#pragma unroll
        for (int bj = 0; bj < 2; ++bj) { g0[bj] = *(const f32x4*)(gfin + col0 + bj * HALF); g1[bj] = *(const f32x4*)(gfin + col0 + bj * HALF + 4); }
#pragma unroll
        for (int ai = 0; ai < 2; ++ai)
#pragma unroll
            for (int m = 0; m < 4; ++m) { const int r = ai * HALF + wr * 64 + m * 16 + fr; const float rs = rsl[r]; float* op = out + (size_t)(u.pm * BM + r) * ldc + col0;
#pragma unroll
                for (int bj = 0; bj < 2; ++bj) { *(f32x4*)(op + bj * HALF) = acc[ai][bj][m][0] * rs * g0[bj]; *(f32x4*)(op + bj * HALF + 4) = acc[ai][bj][m][1] * rs * g1[bj]; } }
    }
};
struct EpiAttnOut {
    static constexpr bool PERM = true, AFTER_DRAIN = false;
    bf16_t* O; const float* RSP;
    __device__ __forceinline__ void operator()(const f32x4 (&acc)[2][2][4][2], const Unit& u, int wr, int wc, int fr, int fq) const {
        const int row0 = u.pm * BM + wr * 64 + fr, col0 = u.pn * BM + wc * 32 + 8 * fq, h = u.pn >> 1;
#pragma unroll
        for (int ai = 0; ai < 2; ++ai)
#pragma unroll
            for (int m = 0; m < 4; ++m) { const int row = row0 + ai * HALF + m * 16; bf16_t* rowp = O + (size_t)row * 2048 + col0;
                const f32x4 ps = *(const f32x4*)(RSP + (size_t)row * 16 + h * 4); const float rs = 1.0f / ((ps[0] + ps[1]) + (ps[2] + ps[3]));
#pragma unroll
                for (int bj = 0; bj < 2; ++bj) { const f32x4 v0 = acc[ai][bj][m][0] * rs, v1 = acc[ai][bj][m][1] * rs;
                    u32x4 w; w.x = cvt_pk_bf16(v0[0], v0[1]); w.y = cvt_pk_bf16(v0[2], v0[3]); w.z = cvt_pk_bf16(v1[0], v1[1]); w.w = cvt_pk_bf16(v1[2], v1[3]);
                    *(u32x4*)(rowp + bj * HALF) = w; } }
    }
};
template <bool RES_F32> struct EpiResid {
    static constexpr bool PERM = true, AFTER_DRAIN = false;
    const float* res32; const bf16_t* res16; bf16_t* xb; float* SS; int ldc; __attribute__((address_space(3))) float* xs;
    __device__ __forceinline__ void operator()(const f32x4 (&acc)[2][2][4][2], const Unit& u, int wr, int wc, int fr, int fq) const {
        const int col0 = u.pn * BM + wc * 32 + 8 * fq;
#pragma unroll
        for (int ai = 0; ai < 2; ++ai) {
            f32x4 rf[RES_F32 ? 4 : 1][2][2]; u32x4 rh[RES_F32 ? 1 : 4][2];
#pragma unroll
            for (int m = 0; m < 4; ++m) { const size_t off = (size_t)(u.pm * BM + ai * HALF + wr * 64 + m * 16 + fr) * ldc + col0;
#pragma unroll
                for (int bj = 0; bj < 2; ++bj) {
                    if constexpr (RES_F32) { rf[m][bj][0] = *(const f32x4*)(res32 + off + bj * HALF); rf[m][bj][1] = *(const f32x4*)(res32 + off + bj * HALF + 4); }
                    else rh[m][bj] = *(const u32x4*)(res16 + off + bj * HALF); } }
#pragma unroll
            for (int m = 0; m < 4; ++m) { const int row = u.pm * BM + ai * HALF + wr * 64 + m * 16 + fr; const size_t off = (size_t)row * ldc + col0; float s = 0.f;
#pragma unroll
                for (int bj = 0; bj < 2; ++bj) { f32x4 r0, r1;
                    if constexpr (RES_F32) { r0 = rf[m][bj][0]; r1 = rf[m][bj][1]; }
                    else { const u32x4 rb = rh[m][bj];
                        r0 = (f32x4){__uint_as_float(rb.x << 16), __uint_as_float(rb.x & 0xffff0000u), __uint_as_float(rb.y << 16), __uint_as_float(rb.y & 0xffff0000u)};
                        r1 = (f32x4){__uint_as_float(rb.z << 16), __uint_as_float(rb.z & 0xffff0000u), __uint_as_float(rb.w << 16), __uint_as_float(rb.w & 0xffff0000u)}; }
                    const f32x4 v0 = r0 + acc[ai][bj][m][0], v1 = r1 + acc[ai][bj][m][1];
                    u32x4 w; w.x = cvt_pk_bf16(v0[0], v0[1]); w.y = cvt_pk_bf16(v0[2], v0[3]); w.z = cvt_pk_bf16(v1[0], v1[1]); w.w = cvt_pk_bf16(v1[2], v1[3]);
                    *(u32x4*)(xb + off + bj * HALF) = w;
                    s += ((v0[0] * v0[0] + v0[1] * v0[1]) + (v0[2] * v0[2] + v0[3] * v0[3])) + ((v1[0] * v1[0] + v1[1] * v1[1]) + (v1[2] * v1[2] + v1[3] * v1[3])); }
                s += __shfl_xor(s, 16); s += __shfl_xor(s, 32); if (fq == 0) xs[(ai * HALF + wr * 64 + m * 16 + fr) * 4 + wc] = s; }
            asm volatile("" ::: "memory"); }
        asm volatile("s_waitcnt lgkmcnt(0)" ::: "memory"); __builtin_amdgcn_s_barrier(); asm volatile("" ::: "memory");
        if (fq == 0) {
#pragma unroll
            for (int ai = 0; ai < 2; ++ai) { const int r = ai * HALF + wr * 64 + wc * 16 + fr; const f32x4 p = *(const __attribute__((address_space(3))) f32x4*)(xs + r * 4);
                SS[(size_t)(u.pm * BM + r) * 8 + u.pn] = (p[0] + p[1]) + (p[2] + p[3]); } }
    }
};
template <class Epi, class Sched, bool ALIGN_EPI = false, bool SP2 = false>
__device__ __forceinline__ void gemm_phase(PG8_LAS unsigned char* lds, const Gemm g, const Sched& S, const Epi& E) {
    int tid_ = threadIdx.x; asm volatile("" : "+v"(tid_));
    const int tid = tid_, wid = __builtin_amdgcn_readfirstlane(tid >> 6), lane = tid & 63, wr = wid >> 2, wc = wid & 3, fr = lane & 15, fq = lane >> 4;
    const int K = g.ld, nt = g.K / BK;
    unsigned voffA[2], voffB[2];
#pragma unroll
    for (int i = 0; i < 2; ++i) { int R, C; stage_rc(tid * 16 + i * 8192, R, C); const int Rb = Epi::PERM ? ((R & ~31) + perm32(R & 31)) : R;
        voffA[i] = (unsigned)(R * K + C) * 2u; voffB[i] = (unsigned)(Rb * K + C) * 2u; }
    const size_t kstep = (size_t)(BK * 2);
    const size_t hstep = (size_t)HALF * K * 2;
    const unsigned ldsw = (unsigned)wid * 1024u;
    const int aoff = lds_byte(wr * 64 + fr, fq * 8), boff = lds_byte(wc * 32 + fr, fq * 8);
#define PG8_SA(b, h) (((b) * 2 + (h)) * HTB)
#define PG8_SB(b, h) ((4 + (b) * 2 + (h)) * HTB)
#define PG8_STAGE(bufoff, gbase, voff) do { _Pragma("unroll") for (int _i = 0; _i < 2; ++_i) \
        __builtin_amdgcn_global_load_lds((const unsigned*)((const char*)(gbase) + (voff)[_i]), (PG8_LAS unsigned*)(lds + (bufoff) + ldsw + _i * 8192), 16, 0, 0); } while (0)
#define PG8_LDA(dst, b, h) do { _Pragma("unroll") for (int m = 0; m < 4; ++m) _Pragma("unroll") for (int k = 0; k < 2; ++k) dst[m][k] = *(const PG8_LAS bf16x8*)(lds + PG8_SA(b, h) + aoff + m * 2048 + k * 1024); } while (0)
#define PG8_LDB(dst, b, h) do { _Pragma("unroll") for (int n = 0; n < 2; ++n) _Pragma("unroll") for (int k = 0; k < 2; ++k) dst[n][k] = *(const PG8_LAS bf16x8*)(lds + PG8_SB(b, h) + boff + n * 2048 + k * 1024); } while (0)
#define PG8_MMA(ai, bj, At, Bt) do { __builtin_amdgcn_s_setprio(1); _Pragma("unroll") for (int m = 0; m < 4; ++m) _Pragma("unroll") for (int n = 0; n < 2; ++n) _Pragma("unroll") for (int k = 0; k < 2; ++k) \
        acc[ai][bj][m][n] = __builtin_amdgcn_mfma_f32_16x16x32_bf16(Bt[n][k], At[m][k], acc[ai][bj][m][n], 0, 0, 0); __builtin_amdgcn_s_setprio(0); } while (0)
#define PG8_WAIT_V(n) asm volatile("s_waitcnt vmcnt(" #n ")" ::: "memory")
#define PG8_WAIT_L(n) asm volatile("s_waitcnt lgkmcnt(" #n ")" ::: "memory")
#define PG8_BAR __builtin_amdgcn_s_barrier()
#define PG8_SCHED __builtin_amdgcn_sched_barrier(0)
    Unit cur, nxt; int ui = 0;
    if (!S.next(0, cur)) return;
    f32x4 acc[2][2][4][2];
#pragma unroll
    for (int a = 0; a < 2; ++a)
#pragma unroll
        for (int b = 0; b < 2; ++b)
#pragma unroll
            for (int m = 0; m < 4; ++m)
#pragma unroll
                for (int n = 0; n < 2; ++n) acc[a][b][m][n] = (f32x4){0.f, 0.f, 0.f, 0.f};
    bf16x8 At[4][2], B0[2][2], B1[2][2];
    const char* cA = S.pA(g, cur); const char* cB = S.pB(g, cur);
    S.a_ready(cur);
    if constexpr (SP2) {
        PG8_STAGE(PG8_SB(0, 0), cB, voffB); PG8_STAGE(PG8_SB(0, 1), cB + hstep, voffB); PG8_STAGE(PG8_SA(0, 0), cA, voffA); PG8_STAGE(PG8_SA(0, 1), cA + hstep, voffA);
        if (wr == 1) PG8_BAR;
        PG8_WAIT_V(2); PG8_BAR;
        PG8_STAGE(PG8_SB(1, 0), cB + kstep, voffB); PG8_STAGE(PG8_SA(1, 0), cA + kstep, voffA); PG8_STAGE(PG8_SB(1, 1), cB + hstep + kstep, voffB);
        PG8_WAIT_V(6); PG8_BAR;
    } else {
        PG8_STAGE(PG8_SB(0, 0), cB, voffB); PG8_STAGE(PG8_SA(0, 0), cA, voffA); PG8_STAGE(PG8_SB(0, 1), cB + hstep, voffB); PG8_STAGE(PG8_SA(0, 1), cA + hstep, voffA);
        if (wr == 1) PG8_BAR;
        PG8_WAIT_V(4); PG8_BAR;
        PG8_STAGE(PG8_SB(1, 0), cB + kstep, voffB); PG8_STAGE(PG8_SA(1, 0), cA + kstep, voffA); PG8_STAGE(PG8_SB(1, 1), cB + hstep + kstep, voffB);
        PG8_WAIT_V(6); PG8_BAR;
    }
    for (;;) {
        const bool has_next = S.next(ui + 1, nxt);
        const char* nA = has_next ? S.pA(g, nxt) : cA; const char* nB = has_next ? S.pB(g, nxt) : cB;
        for (int t = 0; t < nt; t += 2) {
            const bool last = (t == nt - 2);
            const char* a1 = cA + (size_t)(t + 1) * kstep;
            const char* a2 = last ? nA : cA + (size_t)(t + 2) * kstep; const char* b2 = last ? nB : cB + (size_t)(t + 2) * kstep;
            const char* a3 = a2 + kstep; const char* b3 = b2 + kstep;
            if (last && has_next) S.a_ready(nxt);
            if constexpr (SP2) {
            PG8_LDB(B0, 0, 0); PG8_LDB(B1, 0, 1); PG8_SCHED; PG8_LDA(At, 0, 0); PG8_STAGE(PG8_SA(1, 1), a1 + hstep, voffA);
            PG8_WAIT_V(8); PG8_WAIT_L(0); PG8_BAR; PG8_MMA(0, 0, At, B0); PG8_MMA(0, 1, At, B1); PG8_BAR; PG8_SCHED;
            PG8_LDA(At, 0, 1); PG8_STAGE(PG8_SB(0, 0), b2, voffB); PG8_STAGE(PG8_SB(0, 1), b2 + hstep, voffB); PG8_STAGE(PG8_SA(0, 0), a2, voffA);
            PG8_WAIT_V(8); PG8_WAIT_L(0); PG8_BAR; PG8_MMA(1, 0, At, B0); PG8_MMA(1, 1, At, B1); PG8_BAR; PG8_SCHED;
            PG8_LDB(B0, 1, 0); PG8_LDB(B1, 1, 1); PG8_SCHED; PG8_LDA(At, 1, 0); PG8_STAGE(PG8_SA(0, 1), a2 + hstep, voffA);
            PG8_WAIT_V(8); PG8_WAIT_L(0); PG8_BAR; PG8_MMA(0, 0, At, B0); PG8_MMA(0, 1, At, B1); PG8_BAR; PG8_SCHED;
            PG8_LDA(At, 1, 1); PG8_STAGE(PG8_SB(1, 0), b3, voffB); PG8_STAGE(PG8_SB(1, 1), b3 + hstep, voffB); PG8_STAGE(PG8_SA(1, 0), a3, voffA);
            PG8_WAIT_V(8); PG8_WAIT_L(0); PG8_BAR; PG8_MMA(1, 0, At, B0); PG8_MMA(1, 1, At, B1); PG8_BAR; PG8_SCHED;
            } else {
            PG8_LDB(B0, 0, 0); PG8_SCHED; PG8_LDA(At, 0, 0); PG8_STAGE(PG8_SA(1, 1), a1 + hstep, voffA);
            PG8_WAIT_L(8); PG8_BAR; PG8_WAIT_L(0); PG8_MMA(0, 0, At, B0); PG8_BAR; PG8_SCHED;
            PG8_LDB(B1, 0, 1); PG8_STAGE(PG8_SB(0, 0), b2, voffB);
            PG8_BAR; PG8_WAIT_L(0); PG8_MMA(0, 1, At, B1); PG8_BAR;
            PG8_LDA(At, 0, 1); PG8_STAGE(PG8_SA(0, 0), a2, voffA);
            PG8_BAR; PG8_WAIT_L(0); PG8_MMA(1, 0, At, B0); PG8_BAR; PG8_SCHED;
            PG8_STAGE(PG8_SB(0, 1), b2 + hstep, voffB);
            PG8_WAIT_V(6); PG8_BAR; PG8_MMA(1, 1, At, B1); PG8_BAR;
            PG8_LDB(B0, 1, 0); PG8_SCHED; PG8_LDA(At, 1, 0); PG8_STAGE(PG8_SA(0, 1), a2 + hstep, voffA);
            PG8_WAIT_L(8); PG8_BAR; PG8_WAIT_L(0); PG8_MMA(0, 0, At, B0); PG8_BAR; PG8_SCHED;
            PG8_LDB(B1, 1, 1); PG8_STAGE(PG8_SB(1, 0), b3, voffB);
            PG8_BAR; PG8_WAIT_L(0); PG8_MMA(0, 1, At, B1); PG8_BAR;
            PG8_LDA(At, 1, 1); PG8_STAGE(PG8_SA(1, 0), a3, voffA);
            PG8_BAR; PG8_WAIT_L(0); PG8_MMA(1, 0, At, B0); PG8_BAR; PG8_SCHED;
            PG8_STAGE(PG8_SB(1, 1), b3 + hstep, voffB);
            PG8_WAIT_V(6); PG8_BAR; PG8_MMA(1, 1, At, B1); PG8_BAR;
            }
        }
        if constexpr (ALIGN_EPI) { if (wr == 0) PG8_BAR; }
        if constexpr (!Epi::AFTER_DRAIN) { E(acc, cur, wr, wc, fr, fq); S.done(cur); }
        if (!has_next) break;
#pragma unroll
        for (int a = 0; a < 2; ++a)
#pragma unroll
            for (int b = 0; b < 2; ++b)
#pragma unroll
                for (int m = 0; m < 4; ++m)
#pragma unroll
                    for (int n = 0; n < 2; ++n) acc[a][b][m][n] = (f32x4){0.f, 0.f, 0.f, 0.f};
        cur = nxt; cA = nA; cB = nB; ++ui;
        if constexpr (ALIGN_EPI) { if (wr == 1) PG8_BAR; }
    }
    PG8_WAIT_V(0);
    if constexpr (!ALIGN_EPI) { if (wr == 0) PG8_BAR; }
    PG8_BAR;
    if constexpr (Epi::AFTER_DRAIN) { E.fused(acc, cur, wr, wc, fr, fq, lds, wid, lane); S.done(cur); }
#undef PG8_SA
#undef PG8_SB
#undef PG8_STAGE
#undef PG8_LDA
#undef PG8_LDB
#undef PG8_MMA
#undef PG8_WAIT_V
#undef PG8_WAIT_L
#undef PG8_BAR
#undef PG8_SCHED
}
}
#define LAS __attribute__((address_space(3)))
using pg8::bf16_t; using pg8::bf16x8; using pg8::f32x4; using pg8::u32x4; using pg8::u32x2; using pg8::cvt_pk_bf16; using pg8::RMS_EPS;
constexpr int BATCH = 4, SEQ = 4096, D = 2048, M = BATCH * SEQ, NMEM = 256, MM = BATCH * NMEM, DFF = 5632, DPOOL = 1024, DSGU = 1024;
constexpr int NWAVES = 8, NTHR = NWAVES * 64;
constexpr int LDS_BYTES = 147456;
constexpr size_t MiB = 1u << 20;
constexpr size_t WS_BAR = 0, WS_PCNT = 16384, WS_ZERO_BYTES = 65536;
constexpr size_t WS_WIN = 1 * MiB, WS_WOUT = 13 * MiB, WS_WQ = 21 * MiB, WS_WK = 29 * MiB, WS_WV = 37 * MiB, WS_WO = 45 * MiB, WS_WGU = 53 * MiB, WS_WD = 97 * MiB;
constexpr size_t WS_PW = 119 * MiB, WS_WSP = 119 * MiB + 512 * 1024;
constexpr size_t WS_MN = 120 * MiB, WS_KB = 124 * MiB, WS_VTM = 128 * MiB;
constexpr size_t WS_XB = 132 * MiB;
constexpr size_t WS_HG = 196 * MiB;
constexpr size_t WS_PAU = 196 * MiB, WS_Q = 196 * MiB, WS_VT = 260 * MiB, WS_Y = 292 * MiB, WS_O = 292 * MiB;
constexpr size_t WS_PM = 260 * MiB;
constexpr size_t WS_RSP = 356 * MiB;
constexpr size_t WS_SS1 = 372 * MiB, WS_SS2 = WS_SS1 + 512 * 1024, WS_SS3 = WS_SS2 + 512 * 1024;
constexpr size_t WS_RS0 = 375 * MiB;
constexpr size_t WS_WQK = 356 * MiB;
constexpr size_t WS_VWO = 376 * MiB;
constexpr size_t WS_PWN = 392 * MiB;
constexpr size_t WS_END = 396 * MiB;

__device__ __forceinline__ float bf_lo(unsigned w) { return __uint_as_float(w << 16); }
__device__ __forceinline__ float bf_hi(unsigned w) { return __uint_as_float(w & 0xffff0000u); }
__device__ __forceinline__ float wave_sum(float v) {
#pragma unroll
    for (int o = 1; o < 64; o <<= 1) v += __shfl_xor(v, o);
    return v;
}
#define LDS_WAIT() asm volatile("s_waitcnt lgkmcnt(0)" ::: "memory")
#define MFMA16(a, b, c) __builtin_amdgcn_mfma_f32_16x16x32_bf16((a), (b), (c), 0, 0, 0)

#define XB_TMO      128
#define XB_XCNT(j)  (256  + 64 * (j))
#define XB_XSUB(j)  (1280 + 64 * (j))
#define XB_XGEN(j)  (2304 + 64 * (j))
#define XB_TOP      3328
#define XB_TOPGEN   3392
#define XCD_BAR_WORDS 3456
#define XB_SPIN_CAP (1u << 18)

__device__ __forceinline__ unsigned xb_ld(unsigned* p)              { return __hip_atomic_load(p, __ATOMIC_RELAXED, __HIP_MEMORY_SCOPE_AGENT); }
__device__ __forceinline__ unsigned xb_add(unsigned* p, unsigned v) { return __hip_atomic_fetch_add(p, v, __ATOMIC_RELAXED, __HIP_MEMORY_SCOPE_AGENT); }
__device__ __forceinline__ unsigned xb_xcc_id() { return (unsigned)__builtin_amdgcn_s_getreg((3 << 11) | 20) & 0xFu; }
#define XB_SPIN(cond, bar) do { unsigned _sp = 0; while (cond) { __builtin_amdgcn_s_sleep(1); \
    if ((++_sp & 255u) == 0u) { if (xb_ld(&(bar)[XB_TMO])) break; if (_sp > XB_SPIN_CAP) { atomicAdd(&(bar)[XB_TMO], 1u); break; } } } } while (0)

struct XcdBarrier {
    unsigned* bar; unsigned x;
    volatile LAS unsigned* st;
};

__device__ __forceinline__ XcdBarrier xcd_barrier_post(unsigned* bar, volatile LAS unsigned* st) {
    XcdBarrier b; b.bar = bar; b.x = xb_xcc_id(); b.st = st;
    if (threadIdx.x == 0) (void)xb_add(&bar[XB_XCNT(b.x)], 1u);
    return b;
}
__device__ __forceinline__ void xcd_barrier_complete(unsigned* bar, unsigned x, unsigned& nloc, unsigned& nx) {
    const unsigned G = gridDim.x * gridDim.y * gridDim.z;
    unsigned sum, cnt, mine, sp = 0u;
    for (;;) {
        sum = 0u; cnt = 0u; mine = 0u;
#pragma unroll
        for (unsigned j = 0; j < 16; ++j) { const unsigned c = xb_ld(&bar[XB_XCNT(j)]); sum += c; cnt += (c > 0u) ? 1u : 0u; mine = (j == x) ? c : mine; }
        if (sum == G) break;
        __builtin_amdgcn_s_sleep(1);
        if ((++sp & 255u) == 0u) { if (xb_ld(&bar[XB_TMO])) break; if (sp > XB_SPIN_CAP) { atomicAdd(&bar[XB_TMO], 1u); break; } }
    }
    nloc = mine > 0u ? mine : 1u; nx = cnt > 0u ? cnt : 1u;
}

__device__ __forceinline__ void xcd_barrier(const XcdBarrier& b) {
    asm volatile("s_waitcnt vmcnt(0)" ::: "memory");
    __syncthreads();
    if (threadIdx.x == 0) {
        unsigned* bar = b.bar;
        __builtin_amdgcn_s_waitcnt(0);
        unsigned nloc = b.st[0], nx = b.st[1];
        if (nloc == 0u) { xcd_barrier_complete(bar, b.x, nloc, nx); b.st[0] = nloc; b.st[1] = nx; }
        const unsigned old = xb_add(&bar[XB_XSUB(b.x)], 1u);
        const unsigned gen = old / nloc;
        if (old + 1u == (gen + 1u) * nloc) {
            __builtin_amdgcn_fence(__ATOMIC_RELEASE, "agent");
            asm volatile("s_waitcnt vmcnt(0)" ::: "memory");
            const unsigned og = xb_add(&bar[XB_TOP], 1u);
            const unsigned tg = og / nx;
            if (og + 1u == (tg + 1u) * nx) xb_add(&bar[XB_TOPGEN], 1u);
            else XB_SPIN(xb_ld(&bar[XB_TOPGEN]) == tg, bar);
            __builtin_amdgcn_fence(__ATOMIC_ACQUIRE, "agent");
            xb_add(&bar[XB_XGEN(b.x)], 1u);
            asm volatile("s_waitcnt vmcnt(0)" ::: "memory");
        } else {
            XB_SPIN(xb_ld(&bar[XB_XGEN(b.x)]) == gen, bar);
            __builtin_amdgcn_fence(__ATOMIC_ACQUIRE, "agent");
            asm volatile("s_waitcnt vmcnt(0)" ::: "memory");
        }
    }
    __syncthreads();
}

__device__ __forceinline__ void tr_item(const float* W, int ldw, int k0, int n0, bf16_t* WT, int ldt, int orow0, const float* kgain, const float* nscale, LAS float* scr, int lane) {
    f32x4 v[16];
#pragma unroll
    for (int i = 0; i < 16; ++i) { const int kk = 4 * i + (lane >> 4), nn = (lane & 15) * 4; v[i] = *(const f32x4*)(W + (size_t)(k0 + kk) * ldw + n0 + nn); }
#pragma unroll
    for (int i = 0; i < 16; ++i) { const int kk = 4 * i + (lane >> 4), nn = (lane & 15) * 4;
        if (kgain) v[i] = v[i] * kgain[k0 + kk];
        LAS float* s = scr + kk * 65 + nn; s[0] = v[i][0]; s[1] = v[i][1]; s[2] = v[i][2]; s[3] = v[i][3]; }
    LDS_WAIT();
    const int c = lane & 7;
#pragma unroll
    for (int j = 0; j < 8; ++j) { const int n = (lane >> 3) + 8 * j; const LAS float* s = scr + (8 * c) * 65 + n;
        const float sc = nscale ? nscale[n] : 1.0f;
        u32x4 o; o.x = cvt_pk_bf16(s[0 * 65] * sc, s[1 * 65] * sc); o.y = cvt_pk_bf16(s[2 * 65] * sc, s[3 * 65] * sc); o.z = cvt_pk_bf16(s[4 * 65] * sc, s[5 * 65] * sc); o.w = cvt_pk_bf16(s[6 * 65] * sc, s[7 * 65] * sc);
        *(u32x4*)(WT + (size_t)(orow0 + n) * ldt + k0 + 8 * c) = o; }
    LDS_WAIT();
}
__device__ __forceinline__ void norm_row_bf16(const float* xrow, const float* g, bf16_t* orow, int lane) {
    const f32x4* xr = (const f32x4*)xrow + lane; f32x4 v[8]; float s = 0.f;
#pragma unroll
    for (int j = 0; j < 8; ++j) { v[j] = xr[64 * j]; s += (v[j][0] * v[j][0] + v[j][1] * v[j][1]) + (v[j][2] * v[j][2] + v[j][3] * v[j][3]); }
    const float rstd = 1.0f / sqrtf(wave_sum(s) * (1.0f / D) + RMS_EPS);
    const f32x4* gr = (const f32x4*)g + lane; u32x2* o = (u32x2*)orow + lane;
#pragma unroll
    for (int j = 0; j < 8; ++j) { const f32x4 gg = gr[64 * j]; const f32x4 y = v[j] * rstd * gg; u32x2 w; w.x = cvt_pk_bf16(y[0], y[1]); w.y = cvt_pk_bf16(y[2], y[3]); o[64 * j] = w; }
}
__device__ __forceinline__ void norm_row2_bf16(const float* xa, const float* xb_, bool has2, const float* g, bf16_t* oa, bf16_t* ob, int lane) {
    const f32x4* ra = (const f32x4*)xa + lane; const f32x4* rb = (const f32x4*)(has2 ? xb_ : xa) + lane; f32x4 va[8], vb[8]; float sa = 0.f, sb = 0.f;
#pragma unroll
    for (int j = 0; j < 8; ++j) { va[j] = ra[64 * j]; vb[j] = rb[64 * j]; }
#pragma unroll
    for (int j = 0; j < 8; ++j) { sa += (va[j][0] * va[j][0] + va[j][1] * va[j][1]) + (va[j][2] * va[j][2] + va[j][3] * va[j][3]); sb += (vb[j][0] * vb[j][0] + vb[j][1] * vb[j][1]) + (vb[j][2] * vb[j][2] + vb[j][3] * vb[j][3]); }
    const float ka = 1.0f / sqrtf(wave_sum(sa) * (1.0f / D) + RMS_EPS), kb = 1.0f / sqrtf(wave_sum(sb) * (1.0f / D) + RMS_EPS);
    const f32x4* gr = (const f32x4*)g + lane; u32x2* pa = (u32x2*)oa + lane; u32x2* pb = (u32x2*)ob + lane;
#pragma unroll
    for (int j = 0; j < 8; ++j) { const f32x4 gg = gr[64 * j]; const f32x4 ya = va[j] * ka * gg, yb = vb[j] * kb * gg; u32x2 w; w.x = cvt_pk_bf16(ya[0], ya[1]); w.y = cvt_pk_bf16(ya[2], ya[3]); pa[64 * j] = w;
        if (has2) { u32x2 w2; w2.x = cvt_pk_bf16(yb[0], yb[1]); w2.y = cvt_pk_bf16(yb[2], yb[3]); pb[64 * j] = w2; } }
}
__device__ __forceinline__ void raw_row2_bf16(const float* xa, const float* xb_, bool has2, bf16_t* oa, bf16_t* ob, float* rsa, float* rsb, int lane) {
    const f32x4* ra = (const f32x4*)xa + lane; const f32x4* rb = (const f32x4*)(has2 ? xb_ : xa) + lane; f32x4 va[8], vb[8]; float sa = 0.f, sb = 0.f;
#pragma unroll
    for (int j = 0; j < 8; ++j) { va[j] = ra[64 * j]; vb[j] = rb[64 * j]; }
    u32x2* pa = (u32x2*)oa + lane; u32x2* pb = (u32x2*)ob + lane;
#pragma unroll
    for (int j = 0; j < 8; ++j) { sa += (va[j][0] * va[j][0] + va[j][1] * va[j][1]) + (va[j][2] * va[j][2] + va[j][3] * va[j][3]); sb += (vb[j][0] * vb[j][0] + vb[j][1] * vb[j][1]) + (vb[j][2] * vb[j][2] + vb[j][3] * vb[j][3]);
        u32x2 w; w.x = cvt_pk_bf16(va[j][0], va[j][1]); w.y = cvt_pk_bf16(va[j][2], va[j][3]); pa[64 * j] = w;
        if (has2) { u32x2 w2; w2.x = cvt_pk_bf16(vb[j][0], vb[j][1]); w2.y = cvt_pk_bf16(vb[j][2], vb[j][3]); pb[64 * j] = w2; } }
    const float ka = 1.0f / sqrtf(wave_sum(sa) * (1.0f / D) + RMS_EPS), kb = 1.0f / sqrtf(wave_sum(sb) * (1.0f / D) + RMS_EPS);
    if (lane == 0) { *rsa = ka; if (has2) *rsb = kb; }
}
__device__ __forceinline__ void norm_row_out(const bf16_t* xrow, float ss, const float* g, float* orow, int lane) {
    const float rstd = 1.0f / sqrtf(ss * (1.0f / D) + RMS_EPS);
#pragma unroll
    for (int j = 0; j < 4; ++j) { const int c = (lane + 64 * j) * 8; const u32x4 w = *(const u32x4*)(xrow + c);
        const f32x4 g0 = *(const f32x4*)(g + c), g1 = *(const f32x4*)(g + c + 4);
        const f32x4 y0 = (f32x4){bf_lo(w.x), bf_hi(w.x), bf_lo(w.y), bf_hi(w.y)} * rstd * g0, y1 = (f32x4){bf_lo(w.z), bf_hi(w.z), bf_lo(w.w), bf_hi(w.w)} * rstd * g1;
        *(f32x4*)(orow + c) = y0; *(f32x4*)(orow + c + 4) = y1; }
}

__device__ __forceinline__ void sgu_unit(LAS unsigned char* lds, int nb, int h0, const bf16_t* VT, const bf16_t* PAU, bf16_t* Y, const bf16_t* WSb, const float* sg, const float* bsp, int tid) {
    asm volatile("" : "+v"(tid));
    const int lane = tid & 63, wave = tid >> 6, fr = lane & 15, fq = lane >> 4;
    const int T0 = nb * 128;
    LAS float* red = (LAS float*)lds;
    LAS float* rstd = (LAS float*)(lds + 4096);
    LAS unsigned char* Bb = lds + 8192;
    {
        const int tg = tid & 15, rl = tid >> 4;
        float s[8];
#pragma unroll
        for (int e = 0; e < 8; ++e) s[e] = 0.f;
#pragma unroll 4
        for (int i = 0; i < 32; ++i) { const int c = rl + 32 * i; const u32x4 w = *(const u32x4*)(VT + (size_t)c * M + T0 + tg * 8);
#pragma unroll
            for (int e = 0; e < 4; ++e) { const float lo = bf_lo(w[e]), hi = bf_hi(w[e]); s[2 * e] += lo * lo; s[2 * e + 1] += hi * hi; } }
#pragma unroll
        for (int e = 0; e < 8; ++e) { s[e] += __shfl_xor(s[e], 16); s[e] += __shfl_xor(s[e], 32); }
        if (fq == 0) {
#pragma unroll
            for (int e = 0; e < 8; ++e) red[wave * 128 + tg * 8 + e] = s[e]; }
    }
    __syncthreads();
    if (tid < 128) { float t = 0.f;
#pragma unroll
        for (int w = 0; w < 8; ++w) t += red[w * 128 + tid];
        rstd[tid] = 1.0f / sqrtf(t * (1.0f / DSGU) + RMS_EPS); }
    __syncthreads();
    const int wr = wave >> 1, wc = wave & 1;
    for (int h = h0; h < h0 + 4; ++h) {
        LAS unsigned char* B = Bb + (h & 1) * 34816;
#pragma unroll
        for (int i = 0; i < 4; ++i) { const int p = tid + 512 * i, c = p >> 4, sgp = p & 15;
            const u32x4 w = *(const u32x4*)(VT + (size_t)(h * 128 + c) * M + T0 + sgp * 8);
            const float g = sg[h * 128 + c];
            const f32x4 r0 = *(const LAS f32x4*)(rstd + sgp * 8) * g, r1 = *(const LAS f32x4*)(rstd + sgp * 8 + 4) * g;
            u32x4 o; o.x = cvt_pk_bf16(bf_lo(w.x) * r0[0], bf_hi(w.x) * r0[1]); o.y = cvt_pk_bf16(bf_lo(w.y) * r0[2], bf_hi(w.y) * r0[3]);
            o.z = cvt_pk_bf16(bf_lo(w.z) * r1[0], bf_hi(w.z) * r1[1]); o.w = cvt_pk_bf16(bf_lo(w.w) * r1[2], bf_hi(w.w) * r1[3]);
            *(LAS u32x4*)(B + c * 272 + sgp * 16) = o; }
        __syncthreads();
        f32x4 acc[2][4];
#pragma unroll
        for (int m = 0; m < 2; ++m)
#pragma unroll
            for (int n = 0; n < 4; ++n) acc[m][n] = (f32x4){0.f, 0.f, 0.f, 0.f};
#pragma unroll
        for (int ks = 0; ks < 4; ++ks) { bf16x8 a[2], b[4];
#pragma unroll
            for (int m = 0; m < 2; ++m) a[m] = *(const bf16x8*)(WSb + (size_t)((h * 128 + wr * 32 + m * 16 + fr) * 128 + ks * 32 + fq * 8));
#pragma unroll
            for (int n = 0; n < 4; ++n) b[n] = *(const LAS bf16x8*)(B + (wc * 64 + n * 16 + fr) * 272 + (ks * 32 + fq * 8) * 2);
#pragma unroll
            for (int m = 0; m < 2; ++m)
#pragma unroll
                for (int n = 0; n < 4; ++n) acc[m][n] = MFMA16(b[n], a[m], acc[m][n]); }
#pragma unroll
        for (int m = 0; m < 2; ++m) { const int t = wr * 32 + m * 16 + fr; const float bias = bsp[h * 128 + t];
#pragma unroll
            for (int n = 0; n < 4; ++n) { const size_t off = (size_t)(T0 + t) * D + DPOOL + h * 128 + wc * 64 + n * 16 + fq * 4;
                const u32x2 uu = *(const u32x2*)(PAU + off); const f32x4 mx = acc[m][n] + bias;
                u32x2 o; o.x = cvt_pk_bf16(bf_lo(uu.x) * mx[0], bf_hi(uu.x) * mx[1]); o.y = cvt_pk_bf16(bf_lo(uu.y) * mx[2], bf_hi(uu.y) * mx[3]);
                *(u32x2*)(Y + off) = o; } }
    }
    __syncthreads();
}
template <int W> __device__ __forceinline__ void pool_p(const bf16_t* base, bf16_t* ybase, int ts, int tp0) {
    u32x4 arr[W + 7];
#pragma unroll
    for (int j = 0; j < W + 7; ++j) { const int t = ts - (W - 1) + j, tc = t < -tp0 ? -tp0 : t; arr[j] = *(const u32x4*)(base + (ptrdiff_t)tc * D); }
#pragma unroll
    for (int j = 0; j < W - 1; ++j) { const int t = ts - (W - 1) + j; if (tp0 + t < 0) arr[j] = (u32x4){0u, 0u, 0u, 0u}; }
    float S[8];
#pragma unroll
    for (int e = 0; e < 8; ++e) S[e] = 0.f;
#pragma unroll
    for (int j = 0; j < W - 1; ++j)
#pragma unroll
        for (int e = 0; e < 4; ++e) { S[2 * e] += bf_lo(arr[j][e]); S[2 * e + 1] += bf_hi(arr[j][e]); }
#pragma unroll
    for (int i = 0; i < 8; ++i) { const int t = ts + i, tp = tp0 + t; float cur[8], p[8];
#pragma unroll
        for (int e = 0; e < 4; ++e) { cur[2 * e] = bf_lo(arr[W - 1 + i][e]); cur[2 * e + 1] = bf_hi(arr[W - 1 + i][e]); }
        const float inv = 1.0f / (float)(tp + 1 < W ? tp + 1 : W);
#pragma unroll
        for (int e = 0; e < 8; ++e) { S[e] += cur[e]; p[e] = S[e] * inv - cur[e]; }
        u32x4 o; o.x = cvt_pk_bf16(p[0], p[1]); o.y = cvt_pk_bf16(p[2], p[3]); o.z = cvt_pk_bf16(p[4], p[5]); o.w = cvt_pk_bf16(p[6], p[7]);
        *(u32x4*)(ybase + (size_t)t * D) = o;
#pragma unroll
        for (int e = 0; e < 4; ++e) { S[2 * e] -= bf_lo(arr[i][e]); S[2 * e + 1] -= bf_hi(arr[i][e]); } }
}
__device__ __forceinline__ void pool_half(int nb, int gh, const bf16_t* PAU, bf16_t* Y, int tid) {
    asm volatile("" : "+v"(tid));
    const int T0 = nb * 128, tp0 = T0 & (SEQ - 1), cgp = tid & 31, ts = (tid >> 5) * 8;
    const bf16_t* src = PAU + (size_t)T0 * D + cgp * 8; bf16_t* dst = Y + (size_t)T0 * D + cgp * 8;
    if (gh == 0) { pool_p<2>(src, dst, ts, tp0); pool_p<16>(src + 768, dst + 768, ts, tp0); }
    else { pool_p<4>(src + 256, dst + 256, ts, tp0); pool_p<8>(src + 512, dst + 512, ts, tp0); }
}
__device__ __forceinline__ void attn_unit(LAS unsigned char* lds, int unit, const bf16_t* Q, const bf16_t* KB, const bf16_t* VTM, bf16_t* O, int tid) {
    asm volatile("" : "+v"(tid));
    const int lane = tid & 63, wave = tid >> 6, fr = lane & 15, fq = lane >> 4, wr = wave >> 1, wc = wave & 1;
    const int qt = unit & 31, h = (unit >> 5) & 3, b = unit >> 7;
    const int R0 = b * SEQ + qt * 128;
    LAS unsigned char* P = lds;
    LAS float* xm = (LAS float*)(lds + 67584);
    LAS float* xs = xm + 256;
    f32x4 acc[2][8];
#pragma unroll
    for (int m = 0; m < 2; ++m)
#pragma unroll
        for (int n = 0; n < 8; ++n) acc[m][n] = (f32x4){0.f, 0.f, 0.f, 0.f};
    const bf16_t* qp = Q + (size_t)(R0 + wr * 32 + fr) * D + h * 512 + fq * 8;
    const bf16_t* kp = KB + (size_t)(b * NMEM + wc * 128 + fr) * D + h * 512 + fq * 8;
#pragma unroll 2
    for (int ks = 0; ks < 16; ++ks) { bf16x8 a[2], bb[8];
#pragma unroll
        for (int m = 0; m < 2; ++m) a[m] = *(const bf16x8*)(qp + (size_t)m * 16 * D + ks * 32);
#pragma unroll
        for (int n = 0; n < 8; ++n) bb[n] = *(const bf16x8*)(kp + (size_t)n * 16 * D + ks * 32);
#pragma unroll
        for (int m = 0; m < 2; ++m)
#pragma unroll
            for (int n = 0; n < 8; ++n) acc[m][n] = MFMA16(bb[n], a[m], acc[m][n]); }
    const float sc = 0.044194173824159216f;
#pragma unroll
    for (int m = 0; m < 2; ++m) { float v = -3.0e38f;
#pragma unroll
        for (int n = 0; n < 8; ++n) { acc[m][n] = acc[m][n] * sc; v = fmaxf(v, fmaxf(fmaxf(acc[m][n][0], acc[m][n][1]), fmaxf(acc[m][n][2], acc[m][n][3]))); }
        v = fmaxf(v, __shfl_xor(v, 16)); v = fmaxf(v, __shfl_xor(v, 32));
        if (fq == 0) xm[wc * 128 + wr * 32 + m * 16 + fr] = v; }
    __syncthreads();
#pragma unroll
    for (int m = 0; m < 2; ++m) { const int row = wr * 32 + m * 16 + fr; const float mx = fmaxf(xm[row], xm[128 + row]); float s = 0.f;
#pragma unroll
        for (int n = 0; n < 8; ++n) { const float p0 = __expf(acc[m][n][0] - mx), p1 = __expf(acc[m][n][1] - mx), p2 = __expf(acc[m][n][2] - mx), p3 = __expf(acc[m][n][3] - mx);
            s += (p0 + p1) + (p2 + p3);
            u32x2 o; o.x = cvt_pk_bf16(p0, p1); o.y = cvt_pk_bf16(p2, p3);
            *(LAS u32x2*)(P + row * 528 + (wc * 128 + n * 16 + fq * 4) * 2) = o; }
        s += __shfl_xor(s, 16); s += __shfl_xor(s, 32);
        if (fq == 0) xs[wc * 128 + row] = s; }
    __syncthreads();
    float inv[2];
#pragma unroll
    for (int m = 0; m < 2; ++m) { const int row = wr * 32 + m * 16 + fr; inv[m] = 1.0f / (xs[row] + xs[128 + row]); }
    f32x4 o[2][16];
#pragma unroll
    for (int m = 0; m < 2; ++m)
#pragma unroll
        for (int n = 0; n < 16; ++n) o[m][n] = (f32x4){0.f, 0.f, 0.f, 0.f};
    const bf16_t* vp = VTM + (size_t)(h * 512 + wc * 256 + fr) * MM + b * NMEM + fq * 8;
    for (int ks = 0; ks < 8; ++ks) { bf16x8 a[2];
#pragma unroll
        for (int m = 0; m < 2; ++m) a[m] = *(const LAS bf16x8*)(P + (wr * 32 + m * 16 + fr) * 528 + (ks * 32 + fq * 8) * 2);
#pragma unroll
        for (int n = 0; n < 16; ++n) { const bf16x8 bv = *(const bf16x8*)(vp + (size_t)n * 16 * MM + ks * 32);
#pragma unroll
            for (int m = 0; m < 2; ++m) o[m][n] = MFMA16(bv, a[m], o[m][n]); } }
#pragma unroll
    for (int m = 0; m < 2; ++m) { const size_t rowoff = (size_t)(R0 + wr * 32 + m * 16 + fr) * D + h * 512 + wc * 256 + fq * 4;
#pragma unroll
        for (int n = 0; n < 16; ++n) { const f32x4 v = o[m][n] * inv[m]; u32x2 w; w.x = cvt_pk_bf16(v[0], v[1]); w.y = cvt_pk_bf16(v[2], v[3]); *(u32x2*)(O + rowoff + n * 16) = w; } }
    __syncthreads();
}

#ifndef REP_P0
#define REP_P0 1
#endif
#ifndef REP_P0N
#define REP_P0N 1
#endif
#ifndef REP_P1
#define REP_P1 1
#endif
#ifndef REP_P3
#define REP_P3 1
#endif
#ifndef REP_P7
#define REP_P7 1
#endif
#ifndef TS_K
#define TS_K -1
#endif
#ifndef ABSORB
#define ABSORB 1
#endif
#ifndef OLD_ATTN
#define OLD_ATTN 0
#endif
#ifndef REP_P2
#define REP_P2 1
#endif
#ifndef REP_P5
#define REP_P5 1
#endif
#ifndef REP_SYNC
#define REP_SYNC 1
#endif
#ifndef REP_P4
#define REP_P4 1
#endif
struct Args { const float* in[21]; float* out; unsigned char* ws; };
#define GEMM_PHASE(EPI, g, S, E) pg8::gemm_phase<EPI, pg8::StaticOrder, true, true>(lds, g, S, E)
__global__ void __launch_bounds__(NTHR, 2) mk_fwd(Args a) {
    extern __shared__ __attribute__((aligned(16))) unsigned char lds_raw[];
    LAS unsigned char* lds = (LAS unsigned char*)lds_raw;
    cg::grid_group grid = cg::this_grid();
    const int G = gridDim.x, bx = blockIdx.x;
    volatile LAS unsigned* bar_st = (volatile LAS unsigned*)(lds + LDS_BYTES - 64);
    if (threadIdx.x < 2) bar_st[threadIdx.x] = 0u;
    __syncthreads();
    const XcdBarrier xbar = xcd_barrier_post((unsigned*)(a.ws + WS_BAR), bar_st);
    volatile LAS unsigned* ts_lds = (volatile LAS unsigned*)(lds + LDS_BYTES - 32);
    if (TS_K >= 0 && bx == 0 && threadIdx.x == 0) ts_lds[0] = (unsigned)__builtin_amdgcn_s_memrealtime();
#define STAMP(k) do { if (TS_K == (k) && bx == 0 && threadIdx.x == 0) ts_lds[1] = (unsigned)__builtin_amdgcn_s_memrealtime(); } while (0)
#define TID_FRESH() ({ int t_ = threadIdx.x; asm volatile("" : "+v"(t_)); t_; })
    const float *x = a.in[0], *mem = a.in[1], *norm_mix_g = a.in[2], *w_in = a.in[3], *pool_w = a.in[4], *pool_scale = a.in[5], *sgu_norm_g = a.in[6], *w_spatial = a.in[7], *b_spatial = a.in[8],
                *w_out = a.in[9], *norm_xattn_g = a.in[10], *norm_mem_g = a.in[11], *w_q = a.in[12], *w_k = a.in[13], *w_v = a.in[14], *w_o = a.in[15], *norm_ffn_g = a.in[16],
                *w_gate = a.in[17], *w_up = a.in[18], *w_down = a.in[19], *final_norm_g = a.in[20];
    float* out = a.out; unsigned char* ws = a.ws;
    float *SS1 = (float*)(ws + WS_SS1), *SS2 = (float*)(ws + WS_SS2), *SS3 = (float*)(ws + WS_SS3);
    bf16_t *Win_t = (bf16_t*)(ws + WS_WIN), *Wout_t = (bf16_t*)(ws + WS_WOUT), *Wq_t = (bf16_t*)(ws + WS_WQ), *Wk_t = (bf16_t*)(ws + WS_WK), *Wv_t = (bf16_t*)(ws + WS_WV), *Wo_t = (bf16_t*)(ws + WS_WO),
           *Wgu_t = (bf16_t*)(ws + WS_WGU), *Wd_t = (bf16_t*)(ws + WS_WD), *PWt = (bf16_t*)(ws + WS_PW), *WSb = (bf16_t*)(ws + WS_WSP), *MN = (bf16_t*)(ws + WS_MN), *KB = (bf16_t*)(ws + WS_KB),
           *VTM = (bf16_t*)(ws + WS_VTM), *XB = (bf16_t*)(ws + WS_XB), *HG = (bf16_t*)(ws + WS_HG), *PAU = (bf16_t*)(ws + WS_PAU), *Qb = (bf16_t*)(ws + WS_Q), *VT = (bf16_t*)(ws + WS_VT),
           *Yb = (bf16_t*)(ws + WS_Y), *Ob = (bf16_t*)(ws + WS_O);

    {
        const int tid = TID_FRESH(), lane = tid & 63, wave = __builtin_amdgcn_readfirstlane(tid >> 6);
        LAS float* scr = (LAS float*)(lds + wave * 16640);
        const int gw = bx * NWAVES + wave, NGW = G * NWAVES;
        constexpr int I_IN = 32 * 48, I_SQ = 32 * 32, I_PW = 4 * 16;
        constexpr int NITEMS = I_IN + 4 * I_SQ + I_PW;
        { float* RS0 = (float*)(ws + WS_RS0); for (int m = gw; m < M; m += 2 * NGW) raw_row2_bf16(x + (size_t)m * D, x + (size_t)(m + NGW) * D, m + NGW < M, XB + (size_t)m * D, XB + (size_t)(m + NGW) * D, RS0 + m, RS0 + m + NGW, lane); }
        for (int m = gw; m < MM; m += NGW) norm_row_bf16(mem + (size_t)m * D, norm_mem_g, MN + (size_t)m * D, lane);
        for (int it = gw; it < NITEMS * REP_P0; it += NGW) {
            int r = it % NITEMS;
            if (r < I_IN) { tr_item(w_in, 3072, (r / 48) * 64, (r % 48) * 64, Win_t, D, (r % 48) * 64, norm_mix_g, nullptr, scr, lane); continue; } r -= I_IN;
            if (r < I_SQ) { tr_item(w_k, D, (r / 32) * 64, (r % 32) * 64, Wk_t, D, (r % 32) * 64, nullptr, nullptr, scr, lane); continue; } r -= I_SQ;
            if (r < I_SQ) { tr_item(w_v, D, (r / 32) * 64, (r % 32) * 64, Wv_t, D, (r % 32) * 64, nullptr, nullptr, scr, lane); continue; } r -= I_SQ;
            if (r < I_SQ) { tr_item(w_out, D, (r / 32) * 64, (r % 32) * 64, Wout_t, D, (r % 32) * 64, nullptr, nullptr, scr, lane); continue; } r -= I_SQ;
#if ABSORB
            if (r < I_SQ) continue; r -= I_SQ;
#else
            if (r < I_SQ) { tr_item(w_q, D, (r / 32) * 64, (r % 32) * 64, Wq_t, D, (r % 32) * 64, norm_xattn_g, nullptr, scr, lane); continue; } r -= I_SQ;
#endif
            {
              bf16_t* PWn = (bf16_t*)(ws + WS_PWN);
#pragma unroll 4
              for (int j = 0; j < 16; ++j) { const int gc = r * 16 + j, g = gc >> 8; const f32x4 v = *(const f32x4*)(pool_w + (size_t)gc * 256 + lane * 4) * *(const f32x4*)(pool_scale + g * 256 + lane * 4);
                  u32x2 o; o.x = cvt_pk_bf16(v[0], v[1]); o.y = cvt_pk_bf16(v[2], v[3]); *(u32x2*)(PWn + (size_t)gc * 2048 + lane * 4) = o; *(u32x2*)(PWn + (size_t)gc * 2048 + 256 + lane * 4) = (u32x2){0u, 0u}; } }
        }
        for (int i = bx * NTHR + tid; i < 8 * 128 * 128 / 4; i += G * NTHR) { const f32x4 v = *((const f32x4*)w_spatial + i); const int s = (i * 4) & 127, t = ((i * 4) >> 7) & 127;
            const bool keep = (s >> 6) <= (t >> 6); u32x2 o; o.x = keep ? cvt_pk_bf16(v[0], v[1]) : 0u; o.y = keep ? cvt_pk_bf16(v[2], v[3]) : 0u; *((u32x2*)WSb + i) = o; }
    }
    if (a.ws == nullptr) grid.sync();
    xcd_barrier(xbar);
    STAMP(0);
    for (int rep = 0; rep < REP_P1; ++rep) {
        { pg8::Gemm g{XB, Win_t, M, 2048, D, D}; pg8::StaticOrder S; S.init(M, 2048, G, bx); pg8::EpiRowScaleC E{PAU, D, (const float*)(ws + WS_RS0)}; GEMM_PHASE(pg8::EpiRowScaleC, g, S, E); }
        { pg8::Gemm g{Win_t + (size_t)2048 * D, XB, 1024, M, D, D}; pg8::StaticOrder S; S.init(1024, M, G, bx); pg8::EpiColScale E{VT, M, (const float*)(ws + WS_RS0)}; GEMM_PHASE(pg8::EpiColScale, g, S, E); }
        { pg8::Gemm g{MN, Wk_t, MM, D, D, D}; pg8::StaticOrder S; S.init(MM, D, G, bx); pg8::EpiPlain E{KB, D}; GEMM_PHASE(pg8::EpiPlain, g, S, E); }
#if ABSORB
        { pg8::Gemm g{MN, Wv_t, MM, D, D, D}; pg8::StaticOrder S; S.init(MM, D, G, (bx + G - 32) % G); pg8::EpiPlain E{VTM, D}; GEMM_PHASE(pg8::EpiPlain, g, S, E); }
#else
        { pg8::Gemm g{Wv_t, MN, D, MM, D, D}; pg8::StaticOrder S; S.init(D, MM, G, (bx + G - 32) % G); pg8::EpiPlain E{VTM, MM}; GEMM_PHASE(pg8::EpiPlain, g, S, E); }
#endif
        { pg8::Gemm g{KB, Wq_t, 4096, D, 512, D}; pg8::PreQKOrder S{G, bx + 128, 160, Wout_t, (const bf16_t*)(ws + WS_PWN)}; pg8::EpiPre E{(bf16_t*)(ws + WS_WQK), Wout_t};
          pg8::gemm_phase<pg8::EpiPre, pg8::PreQKOrder, true, true>(lds, g, S, E); }
        {
            const int f0q = G > 64 ? 64 : 0; const int cq = bx - f0q, ncu = G - f0q;
            if (cq >= 0) { const int tid = TID_FRESH(), lane = tid & 63, wave = __builtin_amdgcn_readfirstlane(tid >> 6);
                for (int it = cq * NWAVES + wave; it < 1024; it += ncu * NWAVES) { const int k = it * 2 + (lane >> 5);
                    const float gk = norm_xattn_g[k]; const f32x4* src = (const f32x4*)(w_q + (size_t)k * D); u32x2* dst = (u32x2*)(Wq_t + (size_t)k * D);
#pragma unroll 4
                    for (int j = 0; j < 16; ++j) { const int q = (lane & 31) + 32 * j; const f32x4 v = src[q] * gk; u32x2 o; o.x = cvt_pk_bf16(v[0], v[1]); o.y = cvt_pk_bf16(v[2], v[3]); dst[q] = o; } } } }
        const int f0 = G > 64 ? 64 : 0;
        if (bx >= f0) {
            const int tid = TID_FRESH(), lane = tid & 63, wave = __builtin_amdgcn_readfirstlane(tid >> 6);
            LAS float* scr = (LAS float*)(lds + wave * 16640);
            constexpr int I_SQ = 32 * 32, I_GU = 32 * 88, I_DN = 88 * 32, NIT = I_SQ + 2 * I_GU + I_DN;
            for (int it = (bx - f0) * NWAVES + wave; it < NIT; it += (G - f0) * NWAVES) {
                int r = it;
                if (r < I_SQ) { tr_item(w_o, D, (r / 32) * 64, (r % 32) * 64, Wo_t, D, (r % 32) * 64, nullptr, nullptr, scr, lane); continue; } r -= I_SQ;
                if (r < 2 * I_GU) { const int up = r >= I_GU; if (up) r -= I_GU; const int n0 = (r % 88) * 64;
                    tr_item(up ? w_up : w_gate, DFF, (r / 88) * 64, n0, Wgu_t, D, (n0 >> 7) * 256 + (n0 & 127) + up * 128, norm_ffn_g, nullptr, scr, lane); continue; } r -= 2 * I_GU;
                tr_item(w_down, D, (r / 32) * 64, (r % 32) * 64, Wd_t, DFF, (r % 32) * 64, nullptr, nullptr, scr, lane);
            }
        }
    }
    xcd_barrier(xbar);
    STAMP(101);
    for (int uu = bx; uu < 256 * REP_P2; uu += G) { const int u = uu & 255; sgu_unit(lds, u >> 1, (u & 1) * 4, VT, PAU, Yb, WSb, sgu_norm_g, b_spatial, (int)threadIdx.x); pool_half(u >> 1, u & 1, PAU, Yb, (int)threadIdx.x); }
#if ABSORB
    { pg8::Gemm g{KB, Wq_t, 4096, D, 512, D}; pg8::PreQKOrder S{G, bx, 128, Wout_t, (const bf16_t*)(ws + WS_PWN)}; pg8::EpiPre E{(bf16_t*)(ws + WS_WQK), Wout_t}; pg8::gemm_phase<pg8::EpiPre, pg8::PreQKOrder, true, true>(lds, g, S, E); }
    { pg8::Gemm g{Wo_t, VTM, 8192, 1024, 512, D}; pg8::PreVOOrder S{G, (bx + G - 128 % G) % G}; pg8::EpiPlain E{(bf16_t*)(ws + WS_VWO), 1024}; pg8::gemm_phase<pg8::EpiPlain, pg8::PreVOOrder, true, true>(lds, g, S, E); }
#endif
    xcd_barrier(xbar);
    STAMP(102);
    for (int rep = 0; rep < REP_P3; ++rep) { pg8::Gemm g{Yb, Wout_t, M, D, D, D}; pg8::StaticOrder S; S.init(M, D, G, bx); pg8::EpiResid<false> E{nullptr, XB, XB, SS1, D, (LAS float*)(lds + 131072)}; GEMM_PHASE(pg8::EpiResid<false>, g, S, E); }
    xcd_barrier(xbar);
    STAMP(103);
#if ABSORB
    { pg8::Gemm g{XB, (const bf16_t*)(ws + WS_WQK), M, 1024, D, D}; pg8::ScoreOrder S{G, bx}; pg8::EpiSoftmaxN E{(bf16_t*)(ws + WS_PM), SS1, 1.0f / D, (LAS float*)(lds + 131072), 0.044194173824159216f * 1.4426950408889634f};
      pg8::gemm_phase<pg8::EpiSoftmaxN, pg8::ScoreOrder, true, true>(lds, g, S, E); }
    xcd_barrier(xbar);
    STAMP(104);
    { pg8::Gemm g{(const bf16_t*)(ws + WS_PM), (const bf16_t*)(ws + WS_VWO), M, D, 1024, 1024}; pg8::AttnOutOrder S{G, bx}; pg8::EpiResid<false> E{nullptr, XB, XB, SS2, D, (LAS float*)(lds + 131072)};
      pg8::gemm_phase<pg8::EpiResid<false>, pg8::AttnOutOrder, true, true>(lds, g, S, E); }
    xcd_barrier(xbar);
    STAMP(108);
#else
    for (int rep = 0; rep < REP_P4; ++rep) { pg8::Gemm g{XB, Wq_t, M, D, D, D}; pg8::StaticOrder S; S.init(M, D, G, bx); pg8::EpiRowScale E{Qb, D, SS1, 1.0f / D}; GEMM_PHASE(pg8::EpiRowScale, g, S, E); }
    xcd_barrier(xbar);
    STAMP(104);
#if OLD_ATTN
    for (int u = bx; u < 512 * REP_P5; u += G) attn_unit(lds, u & 511, Qb, KB, VTM, Ob, (int)threadIdx.x);
    xcd_barrier(xbar);
    STAMP(105);
#else
    for (int rep = 0; rep < REP_P5; ++rep) {
    { pg8::Gemm g{Qb, KB, M, 1024, 512, D}; pg8::AttnSOrder S{G, bx}; pg8::EpiSoftmax E{(bf16_t*)(ws + WS_PM), (float*)(ws + WS_RSP), (LAS float*)(lds + 131072), 0.044194173824159216f * 1.4426950408889634f};
      pg8::gemm_phase<pg8::EpiSoftmax, pg8::AttnSOrder, true, true>(lds, g, S, E); }
    xcd_barrier(xbar);
    STAMP(106);
    { pg8::Gemm g{(const bf16_t*)(ws + WS_PM), VTM, M, 2048, 256, 1024}; pg8::AttnPVOrder S{G, bx}; pg8::EpiAttnOut E{Ob, (const float*)(ws + WS_RSP)};
      pg8::gemm_phase<pg8::EpiAttnOut, pg8::AttnPVOrder, true, true>(lds, g, S, E); }
    xcd_barrier(xbar);
    STAMP(107);
    }
#endif
    { pg8::Gemm g{Ob, Wo_t, M, D, D, D}; pg8::StaticOrder S; S.init(M, D, G, bx); pg8::EpiResid<false> E{nullptr, XB, XB, SS2, D, (LAS float*)(lds + 131072)}; GEMM_PHASE(pg8::EpiResid<false>, g, S, E); }
    xcd_barrier(xbar);
    STAMP(108);
#endif
    for (int rep = 0; rep < REP_P7; ++rep) { pg8::Gemm g{XB, Wgu_t, M, 2 * DFF, D, D}; pg8::StaticOrder S; S.init(M, 2 * DFF, G, bx); pg8::EpiSwiglu E{HG, DFF, SS2, 1.0f / D}; GEMM_PHASE(pg8::EpiSwiglu, g, S, E); }
    xcd_barrier(xbar);
    STAMP(109);
#ifndef FUSE_FINAL
#define FUSE_FINAL 1
#endif
    if (FUSE_FINAL && G == 256) {
        pg8::Gemm g{HG, Wd_t, M, D, DFF, DFF}; pg8::DownOrder S{bx}; pg8::EpiFinal E{XB, out, SS3, (unsigned*)(ws + WS_PCNT), final_norm_g, (LAS float*)(lds + 131072), D};
        pg8::gemm_phase<pg8::EpiFinal, pg8::DownOrder, true, true>(lds, g, S, E);
    } else {
    { pg8::Gemm g{HG, Wd_t, M, D, DFF, DFF}; pg8::StaticOrder S; S.init(M, D, G, bx); pg8::EpiResid<false> E{nullptr, XB, XB, SS3, D, (LAS float*)(lds + 131072)}; GEMM_PHASE(pg8::EpiResid<false>, g, S, E); }
    xcd_barrier(xbar);
    STAMP(110);
    { const int tid = TID_FRESH(), lane = tid & 63, wave = __builtin_amdgcn_readfirstlane(tid >> 6); const int gw = bx * NWAVES + wave, NGW = G * NWAVES;
      for (int m0 = gw; m0 < M; m0 += 4 * NGW) {
          u32x4 w[4][4]; f32x4 pa[4], pb[4];
#pragma unroll
          for (int q = 0; q < 4; ++q) { const int m = m0 + q * NGW; if (m < M) { pa[q] = *(const f32x4*)(SS3 + (size_t)m * 8); pb[q] = *(const f32x4*)(SS3 + (size_t)m * 8 + 4);
#pragma unroll
              for (int j = 0; j < 4; ++j) w[q][j] = *(const u32x4*)(XB + (size_t)m * D + (lane + 64 * j) * 8); } }
#pragma unroll
          for (int q = 0; q < 4; ++q) { const int m = m0 + q * NGW; if (m < M) {
              const float rstd = 1.0f / sqrtf((((pa[q][0] + pa[q][1]) + (pa[q][2] + pa[q][3])) + ((pb[q][0] + pb[q][1]) + (pb[q][2] + pb[q][3]))) * (1.0f / D) + RMS_EPS);
#pragma unroll
              for (int j = 0; j < 4; ++j) { const int c = (lane + 64 * j) * 8; const f32x4 g0 = *(const f32x4*)(final_norm_g + c), g1 = *(const f32x4*)(final_norm_g + c + 4); const u32x4 ww = w[q][j];
                  const f32x4 y0 = (f32x4){bf_lo(ww.x), bf_hi(ww.x), bf_lo(ww.y), bf_hi(ww.y)} * rstd * g0, y1 = (f32x4){bf_lo(ww.z), bf_hi(ww.z), bf_lo(ww.w), bf_hi(ww.w)} * rstd * g1;
                  *(f32x4*)(out + (size_t)m * D + c) = y0; *(f32x4*)(out + (size_t)m * D + c + 4) = y1; } } } } }
    }
    if (TS_K >= 0 && bx == 0 && threadIdx.x == 0) { const unsigned dt = ts_lds[1] - ts_lds[0]; const unsigned t0 = (unsigned)__builtin_amdgcn_s_memrealtime(); while ((unsigned)__builtin_amdgcn_s_memrealtime() - t0 < dt) __builtin_amdgcn_s_sleep(8); }
}

extern "C" void kernel_launch(void* const* d_in, const int* in_sizes, int n_in, void* d_out, int out_size, void* d_ws, size_t ws_size, hipStream_t stream) {
    static int grid = 0;
    if (grid == 0) {
        if (n_in != 21 || in_sizes[0] != M * D || out_size != M * D || ws_size < WS_END) { fprintf(stderr, "kernel_launch: unexpected shapes (n_in %d, in0 %d, out %d, ws %zu); nothing launched\n", n_in, n_in > 0 ? in_sizes[0] : -1, out_size, ws_size); grid = -1; return; }
        int dev = 0, cus = 0, per_cu = 0;
        if (hipGetDevice(&dev) != hipSuccess || hipDeviceGetAttribute(&cus, hipDeviceAttributeMultiprocessorCount, dev) != hipSuccess) { grid = -1; return; }
        if (hipFuncSetAttribute((const void*)mk_fwd, hipFuncAttributeMaxDynamicSharedMemorySize, LDS_BYTES) != hipSuccess) { fprintf(stderr, "kernel_launch: hipFuncSetAttribute failed\n"); grid = -1; return; }
        if (hipOccupancyMaxActiveBlocksPerMultiprocessor(&per_cu, (const void*)mk_fwd, NTHR, LDS_BYTES) != hipSuccess || per_cu < 1) { fprintf(stderr, "kernel_launch: occupancy query says %d blocks per CU\n", per_cu); (void)hipGetLastError(); grid = -1; return; }
        grid = cus * per_cu;
    }
    if (grid < 0) return;
    if (hipMemsetAsync(d_ws, 0, WS_ZERO_BYTES, stream) != hipSuccess) { fprintf(stderr, "kernel_launch: hipMemsetAsync failed\n"); return; }
    Args a{};
    for (int i = 0; i < 21; ++i) a.in[i] = (const float*)d_in[i];
    a.out = (float*)d_out; a.ws = (unsigned char*)d_ws;
    void* args[] = {&a};
    const hipError_t e = hipLaunchCooperativeKernel((const void*)mk_fwd, dim3(grid), dim3(NTHR), args, LDS_BYTES, stream);
    if (e != hipSuccess) fprintf(stderr, "kernel_launch: cooperative launch failed: %s (grid %d)\n", hipGetErrorString(e), grid);
}
```

```cpp
#include <hip/hip_runtime.h>
#include <hip/hip_cooperative_groups.h>
#include <cstdio>
#include <cstdint>
namespace cg = cooperative_groups;
namespace pg8 {
#define PG8_LAS __attribute__((address_space(3)))
typedef unsigned short bf16_t;
typedef short bf16x8 __attribute__((ext_vector_type(8)));
typedef float f32x4 __attribute__((ext_vector_type(4)));
typedef unsigned u32x4 __attribute__((ext_vector_type(4)));
constexpr int BM = 256, BK = 64, HALF = 128, HTB = HALF * BK * 2  , STAGE_BYTES = 8 * HTB, NXCD = 8, WGM = 8;

__host__ __device__ __forceinline__ int lds_byte(int r, int c) { const int st = (r >> 4) * 2 + (c >> 5), rr = r & 15, cc = c & 31, ob = rr * 64 + cc * 2; return st * 1024 + (ob ^ (((ob >> 9) & 1) << 5)); }
__host__ __device__ __forceinline__ void stage_rc(int b, int& R, int& C) { const int st = b / 1024, sb = b % 1024, swz = sb ^ (((sb >> 9) & 1) << 5); R = (st >> 1) * 16 + swz / 64; C = (st & 1) * 32 + (swz % 64) / 2; }
__host__ __device__ __forceinline__ int perm32(int rho) { const int n = rho >> 4, i = rho & 15; return 8 * (i >> 2) + 4 * n + (i & 3); }

__device__ __forceinline__ const bf16_t* sel_ptr(bool c, const bf16_t* a, const bf16_t* b) { const unsigned long long m = 0ull - (unsigned long long)c; return (const bf16_t*)((((unsigned long long)a) & m) | (((unsigned long long)b) & ~m)); }
struct Unit { int pm, pn; };
struct Gemm { const bf16_t* A; const bf16_t* Bt; int M, N, K, ld; };

struct StaticOrder {
    int nM, nN, nwg, G, c;
    __host__ __device__ void init(int M, int N, int G_, int c_) { nM = M / BM; nN = N / BM; nwg = nM * nN; G = G_; c = c_; }
    __host__ __device__ bool next(int i, Unit& u) const {
        const long L = (long)i * G + c; if (L >= nwg) return false;
        int wgid = (int)L; { const int q = nwg / NXCD, r = nwg % NXCD, xcd = wgid % NXCD, off = wgid / NXCD; wgid = (xcd < r ? xcd * (q + 1) : r * (q + 1) + (xcd - r) * q) + off; }
        const int nig = WGM * nN, gid = wgid / nig, fm = gid * WGM, gsz = (nM - fm) < WGM ? (nM - fm) : WGM;
        u.pm = fm + ((wgid % nig) % gsz); u.pn = (wgid % nig) / gsz; return true;
    }
    __device__ __forceinline__ void a_ready(const Unit&) const {}
    __device__ __forceinline__ void done(const Unit&) const {}
    __device__ __forceinline__ const char* pA(const Gemm& g, const Unit& u) const { return (const char*)g.A + (size_t)u.pm * BM * g.ld * 2; }
    __device__ __forceinline__ const char* pB(const Gemm& g, const Unit& u) const { return (const char*)g.Bt + (size_t)u.pn * BM * g.ld * 2; }
};
struct DownOrder {
    int c;
    __device__ bool next(int i, Unit& u) const { if (i > 1) return false; const int xcd = c & 7, j = c >> 3; u.pm = i * 32 + xcd * 4 + (j >> 3); u.pn = j & 7; return true; }
    __device__ __forceinline__ void a_ready(const Unit&) const {}
    __device__ __forceinline__ void done(const Unit&) const {}
    __device__ __forceinline__ const char* pA(const Gemm& g, const Unit& u) const { return (const char*)g.A + (size_t)u.pm * BM * g.ld * 2; }
    __device__ __forceinline__ const char* pB(const Gemm& g, const Unit& u) const { return (const char*)g.Bt + (size_t)u.pn * BM * g.ld * 2; }
};
struct PreQKOrder {
    int G, c0, cmax; const bf16_t* Wout_t; const bf16_t* PWn;
    __device__ __forceinline__ bool next(int i, Unit& u) const { const int c = i * G + c0; if (c >= cmax) return false;
        if (c < 128) { u.pm = (c >> 5) * 4 + ((c >> 3) & 3); u.pn = c & 7; } else { const int q = c - 128; u.pm = 0x1000 | (q >> 2); u.pn = q & 3; } return true; }
    __device__ __forceinline__ void a_ready(const Unit&) const {}
    __device__ __forceinline__ void done(const Unit&) const {}
    __device__ __forceinline__ const char* pA(const Gemm& g, const Unit& u) const { const bool pw = (u.pm & 0x1000) != 0;
        const bf16_t* p = sel_ptr(pw, Wout_t + (size_t)(u.pm & 0xfff) * 256 * 2048 + u.pn * 256, g.A + (size_t)((u.pm & 0xfff) >> 2) * 256 * 2048 + (u.pm & 3) * 512); return (const char*)p; }
    __device__ __forceinline__ const char* pB(const Gemm& g, const Unit& u) const { const bool pw = (u.pm & 0x1000) != 0;
        const bf16_t* p = sel_ptr(pw, PWn + (size_t)u.pn * 256 * 2048, g.Bt + (size_t)u.pn * 256 * 2048 + (u.pm & 3) * 512); return (const char*)p; }
};
struct PreVOOrder {
    int G, c0;
    __device__ bool next(int i, Unit& u) const { const int c = i * G + c0; if (c >= 128) return false; u.pm = (c >> 5) * 8 + ((c >> 2) & 7); u.pn = c & 3; return true; }
    __device__ __forceinline__ void a_ready(const Unit&) const {}
    __device__ __forceinline__ void done(const Unit&) const {}
    __device__ __forceinline__ const char* pA(const Gemm& g, const Unit& u) const { return (const char*)(g.A + (size_t)(u.pm & 7) * 256 * 2048 + u.pn * 512); }
    __device__ __forceinline__ const char* pB(const Gemm& g, const Unit& u) const { return (const char*)(g.Bt + (size_t)(u.pm >> 3) * 256 * 2048 + u.pn * 512); }
};
struct ScoreOrder {
    int G, c;
    __device__ bool next(int i, Unit& u) const { if (G != 256) { const int L = i * G + c; if (L >= 256) return false; u.pm = L >> 2; u.pn = L & 3; return true; }
        if (i > 0) return false; const int xcd = c & 7, j = c >> 3; u.pm = xcd * 8 + (j >> 2); u.pn = j & 3; return true; }
    __device__ __forceinline__ void a_ready(const Unit&) const {}
    __device__ __forceinline__ void done(const Unit&) const {}
    __device__ __forceinline__ const char* pA(const Gemm& g, const Unit& u) const { return (const char*)(g.A + (size_t)u.pm * BM * 2048); }
    __device__ __forceinline__ const char* pB(const Gemm& g, const Unit& u) const { return (const char*)(g.Bt + (size_t)((u.pm >> 4) * 1024 + u.pn * 256) * 2048); }
};
struct AttnOutOrder {
    int G, c;
    __device__ bool next(int i, Unit& u) const { if (G != 256) { const int L = i * G + c; if (L >= 512) return false; u.pm = L >> 3; u.pn = L & 7; return true; }
        if (i > 1) return false; const int xcd = c & 7, j = c >> 3; u.pm = xcd * 8 + (j >> 2); u.pn = i * 4 + (j & 3); return true; }
    __device__ __forceinline__ void a_ready(const Unit&) const {}
    __device__ __forceinline__ void done(const Unit&) const {}
    __device__ __forceinline__ const char* pA(const Gemm& g, const Unit& u) const { return (const char*)(g.A + (size_t)u.pm * BM * 1024); }
    __device__ __forceinline__ const char* pB(const Gemm& g, const Unit& u) const { return (const char*)(g.Bt + (size_t)((u.pm >> 4) * 2048 + u.pn * 256) * 1024); }
};
struct AttnSOrder {
    int G, c;
    __device__ bool next(int i, Unit& u) const { const int L = i * G + c; if (L >= 256) return false; u.pm = L >> 2; u.pn = L & 3; return true; }
    __device__ __forceinline__ void a_ready(const Unit&) const {}
    __device__ __forceinline__ void done(const Unit&) const {}
    __device__ __forceinline__ const char* pA(const Gemm& g, const Unit& u) const { return (const char*)(g.A + (size_t)u.pm * BM * 2048 + u.pn * 512); }
    __device__ __forceinline__ const char* pB(const Gemm& g, const Unit& u) const { return (const char*)(g.Bt + (size_t)(u.pm >> 4) * 256 * 2048 + u.pn * 512); }
};
struct AttnPVOrder {
    int G, c;
    __device__ bool next(int i, Unit& u) const { const int L = i * G + c; if (L >= 512) return false; u.pm = L >> 3; u.pn = L & 7; return true; }
    __device__ __forceinline__ void a_ready(const Unit&) const {}
    __device__ __forceinline__ void done(const Unit&) const {}
    __device__ __forceinline__ const char* pA(const Gemm& g, const Unit& u) const { return (const char*)(g.A + (size_t)u.pm * BM * 1024 + (u.pn >> 1) * 256); }
    __device__ __forceinline__ const char* pB(const Gemm& g, const Unit& u) const { return (const char*)(g.Bt + (size_t)u.pn * BM * 1024 + (u.pm >> 4) * 256); }
};

typedef __bf16 bf16x2v_ __attribute__((ext_vector_type(2)));
typedef float f32x2v_ __attribute__((ext_vector_type(2)));
__device__ __forceinline__ unsigned cvt_pk_bf16(float lo, float hi) { const f32x2v_ f = {lo, hi}; const bf16x2v_ b = __builtin_convertvector(f, bf16x2v_); return __builtin_bit_cast(unsigned, b); }
typedef unsigned u32x2 __attribute__((ext_vector_type(2)));
constexpr float RMS_EPS = 1e-6f;

struct EpiPlain {
    static constexpr bool PERM = true, AFTER_DRAIN = false;
    bf16_t* O; int ldc;
    __device__ __forceinline__ void operator()(const f32x4 (&acc)[2][2][4][2], const Unit& u, int wr, int wc, int fr, int fq) const {
        { const int l_ = (int)__builtin_amdgcn_mbcnt_hi(~0u, __builtin_amdgcn_mbcnt_lo(~0u, 0u)); fr = l_ & 15; fq = l_ >> 4; }
        const int row0 = u.pm * BM + wr * 64 + fr, col0 = u.pn * BM + wc * 32 + 8 * fq;
#pragma unroll
        for (int ai = 0; ai < 2; ++ai)
#pragma unroll
            for (int m = 0; m < 4; ++m) { bf16_t* rowp = O + (size_t)(row0 + ai * HALF + m * 16) * ldc + col0;
#pragma unroll
                for (int bj = 0; bj < 2; ++bj) { const f32x4 v0 = acc[ai][bj][m][0], v1 = acc[ai][bj][m][1];
                    u32x4 w; w.x = cvt_pk_bf16(v0[0], v0[1]); w.y = cvt_pk_bf16(v0[2], v0[3]); w.z = cvt_pk_bf16(v1[0], v1[1]); w.w = cvt_pk_bf16(v1[2], v1[3]);
                    *(u32x4*)(rowp + bj * HALF) = w; } }
    }
};
struct EpiPre {
    static constexpr bool PERM = true, AFTER_DRAIN = false;
    bf16_t* WQK; bf16_t* Wout_t;
    __device__ __forceinline__ void operator()(const f32x4 (&acc)[2][2][4][2], const Unit& u, int wr, int wc, int fr, int fq) const {
        const bool pw = (u.pm & 0x1000) != 0; Unit t; t.pm = u.pm & 0xfff; t.pn = u.pn; const EpiPlain E{(bf16_t*)sel_ptr(pw, Wout_t, WQK), 2048}; E(acc, t, wr, wc, fr, fq);
    }
};
struct EpiRowScale {
    static constexpr bool PERM = true, AFTER_DRAIN = false;
    bf16_t* O; int ldc; const float* SS; float inv_n;
    __device__ __forceinline__ void operator()(const f32x4 (&acc)[2][2][4][2], const Unit& u, int wr, int wc, int fr, int fq) const {
        const int row0 = u.pm * BM + wr * 64 + fr, col0 = u.pn * BM + wc * 32 + 8 * fq;
#pragma unroll
        for (int ai = 0; ai < 2; ++ai)
#pragma unroll
            for (int m = 0; m < 4; ++m) { const int row = row0 + ai * HALF + m * 16; bf16_t* rowp = O + (size_t)row * ldc + col0;
                const f32x4 pa = *(const f32x4*)(SS + (size_t)row * 8), pb = *(const f32x4*)(SS + (size_t)row * 8 + 4); const float rs = __builtin_amdgcn_rsqf((((pa[0] + pa[1]) + (pa[2] + pa[3])) + ((pb[0] + pb[1]) + (pb[2] + pb[3]))) * inv_n + RMS_EPS);
#pragma unroll
                for (int bj = 0; bj < 2; ++bj) { const f32x4 v0 = acc[ai][bj][m][0] * rs, v1 = acc[ai][bj][m][1] * rs;
                    u32x4 w; w.x = cvt_pk_bf16(v0[0], v0[1]); w.y = cvt_pk_bf16(v0[2], v0[3]); w.z = cvt_pk_bf16(v1[0], v1[1]); w.w = cvt_pk_bf16(v1[2], v1[3]);
                    *(u32x4*)(rowp + bj * HALF) = w; } }
    }
};
struct EpiRowScaleC {
    static constexpr bool PERM = true, AFTER_DRAIN = false;
    bf16_t* O; int ldc; const float* RS;
    __device__ __forceinline__ void operator()(const f32x4 (&acc)[2][2][4][2], const Unit& u, int wr, int wc, int fr, int fq) const {
        const int row0 = u.pm * BM + wr * 64 + fr, col0 = u.pn * BM + wc * 32 + 8 * fq;
#pragma unroll
        for (int ai = 0; ai < 2; ++ai)
#pragma unroll
            for (int m = 0; m < 4; ++m) { const int row = row0 + ai * HALF + m * 16; bf16_t* rowp = O + (size_t)row * ldc + col0; const float rs = RS[row];
#pragma unroll
                for (int bj = 0; bj < 2; ++bj) { const f32x4 v0 = acc[ai][bj][m][0] * rs, v1 = acc[ai][bj][m][1] * rs;
                    u32x4 w; w.x = cvt_pk_bf16(v0[0], v0[1]); w.y = cvt_pk_bf16(v0[2], v0[3]); w.z = cvt_pk_bf16(v1[0], v1[1]); w.w = cvt_pk_bf16(v1[2], v1[3]);
                    *(u32x4*)(rowp + bj * HALF) = w; } }
    }
};
struct EpiColScale {
    static constexpr bool PERM = true, AFTER_DRAIN = false;
    bf16_t* O; int ldc; const float* RS;
    __device__ __forceinline__ void operator()(const f32x4 (&acc)[2][2][4][2], const Unit& u, int wr, int wc, int fr, int fq) const {
        const int row0 = u.pm * BM + wr * 64 + fr, col0 = u.pn * BM + wc * 32 + 8 * fq;
        f32x4 c0[2], c1[2];
#pragma unroll
        for (int bj = 0; bj < 2; ++bj) { c0[bj] = *(const f32x4*)(RS + col0 + bj * HALF); c1[bj] = *(const f32x4*)(RS + col0 + bj * HALF + 4); }
#pragma unroll
        for (int ai = 0; ai < 2; ++ai)
#pragma unroll
            for (int m = 0; m < 4; ++m) { bf16_t* rowp = O + (size_t)(row0 + ai * HALF + m * 16) * ldc + col0;
#pragma unroll
                for (int bj = 0; bj < 2; ++bj) { const f32x4 v0 = acc[ai][bj][m][0] * c0[bj], v1 = acc[ai][bj][m][1] * c1[bj];
                    u32x4 w; w.x = cvt_pk_bf16(v0[0], v0[1]); w.y = cvt_pk_bf16(v0[2], v0[3]); w.z = cvt_pk_bf16(v1[0], v1[1]); w.w = cvt_pk_bf16(v1[2], v1[3]);
                    *(u32x4*)(rowp + bj * HALF) = w; } }
    }
};
__device__ __forceinline__ float silu_mul(float g, float u) { return g * u * __builtin_amdgcn_rcpf(1.0f + __expf(-g)); }
struct EpiSwiglu {
    static constexpr bool PERM = true, AFTER_DRAIN = false;
    bf16_t* O; int ldc; const float* SS; float inv_n;
    __device__ __forceinline__ void operator()(const f32x4 (&acc)[2][2][4][2], const Unit& u, int wr, int wc, int fr, int fq) const {
        const int row0 = u.pm * BM + wr * 64 + fr, col0 = u.pn * HALF + wc * 32 + 8 * fq;
#pragma unroll
        for (int ai = 0; ai < 2; ++ai)
#pragma unroll
            for (int m = 0; m < 4; ++m) { const int row = row0 + ai * HALF + m * 16;
                const f32x4 pa = *(const f32x4*)(SS + (size_t)row * 8), pb = *(const f32x4*)(SS + (size_t)row * 8 + 4); const float rs = __builtin_amdgcn_rsqf((((pa[0] + pa[1]) + (pa[2] + pa[3])) + ((pb[0] + pb[1]) + (pb[2] + pb[3]))) * inv_n + RMS_EPS);
                const f32x4 g0 = acc[ai][0][m][0] * rs, g1 = acc[ai][0][m][1] * rs, u0 = acc[ai][1][m][0] * rs, u1 = acc[ai][1][m][1] * rs;
                u32x4 w;
                w.x = cvt_pk_bf16(silu_mul(g0[0], u0[0]), silu_mul(g0[1], u0[1])); w.y = cvt_pk_bf16(silu_mul(g0[2], u0[2]), silu_mul(g0[3], u0[3]));
                w.z = cvt_pk_bf16(silu_mul(g1[0], u1[0]), silu_mul(g1[1], u1[1])); w.w = cvt_pk_bf16(silu_mul(g1[2], u1[2]), silu_mul(g1[3], u1[3]));
                *(u32x4*)(O + (size_t)row * ldc + col0) = w; }
    }
};
struct EpiSoftmax {
    static constexpr bool PERM = true, AFTER_DRAIN = false;
    bf16_t* P; float* RSP; __attribute__((address_space(3))) float* xm; float sl2;
    __device__ __forceinline__ void operator()(const f32x4 (&acc)[2][2][4][2], const Unit& u, int wr, int wc, int fr, int fq) const {
        const int h = u.pn;
#pragma unroll
        for (int ai = 0; ai < 2; ++ai)
#pragma unroll
            for (int m = 0; m < 4; ++m) { float v = -3.0e38f;
#pragma unroll
                for (int bj = 0; bj < 2; ++bj)
#pragma unroll
                    for (int n = 0; n < 2; ++n) { const f32x4 x = acc[ai][bj][m][n]; v = fmaxf(v, fmaxf(fmaxf(x[0], x[1]), fmaxf(x[2], x[3]))); }
                v = fmaxf(v, __shfl_xor(v, 16)); v = fmaxf(v, __shfl_xor(v, 32));
                if (fq == 0) xm[(ai * HALF + wr * 64 + m * 16 + fr) * 4 + wc] = v; }
        asm volatile("s_waitcnt lgkmcnt(0)" ::: "memory"); __builtin_amdgcn_s_barrier(); asm volatile("" ::: "memory");
#pragma unroll
        for (int ai = 0; ai < 2; ++ai)
#pragma unroll
            for (int m = 0; m < 4; ++m) { const int r = ai * HALF + wr * 64 + m * 16 + fr; const int row = u.pm * BM + r;
                const f32x4 mm = *(const __attribute__((address_space(3))) f32x4*)(xm + r * 4); const float mx = fmaxf(fmaxf(mm[0], mm[1]), fmaxf(mm[2], mm[3])) * sl2; float s = 0.f;
#pragma unroll
                for (int bj = 0; bj < 2; ++bj) { f32x4 p0, p1;
#pragma unroll
                    for (int j = 0; j < 4; ++j) { p0[j] = __builtin_amdgcn_exp2f(acc[ai][bj][m][0][j] * sl2 - mx); p1[j] = __builtin_amdgcn_exp2f(acc[ai][bj][m][1][j] * sl2 - mx); }
                    s += ((p0[0] + p0[1]) + (p0[2] + p0[3])) + ((p1[0] + p1[1]) + (p1[2] + p1[3]));
                    u32x4 w; w.x = cvt_pk_bf16(p0[0], p0[1]); w.y = cvt_pk_bf16(p0[2], p0[3]); w.z = cvt_pk_bf16(p1[0], p1[1]); w.w = cvt_pk_bf16(p1[2], p1[3]);
                    *(u32x4*)(P + (size_t)row * 1024 + h * 256 + bj * HALF + wc * 32 + 8 * fq) = w; }
                s += __shfl_xor(s, 16); s += __shfl_xor(s, 32);
                if (fq == 0) RSP[(size_t)row * 16 + h * 4 + wc] = s; }
    }
};
struct EpiSoftmaxN {
    static constexpr bool PERM = true, AFTER_DRAIN = false;
    bf16_t* P; const float* SS; float inv_n; __attribute__((address_space(3))) float* xm; float sl2;
    __device__ __forceinline__ void operator()(f32x4 (&acc)[2][2][4][2], const Unit& u, int wr, int wc, int fr, int fq) const {
        { const int l_ = (int)__builtin_amdgcn_mbcnt_hi(~0u, __builtin_amdgcn_mbcnt_lo(~0u, 0u)); fr = l_ & 15; fq = l_ >> 4; }
        const int h = u.pn; __attribute__((address_space(3))) float* xs = xm + 1024;
#pragma unroll
        for (int ai = 0; ai < 2; ++ai)
#pragma unroll
            for (int m = 0; m < 4; ++m) { float v = -3.0e38f;
#pragma unroll
                for (int bj = 0; bj < 2; ++bj)
#pragma unroll
                    for (int n = 0; n < 2; ++n) { const f32x4 x = acc[ai][bj][m][n]; v = fmaxf(v, fmaxf(fmaxf(x[0], x[1]), fmaxf(x[2], x[3]))); }
                v = fmaxf(v, __shfl_xor(v, 16)); v = fmaxf(v, __shfl_xor(v, 32));
                if (fq == 0) xm[(ai * HALF + wr * 64 + m * 16 + fr) * 4 + wc] = v; }
        asm volatile("s_waitcnt lgkmcnt(0)" ::: "memory"); __builtin_amdgcn_s_barrier(); asm volatile("" ::: "memory");
#pragma unroll
        for (int ai = 0; ai < 2; ++ai)
#pragma unroll
            for (int m = 0; m < 4; ++m) { const int r = ai * HALF + wr * 64 + m * 16 + fr; const int row = u.pm * BM + r;
                const f32x4 pa = *(const f32x4*)(SS + (size_t)row * 8), pb = *(const f32x4*)(SS + (size_t)row * 8 + 4);
                const float f = sl2 * __builtin_amdgcn_rsqf((((pa[0] + pa[1]) + (pa[2] + pa[3])) + ((pb[0] + pb[1]) + (pb[2] + pb[3]))) * inv_n + RMS_EPS);
                const f32x4 mm = *(const __attribute__((address_space(3))) f32x4*)(xm + r * 4); const float mx = fmaxf(fmaxf(mm[0], mm[1]), fmaxf(mm[2], mm[3])) * f; float s = 0.f;
#pragma unroll
                for (int bj = 0; bj < 2; ++bj)
#pragma unroll
                    for (int n = 0; n < 2; ++n) { f32x4 p;
#pragma unroll
                        for (int j = 0; j < 4; ++j) p[j] = __builtin_amdgcn_exp2f(acc[ai][bj][m][n][j] * f - mx);
                        acc[ai][bj][m][n] = p; s += (p[0] + p[1]) + (p[2] + p[3]); }
                s += __shfl_xor(s, 16); s += __shfl_xor(s, 32);
                if (fq == 0) xs[r * 4 + wc] = s; }
        asm volatile("s_waitcnt lgkmcnt(0)" ::: "memory"); __builtin_amdgcn_s_barrier(); asm volatile("" ::: "memory");
#pragma unroll
        for (int ai = 0; ai < 2; ++ai)
#pragma unroll
            for (int m = 0; m < 4; ++m) { const int r = ai * HALF + wr * 64 + m * 16 + fr; const int row = u.pm * BM + r;
                const f32x4 ps = *(const __attribute__((address_space(3))) f32x4*)(xs + r * 4); const float inv = 1.0f / ((ps[0] + ps[1]) + (ps[2] + ps[3]));
#pragma unroll
                for (int bj = 0; bj < 2; ++bj) { const f32x4 v0 = acc[ai][bj][m][0] * inv, v1 = acc[ai][bj][m][1] * inv;
                    u32x4 w; w.x = cvt_pk_bf16(v0[0], v0[1]); w.y = cvt_pk_bf16(v0[2], v0[3]); w.z = cvt_pk_bf16(v1[0], v1[1]); w.w = cvt_pk_bf16(v1[2], v1[3]);
                    *(u32x4*)(P + (size_t)row * 1024 + h * 256 + bj * HALF + wc * 32 + 8 * fq) = w; } }
    }
};
struct EpiFinal {
    static constexpr bool PERM = true, AFTER_DRAIN = false;
    const bf16_t* res16; float* out; float* SS; unsigned* cnt; const float* gfin; __attribute__((address_space(3))) float* xs; int ldc;
    __device__ __forceinline__ void operator()(f32x4 (&acc)[2][2][4][2], const Unit& u, int wr, int wc, int fr, int fq) const {
        const int lane = (int)__builtin_amdgcn_mbcnt_hi(~0u, __builtin_amdgcn_mbcnt_lo(~0u, 0u)); fr = lane & 15; fq = lane >> 4;
        __attribute__((address_space(3))) float* rsl = xs + 1024;
        const int col0 = u.pn * BM + wc * 32 + 8 * fq;
#pragma unroll
        for (int ai = 0; ai < 2; ++ai) { u32x4 rh[4][2];
#pragma unroll
            for (int m = 0; m < 4; ++m) { const size_t off = (size_t)(u.pm * BM + ai * HALF + wr * 64 + m * 16 + fr) * ldc + col0;
#pragma unroll
                for (int bj = 0; bj < 2; ++bj) rh[m][bj] = *(const u32x4*)(res16 + off + bj * HALF); }
#pragma unroll
            for (int m = 0; m < 4; ++m) { float s = 0.f;
#pragma unroll
                for (int bj = 0; bj < 2; ++bj) { const u32x4 rb = rh[m][bj];
                    const f32x4 r0 = (f32x4){__uint_as_float(rb.x << 16), __uint_as_float(rb.x & 0xffff0000u), __uint_as_float(rb.y << 16), __uint_as_float(rb.y & 0xffff0000u)};
                    const f32x4 r1 = (f32x4){__uint_as_float(rb.z << 16), __uint_as_float(rb.z & 0xffff0000u), __uint_as_float(rb.w << 16), __uint_as_float(rb.w & 0xffff0000u)};
                    const f32x4 v0 = r0 + acc[ai][bj][m][0], v1 = r1 + acc[ai][bj][m][1]; acc[ai][bj][m][0] = v0; acc[ai][bj][m][1] = v1;
                    s += ((v0[0] * v0[0] + v0[1] * v0[1]) + (v0[2] * v0[2] + v0[3] * v0[3])) + ((v1[0] * v1[0] + v1[1] * v1[1]) + (v1[2] * v1[2] + v1[3] * v1[3])); }
                s += __shfl_xor(s, 16); s += __shfl_xor(s, 32); if (fq == 0) xs[(ai * HALF + wr * 64 + m * 16 + fr) * 4 + wc] = s; }
            asm volatile("" ::: "memory"); }
        asm volatile("s_waitcnt lgkmcnt(0)" ::: "memory"); __builtin_amdgcn_s_barrier(); asm volatile("" ::: "memory");
        if (fq == 0) {
#pragma unroll
            for (int ai = 0; ai < 2; ++ai) { const int r = ai * HALF + wr * 64 + wc * 16 + fr; const f32x4 p = *(const __attribute__((address_space(3))) f32x4*)(xs + r * 4);
                __hip_atomic_store(SS + (size_t)(u.pm * BM + r) * 8 + u.pn, (p[0] + p[1]) + (p[2] + p[3]), __ATOMIC_RELAXED, __HIP_MEMORY_SCOPE_AGENT); } }
        asm volatile("s_waitcnt vmcnt(0)" ::: "memory");
        if (lane == 0) __hip_atomic_fetch_add(cnt + 64 * u.pm, 1u, __ATOMIC_RELAXED, __HIP_MEMORY_SCOPE_AGENT);
        if (wr == 0 && wc == 0) {
            unsigned sp = 0u;
            while ((unsigned)__builtin_amdgcn_readfirstlane((int)__hip_atomic_load(cnt + 64 * u.pm, __ATOMIC_RELAXED, __HIP_MEMORY_SCOPE_AGENT)) < 64u) { __builtin_amdgcn_s_sleep(2); if (++sp > (1u << 22)) break; }
            __builtin_amdgcn_fence(__ATOMIC_ACQUIRE, "agent"); }
        asm volatile("s_waitcnt vmcnt(0) lgkmcnt(0)" ::: "memory"); __builtin_amdgcn_s_barrier(); asm volatile("" ::: "memory");
        if (wr == 0) {
            const int r = wc * 64 + lane; const unsigned long long* sp = (const unsigned long long*)(SS + (size_t)(u.pm * BM + r) * 8); float t = 0.f;
#pragma unroll
            for (int q = 0; q < 4; ++q) { const unsigned long long w = __hip_atomic_load(sp + q, __ATOMIC_RELAXED, __HIP_MEMORY_SCOPE_AGENT); t += __uint_as_float((unsigned)w) + __uint_as_float((unsigned)(w >> 32)); }
            rsl[r] = __builtin_amdgcn_rsqf(t * (1.0f / 2048.0f) + RMS_EPS); }
        asm volatile("s_waitcnt vmcnt(0) lgkmcnt(0)" ::: "memory"); __builtin_amdgcn_s_barrier(); asm volatile("" ::: "memory");
        f32x4 g0[2], g1[2];
#pragma unroll
        for (int bj = 0; bj < 2; ++bj) { g0[bj] = *(const f32x4*)(gfin + col0 + bj * HALF); g1[bj] = *(const f32x4*)(gfin + col0 + bj * HALF + 4); }
#pragma unroll
        for (int ai = 0; ai < 2; ++ai)
#pragma unroll
            for (int m = 0; m < 4; ++m) { const int r = ai * HALF + wr * 64 + m * 16 + fr; const float rs = rsl[r]; float* op = out + (size_t)(u.pm * BM + r) * ldc + col0;
#pragma unroll
                for (int bj = 0; bj < 2; ++bj) { *(f32x4*)(op + bj * HALF) = acc[ai][bj][m][0] * rs * g0[bj]; *(f32x4*)(op + bj * HALF + 4) = acc[ai][bj][m][1] * rs * g1[bj]; } }
    }
};
struct EpiAttnOut {
    static constexpr bool PERM = true, AFTER_DRAIN = false;
    bf16_t* O; const float* RSP;
    __device__ __forceinline__ void operator()(const f32x4 (&acc)[2][2][4][2], const Unit& u, int wr, int wc, int fr, int fq) const {
        const int row0 = u.pm * BM + wr * 64 + fr, col0 = u.pn * BM + wc * 32 + 8 * fq, h = u.pn >> 1;
#pragma unroll
        for (int ai = 0; ai < 2; ++ai)
#pragma unroll
            for (int m = 0; m < 4; ++m) { const int row = row0 + ai * HALF + m * 16; bf16_t* rowp = O + (size_t)row * 2048 + col0;
                const f32x4 ps = *(const f32x4*)(RSP + (size_t)row * 16 + h * 4); const float rs = 1.0f / ((ps[0] + ps[1]) + (ps[2] + ps[3]));
#pragma unroll
                for (int bj = 0; bj < 2; ++bj) { const f32x4 v0 = acc[ai][bj][m][0] * rs, v1 = acc[ai][bj][m][1] * rs;
                    u32x4 w; w.x = cvt_pk_bf16(v0[0], v0[1]); w.y = cvt_pk_bf16(v0[2], v0[3]); w.z = cvt_pk_bf16(v1[0], v1[1]); w.w = cvt_pk_bf16(v1[2], v1[3]);
                    *(u32x4*)(rowp + bj * HALF) = w; } }
    }
};
template <bool RES_F32> struct EpiResid {
    static constexpr bool PERM = true, AFTER_DRAIN = false;
    const float* res32; const bf16_t* res16; bf16_t* xb; float* SS; int ldc; __attribute__((address_space(3))) float* xs;
    __device__ __forceinline__ void operator()(const f32x4 (&acc)[2][2][4][2], const Unit& u, int wr, int wc, int fr, int fq) const {
        const int col0 = u.pn * BM + wc * 32 + 8 * fq;
#pragma unroll
        for (int ai = 0; ai < 2; ++ai) {
            f32x4 rf[RES_F32 ? 4 : 1][2][2]; u32x4 rh[RES_F32 ? 1 : 4][2];
#pragma unroll
            for (int m = 0; m < 4; ++m) { const size_t off = (size_t)(u.pm * BM + ai * HALF + wr * 64 + m * 16 + fr) * ldc + col0;
#pragma unroll
                for (int bj = 0; bj < 2; ++bj) {
                    if constexpr (RES_F32) { rf[m][bj][0] = *(const f32x4*)(res32 + off + bj * HALF); rf[m][bj][1] = *(const f32x4*)(res32 + off + bj * HALF + 4); }
                    else rh[m][bj] = *(const u32x4*)(res16 + off + bj * HALF); } }
#pragma unroll
            for (int m = 0; m < 4; ++m) { const int row = u.pm * BM + ai * HALF + wr * 64 + m * 16 + fr; const size_t off = (size_t)row * ldc + col0; float s = 0.f;
#pragma unroll
                for (int bj = 0; bj < 2; ++bj) { f32x4 r0, r1;
                    if constexpr (RES_F32) { r0 = rf[m][bj][0]; r1 = rf[m][bj][1]; }
                    else { const u32x4 rb = rh[m][bj];
                        r0 = (f32x4){__uint_as_float(rb.x << 16), __uint_as_float(rb.x & 0xffff0000u), __uint_as_float(rb.y << 16), __uint_as_float(rb.y & 0xffff0000u)};
                        r1 = (f32x4){__uint_as_float(rb.z << 16), __uint_as_float(rb.z & 0xffff0000u), __uint_as_float(rb.w << 16), __uint_as_float(rb.w & 0xffff0000u)}; }
                    const f32x4 v0 = r0 + acc[ai][bj][m][0], v1 = r1 + acc[ai][bj][m][1];
                    u32x4 w; w.x = cvt_pk_bf16(v0[0], v0[1]); w.y = cvt_pk_bf16(v0[2], v0[3]); w.z = cvt_pk_bf16(v1[0], v1[1]); w.w = cvt_pk_bf16(v1[2], v1[3]);
                    *(u32x4*)(xb + off + bj * HALF) = w;
                    s += ((v0[0] * v0[0] + v0[1] * v0[1]) + (v0[2] * v0[2] + v0[3] * v0[3])) + ((v1[0] * v1[0] + v1[1] * v1[1]) + (v1[2] * v1[2] + v1[3] * v1[3])); }
                s += __shfl_xor(s, 16); s += __shfl_xor(s, 32); if (fq == 0) xs[(ai * HALF + wr * 64 + m * 16 + fr) * 4 + wc] = s; }
            asm volatile("" ::: "memory"); }
        asm volatile("s_waitcnt lgkmcnt(0)" ::: "memory"); __builtin_amdgcn_s_barrier(); asm volatile("" ::: "memory");
        if (fq == 0) {
#pragma unroll
            for (int ai = 0; ai < 2; ++ai) { const int r = ai * HALF + wr * 64 + wc * 16 + fr; const f32x4 p = *(const __attribute__((address_space(3))) f32x4*)(xs + r * 4);
                SS[(size_t)(u.pm * BM + r) * 8 + u.pn] = (p[0] + p[1]) + (p[2] + p[3]); } }
    }
};
template <class Epi, class Sched, bool ALIGN_EPI = false, bool SP2 = false>
__device__ __forceinline__ void gemm_phase(PG8_LAS unsigned char* lds, const Gemm g, const Sched& S, const Epi& E) {
    int tid_ = threadIdx.x; asm volatile("" : "+v"(tid_));
    const int tid = tid_, wid = __builtin_amdgcn_readfirstlane(tid >> 6), lane = tid & 63, wr = wid >> 2, wc = wid & 3, fr = lane & 15, fq = lane >> 4;
    const int K = g.ld, nt = g.K / BK;
    unsigned voffA[2], voffB[2];
#pragma unroll
    for (int i = 0; i < 2; ++i) { int R, C; stage_rc(tid * 16 + i * 8192, R, C); const int Rb = Epi::PERM ? ((R & ~31) + perm32(R & 31)) : R;
        voffA[i] = (unsigned)(R * K + C) * 2u; voffB[i] = (unsigned)(Rb * K + C) * 2u; }
    const size_t kstep = (size_t)(BK * 2);
    const size_t hstep = (size_t)HALF * K * 2;
    const unsigned ldsw = (unsigned)wid * 1024u;
    const int aoff = lds_byte(wr * 64 + fr, fq * 8), boff = lds_byte(wc * 32 + fr, fq * 8);
#define PG8_SA(b, h) (((b) * 2 + (h)) * HTB)
#define PG8_SB(b, h) ((4 + (b) * 2 + (h)) * HTB)
#define PG8_STAGE(bufoff, gbase, voff) do { _Pragma("unroll") for (int _i = 0; _i < 2; ++_i) \
        __builtin_amdgcn_global_load_lds((const unsigned*)((const char*)(gbase) + (voff)[_i]), (PG8_LAS unsigned*)(lds + (bufoff) + ldsw + _i * 8192), 16, 0, 0); } while (0)
#define PG8_LDA(dst, b, h) do { _Pragma("unroll") for (int m = 0; m < 4; ++m) _Pragma("unroll") for (int k = 0; k < 2; ++k) dst[m][k] = *(const PG8_LAS bf16x8*)(lds + PG8_SA(b, h) + aoff + m * 2048 + k * 1024); } while (0)
#define PG8_LDB(dst, b, h) do { _Pragma("unroll") for (int n = 0; n < 2; ++n) _Pragma("unroll") for (int k = 0; k < 2; ++k) dst[n][k] = *(const PG8_LAS bf16x8*)(lds + PG8_SB(b, h) + boff + n * 2048 + k * 1024); } while (0)
#define PG8_MMA(ai, bj, At, Bt) do { __builtin_amdgcn_s_setprio(1); _Pragma("unroll") for (int m = 0; m < 4; ++m) _Pragma("unroll") for (int n = 0; n < 2; ++n) _Pragma("unroll") for (int k = 0; k < 2; ++k) \
        acc[ai][bj][m][n] = __builtin_amdgcn_mfma_f32_16x16x32_bf16(Bt[n][k], At[m][k], acc[ai][bj][m][n], 0, 0, 0); __builtin_amdgcn_s_setprio(0); } while (0)
#define PG8_WAIT_V(n) asm volatile("s_waitcnt vmcnt(" #n ")" ::: "memory")
#define PG8_WAIT_L(n) asm volatile("s_waitcnt lgkmcnt(" #n ")" ::: "memory")
#define PG8_BAR __builtin_amdgcn_s_barrier()
#define PG8_SCHED __builtin_amdgcn_sched_barrier(0)
    Unit cur, nxt; int ui = 0;
    if (!S.next(0, cur)) return;
    f32x4 acc[2][2][4][2];
#pragma unroll
    for (int a = 0; a < 2; ++a)
#pragma unroll
        for (int b = 0; b < 2; ++b)
#pragma unroll
            for (int m = 0; m < 4; ++m)
#pragma unroll
                for (int n = 0; n < 2; ++n) acc[a][b][m][n] = (f32x4){0.f, 0.f, 0.f, 0.f};
    bf16x8 At[4][2], B0[2][2], B1[2][2];
    const char* cA = S.pA(g, cur); const char* cB = S.pB(g, cur);
    S.a_ready(cur);
    if constexpr (SP2) {
        PG8_STAGE(PG8_SB(0, 0), cB, voffB); PG8_STAGE(PG8_SB(0, 1), cB + hstep, voffB); PG8_STAGE(PG8_SA(0, 0), cA, voffA); PG8_STAGE(PG8_SA(0, 1), cA + hstep, voffA);
        if (wr == 1) PG8_BAR;
        PG8_WAIT_V(2); PG8_BAR;
        PG8_STAGE(PG8_SB(1, 0), cB + kstep, voffB); PG8_STAGE(PG8_SA(1, 0), cA + kstep, voffA); PG8_STAGE(PG8_SB(1, 1), cB + hstep + kstep, voffB);
        PG8_WAIT_V(6); PG8_BAR;
    } else {
        PG8_STAGE(PG8_SB(0, 0), cB, voffB); PG8_STAGE(PG8_SA(0, 0), cA, voffA); PG8_STAGE(PG8_SB(0, 1), cB + hstep, voffB); PG8_STAGE(PG8_SA(0, 1), cA + hstep, voffA);
        if (wr == 1) PG8_BAR;
        PG8_WAIT_V(4); PG8_BAR;
        PG8_STAGE(PG8_SB(1, 0), cB + kstep, voffB); PG8_STAGE(PG8_SA(1, 0), cA + kstep, voffA); PG8_STAGE(PG8_SB(1, 1), cB + hstep + kstep, voffB);
        PG8_WAIT_V(6); PG8_BAR;
    }
    for (;;) {
        const bool has_next = S.next(ui + 1, nxt);
        const char* nA = has_next ? S.pA(g, nxt) : cA; const char* nB = has_next ? S.pB(g, nxt) : cB;
        for (int t = 0; t < nt; t += 2) {
            const bool last = (t == nt - 2);
            const char* a1 = cA + (size_t)(t + 1) * kstep;
            const char* a2 = last ? nA : cA + (size_t)(t + 2) * kstep; const char* b2 = last ? nB : cB + (size_t)(t + 2) * kstep;
            const char* a3 = a2 + kstep; const char* b3 = b2 + kstep;
            if (last && has_next) S.a_ready(nxt);
            if constexpr (SP2) {
            PG8_LDB(B0, 0, 0); PG8_LDB(B1, 0, 1); PG8_SCHED; PG8_LDA(At, 0, 0); PG8_STAGE(PG8_SA(1, 1), a1 + hstep, voffA);
            PG8_WAIT_V(8); PG8_WAIT_L(0); PG8_BAR; PG8_MMA(0, 0, At, B0); PG8_MMA(0, 1, At, B1); PG8_BAR; PG8_SCHED;
            PG8_LDA(At, 0, 1); PG8_STAGE(PG8_SB(0, 0), b2, voffB); PG8_STAGE(PG8_SB(0, 1), b2 + hstep, voffB); PG8_STAGE(PG8_SA(0, 0), a2, voffA);
            PG8_WAIT_V(8); PG8_WAIT_L(0); PG8_BAR; PG8_MMA(1, 0, At, B0); PG8_MMA(1, 1, At, B1); PG8_BAR; PG8_SCHED;
            PG8_LDB(B0, 1, 0); PG8_LDB(B1, 1, 1); PG8_SCHED; PG8_LDA(At, 1, 0); PG8_STAGE(PG8_SA(0, 1), a2 + hstep, voffA);
            PG8_WAIT_V(8); PG8_WAIT_L(0); PG8_BAR; PG8_MMA(0, 0, At, B0); PG8_MMA(0, 1, At, B1); PG8_BAR; PG8_SCHED;
            PG8_LDA(At, 1, 1); PG8_STAGE(PG8_SB(1, 0), b3, voffB); PG8_STAGE(PG8_SB(1, 1), b3 + hstep, voffB); PG8_STAGE(PG8_SA(1, 0), a3, voffA);
            PG8_WAIT_V(8); PG8_WAIT_L(0); PG8_BAR; PG8_MMA(1, 0, At, B0); PG8_MMA(1, 1, At, B1); PG8_BAR; PG8_SCHED;
            } else {
            PG8_LDB(B0, 0, 0); PG8_SCHED; PG8_LDA(At, 0, 0); PG8_STAGE(PG8_SA(1, 1), a1 + hstep, voffA);
            PG8_WAIT_L(8); PG8_BAR; PG8_WAIT_L(0); PG8_MMA(0, 0, At, B0); PG8_BAR; PG8_SCHED;
            PG8_LDB(B1, 0, 1); PG8_STAGE(PG8_SB(0, 0), b2, voffB);
            PG8_BAR; PG8_WAIT_L(0); PG8_MMA(0, 1, At, B1); PG8_BAR;
            PG8_LDA(At, 0, 1); PG8_STAGE(PG8_SA(0, 0), a2, voffA);
            PG8_BAR; PG8_WAIT_L(0); PG8_MMA(1, 0, At, B0); PG8_BAR; PG8_SCHED;
            PG8_STAGE(PG8_SB(0, 1), b2 + hstep, voffB);
            PG8_WAIT_V(6); PG8_BAR; PG8_MMA(1, 1, At, B1); PG8_BAR;
            PG8_LDB(B0, 1, 0); PG8_SCHED; PG8_LDA(At, 1, 0); PG8_STAGE(PG8_SA(0, 1), a2 + hstep, voffA);
            PG8_WAIT_L(8); PG8_BAR; PG8_WAIT_L(0); PG8_MMA(0, 0, At, B0); PG8_BAR; PG8_SCHED;
            PG8_LDB(B1, 1, 1); PG8_STAGE(PG8_SB(1, 0), b3, voffB);
            PG8_BAR; PG8_WAIT_L(0); PG8_MMA(0, 1, At, B1); PG8_BAR;
            PG8_LDA(At, 1, 1); PG8_STAGE(PG8_SA(1, 0), a3, voffA);
            PG8_BAR; PG8_WAIT_L(0); PG8_MMA(1, 0, At, B0); PG8_BAR; PG8_SCHED;
            PG8_STAGE(PG8_SB(1, 1), b3 + hstep, voffB);
            PG8_WAIT_V(6); PG8_BAR; PG8_MMA(1, 1, At, B1); PG8_BAR;
            }
        }
        if constexpr (ALIGN_EPI) { if (wr == 0) PG8_BAR; }
        if constexpr (!Epi::AFTER_DRAIN) { E(acc, cur, wr, wc, fr, fq); S.done(cur); }
        if (!has_next) break;
#pragma unroll
        for (int a = 0; a < 2; ++a)
#pragma unroll
            for (int b = 0; b < 2; ++b)
#pragma unroll
                for (int m = 0; m < 4; ++m)
#pragma unroll
                    for (int n = 0; n < 2; ++n) acc[a][b][m][n] = (f32x4){0.f, 0.f, 0.f, 0.f};
        cur = nxt; cA = nA; cB = nB; ++ui;
        if constexpr (ALIGN_EPI) { if (wr == 1) PG8_BAR; }
    }
    PG8_WAIT_V(0);
    if constexpr (!ALIGN_EPI) { if (wr == 0) PG8_BAR; }
    PG8_BAR;
    if constexpr (Epi::AFTER_DRAIN) { E.fused(acc, cur, wr, wc, fr, fq, lds, wid, lane); S.done(cur); }
#undef PG8_SA
#undef PG8_SB
#undef PG8_STAGE
#undef PG8_LDA
#undef PG8_LDB
#undef PG8_MMA
#undef PG8_WAIT_V
#undef PG8_WAIT_L
#undef PG8_BAR
#undef PG8_SCHED
}
}
#define LAS __attribute__((address_space(3)))
using pg8::bf16_t; using pg8::bf16x8; using pg8::f32x4; using pg8::u32x4; using pg8::u32x2; using pg8::cvt_pk_bf16; using pg8::RMS_EPS;
constexpr int BATCH = 4, SEQ = 4096, D = 2048, M = BATCH * SEQ, NMEM = 256, MM = BATCH * NMEM, DFF = 5632, DPOOL = 1024, DSGU = 1024;
constexpr int NWAVES = 8, NTHR = NWAVES * 64;
constexpr int LDS_BYTES = 147456;
constexpr size_t MiB = 1u << 20;
constexpr size_t WS_BAR = 0, WS_PCNT = 16384, WS_ZERO_BYTES = 65536;
constexpr size_t WS_WIN = 1 * MiB, WS_WOUT = 13 * MiB, WS_WQ = 21 * MiB, WS_WK = 29 * MiB, WS_WV = 37 * MiB, WS_WO = 45 * MiB, WS_WGU = 53 * MiB, WS_WD = 97 * MiB;
constexpr size_t WS_PW = 119 * MiB, WS_WSP = 119 * MiB + 512 * 1024;
constexpr size_t WS_MN = 120 * MiB, WS_KB = 124 * MiB, WS_VTM = 128 * MiB;
constexpr size_t WS_XB = 132 * MiB;
constexpr size_t WS_HG = 196 * MiB;
constexpr size_t WS_PAU = 196 * MiB, WS_Q = 196 * MiB, WS_VT = 260 * MiB, WS_Y = 292 * MiB, WS_O = 292 * MiB;
constexpr size_t WS_PM = 260 * MiB;
constexpr size_t WS_RSP = 356 * MiB;
constexpr size_t WS_SS1 = 372 * MiB, WS_SS2 = WS_SS1 + 512 * 1024, WS_SS3 = WS_SS2 + 512 * 1024;
constexpr size_t WS_RS0 = 375 * MiB;
constexpr size_t WS_WQK = 356 * MiB;
constexpr size_t WS_VWO = 376 * MiB;
constexpr size_t WS_PWN = 392 * MiB;
constexpr size_t WS_END = 396 * MiB;

__device__ __forceinline__ float bf_lo(unsigned w) { return __uint_as_float(w << 16); }
__device__ __forceinline__ float bf_hi(unsigned w) { return __uint_as_float(w & 0xffff0000u); }
__device__ __forceinline__ float wave_sum(float v) {
#pragma unroll
    for (int o = 1; o < 64; o <<= 1) v += __shfl_xor(v, o);
    return v;
}
#define LDS_WAIT() asm volatile("s_waitcnt lgkmcnt(0)" ::: "memory")
#define MFMA16(a, b, c) __builtin_amdgcn_mfma_f32_16x16x32_bf16((a), (b), (c), 0, 0, 0)

#define XB_TMO      128
#define XB_XCNT(j)  (256  + 64 * (j))
#define XB_XSUB(j)  (1280 + 64 * (j))
#define XB_XGEN(j)  (2304 + 64 * (j))
#define XB_TOP      3328
#define XB_TOPGEN   3392
#define XCD_BAR_WORDS 3456
#define XB_SPIN_CAP (1u << 18)

__device__ __forceinline__ unsigned xb_ld(unsigned* p)              { return __hip_atomic_load(p, __ATOMIC_RELAXED, __HIP_MEMORY_SCOPE_AGENT); }
__device__ __forceinline__ unsigned xb_add(unsigned* p, unsigned v) { return __hip_atomic_fetch_add(p, v, __ATOMIC_RELAXED, __HIP_MEMORY_SCOPE_AGENT); }
__device__ __forceinline__ unsigned xb_xcc_id() { return (unsigned)__builtin_amdgcn_s_getreg((3 << 11) | 20) & 0xFu; }
#define XB_SPIN(cond, bar) do { unsigned _sp = 0; while (cond) { __builtin_amdgcn_s_sleep(1); \
    if ((++_sp & 255u) == 0u) { if (xb_ld(&(bar)[XB_TMO])) break; if (_sp > XB_SPIN_CAP) { atomicAdd(&(bar)[XB_TMO], 1u); break; } } } } while (0)

struct XcdBarrier {
    unsigned* bar; unsigned x;
    volatile LAS unsigned* st;
};

__device__ __forceinline__ XcdBarrier xcd_barrier_post(unsigned* bar, volatile LAS unsigned* st) {
    XcdBarrier b; b.bar = bar; b.x = xb_xcc_id(); b.st = st;
    if (threadIdx.x == 0) (void)xb_add(&bar[XB_XCNT(b.x)], 1u);
    return b;
}
__device__ __forceinline__ void xcd_barrier_complete(unsigned* bar, unsigned x, unsigned& nloc, unsigned& nx) {
    const unsigned G = gridDim.x * gridDim.y * gridDim.z;
    unsigned sum, cnt, mine, sp = 0u;
    for (;;) {
        sum = 0u; cnt = 0u; mine = 0u;
#pragma unroll
        for (unsigned j = 0; j < 16; ++j) { const unsigned c = xb_ld(&bar[XB_XCNT(j)]); sum += c; cnt += (c > 0u) ? 1u : 0u; mine = (j == x) ? c : mine; }
        if (sum == G) break;
        __builtin_amdgcn_s_sleep(1);
        if ((++sp & 255u) == 0u) { if (xb_ld(&bar[XB_TMO])) break; if (sp > XB_SPIN_CAP) { atomicAdd(&bar[XB_TMO], 1u); break; } }
    }
    nloc = mine > 0u ? mine : 1u; nx = cnt > 0u ? cnt : 1u;
}

__device__ __forceinline__ void xcd_barrier(const XcdBarrier& b) {
    asm volatile("s_waitcnt vmcnt(0)" ::: "memory");
    __syncthreads();
    if (threadIdx.x == 0) {
        unsigned* bar = b.bar;
        __builtin_amdgcn_s_waitcnt(0);
        unsigned nloc = b.st[0], nx = b.st[1];
        if (nloc == 0u) { xcd_barrier_complete(bar, b.x, nloc, nx); b.st[0] = nloc; b.st[1] = nx; }
        const unsigned old = xb_add(&bar[XB_XSUB(b.x)], 1u);
        const unsigned gen = old / nloc;
        if (old + 1u == (gen + 1u) * nloc) {
            __builtin_amdgcn_fence(__ATOMIC_RELEASE, "agent");
            asm volatile("s_waitcnt vmcnt(0)" ::: "memory");
            const unsigned og = xb_add(&bar[XB_TOP], 1u);
            const unsigned tg = og / nx;
            if (og + 1u == (tg + 1u) * nx) xb_add(&bar[XB_TOPGEN], 1u);
            else XB_SPIN(xb_ld(&bar[XB_TOPGEN]) == tg, bar);
            __builtin_amdgcn_fence(__ATOMIC_ACQUIRE, "agent");
            xb_add(&bar[XB_XGEN(b.x)], 1u);
            asm volatile("s_waitcnt vmcnt(0)" ::: "memory");
        } else {
            XB_SPIN(xb_ld(&bar[XB_XGEN(b.x)]) == gen, bar);
            __builtin_amdgcn_fence(__ATOMIC_ACQUIRE, "agent");
            asm volatile("s_waitcnt vmcnt(0)" ::: "memory");
        }
    }
    __syncthreads();
}

__device__ __forceinline__ void tr_item(const float* W, int ldw, int k0, int n0, bf16_t* WT, int ldt, int orow0, const float* kgain, const float* nscale, LAS float* scr, int lane) {
    f32x4 v[16];
#pragma unroll
    for (int i = 0; i < 16; ++i) { const int kk = 4 * i + (lane >> 4), nn = (lane & 15) * 4; v[i] = *(const f32x4*)(W + (size_t)(k0 + kk) * ldw + n0 + nn); }
#pragma unroll
    for (int i = 0; i < 16; ++i) { const int kk = 4 * i + (lane >> 4), nn = (lane & 15) * 4;
        if (kgain) v[i] = v[i] * kgain[k0 + kk];
        LAS float* s = scr + kk * 65 + nn; s[0] = v[i][0]; s[1] = v[i][1]; s[2] = v[i][2]; s[3] = v[i][3]; }
    LDS_WAIT();
    const int c = lane & 7;
#pragma unroll
    for (int j = 0; j < 8; ++j) { const int n = (lane >> 3) + 8 * j; const LAS float* s = scr + (8 * c) * 65 + n;
        const float sc = nscale ? nscale[n] : 1.0f;
        u32x4 o; o.x = cvt_pk_bf16(s[0 * 65] * sc, s[1 * 65] * sc); o.y = cvt_pk_bf16(s[2 * 65] * sc, s[3 * 65] * sc); o.z = cvt_pk_bf16(s[4 * 65] * sc, s[5 * 65] * sc); o.w = cvt_pk_bf16(s[6 * 65] * sc, s[7 * 65] * sc);
        *(u32x4*)(WT + (size_t)(orow0 + n) * ldt + k0 + 8 * c) = o; }
    LDS_WAIT();
}
__device__ __forceinline__ void norm_row_bf16(const float* xrow, const float* g, bf16_t* orow, int lane) {
    const f32x4* xr = (const f32x4*)xrow + lane; f32x4 v[8]; float s = 0.f;
#pragma unroll
    for (int j = 0; j < 8; ++j) { v[j] = xr[64 * j]; s += (v[j][0] * v[j][0] + v[j][1] * v[j][1]) + (v[j][2] * v[j][2] + v[j][3] * v[j][3]); }
    const float rstd = 1.0f / sqrtf(wave_sum(s) * (1.0f / D) + RMS_EPS);
    const f32x4* gr = (const f32x4*)g + lane; u32x2* o = (u32x2*)orow + lane;
#pragma unroll
    for (int j = 0; j < 8; ++j) { const f32x4 gg = gr[64 * j]; const f32x4 y = v[j] * rstd * gg; u32x2 w; w.x = cvt_pk_bf16(y[0], y[1]); w.y = cvt_pk_bf16(y[2], y[3]); o[64 * j] = w; }
}
__device__ __forceinline__ void norm_row2_bf16(const float* xa, const float* xb_, bool has2, const float* g, bf16_t* oa, bf16_t* ob, int lane) {
    const f32x4* ra = (const f32x4*)xa + lane; const f32x4* rb = (const f32x4*)(has2 ? xb_ : xa) + lane; f32x4 va[8], vb[8]; float sa = 0.f, sb = 0.f;
#pragma unroll
    for (int j = 0; j < 8; ++j) { va[j] = ra[64 * j]; vb[j] = rb[64 * j]; }
#pragma unroll
    for (int j = 0; j < 8; ++j) { sa += (va[j][0] * va[j][0] + va[j][1] * va[j][1]) + (va[j][2] * va[j][2] + va[j][3] * va[j][3]); sb += (vb[j][0] * vb[j][0] + vb[j][1] * vb[j][1]) + (vb[j][2] * vb[j][2] + vb[j][3] * vb[j][3]); }
    const float ka = 1.0f / sqrtf(wave_sum(sa) * (1.0f / D) + RMS_EPS), kb = 1.0f / sqrtf(wave_sum(sb) * (1.0f / D) + RMS_EPS);
    const f32x4* gr = (const f32x4*)g + lane; u32x2* pa = (u32x2*)oa + lane; u32x2* pb = (u32x2*)ob + lane;
#pragma unroll
    for (int j = 0; j < 8; ++j) { const f32x4 gg = gr[64 * j]; const f32x4 ya = va[j] * ka * gg, yb = vb[j] * kb * gg; u32x2 w; w.x = cvt_pk_bf16(ya[0], ya[1]); w.y = cvt_pk_bf16(ya[2], ya[3]); pa[64 * j] = w;
        if (has2) { u32x2 w2; w2.x = cvt_pk_bf16(yb[0], yb[1]); w2.y = cvt_pk_bf16(yb[2], yb[3]); pb[64 * j] = w2; } }
}
__device__ __forceinline__ void raw_row2_bf16(const float* xa, const float* xb_, bool has2, bf16_t* oa, bf16_t* ob, float* rsa, float* rsb, int lane) {
    const f32x4* ra = (const f32x4*)xa + lane; const f32x4* rb = (const f32x4*)(has2 ? xb_ : xa) + lane; f32x4 va[8], vb[8]; float sa = 0.f, sb = 0.f;
#pragma unroll
    for (int j = 0; j < 8; ++j) { va[j] = ra[64 * j]; vb[j] = rb[64 * j]; }
    u32x2* pa = (u32x2*)oa + lane; u32x2* pb = (u32x2*)ob + lane;
#pragma unroll
    for (int j = 0; j < 8; ++j) { sa += (va[j][0] * va[j][0] + va[j][1] * va[j][1]) + (va[j][2] * va[j][2] + va[j][3] * va[j][3]); sb += (vb[j][0] * vb[j][0] + vb[j][1] * vb[j][1]) + (vb[j][2] * vb[j][2] + vb[j][3] * vb[j][3]);
        u32x2 w; w.x = cvt_pk_bf16(va[j][0], va[j][1]); w.y = cvt_pk_bf16(va[j][2], va[j][3]); pa[64 * j] = w;
        if (has2) { u32x2 w2; w2.x = cvt_pk_bf16(vb[j][0], vb[j][1]); w2.y = cvt_pk_bf16(vb[j][2], vb[j][3]); pb[64 * j] = w2; } }
    const float ka = 1.0f / sqrtf(wave_sum(sa) * (1.0f / D) + RMS_EPS), kb = 1.0f / sqrtf(wave_sum(sb) * (1.0f / D) + RMS_EPS);
    if (lane == 0) { *rsa = ka; if (has2) *rsb = kb; }
}
__device__ __forceinline__ void norm_row_out(const bf16_t* xrow, float ss, const float* g, float* orow, int lane) {
    const float rstd = 1.0f / sqrtf(ss * (1.0f / D) + RMS_EPS);
#pragma unroll
    for (int j = 0; j < 4; ++j) { const int c = (lane + 64 * j) * 8; const u32x4 w = *(const u32x4*)(xrow + c);
        const f32x4 g0 = *(const f32x4*)(g + c), g1 = *(const f32x4*)(g + c + 4);
        const f32x4 y0 = (f32x4){bf_lo(w.x), bf_hi(w.x), bf_lo(w.y), bf_hi(w.y)} * rstd * g0, y1 = (f32x4){bf_lo(w.z), bf_hi(w.z), bf_lo(w.w), bf_hi(w.w)} * rstd * g1;
        *(f32x4*)(orow + c) = y0; *(f32x4*)(orow + c + 4) = y1; }
}

__device__ __forceinline__ void sgu_unit(LAS unsigned char* lds, int nb, int h0, const bf16_t* VT, const bf16_t* PAU, bf16_t* Y, const bf16_t* WSb, const float* sg, const float* bsp, int tid) {
    asm volatile("" : "+v"(tid));
    const int lane = tid & 63, wave = tid >> 6, fr = lane & 15, fq = lane >> 4;
    const int T0 = nb * 128;
    LAS float* red = (LAS float*)lds;
    LAS float* rstd = (LAS float*)(lds + 4096);
    LAS unsigned char* Bb = lds + 8192;
    {
        const int tg = tid & 15, rl = tid >> 4;
        float s[8];
#pragma unroll
        for (int e = 0; e < 8; ++e) s[e] = 0.f;
#pragma unroll 4
        for (int i = 0; i < 32; ++i) { const int c = rl + 32 * i; const u32x4 w = *(const u32x4*)(VT + (size_t)c * M + T0 + tg * 8);
#pragma unroll
            for (int e = 0; e < 4; ++e) { const float lo = bf_lo(w[e]), hi = bf_hi(w[e]); s[2 * e] += lo * lo; s[2 * e + 1] += hi * hi; } }
#pragma unroll
        for (int e = 0; e < 8; ++e) { s[e] += __shfl_xor(s[e], 16); s[e] += __shfl_xor(s[e], 32); }
        if (fq == 0) {
#pragma unroll
            for (int e = 0; e < 8; ++e) red[wave * 128 + tg * 8 + e] = s[e]; }
    }
    __syncthreads();
    if (tid < 128) { float t = 0.f;
#pragma unroll
        for (int w = 0; w < 8; ++w) t += red[w * 128 + tid];
        rstd[tid] = 1.0f / sqrtf(t * (1.0f / DSGU) + RMS_EPS); }
    __syncthreads();
    const int wr = wave >> 1, wc = wave & 1;
    for (int h = h0; h < h0 + 4; ++h) {
        LAS unsigned char* B = Bb + (h & 1) * 34816;
#pragma unroll
        for (int i = 0; i < 4; ++i) { const int p = tid + 512 * i, c = p >> 4, sgp = p & 15;
            const u32x4 w = *(const u32x4*)(VT + (size_t)(h * 128 + c) * M + T0 + sgp * 8);
            const float g = sg[h * 128 + c];
            const f32x4 r0 = *(const LAS f32x4*)(rstd + sgp * 8) * g, r1 = *(const LAS f32x4*)(rstd + sgp * 8 + 4) * g;
            u32x4 o; o.x = cvt_pk_bf16(bf_lo(w.x) * r0[0], bf_hi(w.x) * r0[1]); o.y = cvt_pk_bf16(bf_lo(w.y) * r0[2], bf_hi(w.y) * r0[3]);
            o.z = cvt_pk_bf16(bf_lo(w.z) * r1[0], bf_hi(w.z) * r1[1]); o.w = cvt_pk_bf16(bf_lo(w.w) * r1[2], bf_hi(w.w) * r1[3]);
            const int rho = (c & ~31) + ((c >> 2) & 1) * 16 + ((c >> 3) & 3) * 4 + (c & 3);
            *(LAS u32x4*)(B + rho * 272 + sgp * 16) = o; }
        __syncthreads();
        f32x4 acc[2][4];
#pragma unroll
        for (int m = 0; m < 2; ++m)
#pragma unroll
            for (int n = 0; n < 4; ++n) acc[m][n] = (f32x4){0.f, 0.f, 0.f, 0.f};
#pragma unroll
        for (int ks = 0; ks < 4; ++ks) { bf16x8 a[2], b[4];
#pragma unroll
            for (int m = 0; m < 2; ++m) a[m] = *(const bf16x8*)(WSb + (size_t)((h * 128 + wr * 32 + m * 16 + fr) * 128 + ks * 32 + fq * 8));
#pragma unroll
            for (int n = 0; n < 4; ++n) b[n] = *(const LAS bf16x8*)(B + (wc * 64 + n * 16 + fr) * 272 + (ks * 32 + fq * 8) * 2);
#pragma unroll
            for (int m = 0; m < 2; ++m)
#pragma unroll
                for (int n = 0; n < 4; ++n) acc[m][n] = MFMA16(b[n], a[m], acc[m][n]); }
#pragma unroll
        for (int m = 0; m < 2; ++m) { const int t = wr * 32 + m * 16 + fr; const float bias = bsp[h * 128 + t];
#pragma unroll
            for (int gq = 0; gq < 2; ++gq) { const size_t off = (size_t)(T0 + t) * D + DPOOL + h * 128 + wc * 64 + gq * 32 + fq * 8;
                const u32x4 uu = *(const u32x4*)(PAU + off); const f32x4 m0 = acc[m][2 * gq] + bias, m1 = acc[m][2 * gq + 1] + bias;
                u32x4 o; o.x = cvt_pk_bf16(bf_lo(uu.x) * m0[0], bf_hi(uu.x) * m0[1]); o.y = cvt_pk_bf16(bf_lo(uu.y) * m0[2], bf_hi(uu.y) * m0[3]);
                o.z = cvt_pk_bf16(bf_lo(uu.z) * m1[0], bf_hi(uu.z) * m1[1]); o.w = cvt_pk_bf16(bf_lo(uu.w) * m1[2], bf_hi(uu.w) * m1[3]);
                *(u32x4*)(Y + off) = o; } }
    }
    __syncthreads();
}
template <int W> __device__ __forceinline__ void pool_p(const bf16_t* base, bf16_t* ybase, int ts, int tp0) {
    u32x4 arr[W + 7];
#pragma unroll
    for (int j = 0; j < W + 7; ++j) { const int t = ts - (W - 1) + j, tc = t < -tp0 ? -tp0 : t; arr[j] = *(const u32x4*)(base + (ptrdiff_t)tc * D); }
#pragma unroll
    for (int j = 0; j < W - 1; ++j) { const int t = ts - (W - 1) + j; if (tp0 + t < 0) arr[j] = (u32x4){0u, 0u, 0u, 0u}; }
    float S[8];
#pragma unroll
    for (int e = 0; e < 8; ++e) S[e] = 0.f;
#pragma unroll
    for (int j = 0; j < W - 1; ++j)
#pragma unroll
        for (int e = 0; e < 4; ++e) { S[2 * e] += bf_lo(arr[j][e]); S[2 * e + 1] += bf_hi(arr[j][e]); }
#pragma unroll
    for (int i = 0; i < 8; ++i) { const int t = ts + i, tp = tp0 + t; float cur[8], p[8];
#pragma unroll
        for (int e = 0; e < 4; ++e) { cur[2 * e] = bf_lo(arr[W - 1 + i][e]); cur[2 * e + 1] = bf_hi(arr[W - 1 + i][e]); }
        const float inv = 1.0f / (float)(tp + 1 < W ? tp + 1 : W);
#pragma unroll
        for (int e = 0; e < 8; ++e) { S[e] += cur[e]; p[e] = S[e] * inv - cur[e]; }
        u32x4 o; o.x = cvt_pk_bf16(p[0], p[1]); o.y = cvt_pk_bf16(p[2], p[3]); o.z = cvt_pk_bf16(p[4], p[5]); o.w = cvt_pk_bf16(p[6], p[7]);
        *(u32x4*)(ybase + (size_t)t * D) = o;
#pragma unroll
        for (int e = 0; e < 4; ++e) { S[2 * e] -= bf_lo(arr[i][e]); S[2 * e + 1] -= bf_hi(arr[i][e]); } }
}
__device__ __forceinline__ void pool_half(int nb, int gh, const bf16_t* PAU, bf16_t* Y, int tid) {
    asm volatile("" : "+v"(tid));
    const int T0 = nb * 128, tp0 = T0 & (SEQ - 1), cgp = tid & 31, ts = (tid >> 5) * 8;
    const bf16_t* src = PAU + (size_t)T0 * D + cgp * 8; bf16_t* dst = Y + (size_t)T0 * D + cgp * 8;
    if (gh == 0) { pool_p<2>(src, dst, ts, tp0); pool_p<16>(src + 768, dst + 768, ts, tp0); }
    else { pool_p<4>(src + 256, dst + 256, ts, tp0); pool_p<8>(src + 512, dst + 512, ts, tp0); }
}
__device__ __forceinline__ void attn_unit(LAS unsigned char* lds, int unit, const bf16_t* Q, const bf16_t* KB, const bf16_t* VTM, bf16_t* O, int tid) {
    asm volatile("" : "+v"(tid));
    const int lane = tid & 63, wave = tid >> 6, fr = lane & 15, fq = lane >> 4, wr = wave >> 1, wc = wave & 1;
    const int qt = unit & 31, h = (unit >> 5) & 3, b = unit >> 7;
    const int R0 = b * SEQ + qt * 128;
    LAS unsigned char* P = lds;
    LAS float* xm = (LAS float*)(lds + 67584);
    LAS float* xs = xm + 256;
    f32x4 acc[2][8];
#pragma unroll
    for (int m = 0; m < 2; ++m)
#pragma unroll
        for (int n = 0; n < 8; ++n) acc[m][n] = (f32x4){0.f, 0.f, 0.f, 0.f};
    const bf16_t* qp = Q + (size_t)(R0 + wr * 32 + fr) * D + h * 512 + fq * 8;
    const bf16_t* kp = KB + (size_t)(b * NMEM + wc * 128 + fr) * D + h * 512 + fq * 8;
#pragma unroll 2
    for (int ks = 0; ks < 16; ++ks) { bf16x8 a[2], bb[8];
#pragma unroll
        for (int m = 0; m < 2; ++m) a[m] = *(const bf16x8*)(qp + (size_t)m * 16 * D + ks * 32);
#pragma unroll
        for (int n = 0; n < 8; ++n) bb[n] = *(const bf16x8*)(kp + (size_t)n * 16 * D + ks * 32);
#pragma unroll
        for (int m = 0; m < 2; ++m)
#pragma unroll
            for (int n = 0; n < 8; ++n) acc[m][n] = MFMA16(bb[n], a[m], acc[m][n]); }
    const float sc = 0.044194173824159216f;
#pragma unroll
    for (int m = 0; m < 2; ++m) { float v = -3.0e38f;
#pragma unroll
        for (int n = 0; n < 8; ++n) { acc[m][n] = acc[m][n] * sc; v = fmaxf(v, fmaxf(fmaxf(acc[m][n][0], acc[m][n][1]), fmaxf(acc[m][n][2], acc[m][n][3]))); }
        v = fmaxf(v, __shfl_xor(v, 16)); v = fmaxf(v, __shfl_xor(v, 32));
        if (fq == 0) xm[wc * 128 + wr * 32 + m * 16 + fr] = v; }
    __syncthreads();
#pragma unroll
    for (int m = 0; m < 2; ++m) { const int row = wr * 32 + m * 16 + fr; const float mx = fmaxf(xm[row], xm[128 + row]); float s = 0.f;
#pragma unroll
        for (int n = 0; n < 8; ++n) { const float p0 = __expf(acc[m][n][0] - mx), p1 = __expf(acc[m][n][1] - mx), p2 = __expf(acc[m][n][2] - mx), p3 = __expf(acc[m][n][3] - mx);
            s += (p0 + p1) + (p2 + p3);
            u32x2 o; o.x = cvt_pk_bf16(p0, p1); o.y = cvt_pk_bf16(p2, p3);
            *(LAS u32x2*)(P + row * 528 + (wc * 128 + n * 16 + fq * 4) * 2) = o; }
        s += __shfl_xor(s, 16); s += __shfl_xor(s, 32);
        if (fq == 0) xs[wc * 128 + row] = s; }
    __syncthreads();
    float inv[2];
#pragma unroll
    for (int m = 0; m < 2; ++m) { const int row = wr * 32 + m * 16 + fr; inv[m] = 1.0f / (xs[row] + xs[128 + row]); }
    f32x4 o[2][16];
#pragma unroll
    for (int m = 0; m < 2; ++m)
#pragma unroll
        for (int n = 0; n < 16; ++n) o[m][n] = (f32x4){0.f, 0.f, 0.f, 0.f};
    const bf16_t* vp = VTM + (size_t)(h * 512 + wc * 256 + fr) * MM + b * NMEM + fq * 8;
    for (int ks = 0; ks < 8; ++ks) { bf16x8 a[2];
#pragma unroll
        for (int m = 0; m < 2; ++m) a[m] = *(const LAS bf16x8*)(P + (wr * 32 + m * 16 + fr) * 528 + (ks * 32 + fq * 8) * 2);
#pragma unroll
        for (int n = 0; n < 16; ++n) { const bf16x8 bv = *(const bf16x8*)(vp + (size_t)n * 16 * MM + ks * 32);
#pragma unroll
            for (int m = 0; m < 2; ++m) o[m][n] = MFMA16(bv, a[m], o[m][n]); } }
#pragma unroll
    for (int m = 0; m < 2; ++m) { const size_t rowoff = (size_t)(R0 + wr * 32 + m * 16 + fr) * D + h * 512 + wc * 256 + fq * 4;
#pragma unroll
        for (int n = 0; n < 16; ++n) { const f32x4 v = o[m][n] * inv[m]; u32x2 w; w.x = cvt_pk_bf16(v[0], v[1]); w.y = cvt_pk_bf16(v[2], v[3]); *(u32x2*)(O + rowoff + n * 16) = w; } }
    __syncthreads();
}

#ifndef REP_P0
#define REP_P0 1
#endif
#ifndef REP_P0N
#define REP_P0N 1
#endif
#ifndef REP_P1
#define REP_P1 1
#endif
#ifndef REP_P3
#define REP_P3 1
#endif
#ifndef REP_P7
#define REP_P7 1
#endif
#ifndef TS_K
#define TS_K -1
#endif
#ifndef ABSORB
#define ABSORB 1
#endif
#ifndef OLD_ATTN
#define OLD_ATTN 0
#endif
#ifndef REP_P2
#define REP_P2 1
#endif
#ifndef REP_P5
#define REP_P5 1
#endif
#ifndef REP_SYNC
#define REP_SYNC 1
#endif
#ifndef REP_P4
#define REP_P4 1
#endif
struct Args { const float* in[21]; float* out; unsigned char* ws; };
#define GEMM_PHASE(EPI, g, S, E) pg8::gemm_phase<EPI, pg8::StaticOrder, true, true>(lds, g, S, E)
__global__ void __launch_bounds__(NTHR, 2) mk_fwd(Args a) {
    extern __shared__ __attribute__((aligned(16))) unsigned char lds_raw[];
    LAS unsigned char* lds = (LAS unsigned char*)lds_raw;
    cg::grid_group grid = cg::this_grid();
    const int G = gridDim.x, bx = blockIdx.x;
    volatile LAS unsigned* bar_st = (volatile LAS unsigned*)(lds + LDS_BYTES - 64);
    if (threadIdx.x < 2) bar_st[threadIdx.x] = 0u;
    __syncthreads();
    const XcdBarrier xbar = xcd_barrier_post((unsigned*)(a.ws + WS_BAR), bar_st);
    volatile LAS unsigned* ts_lds = (volatile LAS unsigned*)(lds + LDS_BYTES - 32);
    if (TS_K >= 0 && bx == 0 && threadIdx.x == 0) ts_lds[0] = (unsigned)__builtin_amdgcn_s_memrealtime();
#define STAMP(k) do { if (TS_K == (k) && bx == 0 && threadIdx.x == 0) ts_lds[1] = (unsigned)__builtin_amdgcn_s_memrealtime(); } while (0)
#define TID_FRESH() ({ int t_ = threadIdx.x; asm volatile("" : "+v"(t_)); t_; })
    const float *x = a.in[0], *mem = a.in[1], *norm_mix_g = a.in[2], *w_in = a.in[3], *pool_w = a.in[4], *pool_scale = a.in[5], *sgu_norm_g = a.in[6], *w_spatial = a.in[7], *b_spatial = a.in[8],
                *w_out = a.in[9], *norm_xattn_g = a.in[10], *norm_mem_g = a.in[11], *w_q = a.in[12], *w_k = a.in[13], *w_v = a.in[14], *w_o = a.in[15], *norm_ffn_g = a.in[16],
                *w_gate = a.in[17], *w_up = a.in[18], *w_down = a.in[19], *final_norm_g = a.in[20];
    float* out = a.out; unsigned char* ws = a.ws;
    float *SS1 = (float*)(ws + WS_SS1), *SS2 = (float*)(ws + WS_SS2), *SS3 = (float*)(ws + WS_SS3);
    bf16_t *Win_t = (bf16_t*)(ws + WS_WIN), *Wout_t = (bf16_t*)(ws + WS_WOUT), *Wq_t = (bf16_t*)(ws + WS_WQ), *Wk_t = (bf16_t*)(ws + WS_WK), *Wv_t = (bf16_t*)(ws + WS_WV), *Wo_t = (bf16_t*)(ws + WS_WO),
           *Wgu_t = (bf16_t*)(ws + WS_WGU), *Wd_t = (bf16_t*)(ws + WS_WD), *PWt = (bf16_t*)(ws + WS_PW), *WSb = (bf16_t*)(ws + WS_WSP), *MN = (bf16_t*)(ws + WS_MN), *KB = (bf16_t*)(ws + WS_KB),
           *VTM = (bf16_t*)(ws + WS_VTM), *XB = (bf16_t*)(ws + WS_XB), *HG = (bf16_t*)(ws + WS_HG), *PAU = (bf16_t*)(ws + WS_PAU), *Qb = (bf16_t*)(ws + WS_Q), *VT = (bf16_t*)(ws + WS_VT),
           *Yb = (bf16_t*)(ws + WS_Y), *Ob = (bf16_t*)(ws + WS_O);

    {
        const int tid = TID_FRESH(), lane = tid & 63, wave = __builtin_amdgcn_readfirstlane(tid >> 6);
        LAS float* scr = (LAS float*)(lds + wave * 16640);
        const int gw = bx * NWAVES + wave, NGW = G * NWAVES;
        constexpr int I_IN = 32 * 48, I_SQ = 32 * 32, I_PW = 4 * 16;
        constexpr int NITEMS = I_IN + 4 * I_SQ + I_PW;
        { float* RS0 = (float*)(ws + WS_RS0); for (int m = gw; m < M; m += 2 * NGW) raw_row2_bf16(x + (size_t)m * D, x + (size_t)(m + NGW) * D, m + NGW < M, XB + (size_t)m * D, XB + (size_t)(m + NGW) * D, RS0 + m, RS0 + m + NGW, lane); }
        for (int m = gw; m < MM; m += NGW) norm_row_bf16(mem + (size_t)m * D, norm_mem_g, MN + (size_t)m * D, lane);
        for (int it = gw; it < NITEMS * REP_P0; it += NGW) {
            int r = it % NITEMS;
            if (r < I_IN) { tr_item(w_in, 3072, (r / 48) * 64, (r % 48) * 64, Win_t, D, (r % 48) * 64, norm_mix_g, nullptr, scr, lane); continue; } r -= I_IN;
            if (r < I_SQ) { tr_item(w_k, D, (r / 32) * 64, (r % 32) * 64, Wk_t, D, (r % 32) * 64, nullptr, nullptr, scr, lane); continue; } r -= I_SQ;
            if (r < I_SQ) { tr_item(w_v, D, (r / 32) * 64, (r % 32) * 64, Wv_t, D, (r % 32) * 64, nullptr, nullptr, scr, lane); continue; } r -= I_SQ;
            if (r < I_SQ) { tr_item(w_out, D, (r / 32) * 64, (r % 32) * 64, Wout_t, D, (r % 32) * 64, nullptr, nullptr, scr, lane); continue; } r -= I_SQ;
#if ABSORB
            if (r < I_SQ) continue; r -= I_SQ;
#else
            if (r < I_SQ) { tr_item(w_q, D, (r / 32) * 64, (r % 32) * 64, Wq_t, D, (r % 32) * 64, norm_xattn_g, nullptr, scr, lane); continue; } r -= I_SQ;
#endif
            {
              bf16_t* PWn = (bf16_t*)(ws + WS_PWN);
#pragma unroll 4
              for (int j = 0; j < 16; ++j) { const int gc = r * 16 + j, g = gc >> 8; const f32x4 v = *(const f32x4*)(pool_w + (size_t)gc * 256 + lane * 4) * *(const f32x4*)(pool_scale + g * 256 + lane * 4);
                  u32x2 o; o.x = cvt_pk_bf16(v[0], v[1]); o.y = cvt_pk_bf16(v[2], v[3]); *(u32x2*)(PWn + (size_t)gc * 2048 + lane * 4) = o; *(u32x2*)(PWn + (size_t)gc * 2048 + 256 + lane * 4) = (u32x2){0u, 0u}; } }
        }
        for (int i = bx * NTHR + tid; i < 8 * 128 * 128 / 4; i += G * NTHR) { const f32x4 v = *((const f32x4*)w_spatial + i); const int s = (i * 4) & 127, t = ((i * 4) >> 7) & 127;
            const bool keep = (s >> 6) <= (t >> 6); u32x2 o; o.x = keep ? cvt_pk_bf16(v[0], v[1]) : 0u; o.y = keep ? cvt_pk_bf16(v[2], v[3]) : 0u; *((u32x2*)WSb + i) = o; }
    }
    if (a.ws == nullptr) grid.sync();
    xcd_barrier(xbar);
    STAMP(0);
    for (int rep = 0; rep < REP_P1; ++rep) {
        { pg8::Gemm g{XB, Win_t, M, 2048, D, D}; pg8::StaticOrder S; S.init(M, 2048, G, bx); pg8::EpiRowScaleC E{PAU, D, (const float*)(ws + WS_RS0)}; GEMM_PHASE(pg8::EpiRowScaleC, g, S, E); }
        { pg8::Gemm g{Win_t + (size_t)2048 * D, XB, 1024, M, D, D}; pg8::StaticOrder S; S.init(1024, M, G, bx); pg8::EpiColScale E{VT, M, (const float*)(ws + WS_RS0)}; GEMM_PHASE(pg8::EpiColScale, g, S, E); }
        { pg8::Gemm g{MN, Wk_t, MM, D, D, D}; pg8::StaticOrder S; S.init(MM, D, G, bx); pg8::EpiPlain E{KB, D}; GEMM_PHASE(pg8::EpiPlain, g, S, E); }
#if ABSORB
        { pg8::Gemm g{MN, Wv_t, MM, D, D, D}; pg8::StaticOrder S; S.init(MM, D, G, (bx + G - 32) % G); pg8::EpiPlain E{VTM, D}; GEMM_PHASE(pg8::EpiPlain, g, S, E); }
#else
        { pg8::Gemm g{Wv_t, MN, D, MM, D, D}; pg8::StaticOrder S; S.init(D, MM, G, (bx + G - 32) % G); pg8::EpiPlain E{VTM, MM}; GEMM_PHASE(pg8::EpiPlain, g, S, E); }
#endif
        { pg8::Gemm g{KB, Wq_t, 4096, D, 512, D}; pg8::PreQKOrder S{G, bx + 128, 160, Wout_t, (const bf16_t*)(ws + WS_PWN)}; pg8::EpiPre E{(bf16_t*)(ws + WS_WQK), Wout_t};
          pg8::gemm_phase<pg8::EpiPre, pg8::PreQKOrder, true, true>(lds, g, S, E); }
        {
            const int f0q = G > 64 ? 64 : 0; const int cq = bx - f0q, ncu = G - f0q;
            if (cq >= 0) { const int tid = TID_FRESH(), lane = tid & 63, wave = __builtin_amdgcn_readfirstlane(tid >> 6);
                for (int it = cq * NWAVES + wave; it < 1024; it += ncu * NWAVES) { const int k = it * 2 + (lane >> 5);
                    const float gk = norm_xattn_g[k]; const f32x4* src = (const f32x4*)(w_q + (size_t)k * D); u32x2* dst = (u32x2*)(Wq_t + (size_t)k * D);
#pragma unroll 4
                    for (int j = 0; j < 16; ++j) { const int q = (lane & 31) + 32 * j; const f32x4 v = src[q] * gk; u32x2 o; o.x = cvt_pk_bf16(v[0], v[1]); o.y = cvt_pk_bf16(v[2], v[3]); dst[q] = o; } } } }
        const int f0 = G > 64 ? 64 : 0;
        if (bx >= f0) {
            const int tid = TID_FRESH(), lane = tid & 63, wave = __builtin_amdgcn_readfirstlane(tid >> 6);
            LAS float* scr = (LAS float*)(lds + wave * 16640);
            constexpr int I_SQ = 32 * 32, I_GU = 32 * 88, I_DN = 88 * 32, NIT = I_SQ + 2 * I_GU + I_DN;
            for (int it = (bx - f0) * NWAVES + wave; it < NIT; it += (G - f0) * NWAVES) {
                int r = it;
                if (r < I_SQ) { tr_item(w_o, D, (r / 32) * 64, (r % 32) * 64, Wo_t, D, (r % 32) * 64, nullptr, nullptr, scr, lane); continue; } r -= I_SQ;
                if (r < 2 * I_GU) { const int up = r >= I_GU; if (up) r -= I_GU; const int n0 = (r % 88) * 64;
                    tr_item(up ? w_up : w_gate, DFF, (r / 88) * 64, n0, Wgu_t, D, (n0 >> 7) * 256 + (n0 & 127) + up * 128, norm_ffn_g, nullptr, scr, lane); continue; } r -= 2 * I_GU;
                tr_item(w_down, D, (r / 32) * 64, (r % 32) * 64, Wd_t, DFF, (r % 32) * 64, nullptr, nullptr, scr, lane);
            }
        }
    }
    xcd_barrier(xbar);
    STAMP(101);
    for (int uu = bx; uu < 256 * REP_P2; uu += G) { const int u = uu & 255; sgu_unit(lds, u >> 1, (u & 1) * 4, VT, PAU, Yb, WSb, sgu_norm_g, b_spatial, (int)threadIdx.x); pool_half(u >> 1, u & 1, PAU, Yb, (int)threadIdx.x); }
#if ABSORB
    { pg8::Gemm g{KB, Wq_t, 4096, D, 512, D}; pg8::PreQKOrder S{G, bx, 128, Wout_t, (const bf16_t*)(ws + WS_PWN)}; pg8::EpiPre E{(bf16_t*)(ws + WS_WQK), Wout_t}; pg8::gemm_phase<pg8::EpiPre, pg8::PreQKOrder, true, true>(lds, g, S, E); }
    { pg8::Gemm g{Wo_t, VTM, 8192, 1024, 512, D}; pg8::PreVOOrder S{G, (bx + G - 128 % G) % G}; pg8::EpiPlain E{(bf16_t*)(ws + WS_VWO), 1024}; pg8::gemm_phase<pg8::EpiPlain, pg8::PreVOOrder, true, true>(lds, g, S, E); }
#endif
    xcd_barrier(xbar);
    STAMP(102);
    for (int rep = 0; rep < REP_P3; ++rep) { pg8::Gemm g{Yb, Wout_t, M, D, D, D}; pg8::StaticOrder S; S.init(M, D, G, bx); pg8::EpiResid<false> E{nullptr, XB, XB, SS1, D, (LAS float*)(lds + 131072)}; GEMM_PHASE(pg8::EpiResid<false>, g, S, E); }
    xcd_barrier(xbar);
    STAMP(103);
#if ABSORB
    { pg8::Gemm g{XB, (const bf16_t*)(ws + WS_WQK), M, 1024, D, D}; pg8::ScoreOrder S{G, bx}; pg8::EpiSoftmaxN E{(bf16_t*)(ws + WS_PM), SS1, 1.0f / D, (LAS float*)(lds + 131072), 0.044194173824159216f * 1.4426950408889634f};
      pg8::gemm_phase<pg8::EpiSoftmaxN, pg8::ScoreOrder, true, true>(lds, g, S, E); }
    xcd_barrier(xbar);
    STAMP(104);
    { pg8::Gemm g{(const bf16_t*)(ws + WS_PM), (const bf16_t*)(ws + WS_VWO), M, D, 1024, 1024}; pg8::AttnOutOrder S{G, bx}; pg8::EpiResid<false> E{nullptr, XB, XB, SS2, D, (LAS float*)(lds + 131072)};
      pg8::gemm_phase<pg8::EpiResid<false>, pg8::AttnOutOrder, true, true>(lds, g, S, E); }
    xcd_barrier(xbar);
    STAMP(108);
#else
    for (int rep = 0; rep < REP_P4; ++rep) { pg8::Gemm g{XB, Wq_t, M, D, D, D}; pg8::StaticOrder S; S.init(M, D, G, bx); pg8::EpiRowScale E{Qb, D, SS1, 1.0f / D}; GEMM_PHASE(pg8::EpiRowScale, g, S, E); }
    xcd_barrier(xbar);
    STAMP(104);
#if OLD_ATTN
    for (int u = bx; u < 512 * REP_P5; u += G) attn_unit(lds, u & 511, Qb, KB, VTM, Ob, (int)threadIdx.x);
    xcd_barrier(xbar);
    STAMP(105);
#else
    for (int rep = 0; rep < REP_P5; ++rep) {
    { pg8::Gemm g{Qb, KB, M, 1024, 512, D}; pg8::AttnSOrder S{G, bx}; pg8::EpiSoftmax E{(bf16_t*)(ws + WS_PM), (float*)(ws + WS_RSP), (LAS float*)(lds + 131072), 0.044194173824159216f * 1.4426950408889634f};
      pg8::gemm_phase<pg8::EpiSoftmax, pg8::AttnSOrder, true, true>(lds, g, S, E); }
    xcd_barrier(xbar);
    STAMP(106);
    { pg8::Gemm g{(const bf16_t*)(ws + WS_PM), VTM, M, 2048, 256, 1024}; pg8::AttnPVOrder S{G, bx}; pg8::EpiAttnOut E{Ob, (const float*)(ws + WS_RSP)};
      pg8::gemm_phase<pg8::EpiAttnOut, pg8::AttnPVOrder, true, true>(lds, g, S, E); }
    xcd_barrier(xbar);
    STAMP(107);
    }
#endif
    { pg8::Gemm g{Ob, Wo_t, M, D, D, D}; pg8::StaticOrder S; S.init(M, D, G, bx); pg8::EpiResid<false> E{nullptr, XB, XB, SS2, D, (LAS float*)(lds + 131072)}; GEMM_PHASE(pg8::EpiResid<false>, g, S, E); }
    xcd_barrier(xbar);
    STAMP(108);
#endif
    for (int rep = 0; rep < REP_P7; ++rep) { pg8::Gemm g{XB, Wgu_t, M, 2 * DFF, D, D}; pg8::StaticOrder S; S.init(M, 2 * DFF, G, bx); pg8::EpiSwiglu E{HG, DFF, SS2, 1.0f / D}; GEMM_PHASE(pg8::EpiSwiglu, g, S, E); }
    xcd_barrier(xbar);
    STAMP(109);
#ifndef FUSE_FINAL
#define FUSE_FINAL 1
#endif
    if (FUSE_FINAL && G == 256) {
        pg8::Gemm g{HG, Wd_t, M, D, DFF, DFF}; pg8::DownOrder S{bx}; pg8::EpiFinal E{XB, out, SS3, (unsigned*)(ws + WS_PCNT), final_norm_g, (LAS float*)(lds + 131072), D};
        pg8::gemm_phase<pg8::EpiFinal, pg8::DownOrder, true, true>(lds, g, S, E);
    } else {
    { pg8::Gemm g{HG, Wd_t, M, D, DFF, DFF}; pg8::StaticOrder S; S.init(M, D, G, bx); pg8::EpiResid<false> E{nullptr, XB, XB, SS3, D, (LAS float*)(lds + 131072)}; GEMM_PHASE(pg8::EpiResid<false>, g, S, E); }
    xcd_barrier(xbar);
    STAMP(110);
    { const int tid = TID_FRESH(), lane = tid & 63, wave = __builtin_amdgcn_readfirstlane(tid >> 6); const int gw = bx * NWAVES + wave, NGW = G * NWAVES;
      for (int m0 = gw; m0 < M; m0 += 4 * NGW) {
          u32x4 w[4][4]; f32x4 pa[4], pb[4];
#pragma unroll
          for (int q = 0; q < 4; ++q) { const int m = m0 + q * NGW; if (m < M) { pa[q] = *(const f32x4*)(SS3 + (size_t)m * 8); pb[q] = *(const f32x4*)(SS3 + (size_t)m * 8 + 4);
#pragma unroll
              for (int j = 0; j < 4; ++j) w[q][j] = *(const u32x4*)(XB + (size_t)m * D + (lane + 64 * j) * 8); } }
#pragma unroll
          for (int q = 0; q < 4; ++q) { const int m = m0 + q * NGW; if (m < M) {
              const float rstd = 1.0f / sqrtf((((pa[q][0] + pa[q][1]) + (pa[q][2] + pa[q][3])) + ((pb[q][0] + pb[q][1]) + (pb[q][2] + pb[q][3]))) * (1.0f / D) + RMS_EPS);
#pragma unroll
              for (int j = 0; j < 4; ++j) { const int c = (lane + 64 * j) * 8; const f32x4 g0 = *(const f32x4*)(final_norm_g + c), g1 = *(const f32x4*)(final_norm_g + c + 4); const u32x4 ww = w[q][j];
                  const f32x4 y0 = (f32x4){bf_lo(ww.x), bf_hi(ww.x), bf_lo(ww.y), bf_hi(ww.y)} * rstd * g0, y1 = (f32x4){bf_lo(ww.z), bf_hi(ww.z), bf_lo(ww.w), bf_hi(ww.w)} * rstd * g1;
                  *(f32x4*)(out + (size_t)m * D + c) = y0; *(f32x4*)(out + (size_t)m * D + c + 4) = y1; } } } } }
    }
    if (TS_K >= 0 && bx == 0 && threadIdx.x == 0) { const unsigned dt = ts_lds[1] - ts_lds[0]; const unsigned t0 = (unsigned)__builtin_amdgcn_s_memrealtime(); while ((unsigned)__builtin_amdgcn_s_memrealtime() - t0 < dt) __builtin_amdgcn_s_sleep(8); }
}

extern "C" void kernel_launch(void* const* d_in, const int* in_sizes, int n_in, void* d_out, int out_size, void* d_ws, size_t ws_size, hipStream_t stream) {
    static int grid = 0;
    if (grid == 0) {
        if (n_in != 21 || in_sizes[0] != M * D || out_size != M * D || ws_size < WS_END) { fprintf(stderr, "kernel_launch: unexpected shapes (n_in %d, in0 %d, out %d, ws %zu); nothing launched\n", n_in, n_in > 0 ? in_sizes[0] : -1, out_size, ws_size); grid = -1; return; }
        int dev = 0, cus = 0, per_cu = 0;
        if (hipGetDevice(&dev) != hipSuccess || hipDeviceGetAttribute(&cus, hipDeviceAttributeMultiprocessorCount, dev) != hipSuccess) { grid = -1; return; }
        if (hipFuncSetAttribute((const void*)mk_fwd, hipFuncAttributeMaxDynamicSharedMemorySize, LDS_BYTES) != hipSuccess) { fprintf(stderr, "kernel_launch: hipFuncSetAttribute failed\n"); grid = -1; return; }
        if (hipOccupancyMaxActiveBlocksPerMultiprocessor(&per_cu, (const void*)mk_fwd, NTHR, LDS_BYTES) != hipSuccess || per_cu < 1) { fprintf(stderr, "kernel_launch: occupancy query says %d blocks per CU\n", per_cu); (void)hipGetLastError(); grid = -1; return; }
        grid = cus * per_cu;
    }
    if (grid < 0) return;
    if (hipMemsetAsync(d_ws, 0, WS_ZERO_BYTES, stream) != hipSuccess) { fprintf(stderr, "kernel_launch: hipMemsetAsync failed\n"); return; }
    Args a{};
    for (int i = 0; i < 21; ++i) a.in[i] = (const float*)d_in[i];
    a.out = (float*)d_out; a.ws = (unsigned char*)d_ws;
    void* args[] = {&a};
    const hipError_t e = hipLaunchCooperativeKernel((const void*)mk_fwd, dim3(grid), dim3(NTHR), args, LDS_BYTES, stream);
    if (e != hipSuccess) fprintf(stderr, "kernel_launch: cooperative launch failed: %s (grid %d)\n", hipGetErrorString(e), grid);
}
```

```cpp
#include <hip/hip_runtime.h>
#include <hip/hip_cooperative_groups.h>
#include <cstdio>
#include <cstdint>
namespace cg = cooperative_groups;
namespace pg8 {
#define PG8_LAS __attribute__((address_space(3)))
typedef unsigned short bf16_t;
typedef short bf16x8 __attribute__((ext_vector_type(8)));
typedef float f32x4 __attribute__((ext_vector_type(4)));
typedef unsigned u32x4 __attribute__((ext_vector_type(4)));
constexpr int BM = 256, BK = 64, HALF = 128, HTB = HALF * BK * 2  , STAGE_BYTES = 8 * HTB, NXCD = 8, WGM = 8;

__host__ __device__ __forceinline__ int lds_byte(int r, int c) { const int st = (r >> 4) * 2 + (c >> 5), rr = r & 15, cc = c & 31, ob = rr * 64 + cc * 2; return st * 1024 + (ob ^ (((ob >> 9) & 1) << 5)); }
__host__ __device__ __forceinline__ void stage_rc(int b, int& R, int& C) { const int st = b / 1024, sb = b % 1024, swz = sb ^ (((sb >> 9) & 1) << 5); R = (st >> 1) * 16 + swz / 64; C = (st & 1) * 32 + (swz % 64) / 2; }
__host__ __device__ __forceinline__ int perm32(int rho) { const int n = rho >> 4, i = rho & 15; return 8 * (i >> 2) + 4 * n + (i & 3); }

__device__ __forceinline__ const bf16_t* sel_ptr(bool c, const bf16_t* a, const bf16_t* b) { const unsigned long long m = 0ull - (unsigned long long)c; return (const bf16_t*)((((unsigned long long)a) & m) | (((unsigned long long)b) & ~m)); }
struct Unit { int pm, pn; };
struct Gemm { const bf16_t* A; const bf16_t* Bt; int M, N, K, ld; };

struct StaticOrder {
    int nM, nN, nwg, G, c;
    __host__ __device__ void init(int M, int N, int G_, int c_) { nM = M / BM; nN = N / BM; nwg = nM * nN; G = G_; c = c_; }
    __host__ __device__ bool next(int i, Unit& u) const {
        const long L = (long)i * G + c; if (L >= nwg) return false;
        int wgid = (int)L; { const int q = nwg / NXCD, r = nwg % NXCD, xcd = wgid % NXCD, off = wgid / NXCD; wgid = (xcd < r ? xcd * (q + 1) : r * (q + 1) + (xcd - r) * q) + off; }
        const int nig = WGM * nN, gid = wgid / nig, fm = gid * WGM, gsz = (nM - fm) < WGM ? (nM - fm) : WGM;
        u.pm = fm + ((wgid % nig) % gsz); u.pn = (wgid % nig) / gsz; return true;
    }
    __device__ __forceinline__ void a_ready(const Unit&) const {}
    __device__ __forceinline__ void done(const Unit&) const {}
    __device__ __forceinline__ const char* pA(const Gemm& g, const Unit& u) const { return (const char*)g.A + (size_t)u.pm * BM * g.ld * 2; }
    __device__ __forceinline__ const char* pB(const Gemm& g, const Unit& u) const { return (const char*)g.Bt + (size_t)u.pn * BM * g.ld * 2; }
};
struct DownOrder {
    int c;
    __device__ bool next(int i, Unit& u) const { if (i > 1) return false; const int xcd = c & 7, j = c >> 3; u.pm = i * 32 + xcd * 4 + (j >> 3); u.pn = j & 7; return true; }
    __device__ __forceinline__ void a_ready(const Unit&) const {}
    __device__ __forceinline__ void done(const Unit&) const {}
    __device__ __forceinline__ const char* pA(const Gemm& g, const Unit& u) const { return (const char*)g.A + (size_t)u.pm * BM * g.ld * 2; }
    __device__ __forceinline__ const char* pB(const Gemm& g, const Unit& u) const { return (const char*)g.Bt + (size_t)u.pn * BM * g.ld * 2; }
};
struct PreQKOrder {
    int G, c0, cmax; const bf16_t* Wout_t; const bf16_t* PWn;
    __device__ __forceinline__ bool next(int i, Unit& u) const { const int c = i * G + c0; if (c >= cmax) return false;
        if (c < 128) { u.pm = (c >> 5) * 4 + ((c >> 3) & 3); u.pn = c & 7; } else { const int q = c - 128; u.pm = 0x1000 | (q >> 2); u.pn = q & 3; } return true; }
    __device__ __forceinline__ void a_ready(const Unit&) const {}
    __device__ __forceinline__ void done(const Unit&) const {}
    __device__ __forceinline__ const char* pA(const Gemm& g, const Unit& u) const { const bool pw = (u.pm & 0x1000) != 0;
        const bf16_t* p = sel_ptr(pw, Wout_t + (size_t)(u.pm & 0xfff) * 256 * 2048 + u.pn * 256, g.A + (size_t)((u.pm & 0xfff) >> 2) * 256 * 2048 + (u.pm & 3) * 512); return (const char*)p; }
    __device__ __forceinline__ const char* pB(const Gemm& g, const Unit& u) const { const bool pw = (u.pm & 0x1000) != 0;
        const bf16_t* p = sel_ptr(pw, PWn + (size_t)u.pn * 256 * 2048, g.Bt + (size_t)u.pn * 256 * 2048 + (u.pm & 3) * 512); return (const char*)p; }
};
struct PreVOOrder {
    int G, c0;
    __device__ bool next(int i, Unit& u) const { const int c = i * G + c0; if (c >= 128) return false; u.pm = (c >> 5) * 8 + ((c >> 2) & 7); u.pn = c & 3; return true; }
    __device__ __forceinline__ void a_ready(const Unit&) const {}
    __device__ __forceinline__ void done(const Unit&) const {}
    __device__ __forceinline__ const char* pA(const Gemm& g, const Unit& u) const { return (const char*)(g.A + (size_t)(u.pm & 7) * 256 * 2048 + u.pn * 512); }
    __device__ __forceinline__ const char* pB(const Gemm& g, const Unit& u) const { return (const char*)(g.Bt + (size_t)(u.pm >> 3) * 256 * 2048 + u.pn * 512); }
};
struct ScoreOrder {
    int G, c;
    __device__ bool next(int i, Unit& u) const { if (G != 256) { const int L = i * G + c; if (L >= 256) return false; u.pm = L >> 2; u.pn = L & 3; return true; }
        if (i > 0) return false; const int xcd = c & 7, j = c >> 3; u.pm = xcd * 8 + (j >> 2); u.pn = j & 3; return true; }
    __device__ __forceinline__ void a_ready(const Unit&) const {}
    __device__ __forceinline__ void done(const Unit&) const {}
    __device__ __forceinline__ const char* pA(const Gemm& g, const Unit& u) const { return (const char*)(g.A + (size_t)u.pm * BM * 2048); }
    __device__ __forceinline__ const char* pB(const Gemm& g, const Unit& u) const { return (const char*)(g.Bt + (size_t)((u.pm >> 4) * 1024 + u.pn * 256) * 2048); }
};
struct AttnOutOrder {
    int G, c;
    __device__ bool next(int i, Unit& u) const { if (G != 256) { const int L = i * G + c; if (L >= 512) return false; u.pm = L >> 3; u.pn = L & 7; return true; }
        if (i > 1) return false; const int xcd = c & 7, j = c >> 3; u.pm = xcd * 8 + (j >> 2); u.pn = i * 4 + (j & 3); return true; }
    __device__ __forceinline__ void a_ready(const Unit&) const {}
    __device__ __forceinline__ void done(const Unit&) const {}
    __device__ __forceinline__ const char* pA(const Gemm& g, const Unit& u) const { return (const char*)(g.A + (size_t)u.pm * BM * 1024); }
    __device__ __forceinline__ const char* pB(const Gemm& g, const Unit& u) const { return (const char*)(g.Bt + (size_t)((u.pm >> 4) * 2048 + u.pn * 256) * 1024); }
};
struct AttnSOrder {
    int G, c;
    __device__ bool next(int i, Unit& u) const { const int L = i * G + c; if (L >= 256) return false; u.pm = L >> 2; u.pn = L & 3; return true; }
    __device__ __forceinline__ void a_ready(const Unit&) const {}
    __device__ __forceinline__ void done(const Unit&) const {}
    __device__ __forceinline__ const char* pA(const Gemm& g, const Unit& u) const { return (const char*)(g.A + (size_t)u.pm * BM * 2048 + u.pn * 512); }
    __device__ __forceinline__ const char* pB(const Gemm& g, const Unit& u) const { return (const char*)(g.Bt + (size_t)(u.pm >> 4) * 256 * 2048 + u.pn * 512); }
};
struct AttnPVOrder {
    int G, c;
    __device__ bool next(int i, Unit& u) const { const int L = i * G + c; if (L >= 512) return false; u.pm = L >> 3; u.pn = L & 7; return true; }
    __device__ __forceinline__ void a_ready(const Unit&) const {}
    __device__ __forceinline__ void done(const Unit&) const {}
    __device__ __forceinline__ const char* pA(const Gemm& g, const Unit& u) const { return (const char*)(g.A + (size_t)u.pm * BM * 1024 + (u.pn >> 1) * 256); }
    __device__ __forceinline__ const char* pB(const Gemm& g, const Unit& u) const { return (const char*)(g.Bt + (size_t)u.pn * BM * 1024 + (u.pm >> 4) * 256); }
};

typedef __bf16 bf16x2v_ __attribute__((ext_vector_type(2)));
typedef float f32x2v_ __attribute__((ext_vector_type(2)));
__device__ __forceinline__ unsigned cvt_pk_bf16(float lo, float hi) { const f32x2v_ f = {lo, hi}; const bf16x2v_ b = __builtin_convertvector(f, bf16x2v_); return __builtin_bit_cast(unsigned, b); }
typedef unsigned u32x2 __attribute__((ext_vector_type(2)));
constexpr float RMS_EPS = 1e-6f;

struct EpiPlain {
    static constexpr bool PERM = true, AFTER_DRAIN = false;
    bf16_t* O; int ldc;
    __device__ __forceinline__ void operator()(const f32x4 (&acc)[2][2][4][2], const Unit& u, int wr, int wc, int fr, int fq) const {
        { const int l_ = (int)__builtin_amdgcn_mbcnt_hi(~0u, __builtin_amdgcn_mbcnt_lo(~0u, 0u)); fr = l_ & 15; fq = l_ >> 4; }
        const int row0 = u.pm * BM + wr * 64 + fr, col0 = u.pn * BM + wc * 32 + 8 * fq;
#pragma unroll
        for (int ai = 0; ai < 2; ++ai)
#pragma unroll
            for (int m = 0; m < 4; ++m) { bf16_t* rowp = O + (size_t)(row0 + ai * HALF + m * 16) * ldc + col0;
#pragma unroll
                for (int bj = 0; bj < 2; ++bj) { const f32x4 v0 = acc[ai][bj][m][0], v1 = acc[ai][bj][m][1];
                    u32x4 w; w.x = cvt_pk_bf16(v0[0], v0[1]); w.y = cvt_pk_bf16(v0[2], v0[3]); w.z = cvt_pk_bf16(v1[0], v1[1]); w.w = cvt_pk_bf16(v1[2], v1[3]);
                    *(u32x4*)(rowp + bj * HALF) = w; } }
    }
};
struct EpiPre {
    static constexpr bool PERM = true, AFTER_DRAIN = false;
    bf16_t* WQK; bf16_t* Wout_t;
    __device__ __forceinline__ void operator()(const f32x4 (&acc)[2][2][4][2], const Unit& u, int wr, int wc, int fr, int fq) const {
        const bool pw = (u.pm & 0x1000) != 0; Unit t; t.pm = u.pm & 0xfff; t.pn = u.pn; const EpiPlain E{(bf16_t*)sel_ptr(pw, Wout_t, WQK), 2048}; E(acc, t, wr, wc, fr, fq);
    }
};
struct EpiRowScale {
    static constexpr bool PERM = true, AFTER_DRAIN = false;
    bf16_t* O; int ldc; const float* SS; float inv_n;
    __device__ __forceinline__ void operator()(const f32x4 (&acc)[2][2][4][2], const Unit& u, int wr, int wc, int fr, int fq) const {
        const int row0 = u.pm * BM + wr * 64 + fr, col0 = u.pn * BM + wc * 32 + 8 * fq;
#pragma unroll
        for (int ai = 0; ai < 2; ++ai)
#pragma unroll
            for (int m = 0; m < 4; ++m) { const int row = row0 + ai * HALF + m * 16; bf16_t* rowp = O + (size_t)row * ldc + col0;
                const f32x4 pa = *(const f32x4*)(SS + (size_t)row * 8), pb = *(const f32x4*)(SS + (size_t)row * 8 + 4); const float rs = __builtin_amdgcn_rsqf((((pa[0] + pa[1]) + (pa[2] + pa[3])) + ((pb[0] + pb[1]) + (pb[2] + pb[3]))) * inv_n + RMS_EPS);
#pragma unroll
                for (int bj = 0; bj < 2; ++bj) { const f32x4 v0 = acc[ai][bj][m][0] * rs, v1 = acc[ai][bj][m][1] * rs;
                    u32x4 w; w.x = cvt_pk_bf16(v0[0], v0[1]); w.y = cvt_pk_bf16(v0[2], v0[3]); w.z = cvt_pk_bf16(v1[0], v1[1]); w.w = cvt_pk_bf16(v1[2], v1[3]);
                    *(u32x4*)(rowp + bj * HALF) = w; } }
    }
};
struct EpiRowScaleC {
    static constexpr bool PERM = true, AFTER_DRAIN = false;
    bf16_t* O; int ldc; const float* RS;
    __device__ __forceinline__ void operator()(const f32x4 (&acc)[2][2][4][2], const Unit& u, int wr, int wc, int fr, int fq) const {
        const int row0 = u.pm * BM + wr * 64 + fr, col0 = u.pn * BM + wc * 32 + 8 * fq;
#pragma unroll
        for (int ai = 0; ai < 2; ++ai)
#pragma unroll
            for (int m = 0; m < 4; ++m) { const int row = row0 + ai * HALF + m * 16; bf16_t* rowp = O + (size_t)row * ldc + col0; const float rs = RS[row];
#pragma unroll
                for (int bj = 0; bj < 2; ++bj) { const f32x4 v0 = acc[ai][bj][m][0] * rs, v1 = acc[ai][bj][m][1] * rs;
                    u32x4 w; w.x = cvt_pk_bf16(v0[0], v0[1]); w.y = cvt_pk_bf16(v0[2], v0[3]); w.z = cvt_pk_bf16(v1[0], v1[1]); w.w = cvt_pk_bf16(v1[2], v1[3]);
                    *(u32x4*)(rowp + bj * HALF) = w; } }
    }
};
struct EpiColScale {
    static constexpr bool PERM = true, AFTER_DRAIN = false;
    bf16_t* O; int ldc; const float* RS;
    __device__ __forceinline__ void operator()(const f32x4 (&acc)[2][2][4][2], const Unit& u, int wr, int wc, int fr, int fq) const {
        const int row0 = u.pm * BM + wr * 64 + fr, col0 = u.pn * BM + wc * 32 + 8 * fq;
        f32x4 c0[2], c1[2];
#pragma unroll
        for (int bj = 0; bj < 2; ++bj) { c0[bj] = *(const f32x4*)(RS + col0 + bj * HALF); c1[bj] = *(const f32x4*)(RS + col0 + bj * HALF + 4); }
#pragma unroll
        for (int ai = 0; ai < 2; ++ai)
#pragma unroll
            for (int m = 0; m < 4; ++m) { bf16_t* rowp = O + (size_t)(row0 + ai * HALF + m * 16) * ldc + col0;
#pragma unroll
                for (int bj = 0; bj < 2; ++bj) { const f32x4 v0 = acc[ai][bj][m][0] * c0[bj], v1 = acc[ai][bj][m][1] * c1[bj];
                    u32x4 w; w.x = cvt_pk_bf16(v0[0], v0[1]); w.y = cvt_pk_bf16(v0[2], v0[3]); w.z = cvt_pk_bf16(v1[0], v1[1]); w.w = cvt_pk_bf16(v1[2], v1[3]);
                    *(u32x4*)(rowp + bj * HALF) = w; } }
    }
};
__device__ __forceinline__ float silu_mul(float g, float u) { return g * u * __builtin_amdgcn_rcpf(1.0f + __expf(-g)); }
struct EpiSwiglu {
    static constexpr bool PERM = true, AFTER_DRAIN = false;
    bf16_t* O; int ldc; const float* SS; float inv_n;
    __device__ __forceinline__ void operator()(const f32x4 (&acc)[2][2][4][2], const Unit& u, int wr, int wc, int fr, int fq) const {
        const int row0 = u.pm * BM + wr * 64 + fr, col0 = u.pn * HALF + wc * 32 + 8 * fq;
#pragma unroll
        for (int ai = 0; ai < 2; ++ai)
#pragma unroll
            for (int m = 0; m < 4; ++m) { const int row = row0 + ai * HALF + m * 16;
                const f32x4 pa = *(const f32x4*)(SS + (size_t)row * 8), pb = *(const f32x4*)(SS + (size_t)row * 8 + 4); const float rs = __builtin_amdgcn_rsqf((((pa[0] + pa[1]) + (pa[2] + pa[3])) + ((pb[0] + pb[1]) + (pb[2] + pb[3]))) * inv_n + RMS_EPS);
                const f32x4 g0 = acc[ai][0][m][0] * rs, g1 = acc[ai][0][m][1] * rs, u0 = acc[ai][1][m][0] * rs, u1 = acc[ai][1][m][1] * rs;
                u32x4 w;
                w.x = cvt_pk_bf16(silu_mul(g0[0], u0[0]), silu_mul(g0[1], u0[1])); w.y = cvt_pk_bf16(silu_mul(g0[2], u0[2]), silu_mul(g0[3], u0[3]));
                w.z = cvt_pk_bf16(silu_mul(g1[0], u1[0]), silu_mul(g1[1], u1[1])); w.w = cvt_pk_bf16(silu_mul(g1[2], u1[2]), silu_mul(g1[3], u1[3]));
                *(u32x4*)(O + (size_t)row * ldc + col0) = w; }
    }
};
struct EpiSoftmax {
    static constexpr bool PERM = true, AFTER_DRAIN = false;
    bf16_t* P; float* RSP; __attribute__((address_space(3))) float* xm; float sl2;
    __device__ __forceinline__ void operator()(const f32x4 (&acc)[2][2][4][2], const Unit& u, int wr, int wc, int fr, int fq) const {
        const int h = u.pn;
#pragma unroll
        for (int ai = 0; ai < 2; ++ai)
#pragma unroll
            for (int m = 0; m < 4; ++m) { float v = -3.0e38f;
#pragma unroll
                for (int bj = 0; bj < 2; ++bj)
#pragma unroll
                    for (int n = 0; n < 2; ++n) { const f32x4 x = acc[ai][bj][m][n]; v = fmaxf(v, fmaxf(fmaxf(x[0], x[1]), fmaxf(x[2], x[3]))); }
                v = fmaxf(v, __shfl_xor(v, 16)); v = fmaxf(v, __shfl_xor(v, 32));
                if (fq == 0) xm[(ai * HALF + wr * 64 + m * 16 + fr) * 4 + wc] = v; }
        asm volatile("s_waitcnt lgkmcnt(0)" ::: "memory"); __builtin_amdgcn_s_barrier(); asm volatile("" ::: "memory");
#pragma unroll
        for (int ai = 0; ai < 2; ++ai)
#pragma unroll
            for (int m = 0; m < 4; ++m) { const int r = ai * HALF + wr * 64 + m * 16 + fr; const int row = u.pm * BM + r;
                const f32x4 mm = *(const __attribute__((address_space(3))) f32x4*)(xm + r * 4); const float mx = fmaxf(fmaxf(mm[0], mm[1]), fmaxf(mm[2], mm[3])) * sl2; float s = 0.f;
#pragma unroll
                for (int bj = 0; bj < 2; ++bj) { f32x4 p0, p1;
#pragma unroll
                    for (int j = 0; j < 4; ++j) { p0[j] = __builtin_amdgcn_exp2f(acc[ai][bj][m][0][j] * sl2 - mx); p1[j] = __builtin_amdgcn_exp2f(acc[ai][bj][m][1][j] * sl2 - mx); }
                    s += ((p0[0] + p0[1]) + (p0[2] + p0[3])) + ((p1[0] + p1[1]) + (p1[2] + p1[3]));
                    u32x4 w; w.x = cvt_pk_bf16(p0[0], p0[1]); w.y = cvt_pk_bf16(p0[2], p0[3]); w.z = cvt_pk_bf16(p1[0], p1[1]); w.w = cvt_pk_bf16(p1[2], p1[3]);
                    *(u32x4*)(P + (size_t)row * 1024 + h * 256 + bj * HALF + wc * 32 + 8 * fq) = w; }
                s += __shfl_xor(s, 16); s += __shfl_xor(s, 32);
                if (fq == 0) RSP[(size_t)row * 16 + h * 4 + wc] = s; }
    }
};
struct EpiSoftmaxN {
    static constexpr bool PERM = true, AFTER_DRAIN = false;
    bf16_t* P; const float* SS; float inv_n; __attribute__((address_space(3))) float* xm; float sl2;
    __device__ __forceinline__ void operator()(f32x4 (&acc)[2][2][4][2], const Unit& u, int wr, int wc, int fr, int fq) const {
        { const int l_ = (int)__builtin_amdgcn_mbcnt_hi(~0u, __builtin_amdgcn_mbcnt_lo(~0u, 0u)); fr = l_ & 15; fq = l_ >> 4; }
        const int h = u.pn; __attribute__((address_space(3))) float* xs = xm + 1024;
#pragma unroll
        for (int ai = 0; ai < 2; ++ai)
#pragma unroll
            for (int m = 0; m < 4; ++m) { float v = -3.0e38f;
#pragma unroll
                for (int bj = 0; bj < 2; ++bj)
#pragma unroll
                    for (int n = 0; n < 2; ++n) { const f32x4 x = acc[ai][bj][m][n]; v = fmaxf(v, fmaxf(fmaxf(x[0], x[1]), fmaxf(x[2], x[3]))); }
                v = fmaxf(v, __shfl_xor(v, 16)); v = fmaxf(v, __shfl_xor(v, 32));
                if (fq == 0) xm[(ai * HALF + wr * 64 + m * 16 + fr) * 4 + wc] = v; }
        asm volatile("s_waitcnt lgkmcnt(0)" ::: "memory"); __builtin_amdgcn_s_barrier(); asm volatile("" ::: "memory");
#pragma unroll
        for (int ai = 0; ai < 2; ++ai)
#pragma unroll
            for (int m = 0; m < 4; ++m) { const int r = ai * HALF + wr * 64 + m * 16 + fr; const int row = u.pm * BM + r;
                const f32x4 pa = *(const f32x4*)(SS + (size_t)row * 8), pb = *(const f32x4*)(SS + (size_t)row * 8 + 4);
                const float f = sl2 * __builtin_amdgcn_rsqf((((pa[0] + pa[1]) + (pa[2] + pa[3])) + ((pb[0] + pb[1]) + (pb[2] + pb[3]))) * inv_n + RMS_EPS);
                const f32x4 mm = *(const __attribute__((address_space(3))) f32x4*)(xm + r * 4); const float mx = fmaxf(fmaxf(mm[0], mm[1]), fmaxf(mm[2], mm[3])) * f; float s = 0.f;
#pragma unroll
                for (int bj = 0; bj < 2; ++bj)
#pragma unroll
                    for (int n = 0; n < 2; ++n) { f32x4 p;
#pragma unroll
                        for (int j = 0; j < 4; ++j) p[j] = __builtin_amdgcn_exp2f(acc[ai][bj][m][n][j] * f - mx);
                        acc[ai][bj][m][n] = p; s += (p[0] + p[1]) + (p[2] + p[3]); }
                s += __shfl_xor(s, 16); s += __shfl_xor(s, 32);
                if (fq == 0) xs[r * 4 + wc] = s; }
        asm volatile("s_waitcnt lgkmcnt(0)" ::: "memory"); __builtin_amdgcn_s_barrier(); asm volatile("" ::: "memory");
#pragma unroll
        for (int ai = 0; ai < 2; ++ai)
#pragma unroll
            for (int m = 0; m < 4; ++m) { const int r = ai * HALF + wr * 64 + m * 16 + fr; const int row = u.pm * BM + r;
                const f32x4 ps = *(const __attribute__((address_space(3))) f32x4*)(xs + r * 4); const float inv = 1.0f / ((ps[0] + ps[1]) + (ps[2] + ps[3]));
#pragma unroll
                for (int bj = 0; bj < 2; ++bj) { const f32x4 v0 = acc[ai][bj][m][0] * inv, v1 = acc[ai][bj][m][1] * inv;
                    u32x4 w; w.x = cvt_pk_bf16(v0[0], v0[1]); w.y = cvt_pk_bf16(v0[2], v0[3]); w.z = cvt_pk_bf16(v1[0], v1[1]); w.w = cvt_pk_bf16(v1[2], v1[3]);
                    *(u32x4*)(P + (size_t)row * 1024 + h * 256 + bj * HALF + wc * 32 + 8 * fq) = w; } }
    }
};
struct EpiFinal {
    static constexpr bool PERM = true, AFTER_DRAIN = false;
    const bf16_t* res16; float* out; float* SS; unsigned* cnt; const float* gfin; __attribute__((address_space(3))) float* xs; int ldc;
    __device__ __forceinline__ void operator()(f32x4 (&acc)[2][2][4][2], const Unit& u, int wr, int wc, int fr, int fq) const {
        const int lane = (int)__builtin_amdgcn_mbcnt_hi(~0u, __builtin_amdgcn_mbcnt_lo(~0u, 0u)); fr = lane & 15; fq = lane >> 4;
        __attribute__((address_space(3))) float* rsl = xs + 1024;
        const int col0 = u.pn * BM + wc * 32 + 8 * fq;
#pragma unroll
        for (int ai = 0; ai < 2; ++ai) { u32x4 rh[4][2];
#pragma unroll
            for (int m = 0; m < 4; ++m) { const size_t off = (size_t)(u.pm * BM + ai * HALF + wr * 64 + m * 16 + fr) * ldc + col0;
#pragma unroll
                for (int bj = 0; bj < 2; ++bj) rh[m][bj] = *(const u32x4*)(res16 + off + bj * HALF); }
#pragma unroll
            for (int m = 0; m < 4; ++m) { float s = 0.f;
#pragma unroll
                for (int bj = 0; bj < 2; ++bj) { const u32x4 rb = rh[m][bj];
                    const f32x4 r0 = (f32x4){__uint_as_float(rb.x << 16), __uint_as_float(rb.x & 0xffff0000u), __uint_as_float(rb.y << 16), __uint_as_float(rb.y & 0xffff0000u)};
                    const f32x4 r1 = (f32x4){__uint_as_float(rb.z << 16), __uint_as_float(rb.z & 0xffff0000u), __uint_as_float(rb.w << 16), __uint_as_float(rb.w & 0xffff0000u)};
                    const f32x4 v0 = r0 + acc[ai][bj][m][0], v1 = r1 + acc[ai][bj][m][1]; acc[ai][bj][m][0] = v0; acc[ai][bj][m][1] = v1;
                    s += ((v0[0] * v0[0] + v0[1] * v0[1]) + (v0[2] * v0[2] + v0[3] * v0[3])) + ((v1[0] * v1[0] + v1[1] * v1[1]) + (v1[2] * v1[2] + v1[3] * v1[3])); }
                s += __shfl_xor(s, 16); s += __shfl_xor(s, 32); if (fq == 0) xs[(ai * HALF + wr * 64 + m * 16 + fr) * 4 + wc] = s; }
            asm volatile("" ::: "memory"); }
        asm volatile("s_waitcnt lgkmcnt(0)" ::: "memory"); __builtin_amdgcn_s_barrier(); asm volatile("" ::: "memory");
        if (fq == 0) {
#pragma unroll
            for (int ai = 0; ai < 2; ++ai) { const int r = ai * HALF + wr * 64 + wc * 16 + fr; const f32x4 p = *(const __attribute__((address_space(3))) f32x4*)(xs + r * 4);
                __hip_atomic_store(SS + (size_t)(u.pm * BM + r) * 8 + u.pn, (p[0] + p[1]) + (p[2] + p[3]), __ATOMIC_RELAXED, __HIP_MEMORY_SCOPE_AGENT); } }
        asm volatile("s_waitcnt vmcnt(0)" ::: "memory");
        if (lane == 0) __hip_atomic_fetch_add(cnt + 64 * u.pm, 1u, __ATOMIC_RELAXED, __HIP_MEMORY_SCOPE_AGENT);
        if (wr == 0 && wc == 0) {
            unsigned sp = 0u;
            while ((unsigned)__builtin_amdgcn_readfirstlane((int)__hip_atomic_load(cnt + 64 * u.pm, __ATOMIC_RELAXED, __HIP_MEMORY_SCOPE_AGENT)) < 64u) { __builtin_amdgcn_s_sleep(2); if (++sp > (1u << 22)) break; }
            __builtin_amdgcn_fence(__ATOMIC_ACQUIRE, "agent"); }
        asm volatile("s_waitcnt vmcnt(0) lgkmcnt(0)" ::: "memory"); __builtin_amdgcn_s_barrier(); asm volatile("" ::: "memory");
        if (wr == 0) {
            const int r = wc * 64 + lane; const unsigned long long* sp = (const unsigned long long*)(SS + (size_t)(u.pm * BM + r) * 8); float t = 0.f;
#pragma unroll
            for (int q = 0; q < 4; ++q) { const unsigned long long w = __hip_atomic_load(sp + q, __ATOMIC_RELAXED, __HIP_MEMORY_SCOPE_AGENT); t += __uint_as_float((unsigned)w) + __uint_as_float((unsigned)(w >> 32)); }
            rsl[r] = __builtin_amdgcn_rsqf(t * (1.0f / 2048.0f) + RMS_EPS); }
        asm volatile("s_waitcnt vmcnt(0) lgkmcnt(0)" ::: "memory"); __builtin_amdgcn_s_barrier(); asm volatile("" ::: "memory");
        f32x4 g0[2], g1[2];
#pragma unroll
        for (int bj = 0; bj < 2; ++bj) { g0[bj] = *(const f32x4*)(gfin + col0 + bj * HALF); g1[bj] = *(const f32x4*)(gfin + col0 + bj * HALF + 4); }
#pragma unroll
        for (int ai = 0; ai < 2; ++ai)
#pragma unroll
            for (int m = 0; m < 4; ++m) { const int r = ai * HALF + wr * 64 + m * 16 + fr; const float rs = rsl[r]; float* op = out + (size_t)(u.pm * BM + r) * ldc + col0;
#pragma unroll
                for (int bj = 0; bj < 2; ++bj) { *(f32x4*)(op + bj * HALF) = acc[ai][bj][m][0] * rs * g0[bj]; *(f32x4*)(op + bj * HALF + 4) = acc[ai][bj][m][1] * rs * g1[bj]; } }
    }
};
struct EpiAttnOut {
    static constexpr bool PERM = true, AFTER_DRAIN = false;
    bf16_t* O; const float* RSP;
    __device__ __forceinline__ void operator()(const f32x4 (&acc)[2][2][4][2], const Unit& u, int wr, int wc, int fr, int fq) const {
        const int row0 = u.pm * BM + wr * 64 + fr, col0 = u.pn * BM + wc * 32 + 8 * fq, h = u.pn >> 1;
#pragma unroll
        for (int ai = 0; ai < 2; ++ai)
#pragma unroll
            for (int m = 0; m < 4; ++m) { const int row = row0 + ai * HALF + m * 16; bf16_t* rowp = O + (size_t)row * 2048 + col0;
                const f32x4 ps = *(const f32x4*)(RSP + (size_t)row * 16 + h * 4); const float rs = 1.0f / ((ps[0] + ps[1]) + (ps[2] + ps[3]));
#pragma unroll
                for (int bj = 0; bj < 2; ++bj) { const f32x4 v0 = acc[ai][bj][m][0] * rs, v1 = acc[ai][bj][m][1] * rs;
                    u32x4 w; w.x = cvt_pk_bf16(v0[0], v0[1]); w.y = cvt_pk_bf16(v0[2], v0[3]); w.z = cvt_pk_bf16(v1[0], v1[1]); w.w = cvt_pk_bf16(v1[2], v1[3]);
                    *(u32x4*)(rowp + bj * HALF) = w; } }
    }
};
template <bool RES_F32> struct EpiResid {
    static constexpr bool PERM = true, AFTER_DRAIN = false;
    const float* res32; const bf16_t* res16; bf16_t* xb; float* SS; int ldc; __attribute__((address_space(3))) float* xs;
    __device__ __forceinline__ void operator()(const f32x4 (&acc)[2][2][4][2], const Unit& u, int wr, int wc, int fr, int fq) const {
        const int col0 = u.pn * BM + wc * 32 + 8 * fq;
#pragma unroll
        for (int ai = 0; ai < 2; ++ai) {
            f32x4 rf[RES_F32 ? 4 : 1][2][2]; u32x4 rh[RES_F32 ? 1 : 4][2];
#pragma unroll
            for (int m = 0; m < 4; ++m) { const size_t off = (size_t)(u.pm * BM + ai * HALF + wr * 64 + m * 16 + fr) * ldc + col0;
#pragma unroll
                for (int bj = 0; bj < 2; ++bj) {
                    if constexpr (RES_F32) { rf[m][bj][0] = *(const f32x4*)(res32 + off + bj * HALF); rf[m][bj][1] = *(const f32x4*)(res32 + off + bj * HALF + 4); }
                    else rh[m][bj] = *(const u32x4*)(res16 + off + bj * HALF); } }
#pragma unroll
            for (int m = 0; m < 4; ++m) { const int row = u.pm * BM + ai * HALF + wr * 64 + m * 16 + fr; const size_t off = (size_t)row * ldc + col0; float s = 0.f;
#pragma unroll
                for (int bj = 0; bj < 2; ++bj) { f32x4 r0, r1;
                    if constexpr (RES_F32) { r0 = rf[m][bj][0]; r1 = rf[m][bj][1]; }
                    else { const u32x4 rb = rh[m][bj];
                        r0 = (f32x4){__uint_as_float(rb.x << 16), __uint_as_float(rb.x & 0xffff0000u), __uint_as_float(rb.y << 16), __uint_as_float(rb.y & 0xffff0000u)};
                        r1 = (f32x4){__uint_as_float(rb.z << 16), __uint_as_float(rb.z & 0xffff0000u), __uint_as_float(rb.w << 16), __uint_as_float(rb.w & 0xffff0000u)}; }
                    const f32x4 v0 = r0 + acc[ai][bj][m][0], v1 = r1 + acc[ai][bj][m][1];
                    u32x4 w; w.x = cvt_pk_bf16(v0[0], v0[1]); w.y = cvt_pk_bf16(v0[2], v0[3]); w.z = cvt_pk_bf16(v1[0], v1[1]); w.w = cvt_pk_bf16(v1[2], v1[3]);
                    *(u32x4*)(xb + off + bj * HALF) = w;
                    s += ((v0[0] * v0[0] + v0[1] * v0[1]) + (v0[2] * v0[2] + v0[3] * v0[3])) + ((v1[0] * v1[0] + v1[1] * v1[1]) + (v1[2] * v1[2] + v1[3] * v1[3])); }
                s += __shfl_xor(s, 16); s += __shfl_xor(s, 32); if (fq == 0) xs[(ai * HALF + wr * 64 + m * 16 + fr) * 4 + wc] = s; }
            asm volatile("" ::: "memory"); }
        asm volatile("s_waitcnt lgkmcnt(0)" ::: "memory"); __builtin_amdgcn_s_barrier(); asm volatile("" ::: "memory");
        if (fq == 0) {
#pragma unroll
            for (int ai = 0; ai < 2; ++ai) { const int r = ai * HALF + wr * 64 + wc * 16 + fr; const f32x4 p = *(const __attribute__((address_space(3))) f32x4*)(xs + r * 4);
                SS[(size_t)(u.pm * BM + r) * 8 + u.pn] = (p[0] + p[1]) + (p[2] + p[3]); } }
    }
};
template <class Epi, class Sched, bool ALIGN_EPI = false, bool SP2 = false>
__device__ __forceinline__ void gemm_phase(PG8_LAS unsigned char* lds, const Gemm g, const Sched& S, const Epi& E) {
    int tid_ = threadIdx.x; asm volatile("" : "+v"(tid_));
    const int tid = tid_, wid = __builtin_amdgcn_readfirstlane(tid >> 6), lane = tid & 63, wr = wid >> 2, wc = wid & 3, fr = lane & 15, fq = lane >> 4;
    const int K = g.ld, nt = g.K / BK;
    unsigned voffA[2], voffB[2];
#pragma unroll
    for (int i = 0; i < 2; ++i) { int R, C; stage_rc(tid * 16 + i * 8192, R, C); const int Rb = Epi::PERM ? ((R & ~31) + perm32(R & 31)) : R;
        voffA[i] = (unsigned)(R * K + C) * 2u; voffB[i] = (unsigned)(Rb * K + C) * 2u; }
    const size_t kstep = (size_t)(BK * 2);
    const size_t hstep = (size_t)HALF * K * 2;
    const unsigned ldsw = (unsigned)wid * 1024u;
    const int aoff = lds_byte(wr * 64 + fr, fq * 8), boff = lds_byte(wc * 32 + fr, fq * 8);
#define PG8_SA(b, h) (((b) * 2 + (h)) * HTB)
#define PG8_SB(b, h) ((4 + (b) * 2 + (h)) * HTB)
#define PG8_STAGE(bufoff, gbase, voff) do { _Pragma("unroll") for (int _i = 0; _i < 2; ++_i) \
        __builtin_amdgcn_global_load_lds((const unsigned*)((const char*)(gbase) + (voff)[_i]), (PG8_LAS unsigned*)(lds + (bufoff) + ldsw + _i * 8192), 16, 0, 0); } while (0)
#define PG8_LDA(dst, b, h) do { _Pragma("unroll") for (int m = 0; m < 4; ++m) _Pragma("unroll") for (int k = 0; k < 2; ++k) dst[m][k] = *(const PG8_LAS bf16x8*)(lds + PG8_SA(b, h) + aoff + m * 2048 + k * 1024); } while (0)
#define PG8_LDB(dst, b, h) do { _Pragma("unroll") for (int n = 0; n < 2; ++n) _Pragma("unroll") for (int k = 0; k < 2; ++k) dst[n][k] = *(const PG8_LAS bf16x8*)(lds + PG8_SB(b, h) + boff + n * 2048 + k * 1024); } while (0)
#define PG8_MMA(ai, bj, At, Bt) do { __builtin_amdgcn_s_setprio(1); _Pragma("unroll") for (int m = 0; m < 4; ++m) _Pragma("unroll") for (int n = 0; n < 2; ++n) _Pragma("unroll") for (int k = 0; k < 2; ++k) \
        acc[ai][bj][m][n] = __builtin_amdgcn_mfma_f32_16x16x32_bf16(Bt[n][k], At[m][k], acc[ai][bj][m][n], 0, 0, 0); __builtin_amdgcn_s_setprio(0); } while (0)
#define PG8_WAIT_V(n) asm volatile("s_waitcnt vmcnt(" #n ")" ::: "memory")
#define PG8_WAIT_L(n) asm volatile("s_waitcnt lgkmcnt(" #n ")" ::: "memory")
#define PG8_BAR __builtin_amdgcn_s_barrier()
#define PG8_SCHED __builtin_amdgcn_sched_barrier(0)
    Unit cur, nxt; int ui = 0;
    if (!S.next(0, cur)) return;
    f32x4 acc[2][2][4][2];
#pragma unroll
    for (int a = 0; a < 2; ++a)
#pragma unroll
        for (int b = 0; b < 2; ++b)
#pragma unroll
            for (int m = 0; m < 4; ++m)
#pragma unroll
                for (int n = 0; n < 2; ++n) acc[a][b][m][n] = (f32x4){0.f, 0.f, 0.f, 0.f};
    bf16x8 At[4][2], B0[2][2], B1[2][2];
    const char* cA = S.pA(g, cur); const char* cB = S.pB(g, cur);
    S.a_ready(cur);
    if constexpr (SP2) {
        PG8_STAGE(PG8_SB(0, 0), cB, voffB); PG8_STAGE(PG8_SB(0, 1), cB + hstep, voffB); PG8_STAGE(PG8_SA(0, 0), cA, voffA); PG8_STAGE(PG8_SA(0, 1), cA + hstep, voffA);
        if (wr == 1) PG8_BAR;
        PG8_WAIT_V(2); PG8_BAR;
        PG8_STAGE(PG8_SB(1, 0), cB + kstep, voffB); PG8_STAGE(PG8_SA(1, 0), cA + kstep, voffA); PG8_STAGE(PG8_SB(1, 1), cB + hstep + kstep, voffB);
        PG8_WAIT_V(6); PG8_BAR;
    } else {
        PG8_STAGE(PG8_SB(0, 0), cB, voffB); PG8_STAGE(PG8_SA(0, 0), cA, voffA); PG8_STAGE(PG8_SB(0, 1), cB + hstep, voffB); PG8_STAGE(PG8_SA(0, 1), cA + hstep, voffA);
        if (wr == 1) PG8_BAR;
        PG8_WAIT_V(4); PG8_BAR;
        PG8_STAGE(PG8_SB(1, 0), cB + kstep, voffB); PG8_STAGE(PG8_SA(1, 0), cA + kstep, voffA); PG8_STAGE(PG8_SB(1, 1), cB + hstep + kstep, voffB);
        PG8_WAIT_V(6); PG8_BAR;
    }
    for (;;) {
        const bool has_next = S.next(ui + 1, nxt);
        const char* nA = has_next ? S.pA(g, nxt) : cA; const char* nB = has_next ? S.pB(g, nxt) : cB;
        for (int t = 0; t < nt; t += 2) {
            const bool last = (t == nt - 2);
            const char* a1 = cA + (size_t)(t + 1) * kstep;
            const char* a2 = last ? nA : cA + (size_t)(t + 2) * kstep; const char* b2 = last ? nB : cB + (size_t)(t + 2) * kstep;
            const char* a3 = a2 + kstep; const char* b3 = b2 + kstep;
            if (last && has_next) S.a_ready(nxt);
            if constexpr (SP2) {
            PG8_LDB(B0, 0, 0); PG8_LDB(B1, 0, 1); PG8_SCHED; PG8_LDA(At, 0, 0); PG8_STAGE(PG8_SA(1, 1), a1 + hstep, voffA);
            PG8_WAIT_V(8); PG8_WAIT_L(0); PG8_BAR; PG8_MMA(0, 0, At, B0); PG8_MMA(0, 1, At, B1); PG8_BAR; PG8_SCHED;
            PG8_LDA(At, 0, 1); PG8_STAGE(PG8_SB(0, 0), b2, voffB); PG8_STAGE(PG8_SB(0, 1), b2 + hstep, voffB); PG8_STAGE(PG8_SA(0, 0), a2, voffA);
            PG8_WAIT_V(8); PG8_WAIT_L(0); PG8_BAR; PG8_MMA(1, 0, At, B0); PG8_MMA(1, 1, At, B1); PG8_BAR; PG8_SCHED;
            PG8_LDB(B0, 1, 0); PG8_LDB(B1, 1, 1); PG8_SCHED; PG8_LDA(At, 1, 0); PG8_STAGE(PG8_SA(0, 1), a2 + hstep, voffA);
            PG8_WAIT_V(8); PG8_WAIT_L(0); PG8_BAR; PG8_MMA(0, 0, At, B0); PG8_MMA(0, 1, At, B1); PG8_BAR; PG8_SCHED;
            PG8_LDA(At, 1, 1); PG8_STAGE(PG8_SB(1, 0), b3, voffB); PG8_STAGE(PG8_SB(1, 1), b3 + hstep, voffB); PG8_STAGE(PG8_SA(1, 0), a3, voffA);
            PG8_WAIT_V(8); PG8_WAIT_L(0); PG8_BAR; PG8_MMA(1, 0, At, B0); PG8_MMA(1, 1, At, B1); PG8_BAR; PG8_SCHED;
            } else {
            PG8_LDB(B0, 0, 0); PG8_SCHED; PG8_LDA(At, 0, 0); PG8_STAGE(PG8_SA(1, 1), a1 + hstep, voffA);
            PG8_WAIT_L(8); PG8_BAR; PG8_WAIT_L(0); PG8_MMA(0, 0, At, B0); PG8_BAR; PG8_SCHED;
            PG8_LDB(B1, 0, 1); PG8_STAGE(PG8_SB(0, 0), b2, voffB);
            PG8_BAR; PG8_WAIT_L(0); PG8_MMA(0, 1, At, B1); PG8_BAR;
            PG8_LDA(At, 0, 1); PG8_STAGE(PG8_SA(0, 0), a2, voffA);
            PG8_BAR; PG8_WAIT_L(0); PG8_MMA(1, 0, At, B0); PG8_BAR; PG8_SCHED;
            PG8_STAGE(PG8_SB(0, 1), b2 + hstep, voffB);
            PG8_WAIT_V(6); PG8_BAR; PG8_MMA(1, 1, At, B1); PG8_BAR;
            PG8_LDB(B0, 1, 0); PG8_SCHED; PG8_LDA(At, 1, 0); PG8_STAGE(PG8_SA(0, 1), a2 + hstep, voffA);
            PG8_WAIT_L(8); PG8_BAR; PG8_WAIT_L(0); PG8_MMA(0, 0, At, B0); PG8_BAR; PG8_SCHED;
            PG8_LDB(B1, 1, 1); PG8_STAGE(PG8_SB(1, 0), b3, voffB);
            PG8_BAR; PG8_WAIT_L(0); PG8_MMA(0, 1, At, B1); PG8_BAR;
            PG8_LDA(At, 1, 1); PG8_STAGE(PG8_SA(1, 0), a3, voffA);
            PG8_BAR; PG8_WAIT_L(0); PG8_MMA(1, 0, At, B0); PG8_BAR; PG8_SCHED;
            PG8_STAGE(PG8_SB(1, 1), b3 + hstep, voffB);
            PG8_WAIT_V(6); PG8_BAR; PG8_MMA(1, 1, At, B1); PG8_BAR;
            }
        }
        if constexpr (ALIGN_EPI) { if (wr == 0) PG8_BAR; }
        if constexpr (!Epi::AFTER_DRAIN) { E(acc, cur, wr, wc, fr, fq); S.done(cur); }
        if (!has_next) break;
#pragma unroll
        for (int a = 0; a < 2; ++a)
#pragma unroll
            for (int b = 0; b < 2; ++b)
#pragma unroll
                for (int m = 0; m < 4; ++m)
#pragma unroll
                    for (int n = 0; n < 2; ++n) acc[a][b][m][n] = (f32x4){0.f, 0.f, 0.f, 0.f};
        cur = nxt; cA = nA; cB = nB; ++ui;
        if constexpr (ALIGN_EPI) { if (wr == 1) PG8_BAR; }
    }
    PG8_WAIT_V(0);
    if constexpr (!ALIGN_EPI) { if (wr == 0) PG8_BAR; }
    PG8_BAR;
    if constexpr (Epi::AFTER_DRAIN) { E.fused(acc, cur, wr, wc, fr, fq, lds, wid, lane); S.done(cur); }
#undef PG8_SA
#undef PG8_SB
#undef PG8_STAGE
#undef PG8_LDA
#undef PG8_LDB
#undef PG8_MMA
#undef PG8_WAIT_V
#undef PG8_WAIT_L
#undef PG8_BAR
#undef PG8_SCHED
}
}
#define LAS __attribute__((address_space(3)))
using pg8::bf16_t; using pg8::bf16x8; using pg8::f32x4; using pg8::u32x4; using pg8::u32x2; using pg8::cvt_pk_bf16; using pg8::RMS_EPS;
constexpr int BATCH = 4, SEQ = 4096, D = 2048, M = BATCH * SEQ, NMEM = 256, MM = BATCH * NMEM, DFF = 5632, DPOOL = 1024, DSGU = 1024;
constexpr int NWAVES = 8, NTHR = NWAVES * 64;
constexpr int LDS_BYTES = 147456;
constexpr size_t MiB = 1u << 20;
constexpr size_t WS_BAR = 0, WS_PCNT = 16384, WS_ZERO_BYTES = 65536;
constexpr size_t WS_WIN = 1 * MiB, WS_WOUT = 13 * MiB, WS_WQ = 21 * MiB, WS_WK = 29 * MiB, WS_WV = 37 * MiB, WS_WO = 45 * MiB, WS_WGU = 53 * MiB, WS_WD = 97 * MiB;
constexpr size_t WS_PW = 119 * MiB, WS_WSP = 119 * MiB + 512 * 1024;
constexpr size_t WS_MN = 120 * MiB, WS_KB = 124 * MiB, WS_VTM = 128 * MiB;
constexpr size_t WS_XB = 132 * MiB;
constexpr size_t WS_HG = 196 * MiB;
constexpr size_t WS_PAU = 196 * MiB, WS_Q = 196 * MiB, WS_VT = 260 * MiB, WS_Y = 292 * MiB, WS_O = 292 * MiB;
constexpr size_t WS_PM = 260 * MiB;
constexpr size_t WS_RSP = 356 * MiB;
constexpr size_t WS_SS1 = 372 * MiB, WS_SS2 = WS_SS1 + 512 * 1024, WS_SS3 = WS_SS2 + 512 * 1024;
constexpr size_t WS_RS0 = 375 * MiB;
constexpr size_t WS_WQK = 356 * MiB;
constexpr size_t WS_VWO = 376 * MiB;
constexpr size_t WS_PWN = 392 * MiB;
constexpr size_t WS_END = 396 * MiB;

__device__ __forceinline__ float bf_lo(unsigned w) { return __uint_as_float(w << 16); }
__device__ __forceinline__ float bf_hi(unsigned w) { return __uint_as_float(w & 0xffff0000u); }
__device__ __forceinline__ float wave_sum(float v) {
#pragma unroll
    for (int o = 1; o < 64; o <<= 1) v += __shfl_xor(v, o);
    return v;
}
#define LDS_WAIT() asm volatile("s_waitcnt lgkmcnt(0)" ::: "memory")
#define MFMA16(a, b, c) __builtin_amdgcn_mfma_f32_16x16x32_bf16((a), (b), (c), 0, 0, 0)

#define XB_TMO      128
#define XB_XCNT(j)  (256  + 64 * (j))
#define XB_XSUB(j)  (1280 + 64 * (j))
#define XB_XGEN(j)  (2304 + 64 * (j))
#define XB_TOP      3328
#define XB_TOPGEN   3392
#define XCD_BAR_WORDS 3456
#define XB_SPIN_CAP (1u << 18)

__device__ __forceinline__ unsigned xb_ld(unsigned* p)              { return __hip_atomic_load(p, __ATOMIC_RELAXED, __HIP_MEMORY_SCOPE_AGENT); }
__device__ __forceinline__ unsigned xb_add(unsigned* p, unsigned v) { return __hip_atomic_fetch_add(p, v, __ATOMIC_RELAXED, __HIP_MEMORY_SCOPE_AGENT); }
__device__ __forceinline__ unsigned xb_xcc_id() { return (unsigned)__builtin_amdgcn_s_getreg((3 << 11) | 20) & 0xFu; }
#define XB_SPIN(cond, bar) do { unsigned _sp = 0; while (cond) { __builtin_amdgcn_s_sleep(1); \
    if ((++_sp & 255u) == 0u) { if (xb_ld(&(bar)[XB_TMO])) break; if (_sp > XB_SPIN_CAP) { atomicAdd(&(bar)[XB_TMO], 1u); break; } } } } while (0)

struct XcdBarrier {
    unsigned* bar; unsigned x;
    volatile LAS unsigned* st;
};

__device__ __forceinline__ XcdBarrier xcd_barrier_post(unsigned* bar, volatile LAS unsigned* st) {
    XcdBarrier b; b.bar = bar; b.x = xb_xcc_id(); b.st = st;
    if (threadIdx.x == 0) (void)xb_add(&bar[XB_XCNT(b.x)], 1u);
    return b;
}
__device__ __forceinline__ void xcd_barrier_complete(unsigned* bar, unsigned x, unsigned& nloc, unsigned& nx) {
    const unsigned G = gridDim.x * gridDim.y * gridDim.z;
    unsigned sum, cnt, mine, sp = 0u;
    for (;;) {
        sum = 0u; cnt = 0u; mine = 0u;
#pragma unroll
        for (unsigned j = 0; j < 16; ++j) { const unsigned c = xb_ld(&bar[XB_XCNT(j)]); sum += c; cnt += (c > 0u) ? 1u : 0u; mine = (j == x) ? c : mine; }
        if (sum == G) break;
        __builtin_amdgcn_s_sleep(1);
        if ((++sp & 255u) == 0u) { if (xb_ld(&bar[XB_TMO])) break; if (sp > XB_SPIN_CAP) { atomicAdd(&bar[XB_TMO], 1u); break; } }
    }
    nloc = mine > 0u ? mine : 1u; nx = cnt > 0u ? cnt : 1u;
}

__device__ __forceinline__ void xcd_barrier(const XcdBarrier& b) {
    asm volatile("s_waitcnt vmcnt(0)" ::: "memory");
    __syncthreads();
    if (threadIdx.x == 0) {
        unsigned* bar = b.bar;
        __builtin_amdgcn_s_waitcnt(0);
        unsigned nloc = b.st[0], nx = b.st[1];
        if (nloc == 0u) { xcd_barrier_complete(bar, b.x, nloc, nx); b.st[0] = nloc; b.st[1] = nx; }
        const unsigned old = xb_add(&bar[XB_XSUB(b.x)], 1u);
        const unsigned gen = old / nloc;
        if (old + 1u == (gen + 1u) * nloc) {
            __builtin_amdgcn_fence(__ATOMIC_RELEASE, "agent");
            asm volatile("s_waitcnt vmcnt(0)" ::: "memory");
            const unsigned og = xb_add(&bar[XB_TOP], 1u);
            const unsigned tg = og / nx;
            if (og + 1u == (tg + 1u) * nx) xb_add(&bar[XB_TOPGEN], 1u);
            else XB_SPIN(xb_ld(&bar[XB_TOPGEN]) == tg, bar);
            __builtin_amdgcn_fence(__ATOMIC_ACQUIRE, "agent");
            xb_add(&bar[XB_XGEN(b.x)], 1u);
            asm volatile("s_waitcnt vmcnt(0)" ::: "memory");
        } else {
            XB_SPIN(xb_ld(&bar[XB_XGEN(b.x)]) == gen, bar);
            __builtin_amdgcn_fence(__ATOMIC_ACQUIRE, "agent");
            asm volatile("s_waitcnt vmcnt(0)" ::: "memory");
        }
    }
    __syncthreads();
}

__device__ __forceinline__ void tr_item(const float* W, int ldw, int k0, int n0, bf16_t* WT, int ldt, int orow0, const float* kgain, const float* nscale, LAS float* scr, int lane) {
    f32x4 v[16];
#pragma unroll
    for (int i = 0; i < 16; ++i) { const int kk = 4 * i + (lane >> 4), nn = (lane & 15) * 4; v[i] = __builtin_nontemporal_load((const f32x4*)(W + (size_t)(k0 + kk) * ldw + n0 + nn)); }
#pragma unroll
    for (int i = 0; i < 16; ++i) { const int kk = 4 * i + (lane >> 4), nn = (lane & 15) * 4;
        if (kgain) v[i] = v[i] * kgain[k0 + kk];
        LAS float* s = scr + kk * 65 + nn; s[0] = v[i][0]; s[1] = v[i][1]; s[2] = v[i][2]; s[3] = v[i][3]; }
    LDS_WAIT();
    const int c = lane & 7;
#pragma unroll
    for (int j = 0; j < 8; ++j) { const int n = (lane >> 3) + 8 * j; const LAS float* s = scr + (8 * c) * 65 + n;
        const float sc = nscale ? nscale[n] : 1.0f;
        u32x4 o; o.x = cvt_pk_bf16(s[0 * 65] * sc, s[1 * 65] * sc); o.y = cvt_pk_bf16(s[2 * 65] * sc, s[3 * 65] * sc); o.z = cvt_pk_bf16(s[4 * 65] * sc, s[5 * 65] * sc); o.w = cvt_pk_bf16(s[6 * 65] * sc, s[7 * 65] * sc);
        *(u32x4*)(WT + (size_t)(orow0 + n) * ldt + k0 + 8 * c) = o; }
    LDS_WAIT();
}
__device__ __forceinline__ void norm_row_bf16(const float* xrow, const float* g, bf16_t* orow, int lane) {
    const f32x4* xr = (const f32x4*)xrow + lane; f32x4 v[8]; float s = 0.f;
#pragma unroll
    for (int j = 0; j < 8; ++j) { v[j] = xr[64 * j]; s += (v[j][0] * v[j][0] + v[j][1] * v[j][1]) + (v[j][2] * v[j][2] + v[j][3] * v[j][3]); }
    const float rstd = 1.0f / sqrtf(wave_sum(s) * (1.0f / D) + RMS_EPS);
    const f32x4* gr = (const f32x4*)g + lane; u32x2* o = (u32x2*)orow + lane;
#pragma unroll
    for (int j = 0; j < 8; ++j) { const f32x4 gg = gr[64 * j]; const f32x4 y = v[j] * rstd * gg; u32x2 w; w.x = cvt_pk_bf16(y[0], y[1]); w.y = cvt_pk_bf16(y[2], y[3]); o[64 * j] = w; }
}
__device__ __forceinline__ void norm_row2_bf16(const float* xa, const float* xb_, bool has2, const float* g, bf16_t* oa, bf16_t* ob, int lane) {
    const f32x4* ra = (const f32x4*)xa + lane; const f32x4* rb = (const f32x4*)(has2 ? xb_ : xa) + lane; f32x4 va[8], vb[8]; float sa = 0.f, sb = 0.f;
#pragma unroll
    for (int j = 0; j < 8; ++j) { va[j] = ra[64 * j]; vb[j] = rb[64 * j]; }
#pragma unroll
    for (int j = 0; j < 8; ++j) { sa += (va[j][0] * va[j][0] + va[j][1] * va[j][1]) + (va[j][2] * va[j][2] + va[j][3] * va[j][3]); sb += (vb[j][0] * vb[j][0] + vb[j][1] * vb[j][1]) + (vb[j][2] * vb[j][2] + vb[j][3] * vb[j][3]); }
    const float ka = 1.0f / sqrtf(wave_sum(sa) * (1.0f / D) + RMS_EPS), kb = 1.0f / sqrtf(wave_sum(sb) * (1.0f / D) + RMS_EPS);
    const f32x4* gr = (const f32x4*)g + lane; u32x2* pa = (u32x2*)oa + lane; u32x2* pb = (u32x2*)ob + lane;
#pragma unroll
    for (int j = 0; j < 8; ++j) { const f32x4 gg = gr[64 * j]; const f32x4 ya = va[j] * ka * gg, yb = vb[j] * kb * gg; u32x2 w; w.x = cvt_pk_bf16(ya[0], ya[1]); w.y = cvt_pk_bf16(ya[2], ya[3]); pa[64 * j] = w;
        if (has2) { u32x2 w2; w2.x = cvt_pk_bf16(yb[0], yb[1]); w2.y = cvt_pk_bf16(yb[2], yb[3]); pb[64 * j] = w2; } }
}
__device__ __forceinline__ void raw_row2_bf16(const float* xa, const float* xb_, bool has2, bf16_t* oa, bf16_t* ob, float* rsa, float* rsb, int lane) {
    const f32x4* ra = (const f32x4*)xa + lane; const f32x4* rb = (const f32x4*)(has2 ? xb_ : xa) + lane; f32x4 va[8], vb[8]; float sa = 0.f, sb = 0.f;
#pragma unroll
    for (int j = 0; j < 8; ++j) { va[j] = __builtin_nontemporal_load(ra + 64 * j); vb[j] = __builtin_nontemporal_load(rb + 64 * j); }
    u32x2* pa = (u32x2*)oa + lane; u32x2* pb = (u32x2*)ob + lane;
#pragma unroll
    for (int j = 0; j < 8; ++j) { sa += (va[j][0] * va[j][0] + va[j][1] * va[j][1]) + (va[j][2] * va[j][2] + va[j][3] * va[j][3]); sb += (vb[j][0] * vb[j][0] + vb[j][1] * vb[j][1]) + (vb[j][2] * vb[j][2] + vb[j][3] * vb[j][3]);
        u32x2 w; w.x = cvt_pk_bf16(va[j][0], va[j][1]); w.y = cvt_pk_bf16(va[j][2], va[j][3]); pa[64 * j] = w;
        if (has2) { u32x2 w2; w2.x = cvt_pk_bf16(vb[j][0], vb[j][1]); w2.y = cvt_pk_bf16(vb[j][2], vb[j][3]); pb[64 * j] = w2; } }
    const float ka = 1.0f / sqrtf(wave_sum(sa) * (1.0f / D) + RMS_EPS), kb = 1.0f / sqrtf(wave_sum(sb) * (1.0f / D) + RMS_EPS);
    if (lane == 0) { *rsa = ka; if (has2) *rsb = kb; }
}
__device__ __forceinline__ void norm_row_out(const bf16_t* xrow, float ss, const float* g, float* orow, int lane) {
    const float rstd = 1.0f / sqrtf(ss * (1.0f / D) + RMS_EPS);
#pragma unroll
    for (int j = 0; j < 4; ++j) { const int c = (lane + 64 * j) * 8; const u32x4 w = *(const u32x4*)(xrow + c);
        const f32x4 g0 = *(const f32x4*)(g + c), g1 = *(const f32x4*)(g + c + 4);
        const f32x4 y0 = (f32x4){bf_lo(w.x), bf_hi(w.x), bf_lo(w.y), bf_hi(w.y)} * rstd * g0, y1 = (f32x4){bf_lo(w.z), bf_hi(w.z), bf_lo(w.w), bf_hi(w.w)} * rstd * g1;
        *(f32x4*)(orow + c) = y0; *(f32x4*)(orow + c + 4) = y1; }
}

__device__ __forceinline__ void sgu_unit(LAS unsigned char* lds, int nb, int h0, const bf16_t* VT, const bf16_t* PAU, bf16_t* Y, const bf16_t* WSb, const float* sg, const float* bsp, int tid) {
    asm volatile("" : "+v"(tid));
    const int lane = tid & 63, wave = tid >> 6, fr = lane & 15, fq = lane >> 4;
    const int T0 = nb * 128;
    LAS float* red = (LAS float*)lds;
    LAS float* rstd = (LAS float*)(lds + 4096);
    LAS unsigned char* Bb = lds + 8192;
    {
        const int tg = tid & 15, rl = tid >> 4;
        float s[8];
#pragma unroll
        for (int e = 0; e < 8; ++e) s[e] = 0.f;
#pragma unroll 4
        for (int i = 0; i < 32; ++i) { const int c = rl + 32 * i; const u32x4 w = *(const u32x4*)(VT + (size_t)c * M + T0 + tg * 8);
#pragma unroll
            for (int e = 0; e < 4; ++e) { const float lo = bf_lo(w[e]), hi = bf_hi(w[e]); s[2 * e] += lo * lo; s[2 * e + 1] += hi * hi; } }
#pragma unroll
        for (int e = 0; e < 8; ++e) { s[e] += __shfl_xor(s[e], 16); s[e] += __shfl_xor(s[e], 32); }
        if (fq == 0) {
#pragma unroll
            for (int e = 0; e < 8; ++e) red[wave * 128 + tg * 8 + e] = s[e]; }
    }
    __syncthreads();
    if (tid < 128) { float t = 0.f;
#pragma unroll
        for (int w = 0; w < 8; ++w) t += red[w * 128 + tid];
        rstd[tid] = 1.0f / sqrtf(t * (1.0f / DSGU) + RMS_EPS); }
    __syncthreads();
    const int wr = wave >> 1, wc = wave & 1;
    for (int h = h0; h < h0 + 4; ++h) {
        LAS unsigned char* B = Bb + (h & 1) * 34816;
#pragma unroll
        for (int i = 0; i < 4; ++i) { const int p = tid + 512 * i, c = p >> 4, sgp = p & 15;
            const u32x4 w = *(const u32x4*)(VT + (size_t)(h * 128 + c) * M + T0 + sgp * 8);
            const float g = sg[h * 128 + c];
            const f32x4 r0 = *(const LAS f32x4*)(rstd + sgp * 8) * g, r1 = *(const LAS f32x4*)(rstd + sgp * 8 + 4) * g;
            u32x4 o; o.x = cvt_pk_bf16(bf_lo(w.x) * r0[0], bf_hi(w.x) * r0[1]); o.y = cvt_pk_bf16(bf_lo(w.y) * r0[2], bf_hi(w.y) * r0[3]);
            o.z = cvt_pk_bf16(bf_lo(w.z) * r1[0], bf_hi(w.z) * r1[1]); o.w = cvt_pk_bf16(bf_lo(w.w) * r1[2], bf_hi(w.w) * r1[3]);
            const int rho = (c & ~31) + ((c >> 2) & 1) * 16 + ((c >> 3) & 3) * 4 + (c & 3);
            *(LAS u32x4*)(B + rho * 272 + sgp * 16) = o; }
        __syncthreads();
        f32x4 acc[2][4];
#pragma unroll
        for (int m = 0; m < 2; ++m)
#pragma unroll
            for (int n = 0; n < 4; ++n) acc[m][n] = (f32x4){0.f, 0.f, 0.f, 0.f};
#pragma unroll
        for (int ks = 0; ks < 4; ++ks) { bf16x8 a[2], b[4];
#pragma unroll
            for (int m = 0; m < 2; ++m) a[m] = *(const bf16x8*)(WSb + (size_t)((h * 128 + wr * 32 + m * 16 + fr) * 128 + ks * 32 + fq * 8));
#pragma unroll
            for (int n = 0; n < 4; ++n) b[n] = *(const LAS bf16x8*)(B + (wc * 64 + n * 16 + fr) * 272 + (ks * 32 + fq * 8) * 2);
#pragma unroll
            for (int m = 0; m < 2; ++m)
#pragma unroll
                for (int n = 0; n < 4; ++n) acc[m][n] = MFMA16(b[n], a[m], acc[m][n]); }
#pragma unroll
        for (int m = 0; m < 2; ++m) { const int t = wr * 32 + m * 16 + fr; const float bias = bsp[h * 128 + t];
#pragma unroll
            for (int gq = 0; gq < 2; ++gq) { const size_t off = (size_t)(T0 + t) * D + DPOOL + h * 128 + wc * 64 + gq * 32 + fq * 8;
                const u32x4 uu = *(const u32x4*)(PAU + off); const f32x4 m0 = acc[m][2 * gq] + bias, m1 = acc[m][2 * gq + 1] + bias;
                u32x4 o; o.x = cvt_pk_bf16(bf_lo(uu.x) * m0[0], bf_hi(uu.x) * m0[1]); o.y = cvt_pk_bf16(bf_lo(uu.y) * m0[2], bf_hi(uu.y) * m0[3]);
                o.z = cvt_pk_bf16(bf_lo(uu.z) * m1[0], bf_hi(uu.z) * m1[1]); o.w = cvt_pk_bf16(bf_lo(uu.w) * m1[2], bf_hi(uu.w) * m1[3]);
                *(u32x4*)(Y + off) = o; } }
    }
    __syncthreads();
}
template <int W> __device__ __forceinline__ void pool_p(const bf16_t* base, bf16_t* ybase, int ts, int tp0) {
    u32x4 arr[W + 7];
#pragma unroll
    for (int j = 0; j < W + 7; ++j) { const int t = ts - (W - 1) + j, tc = t < -tp0 ? -tp0 : t; arr[j] = *(const u32x4*)(base + (ptrdiff_t)tc * D); }
#pragma unroll
    for (int j = 0; j < W - 1; ++j) { const int t = ts - (W - 1) + j; if (tp0 + t < 0) arr[j] = (u32x4){0u, 0u, 0u, 0u}; }
    float S[8];
#pragma unroll
    for (int e = 0; e < 8; ++e) S[e] = 0.f;
#pragma unroll
    for (int j = 0; j < W - 1; ++j)
#pragma unroll
        for (int e = 0; e < 4; ++e) { S[2 * e] += bf_lo(arr[j][e]); S[2 * e + 1] += bf_hi(arr[j][e]); }
#pragma unroll
    for (int i = 0; i < 8; ++i) { const int t = ts + i, tp = tp0 + t; float cur[8], p[8];
#pragma unroll
        for (int e = 0; e < 4; ++e) { cur[2 * e] = bf_lo(arr[W - 1 + i][e]); cur[2 * e + 1] = bf_hi(arr[W - 1 + i][e]); }
        const float inv = 1.0f / (float)(tp + 1 < W ? tp + 1 : W);
#pragma unroll
        for (int e = 0; e < 8; ++e) { S[e] += cur[e]; p[e] = S[e] * inv - cur[e]; }
        u32x4 o; o.x = cvt_pk_bf16(p[0], p[1]); o.y = cvt_pk_bf16(p[2], p[3]); o.z = cvt_pk_bf16(p[4], p[5]); o.w = cvt_pk_bf16(p[6], p[7]);
        *(u32x4*)(ybase + (size_t)t * D) = o;
#pragma unroll
        for (int e = 0; e < 4; ++e) { S[2 * e] -= bf_lo(arr[i][e]); S[2 * e + 1] -= bf_hi(arr[i][e]); } }
}
__device__ __forceinline__ void pool_half(int nb, int gh, const bf16_t* PAU, bf16_t* Y, int tid) {
    asm volatile("" : "+v"(tid));
    const int T0 = nb * 128, tp0 = T0 & (SEQ - 1), cgp = tid & 31, ts = (tid >> 5) * 8;
    const bf16_t* src = PAU + (size_t)T0 * D + cgp * 8; bf16_t* dst = Y + (size_t)T0 * D + cgp * 8;
    if (gh == 0) { pool_p<2>(src, dst, ts, tp0); pool_p<16>(src + 768, dst + 768, ts, tp0); }
    else { pool_p<4>(src + 256, dst + 256, ts, tp0); pool_p<8>(src + 512, dst + 512, ts, tp0); }
}
__device__ __forceinline__ void attn_unit(LAS unsigned char* lds, int unit, const bf16_t* Q, const bf16_t* KB, const bf16_t* VTM, bf16_t* O, int tid) {
    asm volatile("" : "+v"(tid));
    const int lane = tid & 63, wave = tid >> 6, fr = lane & 15, fq = lane >> 4, wr = wave >> 1, wc = wave & 1;
    const int qt = unit & 31, h = (unit >> 5) & 3, b = unit >> 7;
    const int R0 = b * SEQ + qt * 128;
    LAS unsigned char* P = lds;
    LAS float* xm = (LAS float*)(lds + 67584);
    LAS float* xs = xm + 256;
    f32x4 acc[2][8];
#pragma unroll
    for (int m = 0; m < 2; ++m)
#pragma unroll
        for (int n = 0; n < 8; ++n) acc[m][n] = (f32x4){0.f, 0.f, 0.f, 0.f};
    const bf16_t* qp = Q + (size_t)(R0 + wr * 32 + fr) * D + h * 512 + fq * 8;
    const bf16_t* kp = KB + (size_t)(b * NMEM + wc * 128 + fr) * D + h * 512 + fq * 8;
#pragma unroll 2
    for (int ks = 0; ks < 16; ++ks) { bf16x8 a[2], bb[8];
#pragma unroll
        for (int m = 0; m < 2; ++m) a[m] = *(const bf16x8*)(qp + (size_t)m * 16 * D + ks * 32);
#pragma unroll
        for (int n = 0; n < 8; ++n) bb[n] = *(const bf16x8*)(kp + (size_t)n * 16 * D + ks * 32);
#pragma unroll
        for (int m = 0; m < 2; ++m)
#pragma unroll
            for (int n = 0; n < 8; ++n) acc[m][n] = MFMA16(bb[n], a[m], acc[m][n]); }
    const float sc = 0.044194173824159216f;
#pragma unroll
    for (int m = 0; m < 2; ++m) { float v = -3.0e38f;
#pragma unroll
        for (int n = 0; n < 8; ++n) { acc[m][n] = acc[m][n] * sc; v = fmaxf(v, fmaxf(fmaxf(acc[m][n][0], acc[m][n][1]), fmaxf(acc[m][n][2], acc[m][n][3]))); }
        v = fmaxf(v, __shfl_xor(v, 16)); v = fmaxf(v, __shfl_xor(v, 32));
        if (fq == 0) xm[wc * 128 + wr * 32 + m * 16 + fr] = v; }
    __syncthreads();
#pragma unroll
    for (int m = 0; m < 2; ++m) { const int row = wr * 32 + m * 16 + fr; const float mx = fmaxf(xm[row], xm[128 + row]); float s = 0.f;
#pragma unroll
        for (int n = 0; n < 8; ++n) { const float p0 = __expf(acc[m][n][0] - mx), p1 = __expf(acc[m][n][1] - mx), p2 = __expf(acc[m][n][2] - mx), p3 = __expf(acc[m][n][3] - mx);
            s += (p0 + p1) + (p2 + p3);
            u32x2 o; o.x = cvt_pk_bf16(p0, p1); o.y = cvt_pk_bf16(p2, p3);
            *(LAS u32x2*)(P + row * 528 + (wc * 128 + n * 16 + fq * 4) * 2) = o; }
        s += __shfl_xor(s, 16); s += __shfl_xor(s, 32);
        if (fq == 0) xs[wc * 128 + row] = s; }
    __syncthreads();
    float inv[2];
#pragma unroll
    for (int m = 0; m < 2; ++m) { const int row = wr * 32 + m * 16 + fr; inv[m] = 1.0f / (xs[row] + xs[128 + row]); }
    f32x4 o[2][16];
#pragma unroll
    for (int m = 0; m < 2; ++m)
#pragma unroll
        for (int n = 0; n < 16; ++n) o[m][n] = (f32x4){0.f, 0.f, 0.f, 0.f};
    const bf16_t* vp = VTM + (size_t)(h * 512 + wc * 256 + fr) * MM + b * NMEM + fq * 8;
    for (int ks = 0; ks < 8; ++ks) { bf16x8 a[2];
#pragma unroll
        for (int m = 0; m < 2; ++m) a[m] = *(const LAS bf16x8*)(P + (wr * 32 + m * 16 + fr) * 528 + (ks * 32 + fq * 8) * 2);
#pragma unroll
        for (int n = 0; n < 16; ++n) { const bf16x8 bv = *(const bf16x8*)(vp + (size_t)n * 16 * MM + ks * 32);
#pragma unroll
            for (int m = 0; m < 2; ++m) o[m][n] = MFMA16(bv, a[m], o[m][n]); } }
#pragma unroll
    for (int m = 0; m < 2; ++m) { const size_t rowoff = (size_t)(R0 + wr * 32 + m * 16 + fr) * D + h * 512 + wc * 256 + fq * 4;
#pragma unroll
        for (int n = 0; n < 16; ++n) { const f32x4 v = o[m][n] * inv[m]; u32x2 w; w.x = cvt_pk_bf16(v[0], v[1]); w.y = cvt_pk_bf16(v[2], v[3]); *(u32x2*)(O + rowoff + n * 16) = w; } }
    __syncthreads();
}

#ifndef REP_P0
#define REP_P0 1
#endif
#ifndef REP_P0N
#define REP_P0N 1
#endif
#ifndef REP_P1
#define REP_P1 1
#endif
#ifndef REP_P3
#define REP_P3 1
#endif
#ifndef REP_P7
#define REP_P7 1
#endif
#ifndef TS_K
#define TS_K -1
#endif
#ifndef ABSORB
#define ABSORB 1
#endif
#ifndef OLD_ATTN
#define OLD_ATTN 0
#endif
#ifndef REP_P2
#define REP_P2 1
#endif
#ifndef REP_P5
#define REP_P5 1
#endif
#ifndef REP_SYNC
#define REP_SYNC 1
#endif
#ifndef REP_P4
#define REP_P4 1
#endif
struct Args { const float* in[21]; float* out; unsigned char* ws; };
#define GEMM_PHASE(EPI, g, S, E) pg8::gemm_phase<EPI, pg8::StaticOrder, true, true>(lds, g, S, E)
__global__ void __launch_bounds__(NTHR, 2) mk_fwd(Args a) {
    extern __shared__ __attribute__((aligned(16))) unsigned char lds_raw[];
    LAS unsigned char* lds = (LAS unsigned char*)lds_raw;
    cg::grid_group grid = cg::this_grid();
    const int G = gridDim.x, bx = blockIdx.x;
    volatile LAS unsigned* bar_st = (volatile LAS unsigned*)(lds + LDS_BYTES - 64);
    if (threadIdx.x < 2) bar_st[threadIdx.x] = 0u;
    __syncthreads();
    const XcdBarrier xbar = xcd_barrier_post((unsigned*)(a.ws + WS_BAR), bar_st);
    volatile LAS unsigned* ts_lds = (volatile LAS unsigned*)(lds + LDS_BYTES - 32);
    if (TS_K >= 0 && bx == 0 && threadIdx.x == 0) ts_lds[0] = (unsigned)__builtin_amdgcn_s_memrealtime();
#define STAMP(k) do { if (TS_K == (k) && bx == 0 && threadIdx.x == 0) ts_lds[1] = (unsigned)__builtin_amdgcn_s_memrealtime(); } while (0)
#define TID_FRESH() ({ int t_ = threadIdx.x; asm volatile("" : "+v"(t_)); t_; })
    const float *x = a.in[0], *mem = a.in[1], *norm_mix_g = a.in[2], *w_in = a.in[3], *pool_w = a.in[4], *pool_scale = a.in[5], *sgu_norm_g = a.in[6], *w_spatial = a.in[7], *b_spatial = a.in[8],
                *w_out = a.in[9], *norm_xattn_g = a.in[10], *norm_mem_g = a.in[11], *w_q = a.in[12], *w_k = a.in[13], *w_v = a.in[14], *w_o = a.in[15], *norm_ffn_g = a.in[16],
                *w_gate = a.in[17], *w_up = a.in[18], *w_down = a.in[19], *final_norm_g = a.in[20];
    float* out = a.out; unsigned char* ws = a.ws;
    float *SS1 = (float*)(ws + WS_SS1), *SS2 = (float*)(ws + WS_SS2), *SS3 = (float*)(ws + WS_SS3);
    bf16_t *Win_t = (bf16_t*)(ws + WS_WIN), *Wout_t = (bf16_t*)(ws + WS_WOUT), *Wq_t = (bf16_t*)(ws + WS_WQ), *Wk_t = (bf16_t*)(ws + WS_WK), *Wv_t = (bf16_t*)(ws + WS_WV), *Wo_t = (bf16_t*)(ws + WS_WO),
           *Wgu_t = (bf16_t*)(ws + WS_WGU), *Wd_t = (bf16_t*)(ws + WS_WD), *PWt = (bf16_t*)(ws + WS_PW), *WSb = (bf16_t*)(ws + WS_WSP), *MN = (bf16_t*)(ws + WS_MN), *KB = (bf16_t*)(ws + WS_KB),
           *VTM = (bf16_t*)(ws + WS_VTM), *XB = (bf16_t*)(ws + WS_XB), *HG = (bf16_t*)(ws + WS_HG), *PAU = (bf16_t*)(ws + WS_PAU), *Qb = (bf16_t*)(ws + WS_Q), *VT = (bf16_t*)(ws + WS_VT),
           *Yb = (bf16_t*)(ws + WS_Y), *Ob = (bf16_t*)(ws + WS_O);

    {
        const int tid = TID_FRESH(), lane = tid & 63, wave = __builtin_amdgcn_readfirstlane(tid >> 6);
        LAS float* scr = (LAS float*)(lds + wave * 16640);
        const int gw = bx * NWAVES + wave, NGW = G * NWAVES;
        constexpr int I_IN = 32 * 48, I_SQ = 32 * 32, I_PW = 4 * 16;
        constexpr int NITEMS = I_IN + 4 * I_SQ + I_PW;
        { float* RS0 = (float*)(ws + WS_RS0); for (int m = gw; m < M; m += 2 * NGW) raw_row2_bf16(x + (size_t)m * D, x + (size_t)(m + NGW) * D, m + NGW < M, XB + (size_t)m * D, XB + (size_t)(m + NGW) * D, RS0 + m, RS0 + m + NGW, lane); }
        for (int m = gw; m < MM; m += NGW) norm_row_bf16(mem + (size_t)m * D, norm_mem_g, MN + (size_t)m * D, lane);
        for (int it = gw; it < NITEMS * REP_P0; it += NGW) {
            int r = it % NITEMS;
            if (r < I_IN) { tr_item(w_in, 3072, (r / 48) * 64, (r % 48) * 64, Win_t, D, (r % 48) * 64, norm_mix_g, nullptr, scr, lane); continue; } r -= I_IN;
            if (r < I_SQ) { tr_item(w_k, D, (r / 32) * 64, (r % 32) * 64, Wk_t, D, (r % 32) * 64, nullptr, nullptr, scr, lane); continue; } r -= I_SQ;
            if (r < I_SQ) { tr_item(w_v, D, (r / 32) * 64, (r % 32) * 64, Wv_t, D, (r % 32) * 64, nullptr, nullptr, scr, lane); continue; } r -= I_SQ;
            if (r < I_SQ) { tr_item(w_out, D, (r / 32) * 64, (r % 32) * 64, Wout_t, D, (r % 32) * 64, nullptr, nullptr, scr, lane); continue; } r -= I_SQ;
#if ABSORB
            if (r < I_SQ) continue; r -= I_SQ;
#else
            if (r < I_SQ) { tr_item(w_q, D, (r / 32) * 64, (r % 32) * 64, Wq_t, D, (r % 32) * 64, norm_xattn_g, nullptr, scr, lane); continue; } r -= I_SQ;
#endif
            {
              bf16_t* PWn = (bf16_t*)(ws + WS_PWN);
#pragma unroll 4
              for (int j = 0; j < 16; ++j) { const int gc = r * 16 + j, g = gc >> 8; const f32x4 v = *(const f32x4*)(pool_w + (size_t)gc * 256 + lane * 4) * *(const f32x4*)(pool_scale + g * 256 + lane * 4);
                  u32x2 o; o.x = cvt_pk_bf16(v[0], v[1]); o.y = cvt_pk_bf16(v[2], v[3]); *(u32x2*)(PWn + (size_t)gc * 2048 + lane * 4) = o; *(u32x2*)(PWn + (size_t)gc * 2048 + 256 + lane * 4) = (u32x2){0u, 0u}; } }
        }
        for (int i = bx * NTHR + tid; i < 8 * 128 * 128 / 4; i += G * NTHR) { const f32x4 v = *((const f32x4*)w_spatial + i); const int s = (i * 4) & 127, t = ((i * 4) >> 7) & 127;
            const bool keep = (s >> 6) <= (t >> 6); u32x2 o; o.x = keep ? cvt_pk_bf16(v[0], v[1]) : 0u; o.y = keep ? cvt_pk_bf16(v[2], v[3]) : 0u; *((u32x2*)WSb + i) = o; }
    }
    if (a.ws == nullptr) grid.sync();
    xcd_barrier(xbar);
    STAMP(0);
    for (int rep = 0; rep < REP_P1; ++rep) {
        { pg8::Gemm g{XB, Win_t, M, 2048, D, D}; pg8::StaticOrder S; S.init(M, 2048, G, bx); pg8::EpiRowScaleC E{PAU, D, (const float*)(ws + WS_RS0)}; GEMM_PHASE(pg8::EpiRowScaleC, g, S, E); }
        { pg8::Gemm g{Win_t + (size_t)2048 * D, XB, 1024, M, D, D}; pg8::StaticOrder S; S.init(1024, M, G, bx); pg8::EpiColScale E{VT, M, (const float*)(ws + WS_RS0)}; GEMM_PHASE(pg8::EpiColScale, g, S, E); }
        { pg8::Gemm g{MN, Wk_t, MM, D, D, D}; pg8::StaticOrder S; S.init(MM, D, G, bx); pg8::EpiPlain E{KB, D}; GEMM_PHASE(pg8::EpiPlain, g, S, E); }
#if ABSORB
        { pg8::Gemm g{MN, Wv_t, MM, D, D, D}; pg8::StaticOrder S; S.init(MM, D, G, (bx + G - 32) % G); pg8::EpiPlain E{VTM, D}; GEMM_PHASE(pg8::EpiPlain, g, S, E); }
#else
        { pg8::Gemm g{Wv_t, MN, D, MM, D, D}; pg8::StaticOrder S; S.init(D, MM, G, (bx + G - 32) % G); pg8::EpiPlain E{VTM, MM}; GEMM_PHASE(pg8::EpiPlain, g, S, E); }
#endif
        { pg8::Gemm g{KB, Wq_t, 4096, D, 512, D}; pg8::PreQKOrder S{G, bx + 128, 160, Wout_t, (const bf16_t*)(ws + WS_PWN)}; pg8::EpiPre E{(bf16_t*)(ws + WS_WQK), Wout_t};
          pg8::gemm_phase<pg8::EpiPre, pg8::PreQKOrder, true, true>(lds, g, S, E); }
        {
            const int f0q = G > 64 ? 64 : 0; const int cq = bx - f0q, ncu = G - f0q;
            if (cq >= 0) { const int tid = TID_FRESH(), lane = tid & 63, wave = __builtin_amdgcn_readfirstlane(tid >> 6);
                for (int it = cq * NWAVES + wave; it < 1024; it += ncu * NWAVES) { const int k = it * 2 + (lane >> 5);
                    const float gk = norm_xattn_g[k]; const f32x4* src = (const f32x4*)(w_q + (size_t)k * D); u32x2* dst = (u32x2*)(Wq_t + (size_t)k * D);
#pragma unroll 4
                    for (int j = 0; j < 16; ++j) { const int q = (lane & 31) + 32 * j; const f32x4 v = src[q] * gk; u32x2 o; o.x = cvt_pk_bf16(v[0], v[1]); o.y = cvt_pk_bf16(v[2], v[3]); dst[q] = o; } } } }
        const int f0 = G > 64 ? 64 : 0;
        if (bx >= f0) {
            const int tid = TID_FRESH(), lane = tid & 63, wave = __builtin_amdgcn_readfirstlane(tid >> 6);
            LAS float* scr = (LAS float*)(lds + wave * 16640);
            constexpr int I_SQ = 32 * 32, I_GU = 32 * 88, I_DN = 88 * 32, NIT = I_SQ + 2 * I_GU + I_DN;
            for (int it = (bx - f0) * NWAVES + wave; it < NIT; it += (G - f0) * NWAVES) {
                int r = it;
                if (r < I_SQ) { tr_item(w_o, D, (r / 32) * 64, (r % 32) * 64, Wo_t, D, (r % 32) * 64, nullptr, nullptr, scr, lane); continue; } r -= I_SQ;
                if (r < 2 * I_GU) { const int up = r >= I_GU; if (up) r -= I_GU; const int n0 = (r % 88) * 64;
                    tr_item(up ? w_up : w_gate, DFF, (r / 88) * 64, n0, Wgu_t, D, (n0 >> 7) * 256 + (n0 & 127) + up * 128, norm_ffn_g, nullptr, scr, lane); continue; } r -= 2 * I_GU;
                tr_item(w_down, D, (r / 32) * 64, (r % 32) * 64, Wd_t, DFF, (r % 32) * 64, nullptr, nullptr, scr, lane);
            }
        }
    }
    xcd_barrier(xbar);
    STAMP(101);
    for (int uu = bx; uu < 256 * REP_P2; uu += G) { const int u = uu & 255; sgu_unit(lds, u >> 1, (u & 1) * 4, VT, PAU, Yb, WSb, sgu_norm_g, b_spatial, (int)threadIdx.x); pool_half(u >> 1, u & 1, PAU, Yb, (int)threadIdx.x); }
#if ABSORB
    { pg8::Gemm g{KB, Wq_t, 4096, D, 512, D}; pg8::PreQKOrder S{G, bx, 128, Wout_t, (const bf16_t*)(ws + WS_PWN)}; pg8::EpiPre E{(bf16_t*)(ws + WS_WQK), Wout_t}; pg8::gemm_phase<pg8::EpiPre, pg8::PreQKOrder, true, true>(lds, g, S, E); }
    { pg8::Gemm g{Wo_t, VTM, 8192, 1024, 512, D}; pg8::PreVOOrder S{G, (bx + G - 128 % G) % G}; pg8::EpiPlain E{(bf16_t*)(ws + WS_VWO), 1024}; pg8::gemm_phase<pg8::EpiPlain, pg8::PreVOOrder, true, true>(lds, g, S, E); }
#endif
    xcd_barrier(xbar);
    STAMP(102);
    for (int rep = 0; rep < REP_P3; ++rep) { pg8::Gemm g{Yb, Wout_t, M, D, D, D}; pg8::StaticOrder S; S.init(M, D, G, bx); pg8::EpiResid<false> E{nullptr, XB, XB, SS1, D, (LAS float*)(lds + 131072)}; GEMM_PHASE(pg8::EpiResid<false>, g, S, E); }
    xcd_barrier(xbar);
    STAMP(103);
#if ABSORB
    { pg8::Gemm g{XB, (const bf16_t*)(ws + WS_WQK), M, 1024, D, D}; pg8::ScoreOrder S{G, bx}; pg8::EpiSoftmaxN E{(bf16_t*)(ws + WS_PM), SS1, 1.0f / D, (LAS float*)(lds + 131072), 0.044194173824159216f * 1.4426950408889634f};
      pg8::gemm_phase<pg8::EpiSoftmaxN, pg8::ScoreOrder, true, true>(lds, g, S, E); }
    xcd_barrier(xbar);
    STAMP(104);
    { pg8::Gemm g{(const bf16_t*)(ws + WS_PM), (const bf16_t*)(ws + WS_VWO), M, D, 1024, 1024}; pg8::AttnOutOrder S{G, bx}; pg8::EpiResid<false> E{nullptr, XB, XB, SS2, D, (LAS float*)(lds + 131072)};
      pg8::gemm_phase<pg8::EpiResid<false>, pg8::AttnOutOrder, true, true>(lds, g, S, E); }
    xcd_barrier(xbar);
    STAMP(108);
#else
    for (int rep = 0; rep < REP_P4; ++rep) { pg8::Gemm g{XB, Wq_t, M, D, D, D}; pg8::StaticOrder S; S.init(M, D, G, bx); pg8::EpiRowScale E{Qb, D, SS1, 1.0f / D}; GEMM_PHASE(pg8::EpiRowScale, g, S, E); }
    xcd_barrier(xbar);
    STAMP(104);
#if OLD_ATTN
    for (int u = bx; u < 512 * REP_P5; u += G) attn_unit(lds, u & 511, Qb, KB, VTM, Ob, (int)threadIdx.x);
    xcd_barrier(xbar);
    STAMP(105);
#else
    for (int rep = 0; rep < REP_P5; ++rep) {
    { pg8::Gemm g{Qb, KB, M, 1024, 512, D}; pg8::AttnSOrder S{G, bx}; pg8::EpiSoftmax E{(bf16_t*)(ws + WS_PM), (float*)(ws + WS_RSP), (LAS float*)(lds + 131072), 0.044194173824159216f * 1.4426950408889634f};
      pg8::gemm_phase<pg8::EpiSoftmax, pg8::AttnSOrder, true, true>(lds, g, S, E); }
    xcd_barrier(xbar);
    STAMP(106);
    { pg8::Gemm g{(const bf16_t*)(ws + WS_PM), VTM, M, 2048, 256, 1024}; pg8::AttnPVOrder S{G, bx}; pg8::EpiAttnOut E{Ob, (const float*)(ws + WS_RSP)};
      pg8::gemm_phase<pg8::EpiAttnOut, pg8::AttnPVOrder, true, true>(lds, g, S, E); }
    xcd_barrier(xbar);
    STAMP(107);
    }
#endif
    { pg8::Gemm g{Ob, Wo_t, M, D, D, D}; pg8::StaticOrder S; S.init(M, D, G, bx); pg8::EpiResid<false> E{nullptr, XB, XB, SS2, D, (LAS float*)(lds + 131072)}; GEMM_PHASE(pg8::EpiResid<false>, g, S, E); }
    xcd_barrier(xbar);
    STAMP(108);
#endif
    for (int rep = 0; rep < REP_P7; ++rep) { pg8::Gemm g{XB, Wgu_t, M, 2 * DFF, D, D}; pg8::StaticOrder S; S.init(M, 2 * DFF, G, bx); pg8::EpiSwiglu E{HG, DFF, SS2, 1.0f / D}; GEMM_PHASE(pg8::EpiSwiglu, g, S, E); }
    xcd_barrier(xbar);
    STAMP(109);
#ifndef FUSE_FINAL
#define FUSE_FINAL 1
#endif
    if (FUSE_FINAL && G == 256) {
        pg8::Gemm g{HG, Wd_t, M, D, DFF, DFF}; pg8::DownOrder S{bx}; pg8::EpiFinal E{XB, out, SS3, (unsigned*)(ws + WS_PCNT), final_norm_g, (LAS float*)(lds + 131072), D};
        pg8::gemm_phase<pg8::EpiFinal, pg8::DownOrder, true, true>(lds, g, S, E);
    } else {
    { pg8::Gemm g{HG, Wd_t, M, D, DFF, DFF}; pg8::StaticOrder S; S.init(M, D, G, bx); pg8::EpiResid<false> E{nullptr, XB, XB, SS3, D, (LAS float*)(lds + 131072)}; GEMM_PHASE(pg8::EpiResid<false>, g, S, E); }
    xcd_barrier(xbar);
    STAMP(110);
    { const int tid = TID_FRESH(), lane = tid & 63, wave = __builtin_amdgcn_readfirstlane(tid >> 6); const int gw = bx * NWAVES + wave, NGW = G * NWAVES;
      for (int m0 = gw; m0 < M; m0 += 4 * NGW) {
          u32x4 w[4][4]; f32x4 pa[4], pb[4];
#pragma unroll
          for (int q = 0; q < 4; ++q) { const int m = m0 + q * NGW; if (m < M) { pa[q] = *(const f32x4*)(SS3 + (size_t)m * 8); pb[q] = *(const f32x4*)(SS3 + (size_t)m * 8 + 4);
#pragma unroll
              for (int j = 0; j < 4; ++j) w[q][j] = *(const u32x4*)(XB + (size_t)m * D + (lane + 64 * j) * 8); } }
#pragma unroll
          for (int q = 0; q < 4; ++q) { const int m = m0 + q * NGW; if (m < M) {
              const float rstd = 1.0f / sqrtf((((pa[q][0] + pa[q][1]) + (pa[q][2] + pa[q][3])) + ((pb[q][0] + pb[q][1]) + (pb[q][2] + pb[q][3]))) * (1.0f / D) + RMS_EPS);
#pragma unroll
              for (int j = 0; j < 4; ++j) { const int c = (lane + 64 * j) * 8; const f32x4 g0 = *(const f32x4*)(final_norm_g + c), g1 = *(const f32x4*)(final_norm_g + c + 4); const u32x4 ww = w[q][j];
                  const f32x4 y0 = (f32x4){bf_lo(ww.x), bf_hi(ww.x), bf_lo(ww.y), bf_hi(ww.y)} * rstd * g0, y1 = (f32x4){bf_lo(ww.z), bf_hi(ww.z), bf_lo(ww.w), bf_hi(ww.w)} * rstd * g1;
                  *(f32x4*)(out + (size_t)m * D + c) = y0; *(f32x4*)(out + (size_t)m * D + c + 4) = y1; } } } } }
    }
    if (TS_K >= 0 && bx == 0 && threadIdx.x == 0) { const unsigned dt = ts_lds[1] - ts_lds[0]; const unsigned t0 = (unsigned)__builtin_amdgcn_s_memrealtime(); while ((unsigned)__builtin_amdgcn_s_memrealtime() - t0 < dt) __builtin_amdgcn_s_sleep(8); }
}

extern "C" void kernel_launch(void* const* d_in, const int* in_sizes, int n_in, void* d_out, int out_size, void* d_ws, size_t ws_size, hipStream_t stream) {
    static int grid = 0;
    if (grid == 0) {
        if (n_in != 21 || in_sizes[0] != M * D || out_size != M * D || ws_size < WS_END) { fprintf(stderr, "kernel_launch: unexpected shapes (n_in %d, in0 %d, out %d, ws %zu); nothing launched\n", n_in, n_in > 0 ? in_sizes[0] : -1, out_size, ws_size); grid = -1; return; }
        int dev = 0, cus = 0, per_cu = 0;
        if (hipGetDevice(&dev) != hipSuccess || hipDeviceGetAttribute(&cus, hipDeviceAttributeMultiprocessorCount, dev) != hipSuccess) { grid = -1; return; }
        if (hipFuncSetAttribute((const void*)mk_fwd, hipFuncAttributeMaxDynamicSharedMemorySize, LDS_BYTES) != hipSuccess) { fprintf(stderr, "kernel_launch: hipFuncSetAttribute failed\n"); grid = -1; return; }
        if (hipOccupancyMaxActiveBlocksPerMultiprocessor(&per_cu, (const void*)mk_fwd, NTHR, LDS_BYTES) != hipSuccess || per_cu < 1) { fprintf(stderr, "kernel_launch: occupancy query says %d blocks per CU\n", per_cu); (void)hipGetLastError(); grid = -1; return; }
        grid = cus * per_cu;
    }
    if (grid < 0) return;
    if (hipMemsetAsync(d_ws, 0, WS_ZERO_BYTES, stream) != hipSuccess) { fprintf(stderr, "kernel_launch: hipMemsetAsync failed\n"); return; }
    Args a{};
    for (int i = 0; i < 21; ++i) a.in[i] = (const float*)d_in[i];
    a.out = (float*)d_out; a.ws = (unsigned char*)d_ws;
    void* args[] = {&a};
    const hipError_t e = hipLaunchCooperativeKernel((const void*)mk_fwd, dim3(grid), dim3(NTHR), args, LDS_BYTES, stream);
    if (e != hipSuccess) fprintf(stderr, "kernel_launch: cooperative launch failed: %s (grid %d)\n", hipGetErrorString(e), grid);
}
```

```cpp
#include <hip/hip_runtime.h>
#include <hip/hip_cooperative_groups.h>
#include <cstdio>
#include <cstdint>
namespace cg = cooperative_groups;
namespace pg8 {
#define PG8_LAS __attribute__((address_space(3)))
typedef unsigned short bf16_t;
typedef short bf16x8 __attribute__((ext_vector_type(8)));
typedef float f32x4 __attribute__((ext_vector_type(4)));
typedef unsigned u32x4 __attribute__((ext_vector_type(4)));
constexpr int BM = 256, BK = 64, HALF = 128, HTB = HALF * BK * 2  , STAGE_BYTES = 8 * HTB, NXCD = 8, WGM = 8;

__host__ __device__ __forceinline__ int lds_byte(int r, int c) { const int st = (r >> 4) * 2 + (c >> 5), rr = r & 15, cc = c & 31, ob = rr * 64 + cc * 2; return st * 1024 + (ob ^ (((ob >> 9) & 1) << 5)); }
__host__ __device__ __forceinline__ void stage_rc(int b, int& R, int& C) { const int st = b / 1024, sb = b % 1024, swz = sb ^ (((sb >> 9) & 1) << 5); R = (st >> 1) * 16 + swz / 64; C = (st & 1) * 32 + (swz % 64) / 2; }
__host__ __device__ __forceinline__ int perm32(int rho) { const int n = rho >> 4, i = rho & 15; return 8 * (i >> 2) + 4 * n + (i & 3); }

__device__ __forceinline__ const bf16_t* sel_ptr(bool c, const bf16_t* a, const bf16_t* b) { const unsigned long long m = 0ull - (unsigned long long)c; return (const bf16_t*)((((unsigned long long)a) & m) | (((unsigned long long)b) & ~m)); }
struct Unit { int pm, pn; const char* a = nullptr; const char* b = nullptr; };
struct Gemm { const bf16_t* A; const bf16_t* Bt; int M, N, K, ld; };

struct StaticOrder {
    int nM, nN, nwg, G, c;
    __host__ __device__ void init(int M, int N, int G_, int c_) { nM = M / BM; nN = N / BM; nwg = nM * nN; G = G_; c = c_; }
    __host__ __device__ bool next(int i, Unit& u) const {
        const long L = (long)i * G + c; if (L >= nwg) return false;
        int wgid = (int)L; { const int q = nwg / NXCD, r = nwg % NXCD, xcd = wgid % NXCD, off = wgid / NXCD; wgid = (xcd < r ? xcd * (q + 1) : r * (q + 1) + (xcd - r) * q) + off; }
        const int nig = WGM * nN, gid = wgid / nig, fm = gid * WGM, gsz = (nM - fm) < WGM ? (nM - fm) : WGM;
        u.pm = fm + ((wgid % nig) % gsz); u.pn = (wgid % nig) / gsz; return true;
    }
    __device__ __forceinline__ void a_ready(const Unit&) const {}
    __device__ __forceinline__ void done(const Unit&) const {}
    __device__ __forceinline__ const char* pA(const Gemm& g, const Unit& u) const { return (const char*)g.A + (size_t)u.pm * BM * g.ld * 2; }
    __device__ __forceinline__ const char* pB(const Gemm& g, const Unit& u) const { return (const char*)g.Bt + (size_t)u.pn * BM * g.ld * 2; }
};
struct DownOrder {
    int c;
    __device__ bool next(int i, Unit& u) const { if (i > 1) return false; const int xcd = c & 7, j = c >> 3; u.pm = i * 32 + xcd * 4 + (j >> 3); u.pn = j & 7; return true; }
    __device__ __forceinline__ void a_ready(const Unit&) const {}
    __device__ __forceinline__ void done(const Unit&) const {}
    __device__ __forceinline__ const char* pA(const Gemm& g, const Unit& u) const { return (const char*)g.A + (size_t)u.pm * BM * g.ld * 2; }
    __device__ __forceinline__ const char* pB(const Gemm& g, const Unit& u) const { return (const char*)g.Bt + (size_t)u.pn * BM * g.ld * 2; }
};
struct PreQKOrder {
    int G, c0, cmax; const bf16_t* Wout_t; const bf16_t* PWn;
    __device__ __forceinline__ bool next(int i, Unit& u) const { const int c = i * G + c0; if (c >= cmax) return false;
        if (c < 128) { u.pm = (c >> 5) * 4 + ((c >> 3) & 3); u.pn = c & 7; } else { const int q = c - 128; u.pm = 0x1000 | (q >> 2); u.pn = q & 3; } return true; }
    __device__ __forceinline__ void a_ready(const Unit&) const {}
    __device__ __forceinline__ void done(const Unit&) const {}
    __device__ __forceinline__ const char* pA(const Gemm& g, const Unit& u) const { const bool pw = (u.pm & 0x1000) != 0;
        const bf16_t* p = sel_ptr(pw, Wout_t + (size_t)(u.pm & 0xfff) * 256 * 2048 + u.pn * 256, g.A + (size_t)((u.pm & 0xfff) >> 2) * 256 * 2048 + (u.pm & 3) * 512); return (const char*)p; }
    __device__ __forceinline__ const char* pB(const Gemm& g, const Unit& u) const { const bool pw = (u.pm & 0x1000) != 0;
        const bf16_t* p = sel_ptr(pw, PWn + (size_t)u.pn * 256 * 2048, g.Bt + (size_t)u.pn * 256 * 2048 + (u.pm & 3) * 512); return (const char*)p; }
};
struct PreVOOrder {
    int G, c0;
    __device__ bool next(int i, Unit& u) const { const int c = i * G + c0; if (c >= 128) return false; u.pm = (c >> 5) * 8 + ((c >> 2) & 7); u.pn = c & 3; return true; }
    __device__ __forceinline__ void a_ready(const Unit&) const {}
    __device__ __forceinline__ void done(const Unit&) const {}
    __device__ __forceinline__ const char* pA(const Gemm& g, const Unit& u) const { return (const char*)(g.A + (size_t)(u.pm & 7) * 256 * 2048 + u.pn * 512); }
    __device__ __forceinline__ const char* pB(const Gemm& g, const Unit& u) const { return (const char*)(g.Bt + (size_t)(u.pm >> 3) * 256 * 2048 + u.pn * 512); }
};
struct ScoreOrder {
    int G, c;
    __device__ bool next(int i, Unit& u) const { if (G != 256) { const int L = i * G + c; if (L >= 256) return false; u.pm = L >> 2; u.pn = L & 3; return true; }
        if (i > 0) return false; const int xcd = c & 7, j = c >> 3; u.pm = xcd * 8 + (j >> 2); u.pn = j & 3; return true; }
    __device__ __forceinline__ void a_ready(const Unit&) const {}
    __device__ __forceinline__ void done(const Unit&) const {}
    __device__ __forceinline__ const char* pA(const Gemm& g, const Unit& u) const { return (const char*)(g.A + (size_t)u.pm * BM * 2048); }
    __device__ __forceinline__ const char* pB(const Gemm& g, const Unit& u) const { return (const char*)(g.Bt + (size_t)((u.pm >> 4) * 1024 + u.pn * 256) * 2048); }
};
struct AttnOutOrder {
    int G, c;
    __device__ bool next(int i, Unit& u) const { if (G != 256) { const int L = i * G + c; if (L >= 512) return false; u.pm = L >> 3; u.pn = L & 7; return true; }
        if (i > 1) return false; const int xcd = c & 7, j = c >> 3; u.pm = xcd * 8 + (j >> 2); u.pn = i * 4 + (j & 3); return true; }
    __device__ __forceinline__ void a_ready(const Unit&) const {}
    __device__ __forceinline__ void done(const Unit&) const {}
    __device__ __forceinline__ const char* pA(const Gemm& g, const Unit& u) const { return (const char*)(g.A + (size_t)u.pm * BM * 1024); }
    __device__ __forceinline__ const char* pB(const Gemm& g, const Unit& u) const { return (const char*)(g.Bt + (size_t)((u.pm >> 4) * 2048 + u.pn * 256) * 1024); }
};
struct AttnSOrder {
    int G, c;
    __device__ bool next(int i, Unit& u) const { const int L = i * G + c; if (L >= 256) return false; u.pm = L >> 2; u.pn = L & 3; return true; }
    __device__ __forceinline__ void a_ready(const Unit&) const {}
    __device__ __forceinline__ void done(const Unit&) const {}
    __device__ __forceinline__ const char* pA(const Gemm& g, const Unit& u) const { return (const char*)(g.A + (size_t)u.pm * BM * 2048 + u.pn * 512); }
    __device__ __forceinline__ const char* pB(const Gemm& g, const Unit& u) const { return (const char*)(g.Bt + (size_t)(u.pm >> 4) * 256 * 2048 + u.pn * 512); }
};
struct AttnPVOrder {
    int G, c;
    __device__ bool next(int i, Unit& u) const { const int L = i * G + c; if (L >= 512) return false; u.pm = L >> 3; u.pn = L & 7; return true; }
    __device__ __forceinline__ void a_ready(const Unit&) const {}
    __device__ __forceinline__ void done(const Unit&) const {}
    __device__ __forceinline__ const char* pA(const Gemm& g, const Unit& u) const { return (const char*)(g.A + (size_t)u.pm * BM * 1024 + (u.pn >> 1) * 256); }
    __device__ __forceinline__ const char* pB(const Gemm& g, const Unit& u) const { return (const char*)(g.Bt + (size_t)u.pn * BM * 1024 + (u.pm >> 4) * 256); }
};

typedef __bf16 bf16x2v_ __attribute__((ext_vector_type(2)));
typedef float f32x2v_ __attribute__((ext_vector_type(2)));
__device__ __forceinline__ unsigned cvt_pk_bf16(float lo, float hi) { const f32x2v_ f = {lo, hi}; const bf16x2v_ b = __builtin_convertvector(f, bf16x2v_); return __builtin_bit_cast(unsigned, b); }
typedef unsigned u32x2 __attribute__((ext_vector_type(2)));
constexpr float RMS_EPS = 1e-6f;

struct EpiPlain {
    static constexpr bool PERM = true, AFTER_DRAIN = false;
    bf16_t* O; int ldc;
    __device__ __forceinline__ void operator()(const f32x4 (&acc)[2][2][4][2], const Unit& u, int wr, int wc, int fr, int fq) const {
        { const int l_ = (int)__builtin_amdgcn_mbcnt_hi(~0u, __builtin_amdgcn_mbcnt_lo(~0u, 0u)); fr = l_ & 15; fq = l_ >> 4; }
        const int row0 = u.pm * BM + wr * 64 + fr, col0 = u.pn * BM + wc * 32 + 8 * fq;
#pragma unroll
        for (int ai = 0; ai < 2; ++ai)
#pragma unroll
            for (int m = 0; m < 4; ++m) { bf16_t* rowp = O + (size_t)(row0 + ai * HALF + m * 16) * ldc + col0;
#pragma unroll
                for (int bj = 0; bj < 2; ++bj) { const f32x4 v0 = acc[ai][bj][m][0], v1 = acc[ai][bj][m][1];
                    u32x4 w; w.x = cvt_pk_bf16(v0[0], v0[1]); w.y = cvt_pk_bf16(v0[2], v0[3]); w.z = cvt_pk_bf16(v1[0], v1[1]); w.w = cvt_pk_bf16(v1[2], v1[3]);
                    *(u32x4*)(rowp + bj * HALF) = w; } }
    }
};
struct EpiPre {
    static constexpr bool PERM = true, AFTER_DRAIN = false;
    bf16_t* WQK; bf16_t* Wout_t;
    __device__ __forceinline__ void operator()(const f32x4 (&acc)[2][2][4][2], const Unit& u, int wr, int wc, int fr, int fq) const {
        const bool pw = (u.pm & 0x1000) != 0; Unit t; t.pm = u.pm & 0xfff; t.pn = u.pn; const EpiPlain E{(bf16_t*)sel_ptr(pw, Wout_t, WQK), 2048}; E(acc, t, wr, wc, fr, fq);
    }
};
struct EpiRowScale {
    static constexpr bool PERM = true, AFTER_DRAIN = false;
    bf16_t* O; int ldc; const float* SS; float inv_n;
    __device__ __forceinline__ void operator()(const f32x4 (&acc)[2][2][4][2], const Unit& u, int wr, int wc, int fr, int fq) const {
        const int row0 = u.pm * BM + wr * 64 + fr, col0 = u.pn * BM + wc * 32 + 8 * fq;
#pragma unroll
        for (int ai = 0; ai < 2; ++ai)
#pragma unroll
            for (int m = 0; m < 4; ++m) { const int row = row0 + ai * HALF + m * 16; bf16_t* rowp = O + (size_t)row * ldc + col0;
                const f32x4 pa = *(const f32x4*)(SS + (size_t)row * 8), pb = *(const f32x4*)(SS + (size_t)row * 8 + 4); const float rs = __builtin_amdgcn_rsqf((((pa[0] + pa[1]) + (pa[2] + pa[3])) + ((pb[0] + pb[1]) + (pb[2] + pb[3]))) * inv_n + RMS_EPS);
#pragma unroll
                for (int bj = 0; bj < 2; ++bj) { const f32x4 v0 = acc[ai][bj][m][0] * rs, v1 = acc[ai][bj][m][1] * rs;
                    u32x4 w; w.x = cvt_pk_bf16(v0[0], v0[1]); w.y = cvt_pk_bf16(v0[2], v0[3]); w.z = cvt_pk_bf16(v1[0], v1[1]); w.w = cvt_pk_bf16(v1[2], v1[3]);
                    *(u32x4*)(rowp + bj * HALF) = w; } }
    }
};
struct EpiRowScaleC {
    static constexpr bool PERM = true, AFTER_DRAIN = false;
    bf16_t* O; int ldc; const float* RS;
    __device__ __forceinline__ void operator()(const f32x4 (&acc)[2][2][4][2], const Unit& u, int wr, int wc, int fr, int fq) const {
        const int row0 = u.pm * BM + wr * 64 + fr, col0 = u.pn * BM + wc * 32 + 8 * fq;
#pragma unroll
        for (int ai = 0; ai < 2; ++ai)
#pragma unroll
            for (int m = 0; m < 4; ++m) { const int row = row0 + ai * HALF + m * 16; bf16_t* rowp = O + (size_t)row * ldc + col0; const float rs = RS[row];
#pragma unroll
                for (int bj = 0; bj < 2; ++bj) { const f32x4 v0 = acc[ai][bj][m][0] * rs, v1 = acc[ai][bj][m][1] * rs;
                    u32x4 w; w.x = cvt_pk_bf16(v0[0], v0[1]); w.y = cvt_pk_bf16(v0[2], v0[3]); w.z = cvt_pk_bf16(v1[0], v1[1]); w.w = cvt_pk_bf16(v1[2], v1[3]);
                    *(u32x4*)(rowp + bj * HALF) = w; } }
    }
};
struct EpiColScale {
    static constexpr bool PERM = true, AFTER_DRAIN = false;
    bf16_t* O; int ldc; const float* RS;
    __device__ __forceinline__ void operator()(const f32x4 (&acc)[2][2][4][2], const Unit& u, int wr, int wc, int fr, int fq) const {
        const int row0 = u.pm * BM + wr * 64 + fr, col0 = u.pn * BM + wc * 32 + 8 * fq;
        f32x4 c0[2], c1[2];
#pragma unroll
        for (int bj = 0; bj < 2; ++bj) { c0[bj] = *(const f32x4*)(RS + col0 + bj * HALF); c1[bj] = *(const f32x4*)(RS + col0 + bj * HALF + 4); }
#pragma unroll
        for (int ai = 0; ai < 2; ++ai)
#pragma unroll
            for (int m = 0; m < 4; ++m) { bf16_t* rowp = O + (size_t)(row0 + ai * HALF + m * 16) * ldc + col0;
#pragma unroll
                for (int bj = 0; bj < 2; ++bj) { const f32x4 v0 = acc[ai][bj][m][0] * c0[bj], v1 = acc[ai][bj][m][1] * c1[bj];
                    u32x4 w; w.x = cvt_pk_bf16(v0[0], v0[1]); w.y = cvt_pk_bf16(v0[2], v0[3]); w.z = cvt_pk_bf16(v1[0], v1[1]); w.w = cvt_pk_bf16(v1[2], v1[3]);
                    *(u32x4*)(rowp + bj * HALF) = w; } }
    }
};
struct InProjOrder {
    int G, c, cv, na, nb, nk, nv;
    const bf16_t *XB, *Win_t, *MN, *Wk_t, *Wv_t;
    static __device__ __forceinline__ int count(int nwg, int c, int G) { return c < nwg ? (nwg - c + G - 1) / G : 0; }
    __device__ __forceinline__ void init(int G_, int bx, const bf16_t* XB_, const bf16_t* Win_t_, const bf16_t* MN_, const bf16_t* Wk_t_, const bf16_t* Wv_t_) {
        G = G_; c = bx; cv = (bx + G_ - 32 % G_) % G_; na = count(512, c, G); nb = count(256, c, G); nk = count(32, c, G); nv = count(32, cv, G);
        XB = XB_; Win_t = Win_t_; MN = MN_; Wk_t = Wk_t_; Wv_t = Wv_t_; }
    __device__ __forceinline__ bool next(int i, Unit& u) const {
        StaticOrder t; t.G = G; bool ok;
        if (i < na) { t.nM = 64; t.nN = 8; t.nwg = 512; t.c = c; ok = t.next(i, u); u.a = (const char*)(XB + (size_t)u.pm * BM * 2048); u.b = (const char*)(Win_t + (size_t)u.pn * BM * 2048); }
        else if (i < na + nb) { t.nM = 4; t.nN = 64; t.nwg = 256; t.c = c; ok = t.next(i - na, u); u.a = (const char*)(Win_t + (size_t)(2048 + u.pm * BM) * 2048); u.b = (const char*)(XB + (size_t)u.pn * BM * 2048); u.pn |= 1 << 16; }
        else if (i < na + nb + nk) { t.nM = 4; t.nN = 8; t.nwg = 32; t.c = c; ok = t.next(i - na - nb, u); u.a = (const char*)(MN + (size_t)u.pm * BM * 2048); u.b = (const char*)(Wk_t + (size_t)u.pn * BM * 2048); u.pn |= 2 << 16; }
        else if (i < na + nb + nk + nv) { t.nM = 4; t.nN = 8; t.nwg = 32; t.c = cv; ok = t.next(i - na - nb - nk, u); u.a = (const char*)(MN + (size_t)u.pm * BM * 2048); u.b = (const char*)(Wv_t + (size_t)u.pn * BM * 2048); u.pn |= 3 << 16; }
        else return false;
        return ok; }
    __device__ __forceinline__ void a_ready(const Unit&) const {}
    __device__ __forceinline__ void done(const Unit&) const {}
    __device__ __forceinline__ const char* pA(const Gemm&, const Unit& u) const { return u.a; }
    __device__ __forceinline__ const char* pB(const Gemm&, const Unit& u) const { return u.b; }
};
struct EpiInProj {
    static constexpr bool PERM = true, AFTER_DRAIN = false;
    bf16_t *PAU, *VT, *KB, *VB; const float* RS0;
    __device__ __forceinline__ void operator()(const f32x4 (&acc)[2][2][4][2], const Unit& u, int wr, int wc, int fr, int fq) const {
        const int kind = u.pn >> 16; Unit t; t.pm = u.pm; t.pn = u.pn & 0xffff;
        if (kind == 0) { EpiRowScaleC E{PAU, 2048, RS0}; E(acc, t, wr, wc, fr, fq); }
        else if (kind == 1) { EpiColScale E{VT, 16384, RS0}; E(acc, t, wr, wc, fr, fq); }
        else { EpiPlain E{kind == 2 ? KB : VB, 2048}; E(acc, t, wr, wc, fr, fq); }
    }
};
__device__ __forceinline__ float silu_mul(float g, float u) { return g * u * __builtin_amdgcn_rcpf(1.0f + __expf(-g)); }
struct EpiSwiglu {
    static constexpr bool PERM = true, AFTER_DRAIN = false;
    bf16_t* O; int ldc; const float* SS; float inv_n;
    __device__ __forceinline__ void operator()(const f32x4 (&acc)[2][2][4][2], const Unit& u, int wr, int wc, int fr, int fq) const {
        const int row0 = u.pm * BM + wr * 64 + fr, col0 = u.pn * HALF + wc * 32 + 8 * fq;
#pragma unroll
        for (int ai = 0; ai < 2; ++ai)
#pragma unroll
            for (int m = 0; m < 4; ++m) { const int row = row0 + ai * HALF + m * 16;
                const f32x4 pa = *(const f32x4*)(SS + (size_t)row * 8), pb = *(const f32x4*)(SS + (size_t)row * 8 + 4); const float rs = __builtin_amdgcn_rsqf((((pa[0] + pa[1]) + (pa[2] + pa[3])) + ((pb[0] + pb[1]) + (pb[2] + pb[3]))) * inv_n + RMS_EPS);
                const f32x4 g0 = acc[ai][0][m][0] * rs, g1 = acc[ai][0][m][1] * rs, u0 = acc[ai][1][m][0] * rs, u1 = acc[ai][1][m][1] * rs;
                u32x4 w;
                w.x = cvt_pk_bf16(silu_mul(g0[0], u0[0]), silu_mul(g0[1], u0[1])); w.y = cvt_pk_bf16(silu_mul(g0[2], u0[2]), silu_mul(g0[3], u0[3]));
                w.z = cvt_pk_bf16(silu_mul(g1[0], u1[0]), silu_mul(g1[1], u1[1])); w.w = cvt_pk_bf16(silu_mul(g1[2], u1[2]), silu_mul(g1[3], u1[3]));
                *(u32x4*)(O + (size_t)row * ldc + col0) = w; }
    }
};
struct EpiSoftmax {
    static constexpr bool PERM = true, AFTER_DRAIN = false;
    bf16_t* P; float* RSP; __attribute__((address_space(3))) float* xm; float sl2;
    __device__ __forceinline__ void operator()(const f32x4 (&acc)[2][2][4][2], const Unit& u, int wr, int wc, int fr, int fq) const {
        const int h = u.pn;
#pragma unroll
        for (int ai = 0; ai < 2; ++ai)
#pragma unroll
            for (int m = 0; m < 4; ++m) { float v = -3.0e38f;
#pragma unroll
                for (int bj = 0; bj < 2; ++bj)
#pragma unroll
                    for (int n = 0; n < 2; ++n) { const f32x4 x = acc[ai][bj][m][n]; v = fmaxf(v, fmaxf(fmaxf(x[0], x[1]), fmaxf(x[2], x[3]))); }
                v = fmaxf(v, __shfl_xor(v, 16)); v = fmaxf(v, __shfl_xor(v, 32));
                if (fq == 0) xm[(ai * HALF + wr * 64 + m * 16 + fr) * 4 + wc] = v; }
        asm volatile("s_waitcnt lgkmcnt(0)" ::: "memory"); __builtin_amdgcn_s_barrier(); asm volatile("" ::: "memory");
#pragma unroll
        for (int ai = 0; ai < 2; ++ai)
#pragma unroll
            for (int m = 0; m < 4; ++m) { const int r = ai * HALF + wr * 64 + m * 16 + fr; const int row = u.pm * BM + r;
                const f32x4 mm = *(const __attribute__((address_space(3))) f32x4*)(xm + r * 4); const float mx = fmaxf(fmaxf(mm[0], mm[1]), fmaxf(mm[2], mm[3])) * sl2; float s = 0.f;
#pragma unroll
                for (int bj = 0; bj < 2; ++bj) { f32x4 p0, p1;
#pragma unroll
                    for (int j = 0; j < 4; ++j) { p0[j] = __builtin_amdgcn_exp2f(acc[ai][bj][m][0][j] * sl2 - mx); p1[j] = __builtin_amdgcn_exp2f(acc[ai][bj][m][1][j] * sl2 - mx); }
                    s += ((p0[0] + p0[1]) + (p0[2] + p0[3])) + ((p1[0] + p1[1]) + (p1[2] + p1[3]));
                    u32x4 w; w.x = cvt_pk_bf16(p0[0], p0[1]); w.y = cvt_pk_bf16(p0[2], p0[3]); w.z = cvt_pk_bf16(p1[0], p1[1]); w.w = cvt_pk_bf16(p1[2], p1[3]);
                    *(u32x4*)(P + (size_t)row * 1024 + h * 256 + bj * HALF + wc * 32 + 8 * fq) = w; }
                s += __shfl_xor(s, 16); s += __shfl_xor(s, 32);
                if (fq == 0) RSP[(size_t)row * 16 + h * 4 + wc] = s; }
    }
};
struct EpiSoftmaxN {
    static constexpr bool PERM = true, AFTER_DRAIN = false;
    bf16_t* P; const float* SS; float inv_n; __attribute__((address_space(3))) float* xm; float sl2;
    __device__ __forceinline__ void operator()(f32x4 (&acc)[2][2][4][2], const Unit& u, int wr, int wc, int fr, int fq) const {
        { const int l_ = (int)__builtin_amdgcn_mbcnt_hi(~0u, __builtin_amdgcn_mbcnt_lo(~0u, 0u)); fr = l_ & 15; fq = l_ >> 4; }
        const int h = u.pn; __attribute__((address_space(3))) float* xs = xm + 1024;
#pragma unroll
        for (int ai = 0; ai < 2; ++ai)
#pragma unroll
            for (int m = 0; m < 4; ++m) { float v = -3.0e38f;
#pragma unroll
                for (int bj = 0; bj < 2; ++bj)
#pragma unroll
                    for (int n = 0; n < 2; ++n) { const f32x4 x = acc[ai][bj][m][n]; v = fmaxf(v, fmaxf(fmaxf(x[0], x[1]), fmaxf(x[2], x[3]))); }
                v = fmaxf(v, __shfl_xor(v, 16)); v = fmaxf(v, __shfl_xor(v, 32));
                if (fq == 0) xm[(ai * HALF + wr * 64 + m * 16 + fr) * 4 + wc] = v; }
        asm volatile("s_waitcnt lgkmcnt(0)" ::: "memory"); __builtin_amdgcn_s_barrier(); asm volatile("" ::: "memory");
#pragma unroll
        for (int ai = 0; ai < 2; ++ai)
#pragma unroll
            for (int m = 0; m < 4; ++m) { const int r = ai * HALF + wr * 64 + m * 16 + fr; const int row = u.pm * BM + r;
                const f32x4 pa = *(const f32x4*)(SS + (size_t)row * 8), pb = *(const f32x4*)(SS + (size_t)row * 8 + 4);
                const float f = sl2 * __builtin_amdgcn_rsqf((((pa[0] + pa[1]) + (pa[2] + pa[3])) + ((pb[0] + pb[1]) + (pb[2] + pb[3]))) * inv_n + RMS_EPS);
                const f32x4 mm = *(const __attribute__((address_space(3))) f32x4*)(xm + r * 4); const float mx = fmaxf(fmaxf(mm[0], mm[1]), fmaxf(mm[2], mm[3])) * f; float s = 0.f;
#pragma unroll
                for (int bj = 0; bj < 2; ++bj)
#pragma unroll
                    for (int n = 0; n < 2; ++n) { f32x4 p;
#pragma unroll
                        for (int j = 0; j < 4; ++j) p[j] = __builtin_amdgcn_exp2f(acc[ai][bj][m][n][j] * f - mx);
                        acc[ai][bj][m][n] = p; s += (p[0] + p[1]) + (p[2] + p[3]); }
                s += __shfl_xor(s, 16); s += __shfl_xor(s, 32);
                if (fq == 0) xs[r * 4 + wc] = s; }
        asm volatile("s_waitcnt lgkmcnt(0)" ::: "memory"); __builtin_amdgcn_s_barrier(); asm volatile("" ::: "memory");
#pragma unroll
        for (int ai = 0; ai < 2; ++ai)
#pragma unroll
            for (int m = 0; m < 4; ++m) { const int r = ai * HALF + wr * 64 + m * 16 + fr; const int row = u.pm * BM + r;
                const f32x4 ps = *(const __attribute__((address_space(3))) f32x4*)(xs + r * 4); const float inv = 1.0f / ((ps[0] + ps[1]) + (ps[2] + ps[3]));
#pragma unroll
                for (int bj = 0; bj < 2; ++bj) { const f32x4 v0 = acc[ai][bj][m][0] * inv, v1 = acc[ai][bj][m][1] * inv;
                    u32x4 w; w.x = cvt_pk_bf16(v0[0], v0[1]); w.y = cvt_pk_bf16(v0[2], v0[3]); w.z = cvt_pk_bf16(v1[0], v1[1]); w.w = cvt_pk_bf16(v1[2], v1[3]);
                    *(u32x4*)(P + (size_t)row * 1024 + h * 256 + bj * HALF + wc * 32 + 8 * fq) = w; } }
    }
};
struct EpiFinal {
    static constexpr bool PERM = true, AFTER_DRAIN = false;
    const bf16_t* res16; float* out; float* SS; unsigned* cnt; const float* gfin; __attribute__((address_space(3))) float* xs; int ldc;
    __device__ __forceinline__ void operator()(f32x4 (&acc)[2][2][4][2], const Unit& u, int wr, int wc, int fr, int fq) const {
        const int lane = (int)__builtin_amdgcn_mbcnt_hi(~0u, __builtin_amdgcn_mbcnt_lo(~0u, 0u)); fr = lane & 15; fq = lane >> 4;
        __attribute__((address_space(3))) float* rsl = xs + 1024;
        const int col0 = u.pn * BM + wc * 32 + 8 * fq;
#pragma unroll
        for (int ai = 0; ai < 2; ++ai) { u32x4 rh[4][2];
#pragma unroll
            for (int m = 0; m < 4; ++m) { const size_t off = (size_t)(u.pm * BM + ai * HALF + wr * 64 + m * 16 + fr) * ldc + col0;
#pragma unroll
                for (int bj = 0; bj < 2; ++bj) rh[m][bj] = *(const u32x4*)(res16 + off + bj * HALF); }
#pragma unroll
            for (int m = 0; m < 4; ++m) { float s = 0.f;
#pragma unroll
                for (int bj = 0; bj < 2; ++bj) { const u32x4 rb = rh[m][bj];
                    const f32x4 r0 = (f32x4){__uint_as_float(rb.x << 16), __uint_as_float(rb.x & 0xffff0000u), __uint_as_float(rb.y << 16), __uint_as_float(rb.y & 0xffff0000u)};
                    const f32x4 r1 = (f32x4){__uint_as_float(rb.z << 16), __uint_as_float(rb.z & 0xffff0000u), __uint_as_float(rb.w << 16), __uint_as_float(rb.w & 0xffff0000u)};
                    const f32x4 v0 = r0 + acc[ai][bj][m][0], v1 = r1 + acc[ai][bj][m][1]; acc[ai][bj][m][0] = v0; acc[ai][bj][m][1] = v1;
                    s += ((v0[0] * v0[0] + v0[1] * v0[1]) + (v0[2] * v0[2] + v0[3] * v0[3])) + ((v1[0] * v1[0] + v1[1] * v1[1]) + (v1[2] * v1[2] + v1[3] * v1[3])); }
                s += __shfl_xor(s, 16); s += __shfl_xor(s, 32); if (fq == 0) xs[(ai * HALF + wr * 64 + m * 16 + fr) * 4 + wc] = s; }
            asm volatile("" ::: "memory"); }
        asm volatile("s_waitcnt lgkmcnt(0)" ::: "memory"); __builtin_amdgcn_s_barrier(); asm volatile("" ::: "memory");
        if (fq == 0) {
#pragma unroll
            for (int ai = 0; ai < 2; ++ai) { const int r = ai * HALF + wr * 64 + wc * 16 + fr; const f32x4 p = *(const __attribute__((address_space(3))) f32x4*)(xs + r * 4);
                __hip_atomic_store(SS + (size_t)(u.pm * BM + r) * 8 + u.pn, (p[0] + p[1]) + (p[2] + p[3]), __ATOMIC_RELAXED, __HIP_MEMORY_SCOPE_AGENT); } }
        asm volatile("s_waitcnt vmcnt(0)" ::: "memory");
        if (lane == 0) __hip_atomic_fetch_add(cnt + 64 * u.pm, 1u, __ATOMIC_RELAXED, __HIP_MEMORY_SCOPE_AGENT);
        if (wr == 0 && wc == 0) {
            unsigned sp = 0u;
            while ((unsigned)__builtin_amdgcn_readfirstlane((int)__hip_atomic_load(cnt + 64 * u.pm, __ATOMIC_RELAXED, __HIP_MEMORY_SCOPE_AGENT)) < 64u) { __builtin_amdgcn_s_sleep(2); if (++sp > (1u << 22)) break; }
            __builtin_amdgcn_fence(__ATOMIC_ACQUIRE, "agent"); }
        asm volatile("s_waitcnt vmcnt(0) lgkmcnt(0)" ::: "memory"); __builtin_amdgcn_s_barrier(); asm volatile("" ::: "memory");
        if (wr == 0) {
            const int r = wc * 64 + lane; const unsigned long long* sp = (const unsigned long long*)(SS + (size_t)(u.pm * BM + r) * 8); float t = 0.f;
#pragma unroll
            for (int q = 0; q < 4; ++q) { const unsigned long long w = __hip_atomic_load(sp + q, __ATOMIC_RELAXED, __HIP_MEMORY_SCOPE_AGENT); t += __uint_as_float((unsigned)w) + __uint_as_float((unsigned)(w >> 32)); }
            rsl[r] = __builtin_amdgcn_rsqf(t * (1.0f / 2048.0f) + RMS_EPS); }
        asm volatile("s_waitcnt vmcnt(0) lgkmcnt(0)" ::: "memory"); __builtin_amdgcn_s_barrier(); asm volatile("" ::: "memory");
        f32x4 g0[2], g1[2];
#pragma unroll
        for (int bj = 0; bj < 2; ++bj) { g0[bj] = *(const f32x4*)(gfin + col0 + bj * HALF); g1[bj] = *(const f32x4*)(gfin + col0 + bj * HALF + 4); }
#pragma unroll
        for (int ai = 0; ai < 2; ++ai)
#pragma unroll
            for (int m = 0; m < 4; ++m) { const int r = ai * HALF + wr * 64 + m * 16 + fr; const float rs = rsl[r]; float* op = out + (size_t)(u.pm * BM + r) * ldc + col0;
#pragma unroll
                for (int bj = 0; bj < 2; ++bj) { *(f32x4*)(op + bj * HALF) = acc[ai][bj][m][0] * rs * g0[bj]; *(f32x4*)(op + bj * HALF + 4) = acc[ai][bj][m][1] * rs * g1[bj]; } }
    }
};
struct EpiAttnOut {
    static constexpr bool PERM = true, AFTER_DRAIN = false;
    bf16_t* O; const float* RSP;
    __device__ __forceinline__ void operator()(const f32x4 (&acc)[2][2][4][2], const Unit& u, int wr, int wc, int fr, int fq) const {
        const int row0 = u.pm * BM + wr * 64 + fr, col0 = u.pn * BM + wc * 32 + 8 * fq, h = u.pn >> 1;
#pragma unroll
        for (int ai = 0; ai < 2; ++ai)
#pragma unroll
            for (int m = 0; m < 4; ++m) { const int row = row0 + ai * HALF + m * 16; bf16_t* rowp = O + (size_t)row * 2048 + col0;
                const f32x4 ps = *(const f32x4*)(RSP + (size_t)row * 16 + h * 4); const float rs = 1.0f / ((ps[0] + ps[1]) + (ps[2] + ps[3]));
#pragma unroll
                for (int bj = 0; bj < 2; ++bj) { const f32x4 v0 = acc[ai][bj][m][0] * rs, v1 = acc[ai][bj][m][1] * rs;
                    u32x4 w; w.x = cvt_pk_bf16(v0[0], v0[1]); w.y = cvt_pk_bf16(v0[2], v0[3]); w.z = cvt_pk_bf16(v1[0], v1[1]); w.w = cvt_pk_bf16(v1[2], v1[3]);
                    *(u32x4*)(rowp + bj * HALF) = w; } }
    }
};
template <bool RES_F32> struct EpiResid {
    static constexpr bool PERM = true, AFTER_DRAIN = false;
    const float* res32; const bf16_t* res16; bf16_t* xb; float* SS; int ldc; __attribute__((address_space(3))) float* xs;
    __device__ __forceinline__ void operator()(const f32x4 (&acc)[2][2][4][2], const Unit& u, int wr, int wc, int fr, int fq) const {
        const int col0 = u.pn * BM + wc * 32 + 8 * fq;
#pragma unroll
        for (int ai = 0; ai < 2; ++ai) {
            f32x4 rf[RES_F32 ? 4 : 1][2][2]; u32x4 rh[RES_F32 ? 1 : 4][2];
#pragma unroll
            for (int m = 0; m < 4; ++m) { const size_t off = (size_t)(u.pm * BM + ai * HALF + wr * 64 + m * 16 + fr) * ldc + col0;
#pragma unroll
                for (int bj = 0; bj < 2; ++bj) {
                    if constexpr (RES_F32) { rf[m][bj][0] = *(const f32x4*)(res32 + off + bj * HALF); rf[m][bj][1] = *(const f32x4*)(res32 + off + bj * HALF + 4); }
                    else rh[m][bj] = *(const u32x4*)(res16 + off + bj * HALF); } }
#pragma unroll
            for (int m = 0; m < 4; ++m) { const int row = u.pm * BM + ai * HALF + wr * 64 + m * 16 + fr; const size_t off = (size_t)row * ldc + col0; float s = 0.f;
#pragma unroll
                for (int bj = 0; bj < 2; ++bj) { f32x4 r0, r1;
                    if constexpr (RES_F32) { r0 = rf[m][bj][0]; r1 = rf[m][bj][1]; }
                    else { const u32x4 rb = rh[m][bj];
                        r0 = (f32x4){__uint_as_float(rb.x << 16), __uint_as_float(rb.x & 0xffff0000u), __uint_as_float(rb.y << 16), __uint_as_float(rb.y & 0xffff0000u)};
                        r1 = (f32x4){__uint_as_float(rb.z << 16), __uint_as_float(rb.z & 0xffff0000u), __uint_as_float(rb.w << 16), __uint_as_float(rb.w & 0xffff0000u)}; }
                    const f32x4 v0 = r0 + acc[ai][bj][m][0], v1 = r1 + acc[ai][bj][m][1];
                    u32x4 w; w.x = cvt_pk_bf16(v0[0], v0[1]); w.y = cvt_pk_bf16(v0[2], v0[3]); w.z = cvt_pk_bf16(v1[0], v1[1]); w.w = cvt_pk_bf16(v1[2], v1[3]);
                    *(u32x4*)(xb + off + bj * HALF) = w;
                    s += ((v0[0] * v0[0] + v0[1] * v0[1]) + (v0[2] * v0[2] + v0[3] * v0[3])) + ((v1[0] * v1[0] + v1[1] * v1[1]) + (v1[2] * v1[2] + v1[3] * v1[3])); }
                s += __shfl_xor(s, 16); s += __shfl_xor(s, 32); if (fq == 0) xs[(ai * HALF + wr * 64 + m * 16 + fr) * 4 + wc] = s; }
            asm volatile("" ::: "memory"); }
        asm volatile("s_waitcnt lgkmcnt(0)" ::: "memory"); __builtin_amdgcn_s_barrier(); asm volatile("" ::: "memory");
        if (fq == 0) {
#pragma unroll
            for (int ai = 0; ai < 2; ++ai) { const int r = ai * HALF + wr * 64 + wc * 16 + fr; const f32x4 p = *(const __attribute__((address_space(3))) f32x4*)(xs + r * 4);
                SS[(size_t)(u.pm * BM + r) * 8 + u.pn] = (p[0] + p[1]) + (p[2] + p[3]); } }
    }
};
template <class Epi, class Sched, bool ALIGN_EPI = false, bool SP2 = false>
__device__ __forceinline__ void gemm_phase(PG8_LAS unsigned char* lds, const Gemm g, const Sched& S, const Epi& E) {
    int tid_ = threadIdx.x; asm volatile("" : "+v"(tid_));
    const int tid = tid_, wid = __builtin_amdgcn_readfirstlane(tid >> 6), lane = tid & 63, wr = wid >> 2, wc = wid & 3, fr = lane & 15, fq = lane >> 4;
    const int K = g.ld, nt = g.K / BK;
    unsigned voffA[2], voffB[2];
#pragma unroll
    for (int i = 0; i < 2; ++i) { int R, C; stage_rc(tid * 16 + i * 8192, R, C); const int Rb = Epi::PERM ? ((R & ~31) + perm32(R & 31)) : R;
        voffA[i] = (unsigned)(R * K + C) * 2u; voffB[i] = (unsigned)(Rb * K + C) * 2u; }
    const size_t kstep = (size_t)(BK * 2);
    const size_t hstep = (size_t)HALF * K * 2;
    const unsigned ldsw = (unsigned)wid * 1024u;
    const int aoff = lds_byte(wr * 64 + fr, fq * 8), boff = lds_byte(wc * 32 + fr, fq * 8);
#define PG8_SA(b, h) (((b) * 2 + (h)) * HTB)
#define PG8_SB(b, h) ((4 + (b) * 2 + (h)) * HTB)
#define PG8_STAGE(bufoff, gbase, voff) do { _Pragma("unroll") for (int _i = 0; _i < 2; ++_i) \
        __builtin_amdgcn_global_load_lds((const unsigned*)((const char*)(gbase) + (voff)[_i]), (PG8_LAS unsigned*)(lds + (bufoff) + ldsw + _i * 8192), 16, 0, 0); } while (0)
#define PG8_LDA(dst, b, h) do { _Pragma("unroll") for (int m = 0; m < 4; ++m) _Pragma("unroll") for (int k = 0; k < 2; ++k) dst[m][k] = *(const PG8_LAS bf16x8*)(lds + PG8_SA(b, h) + aoff + m * 2048 + k * 1024); } while (0)
#define PG8_LDB(dst, b, h) do { _Pragma("unroll") for (int n = 0; n < 2; ++n) _Pragma("unroll") for (int k = 0; k < 2; ++k) dst[n][k] = *(const PG8_LAS bf16x8*)(lds + PG8_SB(b, h) + boff + n * 2048 + k * 1024); } while (0)
#define PG8_MMA(ai, bj, At, Bt) do { __builtin_amdgcn_s_setprio(1); _Pragma("unroll") for (int m = 0; m < 4; ++m) _Pragma("unroll") for (int n = 0; n < 2; ++n) _Pragma("unroll") for (int k = 0; k < 2; ++k) \
        acc[ai][bj][m][n] = __builtin_amdgcn_mfma_f32_16x16x32_bf16(Bt[n][k], At[m][k], acc[ai][bj][m][n], 0, 0, 0); __builtin_amdgcn_s_setprio(0); } while (0)
#define PG8_WAIT_V(n) asm volatile("s_waitcnt vmcnt(" #n ")" ::: "memory")
#define PG8_WAIT_L(n) asm volatile("s_waitcnt lgkmcnt(" #n ")" ::: "memory")
#define PG8_BAR __builtin_amdgcn_s_barrier()
#define PG8_SCHED __builtin_amdgcn_sched_barrier(0)
    Unit cur, nxt; int ui = 0;
    if (!S.next(0, cur)) return;
    f32x4 acc[2][2][4][2];
#pragma unroll
    for (int a = 0; a < 2; ++a)
#pragma unroll
        for (int b = 0; b < 2; ++b)
#pragma unroll
            for (int m = 0; m < 4; ++m)
#pragma unroll
                for (int n = 0; n < 2; ++n) acc[a][b][m][n] = (f32x4){0.f, 0.f, 0.f, 0.f};
    bf16x8 At[4][2], B0[2][2], B1[2][2];
    const char* cA = S.pA(g, cur); const char* cB = S.pB(g, cur);
    S.a_ready(cur);
    if constexpr (SP2) {
        PG8_STAGE(PG8_SB(0, 0), cB, voffB); PG8_STAGE(PG8_SB(0, 1), cB + hstep, voffB); PG8_STAGE(PG8_SA(0, 0), cA, voffA); PG8_STAGE(PG8_SA(0, 1), cA + hstep, voffA);
        if (wr == 1) PG8_BAR;
        PG8_WAIT_V(2); PG8_BAR;
        PG8_STAGE(PG8_SB(1, 0), cB + kstep, voffB); PG8_STAGE(PG8_SA(1, 0), cA + kstep, voffA); PG8_STAGE(PG8_SB(1, 1), cB + hstep + kstep, voffB);
        PG8_WAIT_V(6); PG8_BAR;
    } else {
        PG8_STAGE(PG8_SB(0, 0), cB, voffB); PG8_STAGE(PG8_SA(0, 0), cA, voffA); PG8_STAGE(PG8_SB(0, 1), cB + hstep, voffB); PG8_STAGE(PG8_SA(0, 1), cA + hstep, voffA);
        if (wr == 1) PG8_BAR;
        PG8_WAIT_V(4); PG8_BAR;
        PG8_STAGE(PG8_SB(1, 0), cB + kstep, voffB); PG8_STAGE(PG8_SA(1, 0), cA + kstep, voffA); PG8_STAGE(PG8_SB(1, 1), cB + hstep + kstep, voffB);
        PG8_WAIT_V(6); PG8_BAR;
    }
    for (;;) {
        const bool has_next = S.next(ui + 1, nxt);
        const char* nA = has_next ? S.pA(g, nxt) : cA; const char* nB = has_next ? S.pB(g, nxt) : cB;
        for (int t = 0; t < nt; t += 2) {
            const bool last = (t == nt - 2);
            const char* a1 = cA + (size_t)(t + 1) * kstep;
            const char* a2 = last ? nA : cA + (size_t)(t + 2) * kstep; const char* b2 = last ? nB : cB + (size_t)(t + 2) * kstep;
            const char* a3 = a2 + kstep; const char* b3 = b2 + kstep;
            if (last && has_next) S.a_ready(nxt);
            if constexpr (SP2) {
            PG8_LDB(B0, 0, 0); PG8_LDB(B1, 0, 1); PG8_SCHED; PG8_LDA(At, 0, 0); PG8_STAGE(PG8_SA(1, 1), a1 + hstep, voffA);
            PG8_WAIT_V(8); PG8_WAIT_L(0); PG8_BAR; PG8_MMA(0, 0, At, B0); PG8_MMA(0, 1, At, B1); PG8_BAR; PG8_SCHED;
            PG8_LDA(At, 0, 1); PG8_STAGE(PG8_SB(0, 0), b2, voffB); PG8_STAGE(PG8_SB(0, 1), b2 + hstep, voffB); PG8_STAGE(PG8_SA(0, 0), a2, voffA);
            PG8_WAIT_V(8); PG8_WAIT_L(0); PG8_BAR; PG8_MMA(1, 0, At, B0); PG8_MMA(1, 1, At, B1); PG8_BAR; PG8_SCHED;
            PG8_LDB(B0, 1, 0); PG8_LDB(B1, 1, 1); PG8_SCHED; PG8_LDA(At, 1, 0); PG8_STAGE(PG8_SA(0, 1), a2 + hstep, voffA);
            PG8_WAIT_V(8); PG8_WAIT_L(0); PG8_BAR; PG8_MMA(0, 0, At, B0); PG8_MMA(0, 1, At, B1); PG8_BAR; PG8_SCHED;
            PG8_LDA(At, 1, 1); PG8_STAGE(PG8_SB(1, 0), b3, voffB); PG8_STAGE(PG8_SB(1, 1), b3 + hstep, voffB); PG8_STAGE(PG8_SA(1, 0), a3, voffA);
            PG8_WAIT_V(8); PG8_WAIT_L(0); PG8_BAR; PG8_MMA(1, 0, At, B0); PG8_MMA(1, 1, At, B1); PG8_BAR; PG8_SCHED;
            } else {
            PG8_LDB(B0, 0, 0); PG8_SCHED; PG8_LDA(At, 0, 0); PG8_STAGE(PG8_SA(1, 1), a1 + hstep, voffA);
            PG8_WAIT_L(8); PG8_BAR; PG8_WAIT_L(0); PG8_MMA(0, 0, At, B0); PG8_BAR; PG8_SCHED;
            PG8_LDB(B1, 0, 1); PG8_STAGE(PG8_SB(0, 0), b2, voffB);
            PG8_BAR; PG8_WAIT_L(0); PG8_MMA(0, 1, At, B1); PG8_BAR;
            PG8_LDA(At, 0, 1); PG8_STAGE(PG8_SA(0, 0), a2, voffA);
            PG8_BAR; PG8_WAIT_L(0); PG8_MMA(1, 0, At, B0); PG8_BAR; PG8_SCHED;
            PG8_STAGE(PG8_SB(0, 1), b2 + hstep, voffB);
            PG8_WAIT_V(6); PG8_BAR; PG8_MMA(1, 1, At, B1); PG8_BAR;
            PG8_LDB(B0, 1, 0); PG8_SCHED; PG8_LDA(At, 1, 0); PG8_STAGE(PG8_SA(0, 1), a2 + hstep, voffA);
            PG8_WAIT_L(8); PG8_BAR; PG8_WAIT_L(0); PG8_MMA(0, 0, At, B0); PG8_BAR; PG8_SCHED;
            PG8_LDB(B1, 1, 1); PG8_STAGE(PG8_SB(1, 0), b3, voffB);
            PG8_BAR; PG8_WAIT_L(0); PG8_MMA(0, 1, At, B1); PG8_BAR;
            PG8_LDA(At, 1, 1); PG8_STAGE(PG8_SA(1, 0), a3, voffA);
            PG8_BAR; PG8_WAIT_L(0); PG8_MMA(1, 0, At, B0); PG8_BAR; PG8_SCHED;
            PG8_STAGE(PG8_SB(1, 1), b3 + hstep, voffB);
            PG8_WAIT_V(6); PG8_BAR; PG8_MMA(1, 1, At, B1); PG8_BAR;
            }
        }
        if constexpr (ALIGN_EPI) { if (wr == 0) PG8_BAR; }
        if constexpr (!Epi::AFTER_DRAIN) { E(acc, cur, wr, wc, fr, fq); S.done(cur); }
        if (!has_next) break;
#pragma unroll
        for (int a = 0; a < 2; ++a)
#pragma unroll
            for (int b = 0; b < 2; ++b)
#pragma unroll
                for (int m = 0; m < 4; ++m)
#pragma unroll
                    for (int n = 0; n < 2; ++n) acc[a][b][m][n] = (f32x4){0.f, 0.f, 0.f, 0.f};
        cur = nxt; cA = nA; cB = nB; ++ui;
        if constexpr (ALIGN_EPI) { if (wr == 1) PG8_BAR; }
    }
    PG8_WAIT_V(0);
    if constexpr (!ALIGN_EPI) { if (wr == 0) PG8_BAR; }
    PG8_BAR;
    if constexpr (Epi::AFTER_DRAIN) { E.fused(acc, cur, wr, wc, fr, fq, lds, wid, lane); S.done(cur); }
#undef PG8_SA
#undef PG8_SB
#undef PG8_STAGE
#undef PG8_LDA
#undef PG8_LDB
#undef PG8_MMA
#undef PG8_WAIT_V
#undef PG8_WAIT_L
#undef PG8_BAR
#undef PG8_SCHED
}
}
#define LAS __attribute__((address_space(3)))
using pg8::bf16_t; using pg8::bf16x8; using pg8::f32x4; using pg8::u32x4; using pg8::u32x2; using pg8::cvt_pk_bf16; using pg8::RMS_EPS;
constexpr int BATCH = 4, SEQ = 4096, D = 2048, M = BATCH * SEQ, NMEM = 256, MM = BATCH * NMEM, DFF = 5632, DPOOL = 1024, DSGU = 1024;
constexpr int NWAVES = 8, NTHR = NWAVES * 64;
constexpr int LDS_BYTES = 147456;
constexpr size_t MiB = 1u << 20;
constexpr size_t WS_BAR = 0, WS_PCNT = 16384, WS_ZERO_BYTES = 65536;
constexpr size_t WS_WIN = 1 * MiB, WS_WOUT = 13 * MiB, WS_WQ = 21 * MiB, WS_WK = 29 * MiB, WS_WV = 37 * MiB, WS_WO = 45 * MiB, WS_WGU = 53 * MiB, WS_WD = 97 * MiB;
constexpr size_t WS_PW = 119 * MiB, WS_WSP = 119 * MiB + 512 * 1024;
constexpr size_t WS_MN = 120 * MiB, WS_KB = 124 * MiB, WS_VTM = 128 * MiB;
constexpr size_t WS_XB = 132 * MiB;
constexpr size_t WS_HG = 196 * MiB;
constexpr size_t WS_PAU = 196 * MiB, WS_Q = 196 * MiB, WS_VT = 260 * MiB, WS_Y = 292 * MiB, WS_O = 292 * MiB;
constexpr size_t WS_PM = 260 * MiB;
constexpr size_t WS_RSP = 356 * MiB;
constexpr size_t WS_SS1 = 372 * MiB, WS_SS2 = WS_SS1 + 512 * 1024, WS_SS3 = WS_SS2 + 512 * 1024;
constexpr size_t WS_RS0 = 375 * MiB;
constexpr size_t WS_WQK = 356 * MiB;
constexpr size_t WS_VWO = 376 * MiB;
constexpr size_t WS_PWN = 392 * MiB;
constexpr size_t WS_END = 396 * MiB;

__device__ __forceinline__ float bf_lo(unsigned w) { return __uint_as_float(w << 16); }
__device__ __forceinline__ float bf_hi(unsigned w) { return __uint_as_float(w & 0xffff0000u); }
__device__ __forceinline__ float wave_sum(float v) {
#pragma unroll
    for (int o = 1; o < 64; o <<= 1) v += __shfl_xor(v, o);
    return v;
}
#define LDS_WAIT() asm volatile("s_waitcnt lgkmcnt(0)" ::: "memory")
#define MFMA16(a, b, c) __builtin_amdgcn_mfma_f32_16x16x32_bf16((a), (b), (c), 0, 0, 0)

#define XB_TMO      128
#define XB_XCNT(j)  (256  + 64 * (j))
#define XB_XSUB(j)  (1280 + 64 * (j))
#define XB_XGEN(j)  (2304 + 64 * (j))
#define XB_TOP      3328
#define XB_TOPGEN   3392
#define XCD_BAR_WORDS 3456
#define XB_SPIN_CAP (1u << 18)

__device__ __forceinline__ unsigned xb_ld(unsigned* p)              { return __hip_atomic_load(p, __ATOMIC_RELAXED, __HIP_MEMORY_SCOPE_AGENT); }
__device__ __forceinline__ unsigned xb_add(unsigned* p, unsigned v) { return __hip_atomic_fetch_add(p, v, __ATOMIC_RELAXED, __HIP_MEMORY_SCOPE_AGENT); }
__device__ __forceinline__ unsigned xb_xcc_id() { return (unsigned)__builtin_amdgcn_s_getreg((3 << 11) | 20) & 0xFu; }
#define XB_SPIN(cond, bar) do { unsigned _sp = 0; while (cond) { __builtin_amdgcn_s_sleep(1); \
    if ((++_sp & 255u) == 0u) { if (xb_ld(&(bar)[XB_TMO])) break; if (_sp > XB_SPIN_CAP) { atomicAdd(&(bar)[XB_TMO], 1u); break; } } } } while (0)

struct XcdBarrier {
    unsigned* bar; unsigned x;
    volatile LAS unsigned* st;
};

__device__ __forceinline__ XcdBarrier xcd_barrier_post(unsigned* bar, volatile LAS unsigned* st) {
    XcdBarrier b; b.bar = bar; b.x = xb_xcc_id(); b.st = st;
    if (threadIdx.x == 0) (void)xb_add(&bar[XB_XCNT(b.x)], 1u);
    return b;
}
__device__ __forceinline__ void xcd_barrier_complete(unsigned* bar, unsigned x, unsigned& nloc, unsigned& nx) {
    const unsigned G = gridDim.x * gridDim.y * gridDim.z;
    unsigned sum, cnt, mine, sp = 0u;
    for (;;) {
        sum = 0u; cnt = 0u; mine = 0u;
#pragma unroll
        for (unsigned j = 0; j < 16; ++j) { const unsigned c = xb_ld(&bar[XB_XCNT(j)]); sum += c; cnt += (c > 0u) ? 1u : 0u; mine = (j == x) ? c : mine; }
        if (sum == G) break;
        __builtin_amdgcn_s_sleep(1);
        if ((++sp & 255u) == 0u) { if (xb_ld(&bar[XB_TMO])) break; if (sp > XB_SPIN_CAP) { atomicAdd(&bar[XB_TMO], 1u); break; } }
    }
    nloc = mine > 0u ? mine : 1u; nx = cnt > 0u ? cnt : 1u;
}

__device__ __forceinline__ void xcd_barrier(const XcdBarrier& b) {
    asm volatile("s_waitcnt vmcnt(0)" ::: "memory");
    __syncthreads();
    if (threadIdx.x == 0) {
        unsigned* bar = b.bar;
        __builtin_amdgcn_s_waitcnt(0);
        unsigned nloc = b.st[0], nx = b.st[1];
        if (nloc == 0u) { xcd_barrier_complete(bar, b.x, nloc, nx); b.st[0] = nloc; b.st[1] = nx; }
        const unsigned old = xb_add(&bar[XB_XSUB(b.x)], 1u);
        const unsigned gen = old / nloc;
        if (old + 1u == (gen + 1u) * nloc) {
            __builtin_amdgcn_fence(__ATOMIC_RELEASE, "agent");
            asm volatile("s_waitcnt vmcnt(0)" ::: "memory");
            const unsigned og = xb_add(&bar[XB_TOP], 1u);
            const unsigned tg = og / nx;
            if (og + 1u == (tg + 1u) * nx) xb_add(&bar[XB_TOPGEN], 1u);
            else XB_SPIN(xb_ld(&bar[XB_TOPGEN]) == tg, bar);
            __builtin_amdgcn_fence(__ATOMIC_ACQUIRE, "agent");
            xb_add(&bar[XB_XGEN(b.x)], 1u);
            asm volatile("s_waitcnt vmcnt(0)" ::: "memory");
        } else {
            XB_SPIN(xb_ld(&bar[XB_XGEN(b.x)]) == gen, bar);
            __builtin_amdgcn_fence(__ATOMIC_ACQUIRE, "agent");
            asm volatile("s_waitcnt vmcnt(0)" ::: "memory");
        }
    }
    __syncthreads();
}

__device__ __forceinline__ void tr_item(const float* W, int ldw, int k0, int n0, bf16_t* WT, int ldt, int orow0, const float* kgain, const float* nscale, LAS float* scr, int lane) {
    f32x4 v[16];
#pragma unroll
    for (int i = 0; i < 16; ++i) { const int kk = 4 * i + (lane >> 4), nn = (lane & 15) * 4; v[i] = __builtin_nontemporal_load((const f32x4*)(W + (size_t)(k0 + kk) * ldw + n0 + nn)); }
#pragma unroll
    for (int i = 0; i < 16; ++i) { const int kk = 4 * i + (lane >> 4), nn = (lane & 15) * 4;
        if (kgain) v[i] = v[i] * kgain[k0 + kk];
        LAS float* s = scr + kk * 65 + nn; s[0] = v[i][0]; s[1] = v[i][1]; s[2] = v[i][2]; s[3] = v[i][3]; }
    LDS_WAIT();
    const int c = lane & 7;
#pragma unroll
    for (int j = 0; j < 8; ++j) { const int n = (lane >> 3) + 8 * j; const LAS float* s = scr + (8 * c) * 65 + n;
        const float sc = nscale ? nscale[n] : 1.0f;
        u32x4 o; o.x = cvt_pk_bf16(s[0 * 65] * sc, s[1 * 65] * sc); o.y = cvt_pk_bf16(s[2 * 65] * sc, s[3 * 65] * sc); o.z = cvt_pk_bf16(s[4 * 65] * sc, s[5 * 65] * sc); o.w = cvt_pk_bf16(s[6 * 65] * sc, s[7 * 65] * sc);
        *(u32x4*)(WT + (size_t)(orow0 + n) * ldt + k0 + 8 * c) = o; }
    LDS_WAIT();
}
__device__ __forceinline__ void norm_row_bf16(const float* xrow, const float* g, bf16_t* orow, int lane) {
    const f32x4* xr = (const f32x4*)xrow + lane; f32x4 v[8]; float s = 0.f;
#pragma unroll
    for (int j = 0; j < 8; ++j) { v[j] = xr[64 * j]; s += (v[j][0] * v[j][0] + v[j][1] * v[j][1]) + (v[j][2] * v[j][2] + v[j][3] * v[j][3]); }
    const float rstd = 1.0f / sqrtf(wave_sum(s) * (1.0f / D) + RMS_EPS);
    const f32x4* gr = (const f32x4*)g + lane; u32x2* o = (u32x2*)orow + lane;
#pragma unroll
    for (int j = 0; j < 8; ++j) { const f32x4 gg = gr[64 * j]; const f32x4 y = v[j] * rstd * gg; u32x2 w; w.x = cvt_pk_bf16(y[0], y[1]); w.y = cvt_pk_bf16(y[2], y[3]); o[64 * j] = w; }
}
__device__ __forceinline__ void norm_row2_bf16(const float* xa, const float* xb_, bool has2, const float* g, bf16_t* oa, bf16_t* ob, int lane) {
    const f32x4* ra = (const f32x4*)xa + lane; const f32x4* rb = (const f32x4*)(has2 ? xb_ : xa) + lane; f32x4 va[8], vb[8]; float sa = 0.f, sb = 0.f;
#pragma unroll
    for (int j = 0; j < 8; ++j) { va[j] = ra[64 * j]; vb[j] = rb[64 * j]; }
#pragma unroll
    for (int j = 0; j < 8; ++j) { sa += (va[j][0] * va[j][0] + va[j][1] * va[j][1]) + (va[j][2] * va[j][2] + va[j][3] * va[j][3]); sb += (vb[j][0] * vb[j][0] + vb[j][1] * vb[j][1]) + (vb[j][2] * vb[j][2] + vb[j][3] * vb[j][3]); }
    const float ka = 1.0f / sqrtf(wave_sum(sa) * (1.0f / D) + RMS_EPS), kb = 1.0f / sqrtf(wave_sum(sb) * (1.0f / D) + RMS_EPS);
    const f32x4* gr = (const f32x4*)g + lane; u32x2* pa = (u32x2*)oa + lane; u32x2* pb = (u32x2*)ob + lane;
#pragma unroll
    for (int j = 0; j < 8; ++j) { const f32x4 gg = gr[64 * j]; const f32x4 ya = va[j] * ka * gg, yb = vb[j] * kb * gg; u32x2 w; w.x = cvt_pk_bf16(ya[0], ya[1]); w.y = cvt_pk_bf16(ya[2], ya[3]); pa[64 * j] = w;
        if (has2) { u32x2 w2; w2.x = cvt_pk_bf16(yb[0], yb[1]); w2.y = cvt_pk_bf16(yb[2], yb[3]); pb[64 * j] = w2; } }
}
__device__ __forceinline__ void raw_row2_bf16(const float* xa, const float* xb_, bool has2, bf16_t* oa, bf16_t* ob, float* rsa, float* rsb, int lane) {
    const f32x4* ra = (const f32x4*)xa + lane; const f32x4* rb = (const f32x4*)(has2 ? xb_ : xa) + lane; f32x4 va[8], vb[8]; float sa = 0.f, sb = 0.f;
#pragma unroll
    for (int j = 0; j < 8; ++j) { va[j] = __builtin_nontemporal_load(ra + 64 * j); vb[j] = __builtin_nontemporal_load(rb + 64 * j); }
    u32x2* pa = (u32x2*)oa + lane; u32x2* pb = (u32x2*)ob + lane;
#pragma unroll
    for (int j = 0; j < 8; ++j) { sa += (va[j][0] * va[j][0] + va[j][1] * va[j][1]) + (va[j][2] * va[j][2] + va[j][3] * va[j][3]); sb += (vb[j][0] * vb[j][0] + vb[j][1] * vb[j][1]) + (vb[j][2] * vb[j][2] + vb[j][3] * vb[j][3]);
        u32x2 w; w.x = cvt_pk_bf16(va[j][0], va[j][1]); w.y = cvt_pk_bf16(va[j][2], va[j][3]); pa[64 * j] = w;
        if (has2) { u32x2 w2; w2.x = cvt_pk_bf16(vb[j][0], vb[j][1]); w2.y = cvt_pk_bf16(vb[j][2], vb[j][3]); pb[64 * j] = w2; } }
    const float ka = 1.0f / sqrtf(wave_sum(sa) * (1.0f / D) + RMS_EPS), kb = 1.0f / sqrtf(wave_sum(sb) * (1.0f / D) + RMS_EPS);
    if (lane == 0) { *rsa = ka; if (has2) *rsb = kb; }
}
__device__ __forceinline__ void norm_row_out(const bf16_t* xrow, float ss, const float* g, float* orow, int lane) {
    const float rstd = 1.0f / sqrtf(ss * (1.0f / D) + RMS_EPS);
#pragma unroll
    for (int j = 0; j < 4; ++j) { const int c = (lane + 64 * j) * 8; const u32x4 w = *(const u32x4*)(xrow + c);
        const f32x4 g0 = *(const f32x4*)(g + c), g1 = *(const f32x4*)(g + c + 4);
        const f32x4 y0 = (f32x4){bf_lo(w.x), bf_hi(w.x), bf_lo(w.y), bf_hi(w.y)} * rstd * g0, y1 = (f32x4){bf_lo(w.z), bf_hi(w.z), bf_lo(w.w), bf_hi(w.w)} * rstd * g1;
        *(f32x4*)(orow + c) = y0; *(f32x4*)(orow + c + 4) = y1; }
}

__device__ __forceinline__ void sgu_unit(LAS unsigned char* lds, int nb, int h0, const bf16_t* VT, const bf16_t* PAU, bf16_t* Y, const bf16_t* WSb, const float* sg, const float* bsp, int tid) {
    asm volatile("" : "+v"(tid));
    const int lane = tid & 63, wave = tid >> 6, fr = lane & 15, fq = lane >> 4;
    const int T0 = nb * 128;
    LAS float* red = (LAS float*)lds;
    LAS float* rstd = (LAS float*)(lds + 4096);
    LAS unsigned char* Bb = lds + 8192;
    {
        const int tg = tid & 15, rl = tid >> 4;
        float s[8];
#pragma unroll
        for (int e = 0; e < 8; ++e) s[e] = 0.f;
#pragma unroll 4
        for (int i = 0; i < 32; ++i) { const int c = rl + 32 * i; const u32x4 w = *(const u32x4*)(VT + (size_t)c * M + T0 + tg * 8);
#pragma unroll
            for (int e = 0; e < 4; ++e) { const float lo = bf_lo(w[e]), hi = bf_hi(w[e]); s[2 * e] += lo * lo; s[2 * e + 1] += hi * hi; } }
#pragma unroll
        for (int e = 0; e < 8; ++e) { s[e] += __shfl_xor(s[e], 16); s[e] += __shfl_xor(s[e], 32); }
        if (fq == 0) {
#pragma unroll
            for (int e = 0; e < 8; ++e) red[wave * 128 + tg * 8 + e] = s[e]; }
    }
    __syncthreads();
    if (tid < 128) { float t = 0.f;
#pragma unroll
        for (int w = 0; w < 8; ++w) t += red[w * 128 + tid];
        rstd[tid] = 1.0f / sqrtf(t * (1.0f / DSGU) + RMS_EPS); }
    __syncthreads();
    const int wr = wave >> 1, wc = wave & 1;
    for (int h = h0; h < h0 + 4; ++h) {
        LAS unsigned char* B = Bb + (h & 1) * 34816;
#pragma unroll
        for (int i = 0; i < 4; ++i) { const int p = tid + 512 * i, c = p >> 4, sgp = p & 15;
            const u32x4 w = *(const u32x4*)(VT + (size_t)(h * 128 + c) * M + T0 + sgp * 8);
            const float g = sg[h * 128 + c];
            const f32x4 r0 = *(const LAS f32x4*)(rstd + sgp * 8) * g, r1 = *(const LAS f32x4*)(rstd + sgp * 8 + 4) * g;
            u32x4 o; o.x = cvt_pk_bf16(bf_lo(w.x) * r0[0], bf_hi(w.x) * r0[1]); o.y = cvt_pk_bf16(bf_lo(w.y) * r0[2], bf_hi(w.y) * r0[3]);
            o.z = cvt_pk_bf16(bf_lo(w.z) * r1[0], bf_hi(w.z) * r1[1]); o.w = cvt_pk_bf16(bf_lo(w.w) * r1[2], bf_hi(w.w) * r1[3]);
            const int rho = (c & ~31) + ((c >> 2) & 1) * 16 + ((c >> 3) & 3) * 4 + (c & 3);
            *(LAS u32x4*)(B + rho * 272 + sgp * 16) = o; }
        __syncthreads();
        f32x4 acc[2][4];
#pragma unroll
        for (int m = 0; m < 2; ++m)
#pragma unroll
            for (int n = 0; n < 4; ++n) acc[m][n] = (f32x4){0.f, 0.f, 0.f, 0.f};
#pragma unroll
        for (int ks = 0; ks < 4; ++ks) { bf16x8 a[2], b[4];
#pragma unroll
            for (int m = 0; m < 2; ++m) a[m] = *(const bf16x8*)(WSb + (size_t)((h * 128 + wr * 32 + m * 16 + fr) * 128 + ks * 32 + fq * 8));
#pragma unroll
            for (int n = 0; n < 4; ++n) b[n] = *(const LAS bf16x8*)(B + (wc * 64 + n * 16 + fr) * 272 + (ks * 32 + fq * 8) * 2);
#pragma unroll
            for (int m = 0; m < 2; ++m)
#pragma unroll
                for (int n = 0; n < 4; ++n) acc[m][n] = MFMA16(b[n], a[m], acc[m][n]); }
#pragma unroll
        for (int m = 0; m < 2; ++m) { const int t = wr * 32 + m * 16 + fr; const float bias = bsp[h * 128 + t];
#pragma unroll
            for (int gq = 0; gq < 2; ++gq) { const size_t off = (size_t)(T0 + t) * D + DPOOL + h * 128 + wc * 64 + gq * 32 + fq * 8;
                const u32x4 uu = *(const u32x4*)(PAU + off); const f32x4 m0 = acc[m][2 * gq] + bias, m1 = acc[m][2 * gq + 1] + bias;
                u32x4 o; o.x = cvt_pk_bf16(bf_lo(uu.x) * m0[0], bf_hi(uu.x) * m0[1]); o.y = cvt_pk_bf16(bf_lo(uu.y) * m0[2], bf_hi(uu.y) * m0[3]);
                o.z = cvt_pk_bf16(bf_lo(uu.z) * m1[0], bf_hi(uu.z) * m1[1]); o.w = cvt_pk_bf16(bf_lo(uu.w) * m1[2], bf_hi(uu.w) * m1[3]);
                *(u32x4*)(Y + off) = o; } }
    }
    __syncthreads();
}
template <int W> __device__ __forceinline__ void pool_p(const bf16_t* base, bf16_t* ybase, int ts, int tp0) {
    u32x4 arr[W + 7];
#pragma unroll
    for (int j = 0; j < W + 7; ++j) { const int t = ts - (W - 1) + j, tc = t < -tp0 ? -tp0 : t; arr[j] = *(const u32x4*)(base + (ptrdiff_t)tc * D); }
#pragma unroll
    for (int j = 0; j < W - 1; ++j) { const int t = ts - (W - 1) + j; if (tp0 + t < 0) arr[j] = (u32x4){0u, 0u, 0u, 0u}; }
    float S[8];
#pragma unroll
    for (int e = 0; e < 8; ++e) S[e] = 0.f;
#pragma unroll
    for (int j = 0; j < W - 1; ++j)
#pragma unroll
        for (int e = 0; e < 4; ++e) { S[2 * e] += bf_lo(arr[j][e]); S[2 * e + 1] += bf_hi(arr[j][e]); }
#pragma unroll
    for (int i = 0; i < 8; ++i) { const int t = ts + i, tp = tp0 + t; float cur[8], p[8];
#pragma unroll
        for (int e = 0; e < 4; ++e) { cur[2 * e] = bf_lo(arr[W - 1 + i][e]); cur[2 * e + 1] = bf_hi(arr[W - 1 + i][e]); }
        const float inv = 1.0f / (float)(tp + 1 < W ? tp + 1 : W);
#pragma unroll
        for (int e = 0; e < 8; ++e) { S[e] += cur[e]; p[e] = S[e] * inv - cur[e]; }
        u32x4 o; o.x = cvt_pk_bf16(p[0], p[1]); o.y = cvt_pk_bf16(p[2], p[3]); o.z = cvt_pk_bf16(p[4], p[5]); o.w = cvt_pk_bf16(p[6], p[7]);
        *(u32x4*)(ybase + (size_t)t * D) = o;
#pragma unroll
        for (int e = 0; e < 4; ++e) { S[2 * e] -= bf_lo(arr[i][e]); S[2 * e + 1] -= bf_hi(arr[i][e]); } }
}
__device__ __forceinline__ void pool_half(int nb, int gh, const bf16_t* PAU, bf16_t* Y, int tid) {
    asm volatile("" : "+v"(tid));
    const int T0 = nb * 128, tp0 = T0 & (SEQ - 1), cgp = tid & 31, ts = (tid >> 5) * 8;
    const bf16_t* src = PAU + (size_t)T0 * D + cgp * 8; bf16_t* dst = Y + (size_t)T0 * D + cgp * 8;
    if (gh == 0) { pool_p<2>(src, dst, ts, tp0); pool_p<16>(src + 768, dst + 768, ts, tp0); }
    else { pool_p<4>(src + 256, dst + 256, ts, tp0); pool_p<8>(src + 512, dst + 512, ts, tp0); }
}
__device__ __forceinline__ void attn_unit(LAS unsigned char* lds, int unit, const bf16_t* Q, const bf16_t* KB, const bf16_t* VTM, bf16_t* O, int tid) {
    asm volatile("" : "+v"(tid));
    const int lane = tid & 63, wave = tid >> 6, fr = lane & 15, fq = lane >> 4, wr = wave >> 1, wc = wave & 1;
    const int qt = unit & 31, h = (unit >> 5) & 3, b = unit >> 7;
    const int R0 = b * SEQ + qt * 128;
    LAS unsigned char* P = lds;
    LAS float* xm = (LAS float*)(lds + 67584);
    LAS float* xs = xm + 256;
    f32x4 acc[2][8];
#pragma unroll
    for (int m = 0; m < 2; ++m)
#pragma unroll
        for (int n = 0; n < 8; ++n) acc[m][n] = (f32x4){0.f, 0.f, 0.f, 0.f};
    const bf16_t* qp = Q + (size_t)(R0 + wr * 32 + fr) * D + h * 512 + fq * 8;
    const bf16_t* kp = KB + (size_t)(b * NMEM + wc * 128 + fr) * D + h * 512 + fq * 8;
#pragma unroll 2
    for (int ks = 0; ks < 16; ++ks) { bf16x8 a[2], bb[8];
#pragma unroll
        for (int m = 0; m < 2; ++m) a[m] = *(const bf16x8*)(qp + (size_t)m * 16 * D + ks * 32);
#pragma unroll
        for (int n = 0; n < 8; ++n) bb[n] = *(const bf16x8*)(kp + (size_t)n * 16 * D + ks * 32);
#pragma unroll
        for (int m = 0; m < 2; ++m)
#pragma unroll
            for (int n = 0; n < 8; ++n) acc[m][n] = MFMA16(bb[n], a[m], acc[m][n]); }
    const float sc = 0.044194173824159216f;
#pragma unroll
    for (int m = 0; m < 2; ++m) { float v = -3.0e38f;
#pragma unroll
        for (int n = 0; n < 8; ++n) { acc[m][n] = acc[m][n] * sc; v = fmaxf(v, fmaxf(fmaxf(acc[m][n][0], acc[m][n][1]), fmaxf(acc[m][n][2], acc[m][n][3]))); }
        v = fmaxf(v, __shfl_xor(v, 16)); v = fmaxf(v, __shfl_xor(v, 32));
        if (fq == 0) xm[wc * 128 + wr * 32 + m * 16 + fr] = v; }
    __syncthreads();
#pragma unroll
    for (int m = 0; m < 2; ++m) { const int row = wr * 32 + m * 16 + fr; const float mx = fmaxf(xm[row], xm[128 + row]); float s = 0.f;
#pragma unroll
        for (int n = 0; n < 8; ++n) { const float p0 = __expf(acc[m][n][0] - mx), p1 = __expf(acc[m][n][1] - mx), p2 = __expf(acc[m][n][2] - mx), p3 = __expf(acc[m][n][3] - mx);
            s += (p0 + p1) + (p2 + p3);
            u32x2 o; o.x = cvt_pk_bf16(p0, p1); o.y = cvt_pk_bf16(p2, p3);
            *(LAS u32x2*)(P + row * 528 + (wc * 128 + n * 16 + fq * 4) * 2) = o; }
        s += __shfl_xor(s, 16); s += __shfl_xor(s, 32);
        if (fq == 0) xs[wc * 128 + row] = s; }
    __syncthreads();
    float inv[2];
#pragma unroll
    for (int m = 0; m < 2; ++m) { const int row = wr * 32 + m * 16 + fr; inv[m] = 1.0f / (xs[row] + xs[128 + row]); }
    f32x4 o[2][16];
#pragma unroll
    for (int m = 0; m < 2; ++m)
#pragma unroll
        for (int n = 0; n < 16; ++n) o[m][n] = (f32x4){0.f, 0.f, 0.f, 0.f};
    const bf16_t* vp = VTM + (size_t)(h * 512 + wc * 256 + fr) * MM + b * NMEM + fq * 8;
    for (int ks = 0; ks < 8; ++ks) { bf16x8 a[2];
#pragma unroll
        for (int m = 0; m < 2; ++m) a[m] = *(const LAS bf16x8*)(P + (wr * 32 + m * 16 + fr) * 528 + (ks * 32 + fq * 8) * 2);
#pragma unroll
        for (int n = 0; n < 16; ++n) { const bf16x8 bv = *(const bf16x8*)(vp + (size_t)n * 16 * MM + ks * 32);
#pragma unroll
            for (int m = 0; m < 2; ++m) o[m][n] = MFMA16(bv, a[m], o[m][n]); } }
#pragma unroll
    for (int m = 0; m < 2; ++m) { const size_t rowoff = (size_t)(R0 + wr * 32 + m * 16 + fr) * D + h * 512 + wc * 256 + fq * 4;
#pragma unroll
        for (int n = 0; n < 16; ++n) { const f32x4 v = o[m][n] * inv[m]; u32x2 w; w.x = cvt_pk_bf16(v[0], v[1]); w.y = cvt_pk_bf16(v[2], v[3]); *(u32x2*)(O + rowoff + n * 16) = w; } }
    __syncthreads();
}

#ifndef REP_P0
#define REP_P0 1
#endif
#ifndef REP_P0N
#define REP_P0N 1
#endif
#ifndef REP_P1
#define REP_P1 1
#endif
#ifndef REP_P3
#define REP_P3 1
#endif
#ifndef REP_P7
#define REP_P7 1
#endif
#ifndef TS_K
#define TS_K -1
#endif
#ifndef ABSORB
#define ABSORB 1
#endif
#ifndef OLD_ATTN
#define OLD_ATTN 0
#endif
#ifndef REP_P2
#define REP_P2 1
#endif
#ifndef REP_P5
#define REP_P5 1
#endif
#ifndef REP_SYNC
#define REP_SYNC 1
#endif
#ifndef REP_P4
#define REP_P4 1
#endif
struct Args { const float* in[21]; float* out; unsigned char* ws; };
#define GEMM_PHASE(EPI, g, S, E) pg8::gemm_phase<EPI, pg8::StaticOrder, true, true>(lds, g, S, E)
__global__ void __launch_bounds__(NTHR, 2) mk_fwd(Args a) {
    extern __shared__ __attribute__((aligned(16))) unsigned char lds_raw[];
    LAS unsigned char* lds = (LAS unsigned char*)lds_raw;
    cg::grid_group grid = cg::this_grid();
    const int G = gridDim.x, bx = blockIdx.x;
    volatile LAS unsigned* bar_st = (volatile LAS unsigned*)(lds + LDS_BYTES - 64);
    if (threadIdx.x < 2) bar_st[threadIdx.x] = 0u;
    __syncthreads();
    const XcdBarrier xbar = xcd_barrier_post((unsigned*)(a.ws + WS_BAR), bar_st);
    volatile LAS unsigned* ts_lds = (volatile LAS unsigned*)(lds + LDS_BYTES - 32);
    if (TS_K >= 0 && bx == 0 && threadIdx.x == 0) ts_lds[0] = (unsigned)__builtin_amdgcn_s_memrealtime();
#define STAMP(k) do { if (TS_K == (k) && bx == 0 && threadIdx.x == 0) ts_lds[1] = (unsigned)__builtin_amdgcn_s_memrealtime(); } while (0)
#define TID_FRESH() ({ int t_ = threadIdx.x; asm volatile("" : "+v"(t_)); t_; })
    const float *x = a.in[0], *mem = a.in[1], *norm_mix_g = a.in[2], *w_in = a.in[3], *pool_w = a.in[4], *pool_scale = a.in[5], *sgu_norm_g = a.in[6], *w_spatial = a.in[7], *b_spatial = a.in[8],
                *w_out = a.in[9], *norm_xattn_g = a.in[10], *norm_mem_g = a.in[11], *w_q = a.in[12], *w_k = a.in[13], *w_v = a.in[14], *w_o = a.in[15], *norm_ffn_g = a.in[16],
                *w_gate = a.in[17], *w_up = a.in[18], *w_down = a.in[19], *final_norm_g = a.in[20];
    float* out = a.out; unsigned char* ws = a.ws;
    float *SS1 = (float*)(ws + WS_SS1), *SS2 = (float*)(ws + WS_SS2), *SS3 = (float*)(ws + WS_SS3);
    bf16_t *Win_t = (bf16_t*)(ws + WS_WIN), *Wout_t = (bf16_t*)(ws + WS_WOUT), *Wq_t = (bf16_t*)(ws + WS_WQ), *Wk_t = (bf16_t*)(ws + WS_WK), *Wv_t = (bf16_t*)(ws + WS_WV), *Wo_t = (bf16_t*)(ws + WS_WO),
           *Wgu_t = (bf16_t*)(ws + WS_WGU), *Wd_t = (bf16_t*)(ws + WS_WD), *PWt = (bf16_t*)(ws + WS_PW), *WSb = (bf16_t*)(ws + WS_WSP), *MN = (bf16_t*)(ws + WS_MN), *KB = (bf16_t*)(ws + WS_KB),
           *VTM = (bf16_t*)(ws + WS_VTM), *XB = (bf16_t*)(ws + WS_XB), *HG = (bf16_t*)(ws + WS_HG), *PAU = (bf16_t*)(ws + WS_PAU), *Qb = (bf16_t*)(ws + WS_Q), *VT = (bf16_t*)(ws + WS_VT),
           *Yb = (bf16_t*)(ws + WS_Y), *Ob = (bf16_t*)(ws + WS_O);

    {
        const int tid = TID_FRESH(), lane = tid & 63, wave = __builtin_amdgcn_readfirstlane(tid >> 6);
        LAS float* scr = (LAS float*)(lds + wave * 16640);
        const int gw = bx * NWAVES + wave, NGW = G * NWAVES;
        constexpr int I_IN = 32 * 48, I_SQ = 32 * 32, I_PW = 4 * 16;
        constexpr int NITEMS = I_IN + 4 * I_SQ + I_PW;
        { float* RS0 = (float*)(ws + WS_RS0); for (int m = gw; m < M; m += 2 * NGW) raw_row2_bf16(x + (size_t)m * D, x + (size_t)(m + NGW) * D, m + NGW < M, XB + (size_t)m * D, XB + (size_t)(m + NGW) * D, RS0 + m, RS0 + m + NGW, lane); }
        for (int m = gw; m < MM; m += NGW) norm_row_bf16(mem + (size_t)m * D, norm_mem_g, MN + (size_t)m * D, lane);
        for (int it = gw; it < NITEMS * REP_P0; it += NGW) {
            int r = it % NITEMS;
            if (r < I_IN) { tr_item(w_in, 3072, (r / 48) * 64, (r % 48) * 64, Win_t, D, (r % 48) * 64, norm_mix_g, nullptr, scr, lane); continue; } r -= I_IN;
            if (r < I_SQ) { tr_item(w_k, D, (r / 32) * 64, (r % 32) * 64, Wk_t, D, (r % 32) * 64, nullptr, nullptr, scr, lane); continue; } r -= I_SQ;
            if (r < I_SQ) { tr_item(w_v, D, (r / 32) * 64, (r % 32) * 64, Wv_t, D, (r % 32) * 64, nullptr, nullptr, scr, lane); continue; } r -= I_SQ;
            if (r < I_SQ) { tr_item(w_out, D, (r / 32) * 64, (r % 32) * 64, Wout_t, D, (r % 32) * 64, nullptr, nullptr, scr, lane); continue; } r -= I_SQ;
#if ABSORB
            if (r < I_SQ) continue; r -= I_SQ;
#else
            if (r < I_SQ) { tr_item(w_q, D, (r / 32) * 64, (r % 32) * 64, Wq_t, D, (r % 32) * 64, norm_xattn_g, nullptr, scr, lane); continue; } r -= I_SQ;
#endif
            {
              bf16_t* PWn = (bf16_t*)(ws + WS_PWN);
#pragma unroll 4
              for (int j = 0; j < 16; ++j) { const int gc = r * 16 + j, g = gc >> 8; const f32x4 v = *(const f32x4*)(pool_w + (size_t)gc * 256 + lane * 4) * *(const f32x4*)(pool_scale + g * 256 + lane * 4);
                  u32x2 o; o.x = cvt_pk_bf16(v[0], v[1]); o.y = cvt_pk_bf16(v[2], v[3]); *(u32x2*)(PWn + (size_t)gc * 2048 + lane * 4) = o; *(u32x2*)(PWn + (size_t)gc * 2048 + 256 + lane * 4) = (u32x2){0u, 0u}; } }
        }
        for (int i = bx * NTHR + tid; i < 8 * 128 * 128 / 4; i += G * NTHR) { const f32x4 v = *((const f32x4*)w_spatial + i); const int s = (i * 4) & 127, t = ((i * 4) >> 7) & 127;
            const bool keep = (s >> 6) <= (t >> 6); u32x2 o; o.x = keep ? cvt_pk_bf16(v[0], v[1]) : 0u; o.y = keep ? cvt_pk_bf16(v[2], v[3]) : 0u; *((u32x2*)WSb + i) = o; }
    }
    if (a.ws == nullptr) grid.sync();
    xcd_barrier(xbar);
    STAMP(0);
    for (int rep = 0; rep < REP_P1; ++rep) {
        { pg8::Gemm g{XB, Win_t, M, 2048, D, D}; pg8::InProjOrder S; S.init(G, bx, XB, Win_t, MN, Wk_t, Wv_t); pg8::EpiInProj E{PAU, VT, KB, VTM, (const float*)(ws + WS_RS0)};
          pg8::gemm_phase<pg8::EpiInProj, pg8::InProjOrder, true, true>(lds, g, S, E); }
        { pg8::Gemm g{KB, Wq_t, 4096, D, 512, D}; pg8::PreQKOrder S{G, bx + 128, 160, Wout_t, (const bf16_t*)(ws + WS_PWN)}; pg8::EpiPre E{(bf16_t*)(ws + WS_WQK), Wout_t};
          pg8::gemm_phase<pg8::EpiPre, pg8::PreQKOrder, true, true>(lds, g, S, E); }
        {
            const int f0q = G > 64 ? 64 : 0; const int cq = bx - f0q, ncu = G - f0q;
            if (cq >= 0) { const int tid = TID_FRESH(), lane = tid & 63, wave = __builtin_amdgcn_readfirstlane(tid >> 6);
                for (int it = cq * NWAVES + wave; it < 1024; it += ncu * NWAVES) { const int k = it * 2 + (lane >> 5);
                    const float gk = norm_xattn_g[k]; const f32x4* src = (const f32x4*)(w_q + (size_t)k * D); u32x2* dst = (u32x2*)(Wq_t + (size_t)k * D);
#pragma unroll 4
                    for (int j = 0; j < 16; ++j) { const int q = (lane & 31) + 32 * j; const f32x4 v = src[q] * gk; u32x2 o; o.x = cvt_pk_bf16(v[0], v[1]); o.y = cvt_pk_bf16(v[2], v[3]); dst[q] = o; } } } }
        const int f0 = G > 64 ? 64 : 0;
        if (bx >= f0) {
            const int tid = TID_FRESH(), lane = tid & 63, wave = __builtin_amdgcn_readfirstlane(tid >> 6);
            LAS float* scr = (LAS float*)(lds + wave * 16640);
            constexpr int I_SQ = 32 * 32, I_GU = 32 * 88, I_DN = 88 * 32, NIT = I_SQ + 2 * I_GU + I_DN;
            for (int it = (bx - f0) * NWAVES + wave; it < NIT; it += (G - f0) * NWAVES) {
                int r = it;
                if (r < I_SQ) { tr_item(w_o, D, (r / 32) * 64, (r % 32) * 64, Wo_t, D, (r % 32) * 64, nullptr, nullptr, scr, lane); continue; } r -= I_SQ;
                if (r < 2 * I_GU) { const int up = r >= I_GU; if (up) r -= I_GU; const int n0 = (r % 88) * 64;
                    tr_item(up ? w_up : w_gate, DFF, (r / 88) * 64, n0, Wgu_t, D, (n0 >> 7) * 256 + (n0 & 127) + up * 128, norm_ffn_g, nullptr, scr, lane); continue; } r -= 2 * I_GU;
                tr_item(w_down, D, (r / 32) * 64, (r % 32) * 64, Wd_t, DFF, (r % 32) * 64, nullptr, nullptr, scr, lane);
            }
        }
    }
    xcd_barrier(xbar);
    STAMP(101);
    for (int uu = bx; uu < 256 * REP_P2; uu += G) { const int u = uu & 255; sgu_unit(lds, u >> 1, (u & 1) * 4, VT, PAU, Yb, WSb, sgu_norm_g, b_spatial, (int)threadIdx.x); pool_half(u >> 1, u & 1, PAU, Yb, (int)threadIdx.x); }
#if ABSORB
    { pg8::Gemm g{KB, Wq_t, 4096, D, 512, D}; pg8::PreQKOrder S{G, bx, 128, Wout_t, (const bf16_t*)(ws + WS_PWN)}; pg8::EpiPre E{(bf16_t*)(ws + WS_WQK), Wout_t}; pg8::gemm_phase<pg8::EpiPre, pg8::PreQKOrder, true, true>(lds, g, S, E); }
    { pg8::Gemm g{Wo_t, VTM, 8192, 1024, 512, D}; pg8::PreVOOrder S{G, (bx + G - 128 % G) % G}; pg8::EpiPlain E{(bf16_t*)(ws + WS_VWO), 1024}; pg8::gemm_phase<pg8::EpiPlain, pg8::PreVOOrder, true, true>(lds, g, S, E); }
#endif
    xcd_barrier(xbar);
    STAMP(102);
    for (int rep = 0; rep < REP_P3; ++rep) { pg8::Gemm g{Yb, Wout_t, M, D, D, D}; pg8::StaticOrder S; S.init(M, D, G, bx); pg8::EpiResid<false> E{nullptr, XB, XB, SS1, D, (LAS float*)(lds + 131072)}; GEMM_PHASE(pg8::EpiResid<false>, g, S, E); }
    xcd_barrier(xbar);
    STAMP(103);
#if ABSORB
    { pg8::Gemm g{XB, (const bf16_t*)(ws + WS_WQK), M, 1024, D, D}; pg8::ScoreOrder S{G, bx}; pg8::EpiSoftmaxN E{(bf16_t*)(ws + WS_PM), SS1, 1.0f / D, (LAS float*)(lds + 131072), 0.044194173824159216f * 1.4426950408889634f};
      pg8::gemm_phase<pg8::EpiSoftmaxN, pg8::ScoreOrder, true, true>(lds, g, S, E); }
    xcd_barrier(xbar);
    STAMP(104);
    { pg8::Gemm g{(const bf16_t*)(ws + WS_PM), (const bf16_t*)(ws + WS_VWO), M, D, 1024, 1024}; pg8::AttnOutOrder S{G, bx}; pg8::EpiResid<false> E{nullptr, XB, XB, SS2, D, (LAS float*)(lds + 131072)};
      pg8::gemm_phase<pg8::EpiResid<false>, pg8::AttnOutOrder, true, true>(lds, g, S, E); }
    xcd_barrier(xbar);
    STAMP(108);
#else
    for (int rep = 0; rep < REP_P4; ++rep) { pg8::Gemm g{XB, Wq_t, M, D, D, D}; pg8::StaticOrder S; S.init(M, D, G, bx); pg8::EpiRowScale E{Qb, D, SS1, 1.0f / D}; GEMM_PHASE(pg8::EpiRowScale, g, S, E); }
    xcd_barrier(xbar);
    STAMP(104);
#if OLD_ATTN
    for (int u = bx; u < 512 * REP_P5; u += G) attn_unit(lds, u & 511, Qb, KB, VTM, Ob, (int)threadIdx.x);
    xcd_barrier(xbar);
    STAMP(105);
#else
    for (int rep = 0; rep < REP_P5; ++rep) {
    { pg8::Gemm g{Qb, KB, M, 1024, 512, D}; pg8::AttnSOrder S{G, bx}; pg8::EpiSoftmax E{(bf16_t*)(ws + WS_PM), (float*)(ws + WS_RSP), (LAS float*)(lds + 131072), 0.044194173824159216f * 1.4426950408889634f};
      pg8::gemm_phase<pg8::EpiSoftmax, pg8::AttnSOrder, true, true>(lds, g, S, E); }
    xcd_barrier(xbar);
    STAMP(106);
    { pg8::Gemm g{(const bf16_t*)(ws + WS_PM), VTM, M, 2048, 256, 1024}; pg8::AttnPVOrder S{G, bx}; pg8::EpiAttnOut E{Ob, (const float*)(ws + WS_RSP)};
      pg8::gemm_phase<pg8::EpiAttnOut, pg8::AttnPVOrder, true, true>(lds, g, S, E); }
    xcd_barrier(xbar);
    STAMP(107);
    }
#endif
    { pg8::Gemm g{Ob, Wo_t, M, D, D, D}; pg8::StaticOrder S; S.init(M, D, G, bx); pg8::EpiResid<false> E{nullptr, XB, XB, SS2, D, (LAS float*)(lds + 131072)}; GEMM_PHASE(pg8::EpiResid<false>, g, S, E); }
    xcd_barrier(xbar);
    STAMP(108);
#endif
    for (int rep = 0; rep < REP_P7; ++rep) { pg8::Gemm g{XB, Wgu_t, M, 2 * DFF, D, D}; pg8::StaticOrder S; S.init(M, 2 * DFF, G, bx); pg8::EpiSwiglu E{HG, DFF, SS2, 1.0f / D}; GEMM_PHASE(pg8::EpiSwiglu, g, S, E); }
    xcd_barrier(xbar);
    STAMP(109);
#ifndef FUSE_FINAL
#define FUSE_FINAL 1
#endif
    if (FUSE_FINAL && G == 256) {
        pg8::Gemm g{HG, Wd_t, M, D, DFF, DFF}; pg8::DownOrder S{bx}; pg8::EpiFinal E{XB, out, SS3, (unsigned*)(ws + WS_PCNT), final_norm_g, (LAS float*)(lds + 131072), D};
        pg8::gemm_phase<pg8::EpiFinal, pg8::DownOrder, true, true>(lds, g, S, E);
    } else {
    { pg8::Gemm g{HG, Wd_t, M, D, DFF, DFF}; pg8::StaticOrder S; S.init(M, D, G, bx); pg8::EpiResid<false> E{nullptr, XB, XB, SS3, D, (LAS float*)(lds + 131072)}; GEMM_PHASE(pg8::EpiResid<false>, g, S, E); }
    xcd_barrier(xbar);
    STAMP(110);
    { const int tid = TID_FRESH(), lane = tid & 63, wave = __builtin_amdgcn_readfirstlane(tid >> 6); const int gw = bx * NWAVES + wave, NGW = G * NWAVES;
      for (int m0 = gw; m0 < M; m0 += 4 * NGW) {
          u32x4 w[4][4]; f32x4 pa[4], pb[4];
#pragma unroll
          for (int q = 0; q < 4; ++q) { const int m = m0 + q * NGW; if (m < M) { pa[q] = *(const f32x4*)(SS3 + (size_t)m * 8); pb[q] = *(const f32x4*)(SS3 + (size_t)m * 8 + 4);
#pragma unroll
              for (int j = 0; j < 4; ++j) w[q][j] = *(const u32x4*)(XB + (size_t)m * D + (lane + 64 * j) * 8); } }
#pragma unroll
          for (int q = 0; q < 4; ++q) { const int m = m0 + q * NGW; if (m < M) {
              const float rstd = 1.0f / sqrtf((((pa[q][0] + pa[q][1]) + (pa[q][2] + pa[q][3])) + ((pb[q][0] + pb[q][1]) + (pb[q][2] + pb[q][3]))) * (1.0f / D) + RMS_EPS);
#pragma unroll
              for (int j = 0; j < 4; ++j) { const int c = (lane + 64 * j) * 8; const f32x4 g0 = *(const f32x4*)(final_norm_g + c), g1 = *(const f32x4*)(final_norm_g + c + 4); const u32x4 ww = w[q][j];
                  const f32x4 y0 = (f32x4){bf_lo(ww.x), bf_hi(ww.x), bf_lo(ww.y), bf_hi(ww.y)} * rstd * g0, y1 = (f32x4){bf_lo(ww.z), bf_hi(ww.z), bf_lo(ww.w), bf_hi(ww.w)} * rstd * g1;
                  *(f32x4*)(out + (size_t)m * D + c) = y0; *(f32x4*)(out + (size_t)m * D + c + 4) = y1; } } } } }
    }
    if (TS_K >= 0 && bx == 0 && threadIdx.x == 0) { const unsigned dt = ts_lds[1] - ts_lds[0]; const unsigned t0 = (unsigned)__builtin_amdgcn_s_memrealtime(); while ((unsigned)__builtin_amdgcn_s_memrealtime() - t0 < dt) __builtin_amdgcn_s_sleep(8); }
}

extern "C" void kernel_launch(void* const* d_in, const int* in_sizes, int n_in, void* d_out, int out_size, void* d_ws, size_t ws_size, hipStream_t stream) {
    static int grid = 0;
    if (grid == 0) {
        if (n_in != 21 || in_sizes[0] != M * D || out_size != M * D || ws_size < WS_END) { fprintf(stderr, "kernel_launch: unexpected shapes (n_in %d, in0 %d, out %d, ws %zu); nothing launched\n", n_in, n_in > 0 ? in_sizes[0] : -1, out_size, ws_size); grid = -1; return; }
        int dev = 0, cus = 0, per_cu = 0;
        if (hipGetDevice(&dev) != hipSuccess || hipDeviceGetAttribute(&cus, hipDeviceAttributeMultiprocessorCount, dev) != hipSuccess) { grid = -1; return; }
        if (hipFuncSetAttribute((const void*)mk_fwd, hipFuncAttributeMaxDynamicSharedMemorySize, LDS_BYTES) != hipSuccess) { fprintf(stderr, "kernel_launch: hipFuncSetAttribute failed\n"); grid = -1; return; }
        if (hipOccupancyMaxActiveBlocksPerMultiprocessor(&per_cu, (const void*)mk_fwd, NTHR, LDS_BYTES) != hipSuccess || per_cu < 1) { fprintf(stderr, "kernel_launch: occupancy query says %d blocks per CU\n", per_cu); (void)hipGetLastError(); grid = -1; return; }
        grid = cus * per_cu;
    }
    if (grid < 0) return;
    if (hipMemsetAsync(d_ws, 0, WS_ZERO_BYTES, stream) != hipSuccess) { fprintf(stderr, "kernel_launch: hipMemsetAsync failed\n"); return; }
    Args a{};
    for (int i = 0; i < 21; ++i) a.in[i] = (const float*)d_in[i];
    a.out = (float*)d_out; a.ws = (unsigned char*)d_ws;
    void* args[] = {&a};
    const hipError_t e = hipLaunchCooperativeKernel((const void*)mk_fwd, dim3(grid), dim3(NTHR), args, LDS_BYTES, stream);
    if (e != hipSuccess) fprintf(stderr, "kernel_launch: cooperative launch failed: %s (grid %d)\n", hipGetErrorString(e), grid);
}
```

```cpp
#include <hip/hip_runtime.h>
#include <hip/hip_cooperative_groups.h>
#include <cstdio>
#include <cstdint>
namespace cg = cooperative_groups;
namespace pg8 {
#define PG8_LAS __attribute__((address_space(3)))
typedef unsigned short bf16_t;
typedef short bf16x8 __attribute__((ext_vector_type(8)));
typedef float f32x4 __attribute__((ext_vector_type(4)));
typedef unsigned u32x4 __attribute__((ext_vector_type(4)));
constexpr int BM = 256, BK = 64, HALF = 128, HTB = HALF * BK * 2  , STAGE_BYTES = 8 * HTB, NXCD = 8, WGM = 8;

__host__ __device__ __forceinline__ int lds_byte(int r, int c) { const int st = (r >> 4) * 2 + (c >> 5), rr = r & 15, cc = c & 31, ob = rr * 64 + cc * 2; return st * 1024 + (ob ^ (((ob >> 9) & 1) << 5)); }
__host__ __device__ __forceinline__ void stage_rc(int b, int& R, int& C) { const int st = b / 1024, sb = b % 1024, swz = sb ^ (((sb >> 9) & 1) << 5); R = (st >> 1) * 16 + swz / 64; C = (st & 1) * 32 + (swz % 64) / 2; }
__host__ __device__ __forceinline__ int perm32(int rho) { const int n = rho >> 4, i = rho & 15; return 8 * (i >> 2) + 4 * n + (i & 3); }

__device__ __forceinline__ const bf16_t* sel_ptr(bool c, const bf16_t* a, const bf16_t* b) { const unsigned long long m = 0ull - (unsigned long long)c; return (const bf16_t*)((((unsigned long long)a) & m) | (((unsigned long long)b) & ~m)); }
struct Unit { int pm, pn; const char* a = nullptr; const char* b = nullptr; };
struct Gemm { const bf16_t* A; const bf16_t* Bt; int M, N, K, ld; };

struct StaticOrder {
    int nM, nN, nwg, G, c;
    __host__ __device__ void init(int M, int N, int G_, int c_) { nM = M / BM; nN = N / BM; nwg = nM * nN; G = G_; c = c_; }
    __host__ __device__ bool next(int i, Unit& u) const {
        const long L = (long)i * G + c; if (L >= nwg) return false;
        int wgid = (int)L; { const int q = nwg / NXCD, r = nwg % NXCD, xcd = wgid % NXCD, off = wgid / NXCD; wgid = (xcd < r ? xcd * (q + 1) : r * (q + 1) + (xcd - r) * q) + off; }
        const int nig = WGM * nN, gid = wgid / nig, fm = gid * WGM, gsz = (nM - fm) < WGM ? (nM - fm) : WGM;
        u.pm = fm + ((wgid % nig) % gsz); u.pn = (wgid % nig) / gsz; return true;
    }
    __device__ __forceinline__ void a_ready(const Unit&) const {}
    __device__ __forceinline__ void done(const Unit&) const {}
    __device__ __forceinline__ const char* pA(const Gemm& g, const Unit& u) const { return (const char*)g.A + (size_t)u.pm * BM * g.ld * 2; }
    __device__ __forceinline__ const char* pB(const Gemm& g, const Unit& u) const { return (const char*)g.Bt + (size_t)u.pn * BM * g.ld * 2; }
};
struct DownOrder {
    int c;
    __device__ bool next(int i, Unit& u) const { if (i > 1) return false; const int xcd = c & 7, j = c >> 3; u.pm = i * 32 + xcd * 4 + (j >> 3); u.pn = j & 7; return true; }
    __device__ __forceinline__ void a_ready(const Unit&) const {}
    __device__ __forceinline__ void done(const Unit&) const {}
    __device__ __forceinline__ const char* pA(const Gemm& g, const Unit& u) const { return (const char*)g.A + (size_t)u.pm * BM * g.ld * 2; }
    __device__ __forceinline__ const char* pB(const Gemm& g, const Unit& u) const { return (const char*)g.Bt + (size_t)u.pn * BM * g.ld * 2; }
};
struct PreQKOrder {
    int G, c0, cmax; const bf16_t* Wout_t; const bf16_t* PWn;
    __device__ __forceinline__ bool next(int i, Unit& u) const { const int c = i * G + c0; if (c >= cmax) return false;
        if (c < 128) { u.pm = (c >> 5) * 4 + ((c >> 3) & 3); u.pn = c & 7; } else { const int q = c - 128; u.pm = 0x1000 | (q >> 2); u.pn = q & 3; } return true; }
    __device__ __forceinline__ void a_ready(const Unit&) const {}
    __device__ __forceinline__ void done(const Unit&) const {}
    __device__ __forceinline__ const char* pA(const Gemm& g, const Unit& u) const { const bool pw = (u.pm & 0x1000) != 0;
        const bf16_t* p = sel_ptr(pw, Wout_t + (size_t)(u.pm & 0xfff) * 256 * 2048 + u.pn * 256, g.A + (size_t)((u.pm & 0xfff) >> 2) * 256 * 2048 + (u.pm & 3) * 512); return (const char*)p; }
    __device__ __forceinline__ const char* pB(const Gemm& g, const Unit& u) const { const bool pw = (u.pm & 0x1000) != 0;
        const bf16_t* p = sel_ptr(pw, PWn + (size_t)u.pn * 256 * 2048, g.Bt + (size_t)u.pn * 256 * 2048 + (u.pm & 3) * 512); return (const char*)p; }
};
struct PreVOOrder {
    int G, c0;
    __device__ bool next(int i, Unit& u) const { const int c = i * G + c0; if (c >= 128) return false; u.pm = (c >> 5) * 8 + ((c >> 2) & 7); u.pn = c & 3; return true; }
    __device__ __forceinline__ void a_ready(const Unit&) const {}
    __device__ __forceinline__ void done(const Unit&) const {}
    __device__ __forceinline__ const char* pA(const Gemm& g, const Unit& u) const { return (const char*)(g.A + (size_t)(u.pm & 7) * 256 * 2048 + u.pn * 512); }
    __device__ __forceinline__ const char* pB(const Gemm& g, const Unit& u) const { return (const char*)(g.Bt + (size_t)(u.pm >> 3) * 256 * 2048 + u.pn * 512); }
};
struct ScoreOrder {
    int G, c;
    __device__ bool next(int i, Unit& u) const { if (G != 256) { const int L = i * G + c; if (L >= 256) return false; u.pm = L >> 2; u.pn = L & 3; return true; }
        if (i > 0) return false; const int xcd = c & 7, j = c >> 3; u.pm = xcd * 8 + (j >> 2); u.pn = j & 3; return true; }
    __device__ __forceinline__ void a_ready(const Unit&) const {}
    __device__ __forceinline__ void done(const Unit&) const {}
    __device__ __forceinline__ const char* pA(const Gemm& g, const Unit& u) const { return (const char*)(g.A + (size_t)u.pm * BM * 2048); }
    __device__ __forceinline__ const char* pB(const Gemm& g, const Unit& u) const { return (const char*)(g.Bt + (size_t)((u.pm >> 4) * 1024 + u.pn * 256) * 2048); }
};
struct AttnOutOrder {
    int G, c;
    __device__ bool next(int i, Unit& u) const { if (G != 256) { const int L = i * G + c; if (L >= 512) return false; u.pm = L >> 3; u.pn = L & 7; return true; }
        if (i > 1) return false; const int xcd = c & 7, j = c >> 3; u.pm = xcd * 8 + i * 4 + (j >> 3); u.pn = j & 7; return true; }
    __device__ __forceinline__ void a_ready(const Unit&) const {}
    __device__ __forceinline__ void done(const Unit&) const {}
    __device__ __forceinline__ const char* pA(const Gemm& g, const Unit& u) const { return (const char*)(g.A + (size_t)u.pm * BM * 1024); }
    __device__ __forceinline__ const char* pB(const Gemm& g, const Unit& u) const { return (const char*)(g.Bt + (size_t)((u.pm >> 4) * 2048 + u.pn * 256) * 1024); }
};
struct AttnSOrder {
    int G, c;
    __device__ bool next(int i, Unit& u) const { const int L = i * G + c; if (L >= 256) return false; u.pm = L >> 2; u.pn = L & 3; return true; }
    __device__ __forceinline__ void a_ready(const Unit&) const {}
    __device__ __forceinline__ void done(const Unit&) const {}
    __device__ __forceinline__ const char* pA(const Gemm& g, const Unit& u) const { return (const char*)(g.A + (size_t)u.pm * BM * 2048 + u.pn * 512); }
    __device__ __forceinline__ const char* pB(const Gemm& g, const Unit& u) const { return (const char*)(g.Bt + (size_t)(u.pm >> 4) * 256 * 2048 + u.pn * 512); }
};
struct AttnPVOrder {
    int G, c;
    __device__ bool next(int i, Unit& u) const { const int L = i * G + c; if (L >= 512) return false; u.pm = L >> 3; u.pn = L & 7; return true; }
    __device__ __forceinline__ void a_ready(const Unit&) const {}
    __device__ __forceinline__ void done(const Unit&) const {}
    __device__ __forceinline__ const char* pA(const Gemm& g, const Unit& u) const { return (const char*)(g.A + (size_t)u.pm * BM * 1024 + (u.pn >> 1) * 256); }
    __device__ __forceinline__ const char* pB(const Gemm& g, const Unit& u) const { return (const char*)(g.Bt + (size_t)u.pn * BM * 1024 + (u.pm >> 4) * 256); }
};

typedef __bf16 bf16x2v_ __attribute__((ext_vector_type(2)));
typedef float f32x2v_ __attribute__((ext_vector_type(2)));
__device__ __forceinline__ unsigned cvt_pk_bf16(float lo, float hi) { const f32x2v_ f = {lo, hi}; const bf16x2v_ b = __builtin_convertvector(f, bf16x2v_); return __builtin_bit_cast(unsigned, b); }
typedef unsigned u32x2 __attribute__((ext_vector_type(2)));
constexpr float RMS_EPS = 1e-6f;

struct EpiPlain {
    static constexpr bool PERM = true, AFTER_DRAIN = false;
    bf16_t* O; int ldc;
    __device__ __forceinline__ void operator()(const f32x4 (&acc)[2][2][4][2], const Unit& u, int wr, int wc, int fr, int fq) const {
        { const int l_ = (int)__builtin_amdgcn_mbcnt_hi(~0u, __builtin_amdgcn_mbcnt_lo(~0u, 0u)); fr = l_ & 15; fq = l_ >> 4; }
        const int row0 = u.pm * BM + wr * 64 + fr, col0 = u.pn * BM + wc * 32 + 8 * fq;
#pragma unroll
        for (int ai = 0; ai < 2; ++ai)
#pragma unroll
            for (int m = 0; m < 4; ++m) { bf16_t* rowp = O + (size_t)(row0 + ai * HALF + m * 16) * ldc + col0;
#pragma unroll
                for (int bj = 0; bj < 2; ++bj) { const f32x4 v0 = acc[ai][bj][m][0], v1 = acc[ai][bj][m][1];
                    u32x4 w; w.x = cvt_pk_bf16(v0[0], v0[1]); w.y = cvt_pk_bf16(v0[2], v0[3]); w.z = cvt_pk_bf16(v1[0], v1[1]); w.w = cvt_pk_bf16(v1[2], v1[3]);
                    *(u32x4*)(rowp + bj * HALF) = w; } }
    }
};
struct EpiPre {
    static constexpr bool PERM = true, AFTER_DRAIN = false;
    bf16_t* WQK; bf16_t* Wout_t;
    __device__ __forceinline__ void operator()(const f32x4 (&acc)[2][2][4][2], const Unit& u, int wr, int wc, int fr, int fq) const {
        const bool pw = (u.pm & 0x1000) != 0; Unit t; t.pm = u.pm & 0xfff; t.pn = u.pn; const EpiPlain E{(bf16_t*)sel_ptr(pw, Wout_t, WQK), 2048}; E(acc, t, wr, wc, fr, fq);
    }
};
struct EpiRowScale {
    static constexpr bool PERM = true, AFTER_DRAIN = false;
    bf16_t* O; int ldc; const float* SS; float inv_n;
    __device__ __forceinline__ void operator()(const f32x4 (&acc)[2][2][4][2], const Unit& u, int wr, int wc, int fr, int fq) const {
        const int row0 = u.pm * BM + wr * 64 + fr, col0 = u.pn * BM + wc * 32 + 8 * fq;
#pragma unroll
        for (int ai = 0; ai < 2; ++ai)
#pragma unroll
            for (int m = 0; m < 4; ++m) { const int row = row0 + ai * HALF + m * 16; bf16_t* rowp = O + (size_t)row * ldc + col0;
                const f32x4 pa = *(const f32x4*)(SS + (size_t)row * 8), pb = *(const f32x4*)(SS + (size_t)row * 8 + 4); const float rs = __builtin_amdgcn_rsqf((((pa[0] + pa[1]) + (pa[2] + pa[3])) + ((pb[0] + pb[1]) + (pb[2] + pb[3]))) * inv_n + RMS_EPS);
#pragma unroll
                for (int bj = 0; bj < 2; ++bj) { const f32x4 v0 = acc[ai][bj][m][0] * rs, v1 = acc[ai][bj][m][1] * rs;
                    u32x4 w; w.x = cvt_pk_bf16(v0[0], v0[1]); w.y = cvt_pk_bf16(v0[2], v0[3]); w.z = cvt_pk_bf16(v1[0], v1[1]); w.w = cvt_pk_bf16(v1[2], v1[3]);
                    *(u32x4*)(rowp + bj * HALF) = w; } }
    }
};
struct EpiRowScaleC {
    static constexpr bool PERM = true, AFTER_DRAIN = false;
    bf16_t* O; int ldc; const float* RS;
    __device__ __forceinline__ void operator()(const f32x4 (&acc)[2][2][4][2], const Unit& u, int wr, int wc, int fr, int fq) const {
        const int row0 = u.pm * BM + wr * 64 + fr, col0 = u.pn * BM + wc * 32 + 8 * fq;
#pragma unroll
        for (int ai = 0; ai < 2; ++ai)
#pragma unroll
            for (int m = 0; m < 4; ++m) { const int row = row0 + ai * HALF + m * 16; bf16_t* rowp = O + (size_t)row * ldc + col0; const float rs = RS[row];
#pragma unroll
                for (int bj = 0; bj < 2; ++bj) { const f32x4 v0 = acc[ai][bj][m][0] * rs, v1 = acc[ai][bj][m][1] * rs;
                    u32x4 w; w.x = cvt_pk_bf16(v0[0], v0[1]); w.y = cvt_pk_bf16(v0[2], v0[3]); w.z = cvt_pk_bf16(v1[0], v1[1]); w.w = cvt_pk_bf16(v1[2], v1[3]);
                    *(u32x4*)(rowp + bj * HALF) = w; } }
    }
};
struct EpiColScale {
    static constexpr bool PERM = true, AFTER_DRAIN = false;
    bf16_t* O; int ldc; const float* RS;
    __device__ __forceinline__ void operator()(const f32x4 (&acc)[2][2][4][2], const Unit& u, int wr, int wc, int fr, int fq) const {
        const int row0 = u.pm * BM + wr * 64 + fr, col0 = u.pn * BM + wc * 32 + 8 * fq;
        f32x4 c0[2], c1[2];
#pragma unroll
        for (int bj = 0; bj < 2; ++bj) { c0[bj] = *(const f32x4*)(RS + col0 + bj * HALF); c1[bj] = *(const f32x4*)(RS + col0 + bj * HALF + 4); }
#pragma unroll
        for (int ai = 0; ai < 2; ++ai)
#pragma unroll
            for (int m = 0; m < 4; ++m) { bf16_t* rowp = O + (size_t)(row0 + ai * HALF + m * 16) * ldc + col0;
#pragma unroll
                for (int bj = 0; bj < 2; ++bj) { const f32x4 v0 = acc[ai][bj][m][0] * c0[bj], v1 = acc[ai][bj][m][1] * c1[bj];
                    u32x4 w; w.x = cvt_pk_bf16(v0[0], v0[1]); w.y = cvt_pk_bf16(v0[2], v0[3]); w.z = cvt_pk_bf16(v1[0], v1[1]); w.w = cvt_pk_bf16(v1[2], v1[3]);
                    *(u32x4*)(rowp + bj * HALF) = w; } }
    }
};
struct InProjOrder {
    int G, c, cv, na, nb, nk, nv;
    const bf16_t *XB, *Win_t, *MN, *Wk_t, *Wv_t;
    static __device__ __forceinline__ int count(int nwg, int c, int G) { return c < nwg ? (nwg - c + G - 1) / G : 0; }
    __device__ __forceinline__ void init(int G_, int bx, const bf16_t* XB_, const bf16_t* Win_t_, const bf16_t* MN_, const bf16_t* Wk_t_, const bf16_t* Wv_t_) {
        G = G_; c = bx; cv = (bx + G_ - 32 % G_) % G_; na = count(512, c, G); nb = count(256, c, G); nk = count(32, c, G); nv = count(32, cv, G);
        XB = XB_; Win_t = Win_t_; MN = MN_; Wk_t = Wk_t_; Wv_t = Wv_t_; }
    __device__ __forceinline__ bool next(int i, Unit& u) const {
        StaticOrder t; t.G = G; bool ok;
        if (i < na) { t.nM = 64; t.nN = 8; t.nwg = 512; t.c = c; ok = t.next(i, u); u.a = (const char*)(XB + (size_t)u.pm * BM * 2048); u.b = (const char*)(Win_t + (size_t)u.pn * BM * 2048); }
        else if (i < na + nb) { t.nM = 4; t.nN = 64; t.nwg = 256; t.c = c; ok = t.next(i - na, u); u.a = (const char*)(Win_t + (size_t)(2048 + u.pm * BM) * 2048); u.b = (const char*)(XB + (size_t)u.pn * BM * 2048); u.pn |= 1 << 16; }
        else if (i < na + nb + nk) { t.nM = 4; t.nN = 8; t.nwg = 32; t.c = c; ok = t.next(i - na - nb, u); u.a = (const char*)(MN + (size_t)u.pm * BM * 2048); u.b = (const char*)(Wk_t + (size_t)u.pn * BM * 2048); u.pn |= 2 << 16; }
        else if (i < na + nb + nk + nv) { t.nM = 4; t.nN = 8; t.nwg = 32; t.c = cv; ok = t.next(i - na - nb - nk, u); u.a = (const char*)(MN + (size_t)u.pm * BM * 2048); u.b = (const char*)(Wv_t + (size_t)u.pn * BM * 2048); u.pn |= 3 << 16; }
        else return false;
        return ok; }
    __device__ __forceinline__ void a_ready(const Unit&) const {}
    __device__ __forceinline__ void done(const Unit&) const {}
    __device__ __forceinline__ const char* pA(const Gemm&, const Unit& u) const { return u.a; }
    __device__ __forceinline__ const char* pB(const Gemm&, const Unit& u) const { return u.b; }
};
struct EpiInProj {
    static constexpr bool PERM = true, AFTER_DRAIN = false;
    bf16_t *PAU, *VT, *KB, *VB; const float* RS0;
    __device__ __forceinline__ void operator()(const f32x4 (&acc)[2][2][4][2], const Unit& u, int wr, int wc, int fr, int fq) const {
        const int kind = u.pn >> 16; Unit t; t.pm = u.pm; t.pn = u.pn & 0xffff;
        if (kind == 0) { EpiRowScaleC E{PAU, 2048, RS0}; E(acc, t, wr, wc, fr, fq); }
        else if (kind == 1) { EpiColScale E{VT, 16384, RS0}; E(acc, t, wr, wc, fr, fq); }
        else { EpiPlain E{kind == 2 ? KB : VB, 2048}; E(acc, t, wr, wc, fr, fq); }
    }
};
__device__ __forceinline__ float silu_mul(float g, float u) { return g * u * __builtin_amdgcn_rcpf(1.0f + __expf(-g)); }
struct EpiSwiglu {
    static constexpr bool PERM = true, AFTER_DRAIN = false;
    bf16_t* O; int ldc; const float* SS; float inv_n;
    __device__ __forceinline__ void operator()(const f32x4 (&acc)[2][2][4][2], const Unit& u, int wr, int wc, int fr, int fq) const {
        const int row0 = u.pm * BM + wr * 64 + fr, col0 = u.pn * HALF + wc * 32 + 8 * fq;
#pragma unroll
        for (int ai = 0; ai < 2; ++ai)
#pragma unroll
            for (int m = 0; m < 4; ++m) { const int row = row0 + ai * HALF + m * 16;
                const f32x4 pa = *(const f32x4*)(SS + (size_t)row * 8), pb = *(const f32x4*)(SS + (size_t)row * 8 + 4); const float rs = __builtin_amdgcn_rsqf((((pa[0] + pa[1]) + (pa[2] + pa[3])) + ((pb[0] + pb[1]) + (pb[2] + pb[3]))) * inv_n + RMS_EPS);
                const f32x4 g0 = acc[ai][0][m][0] * rs, g1 = acc[ai][0][m][1] * rs, u0 = acc[ai][1][m][0] * rs, u1 = acc[ai][1][m][1] * rs;
                u32x4 w;
                w.x = cvt_pk_bf16(silu_mul(g0[0], u0[0]), silu_mul(g0[1], u0[1])); w.y = cvt_pk_bf16(silu_mul(g0[2], u0[2]), silu_mul(g0[3], u0[3]));
                w.z = cvt_pk_bf16(silu_mul(g1[0], u1[0]), silu_mul(g1[1], u1[1])); w.w = cvt_pk_bf16(silu_mul(g1[2], u1[2]), silu_mul(g1[3], u1[3]));
                *(u32x4*)(O + (size_t)row * ldc + col0) = w; }
    }
};
struct EpiSoftmax {
    static constexpr bool PERM = true, AFTER_DRAIN = false;
    bf16_t* P; float* RSP; __attribute__((address_space(3))) float* xm; float sl2;
    __device__ __forceinline__ void operator()(const f32x4 (&acc)[2][2][4][2], const Unit& u, int wr, int wc, int fr, int fq) const {
        const int h = u.pn;
#pragma unroll
        for (int ai = 0; ai < 2; ++ai)
#pragma unroll
            for (int m = 0; m < 4; ++m) { float v = -3.0e38f;
#pragma unroll
                for (int bj = 0; bj < 2; ++bj)
#pragma unroll
                    for (int n = 0; n < 2; ++n) { const f32x4 x = acc[ai][bj][m][n]; v = fmaxf(v, fmaxf(fmaxf(x[0], x[1]), fmaxf(x[2], x[3]))); }
                v = fmaxf(v, __shfl_xor(v, 16)); v = fmaxf(v, __shfl_xor(v, 32));
                if (fq == 0) xm[(ai * HALF + wr * 64 + m * 16 + fr) * 4 + wc] = v; }
        asm volatile("s_waitcnt lgkmcnt(0)" ::: "memory"); __builtin_amdgcn_s_barrier(); asm volatile("" ::: "memory");
#pragma unroll
        for (int ai = 0; ai < 2; ++ai)
#pragma unroll
            for (int m = 0; m < 4; ++m) { const int r = ai * HALF + wr * 64 + m * 16 + fr; const int row = u.pm * BM + r;
                const f32x4 mm = *(const __attribute__((address_space(3))) f32x4*)(xm + r * 4); const float mx = fmaxf(fmaxf(mm[0], mm[1]), fmaxf(mm[2], mm[3])) * sl2; float s = 0.f;
#pragma unroll
                for (int bj = 0; bj < 2; ++bj) { f32x4 p0, p1;
#pragma unroll
                    for (int j = 0; j < 4; ++j) { p0[j] = __builtin_amdgcn_exp2f(acc[ai][bj][m][0][j] * sl2 - mx); p1[j] = __builtin_amdgcn_exp2f(acc[ai][bj][m][1][j] * sl2 - mx); }
                    s += ((p0[0] + p0[1]) + (p0[2] + p0[3])) + ((p1[0] + p1[1]) + (p1[2] + p1[3]));
                    u32x4 w; w.x = cvt_pk_bf16(p0[0], p0[1]); w.y = cvt_pk_bf16(p0[2], p0[3]); w.z = cvt_pk_bf16(p1[0], p1[1]); w.w = cvt_pk_bf16(p1[2], p1[3]);
                    *(u32x4*)(P + (size_t)row * 1024 + h * 256 + bj * HALF + wc * 32 + 8 * fq) = w; }
                s += __shfl_xor(s, 16); s += __shfl_xor(s, 32);
                if (fq == 0) RSP[(size_t)row * 16 + h * 4 + wc] = s; }
    }
};
struct EpiSoftmaxN {
    static constexpr bool PERM = true, AFTER_DRAIN = false;
    bf16_t* P; const float* SS; float inv_n; __attribute__((address_space(3))) float* xm; float sl2;
    __device__ __forceinline__ void operator()(f32x4 (&acc)[2][2][4][2], const Unit& u, int wr, int wc, int fr, int fq) const {
        { const int l_ = (int)__builtin_amdgcn_mbcnt_hi(~0u, __builtin_amdgcn_mbcnt_lo(~0u, 0u)); fr = l_ & 15; fq = l_ >> 4; }
        const int h = u.pn; __attribute__((address_space(3))) float* xs = xm + 1024;
#pragma unroll
        for (int ai = 0; ai < 2; ++ai)
#pragma unroll
            for (int m = 0; m < 4; ++m) { float v = -3.0e38f;
#pragma unroll
                for (int bj = 0; bj < 2; ++bj)
#pragma unroll
                    for (int n = 0; n < 2; ++n) { const f32x4 x = acc[ai][bj][m][n]; v = fmaxf(v, fmaxf(fmaxf(x[0], x[1]), fmaxf(x[2], x[3]))); }
                v = fmaxf(v, __shfl_xor(v, 16)); v = fmaxf(v, __shfl_xor(v, 32));
                if (fq == 0) xm[(ai * HALF + wr * 64 + m * 16 + fr) * 4 + wc] = v; }
        asm volatile("s_waitcnt lgkmcnt(0)" ::: "memory"); __builtin_amdgcn_s_barrier(); asm volatile("" ::: "memory");
#pragma unroll
        for (int ai = 0; ai < 2; ++ai)
#pragma unroll
            for (int m = 0; m < 4; ++m) { const int r = ai * HALF + wr * 64 + m * 16 + fr; const int row = u.pm * BM + r;
                const f32x4 pa = *(const f32x4*)(SS + (size_t)row * 8), pb = *(const f32x4*)(SS + (size_t)row * 8 + 4);
                const float f = sl2 * __builtin_amdgcn_rsqf((((pa[0] + pa[1]) + (pa[2] + pa[3])) + ((pb[0] + pb[1]) + (pb[2] + pb[3]))) * inv_n + RMS_EPS);
                const f32x4 mm = *(const __attribute__((address_space(3))) f32x4*)(xm + r * 4); const float mx = fmaxf(fmaxf(mm[0], mm[1]), fmaxf(mm[2], mm[3])) * f; float s = 0.f;
#pragma unroll
                for (int bj = 0; bj < 2; ++bj)
#pragma unroll
                    for (int n = 0; n < 2; ++n) { f32x4 p;
#pragma unroll
                        for (int j = 0; j < 4; ++j) p[j] = __builtin_amdgcn_exp2f(acc[ai][bj][m][n][j] * f - mx);
                        acc[ai][bj][m][n] = p; s += (p[0] + p[1]) + (p[2] + p[3]); }
                s += __shfl_xor(s, 16); s += __shfl_xor(s, 32);
                if (fq == 0) xs[r * 4 + wc] = s; }
        asm volatile("s_waitcnt lgkmcnt(0)" ::: "memory"); __builtin_amdgcn_s_barrier(); asm volatile("" ::: "memory");
#pragma unroll
        for (int ai = 0; ai < 2; ++ai)
#pragma unroll
            for (int m = 0; m < 4; ++m) { const int r = ai * HALF + wr * 64 + m * 16 + fr; const int row = u.pm * BM + r;
                const f32x4 ps = *(const __attribute__((address_space(3))) f32x4*)(xs + r * 4); const float inv = 1.0f / ((ps[0] + ps[1]) + (ps[2] + ps[3]));
#pragma unroll
                for (int bj = 0; bj < 2; ++bj) { const f32x4 v0 = acc[ai][bj][m][0] * inv, v1 = acc[ai][bj][m][1] * inv;
                    u32x4 w; w.x = cvt_pk_bf16(v0[0], v0[1]); w.y = cvt_pk_bf16(v0[2], v0[3]); w.z = cvt_pk_bf16(v1[0], v1[1]); w.w = cvt_pk_bf16(v1[2], v1[3]);
                    *(u32x4*)(P + (size_t)row * 1024 + h * 256 + bj * HALF + wc * 32 + 8 * fq) = w; } }
    }
};
struct EpiFinal {
    static constexpr bool PERM = true, AFTER_DRAIN = false;
    const bf16_t* res16; float* out; float* SS; unsigned* cnt; const float* gfin; __attribute__((address_space(3))) float* xs; int ldc;
    __device__ __forceinline__ void operator()(f32x4 (&acc)[2][2][4][2], const Unit& u, int wr, int wc, int fr, int fq) const {
        const int lane = (int)__builtin_amdgcn_mbcnt_hi(~0u, __builtin_amdgcn_mbcnt_lo(~0u, 0u)); fr = lane & 15; fq = lane >> 4;
        __attribute__((address_space(3))) float* rsl = xs + 1024;
        const int col0 = u.pn * BM + wc * 32 + 8 * fq;
#pragma unroll
        for (int ai = 0; ai < 2; ++ai) { u32x4 rh[4][2];
#pragma unroll
            for (int m = 0; m < 4; ++m) { const size_t off = (size_t)(u.pm * BM + ai * HALF + wr * 64 + m * 16 + fr) * ldc + col0;
#pragma unroll
                for (int bj = 0; bj < 2; ++bj) rh[m][bj] = *(const u32x4*)(res16 + off + bj * HALF); }
#pragma unroll
            for (int m = 0; m < 4; ++m) { float s = 0.f;
#pragma unroll
                for (int bj = 0; bj < 2; ++bj) { const u32x4 rb = rh[m][bj];
                    const f32x4 r0 = (f32x4){__uint_as_float(rb.x << 16), __uint_as_float(rb.x & 0xffff0000u), __uint_as_float(rb.y << 16), __uint_as_float(rb.y & 0xffff0000u)};
                    const f32x4 r1 = (f32x4){__uint_as_float(rb.z << 16), __uint_as_float(rb.z & 0xffff0000u), __uint_as_float(rb.w << 16), __uint_as_float(rb.w & 0xffff0000u)};
                    const f32x4 v0 = r0 + acc[ai][bj][m][0], v1 = r1 + acc[ai][bj][m][1]; acc[ai][bj][m][0] = v0; acc[ai][bj][m][1] = v1;
                    s += ((v0[0] * v0[0] + v0[1] * v0[1]) + (v0[2] * v0[2] + v0[3] * v0[3])) + ((v1[0] * v1[0] + v1[1] * v1[1]) + (v1[2] * v1[2] + v1[3] * v1[3])); }
                s += __shfl_xor(s, 16); s += __shfl_xor(s, 32); if (fq == 0) xs[(ai * HALF + wr * 64 + m * 16 + fr) * 4 + wc] = s; }
            asm volatile("" ::: "memory"); }
        asm volatile("s_waitcnt lgkmcnt(0)" ::: "memory"); __builtin_amdgcn_s_barrier(); asm volatile("" ::: "memory");
        if (fq == 0) {
#pragma unroll
            for (int ai = 0; ai < 2; ++ai) { const int r = ai * HALF + wr * 64 + wc * 16 + fr; const f32x4 p = *(const __attribute__((address_space(3))) f32x4*)(xs + r * 4);
                __hip_atomic_store(SS + (size_t)(u.pm * BM + r) * 8 + u.pn, (p[0] + p[1]) + (p[2] + p[3]), __ATOMIC_RELAXED, __HIP_MEMORY_SCOPE_AGENT); } }
        asm volatile("s_waitcnt vmcnt(0)" ::: "memory");
        if (lane == 0) __hip_atomic_fetch_add(cnt + 64 * u.pm, 1u, __ATOMIC_RELAXED, __HIP_MEMORY_SCOPE_AGENT);
        if (wr == 0 && wc == 0) {
            unsigned sp = 0u;
            while ((unsigned)__builtin_amdgcn_readfirstlane((int)__hip_atomic_load(cnt + 64 * u.pm, __ATOMIC_RELAXED, __HIP_MEMORY_SCOPE_AGENT)) < 64u) { __builtin_amdgcn_s_sleep(2); if (++sp > (1u << 22)) break; }
            __builtin_amdgcn_fence(__ATOMIC_ACQUIRE, "agent"); }
        asm volatile("s_waitcnt vmcnt(0) lgkmcnt(0)" ::: "memory"); __builtin_amdgcn_s_barrier(); asm volatile("" ::: "memory");
        if (wr == 0) {
            const int r = wc * 64 + lane; const unsigned long long* sp = (const unsigned long long*)(SS + (size_t)(u.pm * BM + r) * 8); float t = 0.f;
#pragma unroll
            for (int q = 0; q < 4; ++q) { const unsigned long long w = __hip_atomic_load(sp + q, __ATOMIC_RELAXED, __HIP_MEMORY_SCOPE_AGENT); t += __uint_as_float((unsigned)w) + __uint_as_float((unsigned)(w >> 32)); }
            rsl[r] = __builtin_amdgcn_rsqf(t * (1.0f / 2048.0f) + RMS_EPS); }
        asm volatile("s_waitcnt vmcnt(0) lgkmcnt(0)" ::: "memory"); __builtin_amdgcn_s_barrier(); asm volatile("" ::: "memory");
        f32x4 g0[2], g1[2];
#pragma unroll
        for (int bj = 0; bj < 2; ++bj) { g0[bj] = *(const f32x4*)(gfin + col0 + bj * HALF); g1[bj] = *(const f32x4*)(gfin + col0 + bj * HALF + 4); }
#pragma unroll
        for (int ai = 0; ai < 2; ++ai)
#pragma unroll
            for (int m = 0; m < 4; ++m) { const int r = ai * HALF + wr * 64 + m * 16 + fr; const float rs = rsl[r]; float* op = out + (size_t)(u.pm * BM + r) * ldc + col0;
#pragma unroll
                for (int bj = 0; bj < 2; ++bj) { *(f32x4*)(op + bj * HALF) = acc[ai][bj][m][0] * rs * g0[bj]; *(f32x4*)(op + bj * HALF + 4) = acc[ai][bj][m][1] * rs * g1[bj]; } }
    }
};
struct EpiAttnOut {
    static constexpr bool PERM = true, AFTER_DRAIN = false;
    bf16_t* O; const float* RSP;
    __device__ __forceinline__ void operator()(const f32x4 (&acc)[2][2][4][2], const Unit& u, int wr, int wc, int fr, int fq) const {
        const int row0 = u.pm * BM + wr * 64 + fr, col0 = u.pn * BM + wc * 32 + 8 * fq, h = u.pn >> 1;
#pragma unroll
        for (int ai = 0; ai < 2; ++ai)
#pragma unroll
            for (int m = 0; m < 4; ++m) { const int row = row0 + ai * HALF + m * 16; bf16_t* rowp = O + (size_t)row * 2048 + col0;
                const f32x4 ps = *(const f32x4*)(RSP + (size_t)row * 16 + h * 4); const float rs = 1.0f / ((ps[0] + ps[1]) + (ps[2] + ps[3]));
#pragma unroll
                for (int bj = 0; bj < 2; ++bj) { const f32x4 v0 = acc[ai][bj][m][0] * rs, v1 = acc[ai][bj][m][1] * rs;
                    u32x4 w; w.x = cvt_pk_bf16(v0[0], v0[1]); w.y = cvt_pk_bf16(v0[2], v0[3]); w.z = cvt_pk_bf16(v1[0], v1[1]); w.w = cvt_pk_bf16(v1[2], v1[3]);
                    *(u32x4*)(rowp + bj * HALF) = w; } }
    }
};
template <bool RES_F32> struct EpiResid {
    static constexpr bool PERM = true, AFTER_DRAIN = false;
    const float* res32; const bf16_t* res16; bf16_t* xb; float* SS; int ldc; __attribute__((address_space(3))) float* xs;
    __device__ __forceinline__ void operator()(const f32x4 (&acc)[2][2][4][2], const Unit& u, int wr, int wc, int fr, int fq) const {
        const int col0 = u.pn * BM + wc * 32 + 8 * fq;
#pragma unroll
        for (int ai = 0; ai < 2; ++ai) {
            f32x4 rf[RES_F32 ? 4 : 1][2][2]; u32x4 rh[RES_F32 ? 1 : 4][2];
#pragma unroll
            for (int m = 0; m < 4; ++m) { const size_t off = (size_t)(u.pm * BM + ai * HALF + wr * 64 + m * 16 + fr) * ldc + col0;
#pragma unroll
                for (int bj = 0; bj < 2; ++bj) {
                    if constexpr (RES_F32) { rf[m][bj][0] = *(const f32x4*)(res32 + off + bj * HALF); rf[m][bj][1] = *(const f32x4*)(res32 + off + bj * HALF + 4); }
                    else rh[m][bj] = *(const u32x4*)(res16 + off + bj * HALF); } }
#pragma unroll
            for (int m = 0; m < 4; ++m) { const int row = u.pm * BM + ai * HALF + wr * 64 + m * 16 + fr; const size_t off = (size_t)row * ldc + col0; float s = 0.f;
#pragma unroll
                for (int bj = 0; bj < 2; ++bj) { f32x4 r0, r1;
                    if constexpr (RES_F32) { r0 = rf[m][bj][0]; r1 = rf[m][bj][1]; }
                    else { const u32x4 rb = rh[m][bj];
                        r0 = (f32x4){__uint_as_float(rb.x << 16), __uint_as_float(rb.x & 0xffff0000u), __uint_as_float(rb.y << 16), __uint_as_float(rb.y & 0xffff0000u)};
                        r1 = (f32x4){__uint_as_float(rb.z << 16), __uint_as_float(rb.z & 0xffff0000u), __uint_as_float(rb.w << 16), __uint_as_float(rb.w & 0xffff0000u)}; }
                    const f32x4 v0 = r0 + acc[ai][bj][m][0], v1 = r1 + acc[ai][bj][m][1];
                    u32x4 w; w.x = cvt_pk_bf16(v0[0], v0[1]); w.y = cvt_pk_bf16(v0[2], v0[3]); w.z = cvt_pk_bf16(v1[0], v1[1]); w.w = cvt_pk_bf16(v1[2], v1[3]);
                    *(u32x4*)(xb + off + bj * HALF) = w;
                    s += ((v0[0] * v0[0] + v0[1] * v0[1]) + (v0[2] * v0[2] + v0[3] * v0[3])) + ((v1[0] * v1[0] + v1[1] * v1[1]) + (v1[2] * v1[2] + v1[3] * v1[3])); }
                s += __shfl_xor(s, 16); s += __shfl_xor(s, 32); if (fq == 0) xs[(ai * HALF + wr * 64 + m * 16 + fr) * 4 + wc] = s; }
            asm volatile("" ::: "memory"); }
        asm volatile("s_waitcnt lgkmcnt(0)" ::: "memory"); __builtin_amdgcn_s_barrier(); asm volatile("" ::: "memory");
        if (fq == 0) {
#pragma unroll
            for (int ai = 0; ai < 2; ++ai) { const int r = ai * HALF + wr * 64 + wc * 16 + fr; const f32x4 p = *(const __attribute__((address_space(3))) f32x4*)(xs + r * 4);
                SS[(size_t)(u.pm * BM + r) * 8 + u.pn] = (p[0] + p[1]) + (p[2] + p[3]); } }
    }
};
template <class Epi, class Sched, bool ALIGN_EPI = false, bool SP2 = false>
__device__ __forceinline__ void gemm_phase(PG8_LAS unsigned char* lds, const Gemm g, const Sched& S, const Epi& E) {
    int tid_ = threadIdx.x; asm volatile("" : "+v"(tid_));
    const int tid = tid_, wid = __builtin_amdgcn_readfirstlane(tid >> 6), lane = tid & 63, wr = wid >> 2, wc = wid & 3, fr = lane & 15, fq = lane >> 4;
    const int K = g.ld, nt = g.K / BK;
    unsigned voffA[2], voffB[2];
#pragma unroll
    for (int i = 0; i < 2; ++i) { int R, C; stage_rc(tid * 16 + i * 8192, R, C); const int Rb = Epi::PERM ? ((R & ~31) + perm32(R & 31)) : R;
        voffA[i] = (unsigned)(R * K + C) * 2u; voffB[i] = (unsigned)(Rb * K + C) * 2u; }
    const size_t kstep = (size_t)(BK * 2);
    const size_t hstep = (size_t)HALF * K * 2;
    const unsigned ldsw = (unsigned)wid * 1024u;
    const int aoff = lds_byte(wr * 64 + fr, fq * 8), boff = lds_byte(wc * 32 + fr, fq * 8);
#define PG8_SA(b, h) (((b) * 2 + (h)) * HTB)
#define PG8_SB(b, h) ((4 + (b) * 2 + (h)) * HTB)
#define PG8_STAGE(bufoff, gbase, voff) do { _Pragma("unroll") for (int _i = 0; _i < 2; ++_i) \
        __builtin_amdgcn_global_load_lds((const unsigned*)((const char*)(gbase) + (voff)[_i]), (PG8_LAS unsigned*)(lds + (bufoff) + ldsw + _i * 8192), 16, 0, 0); } while (0)
#define PG8_LDA(dst, b, h) do { _Pragma("unroll") for (int m = 0; m < 4; ++m) _Pragma("unroll") for (int k = 0; k < 2; ++k) dst[m][k] = *(const PG8_LAS bf16x8*)(lds + PG8_SA(b, h) + aoff + m * 2048 + k * 1024); } while (0)
#define PG8_LDB(dst, b, h) do { _Pragma("unroll") for (int n = 0; n < 2; ++n) _Pragma("unroll") for (int k = 0; k < 2; ++k) dst[n][k] = *(const PG8_LAS bf16x8*)(lds + PG8_SB(b, h) + boff + n * 2048 + k * 1024); } while (0)
#define PG8_MMA(ai, bj, At, Bt) do { __builtin_amdgcn_s_setprio(1); _Pragma("unroll") for (int m = 0; m < 4; ++m) _Pragma("unroll") for (int n = 0; n < 2; ++n) _Pragma("unroll") for (int k = 0; k < 2; ++k) \
        acc[ai][bj][m][n] = __builtin_amdgcn_mfma_f32_16x16x32_bf16(Bt[n][k], At[m][k], acc[ai][bj][m][n], 0, 0, 0); __builtin_amdgcn_s_setprio(0); } while (0)
#define PG8_WAIT_V(n) asm volatile("s_waitcnt vmcnt(" #n ")" ::: "memory")
#define PG8_WAIT_L(n) asm volatile("s_waitcnt lgkmcnt(" #n ")" ::: "memory")
#define PG8_BAR __builtin_amdgcn_s_barrier()
#define PG8_SCHED __builtin_amdgcn_sched_barrier(0)
    Unit cur, nxt; int ui = 0;
    if (!S.next(0, cur)) return;
    f32x4 acc[2][2][4][2];
#pragma unroll
    for (int a = 0; a < 2; ++a)
#pragma unroll
        for (int b = 0; b < 2; ++b)
#pragma unroll
            for (int m = 0; m < 4; ++m)
#pragma unroll
                for (int n = 0; n < 2; ++n) acc[a][b][m][n] = (f32x4){0.f, 0.f, 0.f, 0.f};
    bf16x8 At[4][2], B0[2][2], B1[2][2];
    const char* cA = S.pA(g, cur); const char* cB = S.pB(g, cur);
    S.a_ready(cur);
    if constexpr (SP2) {
        PG8_STAGE(PG8_SB(0, 0), cB, voffB); PG8_STAGE(PG8_SB(0, 1), cB + hstep, voffB); PG8_STAGE(PG8_SA(0, 0), cA, voffA); PG8_STAGE(PG8_SA(0, 1), cA + hstep, voffA);
        if (wr == 1) PG8_BAR;
        PG8_WAIT_V(2); PG8_BAR;
        PG8_STAGE(PG8_SB(1, 0), cB + kstep, voffB); PG8_STAGE(PG8_SA(1, 0), cA + kstep, voffA); PG8_STAGE(PG8_SB(1, 1), cB + hstep + kstep, voffB);
        PG8_WAIT_V(6); PG8_BAR;
    } else {
        PG8_STAGE(PG8_SB(0, 0), cB, voffB); PG8_STAGE(PG8_SA(0, 0), cA, voffA); PG8_STAGE(PG8_SB(0, 1), cB + hstep, voffB); PG8_STAGE(PG8_SA(0, 1), cA + hstep, voffA);
        if (wr == 1) PG8_BAR;
        PG8_WAIT_V(4); PG8_BAR;
        PG8_STAGE(PG8_SB(1, 0), cB + kstep, voffB); PG8_STAGE(PG8_SA(1, 0), cA + kstep, voffA); PG8_STAGE(PG8_SB(1, 1), cB + hstep + kstep, voffB);
        PG8_WAIT_V(6); PG8_BAR;
    }
    for (;;) {
        const bool has_next = S.next(ui + 1, nxt);
        const char* nA = has_next ? S.pA(g, nxt) : cA; const char* nB = has_next ? S.pB(g, nxt) : cB;
        for (int t = 0; t < nt; t += 2) {
            const bool last = (t == nt - 2);
            const char* a1 = cA + (size_t)(t + 1) * kstep;
            const char* a2 = last ? nA : cA + (size_t)(t + 2) * kstep; const char* b2 = last ? nB : cB + (size_t)(t + 2) * kstep;
            const char* a3 = a2 + kstep; const char* b3 = b2 + kstep;
            if (last && has_next) S.a_ready(nxt);
            if constexpr (SP2) {
            PG8_LDB(B0, 0, 0); PG8_LDB(B1, 0, 1); PG8_SCHED; PG8_LDA(At, 0, 0); PG8_STAGE(PG8_SA(1, 1), a1 + hstep, voffA);
            PG8_WAIT_V(8); PG8_WAIT_L(0); PG8_BAR; PG8_MMA(0, 0, At, B0); PG8_MMA(0, 1, At, B1); PG8_BAR; PG8_SCHED;
            PG8_LDA(At, 0, 1); PG8_STAGE(PG8_SB(0, 0), b2, voffB); PG8_STAGE(PG8_SB(0, 1), b2 + hstep, voffB); PG8_STAGE(PG8_SA(0, 0), a2, voffA);
            PG8_WAIT_V(8); PG8_WAIT_L(0); PG8_BAR; PG8_MMA(1, 0, At, B0); PG8_MMA(1, 1, At, B1); PG8_BAR; PG8_SCHED;
            PG8_LDB(B0, 1, 0); PG8_LDB(B1, 1, 1); PG8_SCHED; PG8_LDA(At, 1, 0); PG8_STAGE(PG8_SA(0, 1), a2 + hstep, voffA);
            PG8_WAIT_V(8); PG8_WAIT_L(0); PG8_BAR; PG8_MMA(0, 0, At, B0); PG8_MMA(0, 1, At, B1); PG8_BAR; PG8_SCHED;
            PG8_LDA(At, 1, 1); PG8_STAGE(PG8_SB(1, 0), b3, voffB); PG8_STAGE(PG8_SB(1, 1), b3 + hstep, voffB); PG8_STAGE(PG8_SA(1, 0), a3, voffA);
            PG8_WAIT_V(8); PG8_WAIT_L(0); PG8_BAR; PG8_MMA(1, 0, At, B0); PG8_MMA(1, 1, At, B1); PG8_BAR; PG8_SCHED;
            } else {
            PG8_LDB(B0, 0, 0); PG8_SCHED; PG8_LDA(At, 0, 0); PG8_STAGE(PG8_SA(1, 1), a1 + hstep, voffA);
            PG8_WAIT_L(8); PG8_BAR; PG8_WAIT_L(0); PG8_MMA(0, 0, At, B0); PG8_BAR; PG8_SCHED;
            PG8_LDB(B1, 0, 1); PG8_STAGE(PG8_SB(0, 0), b2, voffB);
            PG8_BAR; PG8_WAIT_L(0); PG8_MMA(0, 1, At, B1); PG8_BAR;
            PG8_LDA(At, 0, 1); PG8_STAGE(PG8_SA(0, 0), a2, voffA);
            PG8_BAR; PG8_WAIT_L(0); PG8_MMA(1, 0, At, B0); PG8_BAR; PG8_SCHED;
            PG8_STAGE(PG8_SB(0, 1), b2 + hstep, voffB);
            PG8_WAIT_V(6); PG8_BAR; PG8_MMA(1, 1, At, B1); PG8_BAR;
            PG8_LDB(B0, 1, 0); PG8_SCHED; PG8_LDA(At, 1, 0); PG8_STAGE(PG8_SA(0, 1), a2 + hstep, voffA);
            PG8_WAIT_L(8); PG8_BAR; PG8_WAIT_L(0); PG8_MMA(0, 0, At, B0); PG8_BAR; PG8_SCHED;
            PG8_LDB(B1, 1, 1); PG8_STAGE(PG8_SB(1, 0), b3, voffB);
            PG8_BAR; PG8_WAIT_L(0); PG8_MMA(0, 1, At, B1); PG8_BAR;
            PG8_LDA(At, 1, 1); PG8_STAGE(PG8_SA(1, 0), a3, voffA);
            PG8_BAR; PG8_WAIT_L(0); PG8_MMA(1, 0, At, B0); PG8_BAR; PG8_SCHED;
            PG8_STAGE(PG8_SB(1, 1), b3 + hstep, voffB);
            PG8_WAIT_V(6); PG8_BAR; PG8_MMA(1, 1, At, B1); PG8_BAR;
            }
        }
        if constexpr (ALIGN_EPI) { if (wr == 0) PG8_BAR; }
        if constexpr (!Epi::AFTER_DRAIN) { E(acc, cur, wr, wc, fr, fq); S.done(cur); }
        if (!has_next) break;
#pragma unroll
        for (int a = 0; a < 2; ++a)
#pragma unroll
            for (int b = 0; b < 2; ++b)
#pragma unroll
                for (int m = 0; m < 4; ++m)
#pragma unroll
                    for (int n = 0; n < 2; ++n) acc[a][b][m][n] = (f32x4){0.f, 0.f, 0.f, 0.f};
        cur = nxt; cA = nA; cB = nB; ++ui;
        if constexpr (ALIGN_EPI) { if (wr == 1) PG8_BAR; }
    }
    PG8_WAIT_V(0);
    if constexpr (!ALIGN_EPI) { if (wr == 0) PG8_BAR; }
    PG8_BAR;
    if constexpr (Epi::AFTER_DRAIN) { E.fused(acc, cur, wr, wc, fr, fq, lds, wid, lane); S.done(cur); }
#undef PG8_SA
#undef PG8_SB
#undef PG8_STAGE
#undef PG8_LDA
#undef PG8_LDB
#undef PG8_MMA
#undef PG8_WAIT_V
#undef PG8_WAIT_L
#undef PG8_BAR
#undef PG8_SCHED
}
}
#define LAS __attribute__((address_space(3)))
using pg8::bf16_t; using pg8::bf16x8; using pg8::f32x4; using pg8::u32x4; using pg8::u32x2; using pg8::cvt_pk_bf16; using pg8::RMS_EPS;
constexpr int BATCH = 4, SEQ = 4096, D = 2048, M = BATCH * SEQ, NMEM = 256, MM = BATCH * NMEM, DFF = 5632, DPOOL = 1024, DSGU = 1024;
constexpr int NWAVES = 8, NTHR = NWAVES * 64;
constexpr int LDS_BYTES = 147456;
constexpr size_t MiB = 1u << 20;
constexpr size_t WS_BAR = 0, WS_PCNT = 16384, WS_ZERO_BYTES = 65536;
constexpr size_t WS_WIN = 1 * MiB, WS_WOUT = 13 * MiB, WS_WQ = 21 * MiB, WS_WK = 29 * MiB, WS_WV = 37 * MiB, WS_WO = 45 * MiB, WS_WGU = 53 * MiB, WS_WD = 97 * MiB;
constexpr size_t WS_PW = 119 * MiB, WS_WSP = 119 * MiB + 512 * 1024;
constexpr size_t WS_MN = 120 * MiB, WS_KB = 124 * MiB, WS_VTM = 128 * MiB;
constexpr size_t WS_XB = 132 * MiB;
constexpr size_t WS_HG = 196 * MiB;
constexpr size_t WS_PAU = 196 * MiB, WS_Q = 196 * MiB, WS_VT = 260 * MiB, WS_Y = 292 * MiB, WS_O = 292 * MiB;
constexpr size_t WS_PM = 260 * MiB;
constexpr size_t WS_RSP = 356 * MiB;
constexpr size_t WS_SS1 = 372 * MiB, WS_SS2 = WS_SS1 + 512 * 1024, WS_SS3 = WS_SS2 + 512 * 1024;
constexpr size_t WS_RS0 = 375 * MiB;
constexpr size_t WS_WQK = 356 * MiB;
constexpr size_t WS_VWO = 376 * MiB;
constexpr size_t WS_PWN = 392 * MiB;
constexpr size_t WS_END = 396 * MiB;

__device__ __forceinline__ float bf_lo(unsigned w) { return __uint_as_float(w << 16); }
__device__ __forceinline__ float bf_hi(unsigned w) { return __uint_as_float(w & 0xffff0000u); }
__device__ __forceinline__ float wave_sum(float v) {
#pragma unroll
    for (int o = 1; o < 64; o <<= 1) v += __shfl_xor(v, o);
    return v;
}
#define LDS_WAIT() asm volatile("s_waitcnt lgkmcnt(0)" ::: "memory")
#define MFMA16(a, b, c) __builtin_amdgcn_mfma_f32_16x16x32_bf16((a), (b), (c), 0, 0, 0)

#define XB_TMO      128
#define XB_XCNT(j)  (256  + 64 * (j))
#define XB_XSUB(j)  (1280 + 64 * (j))
#define XB_XGEN(j)  (2304 + 64 * (j))
#define XB_TOP      3328
#define XB_TOPGEN   3392
#define XCD_BAR_WORDS 3456
#define XB_SPIN_CAP (1u << 18)

__device__ __forceinline__ unsigned xb_ld(unsigned* p)              { return __hip_atomic_load(p, __ATOMIC_RELAXED, __HIP_MEMORY_SCOPE_AGENT); }
__device__ __forceinline__ unsigned xb_add(unsigned* p, unsigned v) { return __hip_atomic_fetch_add(p, v, __ATOMIC_RELAXED, __HIP_MEMORY_SCOPE_AGENT); }
__device__ __forceinline__ unsigned xb_xcc_id() { return (unsigned)__builtin_amdgcn_s_getreg((3 << 11) | 20) & 0xFu; }
#define XB_SPIN(cond, bar) do { unsigned _sp = 0; while (cond) { __builtin_amdgcn_s_sleep(1); \
    if ((++_sp & 255u) == 0u) { if (xb_ld(&(bar)[XB_TMO])) break; if (_sp > XB_SPIN_CAP) { atomicAdd(&(bar)[XB_TMO], 1u); break; } } } } while (0)

struct XcdBarrier {
    unsigned* bar; unsigned x;
    volatile LAS unsigned* st;
};

__device__ __forceinline__ XcdBarrier xcd_barrier_post(unsigned* bar, volatile LAS unsigned* st) {
    XcdBarrier b; b.bar = bar; b.x = xb_xcc_id(); b.st = st;
    if (threadIdx.x == 0) (void)xb_add(&bar[XB_XCNT(b.x)], 1u);
    return b;
}
__device__ __forceinline__ void xcd_barrier_complete(unsigned* bar, unsigned x, unsigned& nloc, unsigned& nx) {
    const unsigned G = gridDim.x * gridDim.y * gridDim.z;
    unsigned sum, cnt, mine, sp = 0u;
    for (;;) {
        sum = 0u; cnt = 0u; mine = 0u;
#pragma unroll
        for (unsigned j = 0; j < 16; ++j) { const unsigned c = xb_ld(&bar[XB_XCNT(j)]); sum += c; cnt += (c > 0u) ? 1u : 0u; mine = (j == x) ? c : mine; }
        if (sum == G) break;
        __builtin_amdgcn_s_sleep(1);
        if ((++sp & 255u) == 0u) { if (xb_ld(&bar[XB_TMO])) break; if (sp > XB_SPIN_CAP) { atomicAdd(&bar[XB_TMO], 1u); break; } }
    }
    nloc = mine > 0u ? mine : 1u; nx = cnt > 0u ? cnt : 1u;
}

__device__ __forceinline__ void xcd_barrier(const XcdBarrier& b) {
    asm volatile("s_waitcnt vmcnt(0)" ::: "memory");
    __syncthreads();
    if (threadIdx.x == 0) {
        unsigned* bar = b.bar;
        __builtin_amdgcn_s_waitcnt(0);
        unsigned nloc = b.st[0], nx = b.st[1];
        if (nloc == 0u) { xcd_barrier_complete(bar, b.x, nloc, nx); b.st[0] = nloc; b.st[1] = nx; }
        const unsigned old = xb_add(&bar[XB_XSUB(b.x)], 1u);
        const unsigned gen = old / nloc;
        if (old + 1u == (gen + 1u) * nloc) {
            __builtin_amdgcn_fence(__ATOMIC_RELEASE, "agent");
            asm volatile("s_waitcnt vmcnt(0)" ::: "memory");
            const unsigned og = xb_add(&bar[XB_TOP], 1u);
            const unsigned tg = og / nx;
            if (og + 1u == (tg + 1u) * nx) xb_add(&bar[XB_TOPGEN], 1u);
            else XB_SPIN(xb_ld(&bar[XB_TOPGEN]) == tg, bar);
            __builtin_amdgcn_fence(__ATOMIC_ACQUIRE, "agent");
            xb_add(&bar[XB_XGEN(b.x)], 1u);
            asm volatile("s_waitcnt vmcnt(0)" ::: "memory");
        } else {
            XB_SPIN(xb_ld(&bar[XB_XGEN(b.x)]) == gen, bar);
            __builtin_amdgcn_fence(__ATOMIC_ACQUIRE, "agent");
            asm volatile("s_waitcnt vmcnt(0)" ::: "memory");
        }
    }
    __syncthreads();
}

__device__ __forceinline__ void tr_item(const float* W, int ldw, int k0, int n0, bf16_t* WT, int ldt, int orow0, const float* kgain, const float* nscale, LAS float* scr, int lane) {
    f32x4 v[16];
#pragma unroll
    for (int i = 0; i < 16; ++i) { const int kk = 4 * i + (lane >> 4), nn = (lane & 15) * 4; v[i] = __builtin_nontemporal_load((const f32x4*)(W + (size_t)(k0 + kk) * ldw + n0 + nn)); }
#pragma unroll
    for (int i = 0; i < 16; ++i) { const int kk = 4 * i + (lane >> 4), nn = (lane & 15) * 4;
        if (kgain) v[i] = v[i] * kgain[k0 + kk];
        LAS float* s = scr + kk * 65 + nn; s[0] = v[i][0]; s[1] = v[i][1]; s[2] = v[i][2]; s[3] = v[i][3]; }
    LDS_WAIT();
    const int c = lane & 7;
#pragma unroll
    for (int j = 0; j < 8; ++j) { const int n = (lane >> 3) + 8 * j; const LAS float* s = scr + (8 * c) * 65 + n;
        const float sc = nscale ? nscale[n] : 1.0f;
        u32x4 o; o.x = cvt_pk_bf16(s[0 * 65] * sc, s[1 * 65] * sc); o.y = cvt_pk_bf16(s[2 * 65] * sc, s[3 * 65] * sc); o.z = cvt_pk_bf16(s[4 * 65] * sc, s[5 * 65] * sc); o.w = cvt_pk_bf16(s[6 * 65] * sc, s[7 * 65] * sc);
        *(u32x4*)(WT + (size_t)(orow0 + n) * ldt + k0 + 8 * c) = o; }
    LDS_WAIT();
}
__device__ __forceinline__ void norm_row_bf16(const float* xrow, const float* g, bf16_t* orow, int lane) {
    const f32x4* xr = (const f32x4*)xrow + lane; f32x4 v[8]; float s = 0.f;
#pragma unroll
    for (int j = 0; j < 8; ++j) { v[j] = xr[64 * j]; s += (v[j][0] * v[j][0] + v[j][1] * v[j][1]) + (v[j][2] * v[j][2] + v[j][3] * v[j][3]); }
    const float rstd = 1.0f / sqrtf(wave_sum(s) * (1.0f / D) + RMS_EPS);
    const f32x4* gr = (const f32x4*)g + lane; u32x2* o = (u32x2*)orow + lane;
#pragma unroll
    for (int j = 0; j < 8; ++j) { const f32x4 gg = gr[64 * j]; const f32x4 y = v[j] * rstd * gg; u32x2 w; w.x = cvt_pk_bf16(y[0], y[1]); w.y = cvt_pk_bf16(y[2], y[3]); o[64 * j] = w; }
}
__device__ __forceinline__ void norm_row2_bf16(const float* xa, const float* xb_, bool has2, const float* g, bf16_t* oa, bf16_t* ob, int lane) {
    const f32x4* ra = (const f32x4*)xa + lane; const f32x4* rb = (const f32x4*)(has2 ? xb_ : xa) + lane; f32x4 va[8], vb[8]; float sa = 0.f, sb = 0.f;
#pragma unroll
    for (int j = 0; j < 8; ++j) { va[j] = ra[64 * j]; vb[j] = rb[64 * j]; }
#pragma unroll
    for (int j = 0; j < 8; ++j) { sa += (va[j][0] * va[j][0] + va[j][1] * va[j][1]) + (va[j][2] * va[j][2] + va[j][3] * va[j][3]); sb += (vb[j][0] * vb[j][0] + vb[j][1] * vb[j][1]) + (vb[j][2] * vb[j][2] + vb[j][3] * vb[j][3]); }
    const float ka = 1.0f / sqrtf(wave_sum(sa) * (1.0f / D) + RMS_EPS), kb = 1.0f / sqrtf(wave_sum(sb) * (1.0f / D) + RMS_EPS);
    const f32x4* gr = (const f32x4*)g + lane; u32x2* pa = (u32x2*)oa + lane; u32x2* pb = (u32x2*)ob + lane;
#pragma unroll
    for (int j = 0; j < 8; ++j) { const f32x4 gg = gr[64 * j]; const f32x4 ya = va[j] * ka * gg, yb = vb[j] * kb * gg; u32x2 w; w.x = cvt_pk_bf16(ya[0], ya[1]); w.y = cvt_pk_bf16(ya[2], ya[3]); pa[64 * j] = w;
        if (has2) { u32x2 w2; w2.x = cvt_pk_bf16(yb[0], yb[1]); w2.y = cvt_pk_bf16(yb[2], yb[3]); pb[64 * j] = w2; } }
}
__device__ __forceinline__ void raw_row2_bf16(const float* xa, const float* xb_, bool has2, bf16_t* oa, bf16_t* ob, float* rsa, float* rsb, int lane) {
    const f32x4* ra = (const f32x4*)xa + lane; const f32x4* rb = (const f32x4*)(has2 ? xb_ : xa) + lane; f32x4 va[8], vb[8]; float sa = 0.f, sb = 0.f;
#pragma unroll
    for (int j = 0; j < 8; ++j) { va[j] = __builtin_nontemporal_load(ra + 64 * j); vb[j] = __builtin_nontemporal_load(rb + 64 * j); }
    u32x2* pa = (u32x2*)oa + lane; u32x2* pb = (u32x2*)ob + lane;
#pragma unroll
    for (int j = 0; j < 8; ++j) { sa += (va[j][0] * va[j][0] + va[j][1] * va[j][1]) + (va[j][2] * va[j][2] + va[j][3] * va[j][3]); sb += (vb[j][0] * vb[j][0] + vb[j][1] * vb[j][1]) + (vb[j][2] * vb[j][2] + vb[j][3] * vb[j][3]);
        u32x2 w; w.x = cvt_pk_bf16(va[j][0], va[j][1]); w.y = cvt_pk_bf16(va[j][2], va[j][3]); pa[64 * j] = w;
        if (has2) { u32x2 w2; w2.x = cvt_pk_bf16(vb[j][0], vb[j][1]); w2.y = cvt_pk_bf16(vb[j][2], vb[j][3]); pb[64 * j] = w2; } }
    const float ka = 1.0f / sqrtf(wave_sum(sa) * (1.0f / D) + RMS_EPS), kb = 1.0f / sqrtf(wave_sum(sb) * (1.0f / D) + RMS_EPS);
    if (lane == 0) { *rsa = ka; if (has2) *rsb = kb; }
}
__device__ __forceinline__ void norm_row_out(const bf16_t* xrow, float ss, const float* g, float* orow, int lane) {
    const float rstd = 1.0f / sqrtf(ss * (1.0f / D) + RMS_EPS);
#pragma unroll
    for (int j = 0; j < 4; ++j) { const int c = (lane + 64 * j) * 8; const u32x4 w = *(const u32x4*)(xrow + c);
        const f32x4 g0 = *(const f32x4*)(g + c), g1 = *(const f32x4*)(g + c + 4);
        const f32x4 y0 = (f32x4){bf_lo(w.x), bf_hi(w.x), bf_lo(w.y), bf_hi(w.y)} * rstd * g0, y1 = (f32x4){bf_lo(w.z), bf_hi(w.z), bf_lo(w.w), bf_hi(w.w)} * rstd * g1;
        *(f32x4*)(orow + c) = y0; *(f32x4*)(orow + c + 4) = y1; }
}

__device__ __forceinline__ void sgu_unit(LAS unsigned char* lds, int nb, int h0, const bf16_t* VT, const bf16_t* PAU, bf16_t* Y, const bf16_t* WSb, const float* sg, const float* bsp, int tid) {
    asm volatile("" : "+v"(tid));
    const int lane = tid & 63, wave = tid >> 6, fr = lane & 15, fq = lane >> 4;
    const int T0 = nb * 128;
    LAS float* red = (LAS float*)lds;
    LAS float* rstd = (LAS float*)(lds + 4096);
    LAS unsigned char* Bb = lds + 8192;
    {
        const int tg = tid & 15, rl = tid >> 4;
        float s[8];
#pragma unroll
        for (int e = 0; e < 8; ++e) s[e] = 0.f;
#pragma unroll 4
        for (int i = 0; i < 32; ++i) { const int c = rl + 32 * i; const u32x4 w = *(const u32x4*)(VT + (size_t)c * M + T0 + tg * 8);
#pragma unroll
            for (int e = 0; e < 4; ++e) { const float lo = bf_lo(w[e]), hi = bf_hi(w[e]); s[2 * e] += lo * lo; s[2 * e + 1] += hi * hi; } }
#pragma unroll
        for (int e = 0; e < 8; ++e) { s[e] += __shfl_xor(s[e], 16); s[e] += __shfl_xor(s[e], 32); }
        if (fq == 0) {
#pragma unroll
            for (int e = 0; e < 8; ++e) red[wave * 128 + tg * 8 + e] = s[e]; }
    }
    __syncthreads();
    if (tid < 128) { float t = 0.f;
#pragma unroll
        for (int w = 0; w < 8; ++w) t += red[w * 128 + tid];
        rstd[tid] = 1.0f / sqrtf(t * (1.0f / DSGU) + RMS_EPS); }
    __syncthreads();
    const int wr = wave >> 1, wc = wave & 1;
    for (int h = h0; h < h0 + 4; ++h) {
        LAS unsigned char* B = Bb + (h & 1) * 34816;
#pragma unroll
        for (int i = 0; i < 4; ++i) { const int p = tid + 512 * i, c = p >> 4, sgp = p & 15;
            const u32x4 w = *(const u32x4*)(VT + (size_t)(h * 128 + c) * M + T0 + sgp * 8);
            const float g = sg[h * 128 + c];
            const f32x4 r0 = *(const LAS f32x4*)(rstd + sgp * 8) * g, r1 = *(const LAS f32x4*)(rstd + sgp * 8 + 4) * g;
            u32x4 o; o.x = cvt_pk_bf16(bf_lo(w.x) * r0[0], bf_hi(w.x) * r0[1]); o.y = cvt_pk_bf16(bf_lo(w.y) * r0[2], bf_hi(w.y) * r0[3]);
            o.z = cvt_pk_bf16(bf_lo(w.z) * r1[0], bf_hi(w.z) * r1[1]); o.w = cvt_pk_bf16(bf_lo(w.w) * r1[2], bf_hi(w.w) * r1[3]);
            const int rho = (c & ~31) + ((c >> 2) & 1) * 16 + ((c >> 3) & 3) * 4 + (c & 3);
            *(LAS u32x4*)(B + rho * 272 + sgp * 16) = o; }
        __syncthreads();
        f32x4 acc[2][4];
#pragma unroll
        for (int m = 0; m < 2; ++m)
#pragma unroll
            for (int n = 0; n < 4; ++n) acc[m][n] = (f32x4){0.f, 0.f, 0.f, 0.f};
#pragma unroll
        for (int ks = 0; ks < 4; ++ks) { bf16x8 a[2], b[4];
#pragma unroll
            for (int m = 0; m < 2; ++m) a[m] = *(const bf16x8*)(WSb + (size_t)((h * 128 + wr * 32 + m * 16 + fr) * 128 + ks * 32 + fq * 8));
#pragma unroll
            for (int n = 0; n < 4; ++n) b[n] = *(const LAS bf16x8*)(B + (wc * 64 + n * 16 + fr) * 272 + (ks * 32 + fq * 8) * 2);
#pragma unroll
            for (int m = 0; m < 2; ++m)
#pragma unroll
                for (int n = 0; n < 4; ++n) acc[m][n] = MFMA16(b[n], a[m], acc[m][n]); }
#pragma unroll
        for (int m = 0; m < 2; ++m) { const int t = wr * 32 + m * 16 + fr; const float bias = bsp[h * 128 + t];
#pragma unroll
            for (int gq = 0; gq < 2; ++gq) { const size_t off = (size_t)(T0 + t) * D + DPOOL + h * 128 + wc * 64 + gq * 32 + fq * 8;
                const u32x4 uu = *(const u32x4*)(PAU + off); const f32x4 m0 = acc[m][2 * gq] + bias, m1 = acc[m][2 * gq + 1] + bias;
                u32x4 o; o.x = cvt_pk_bf16(bf_lo(uu.x) * m0[0], bf_hi(uu.x) * m0[1]); o.y = cvt_pk_bf16(bf_lo(uu.y) * m0[2], bf_hi(uu.y) * m0[3]);
                o.z = cvt_pk_bf16(bf_lo(uu.z) * m1[0], bf_hi(uu.z) * m1[1]); o.w = cvt_pk_bf16(bf_lo(uu.w) * m1[2], bf_hi(uu.w) * m1[3]);
                *(u32x4*)(Y + off) = o; } }
    }
    __syncthreads();
}
template <int W> __device__ __forceinline__ void pool_p(const bf16_t* base, bf16_t* ybase, int ts, int tp0) {
    u32x4 arr[W + 7];
#pragma unroll
    for (int j = 0; j < W + 7; ++j) { const int t = ts - (W - 1) + j, tc = t < -tp0 ? -tp0 : t; arr[j] = *(const u32x4*)(base + (ptrdiff_t)tc * D); }
#pragma unroll
    for (int j = 0; j < W - 1; ++j) { const int t = ts - (W - 1) + j; if (tp0 + t < 0) arr[j] = (u32x4){0u, 0u, 0u, 0u}; }
    float S[8];
#pragma unroll
    for (int e = 0; e < 8; ++e) S[e] = 0.f;
#pragma unroll
    for (int j = 0; j < W - 1; ++j)
#pragma unroll
        for (int e = 0; e < 4; ++e) { S[2 * e] += bf_lo(arr[j][e]); S[2 * e + 1] += bf_hi(arr[j][e]); }
#pragma unroll
    for (int i = 0; i < 8; ++i) { const int t = ts + i, tp = tp0 + t; float cur[8], p[8];
#pragma unroll
        for (int e = 0; e < 4; ++e) { cur[2 * e] = bf_lo(arr[W - 1 + i][e]); cur[2 * e + 1] = bf_hi(arr[W - 1 + i][e]); }
        const float inv = 1.0f / (float)(tp + 1 < W ? tp + 1 : W);
#pragma unroll
        for (int e = 0; e < 8; ++e) { S[e] += cur[e]; p[e] = S[e] * inv - cur[e]; }
        u32x4 o; o.x = cvt_pk_bf16(p[0], p[1]); o.y = cvt_pk_bf16(p[2], p[3]); o.z = cvt_pk_bf16(p[4], p[5]); o.w = cvt_pk_bf16(p[6], p[7]);
        *(u32x4*)(ybase + (size_t)t * D) = o;
#pragma unroll
        for (int e = 0; e < 4; ++e) { S[2 * e] -= bf_lo(arr[i][e]); S[2 * e + 1] -= bf_hi(arr[i][e]); } }
}
__device__ __forceinline__ void pool_half(int nb, int gh, const bf16_t* PAU, bf16_t* Y, int tid) {
    asm volatile("" : "+v"(tid));
    const int T0 = nb * 128, tp0 = T0 & (SEQ - 1), cgp = tid & 31, ts = (tid >> 5) * 8;
    const bf16_t* src = PAU + (size_t)T0 * D + cgp * 8; bf16_t* dst = Y + (size_t)T0 * D + cgp * 8;
    if (gh == 0) { pool_p<2>(src, dst, ts, tp0); pool_p<16>(src + 768, dst + 768, ts, tp0); }
    else { pool_p<4>(src + 256, dst + 256, ts, tp0); pool_p<8>(src + 512, dst + 512, ts, tp0); }
}
__device__ __forceinline__ void attn_unit(LAS unsigned char* lds, int unit, const bf16_t* Q, const bf16_t* KB, const bf16_t* VTM, bf16_t* O, int tid) {
    asm volatile("" : "+v"(tid));
    const int lane = tid & 63, wave = tid >> 6, fr = lane & 15, fq = lane >> 4, wr = wave >> 1, wc = wave & 1;
    const int qt = unit & 31, h = (unit >> 5) & 3, b = unit >> 7;
    const int R0 = b * SEQ + qt * 128;
    LAS unsigned char* P = lds;
    LAS float* xm = (LAS float*)(lds + 67584);
    LAS float* xs = xm + 256;
    f32x4 acc[2][8];
#pragma unroll
    for (int m = 0; m < 2; ++m)
#pragma unroll
        for (int n = 0; n < 8; ++n) acc[m][n] = (f32x4){0.f, 0.f, 0.f, 0.f};
    const bf16_t* qp = Q + (size_t)(R0 + wr * 32 + fr) * D + h * 512 + fq * 8;
    const bf16_t* kp = KB + (size_t)(b * NMEM + wc * 128 + fr) * D + h * 512 + fq * 8;
#pragma unroll 2
    for (int ks = 0; ks < 16; ++ks) { bf16x8 a[2], bb[8];
#pragma unroll
        for (int m = 0; m < 2; ++m) a[m] = *(const bf16x8*)(qp + (size_t)m * 16 * D + ks * 32);
#pragma unroll
        for (int n = 0; n < 8; ++n) bb[n] = *(const bf16x8*)(kp + (size_t)n * 16 * D + ks * 32);
#pragma unroll
        for (int m = 0; m < 2; ++m)
#pragma unroll
            for (int n = 0; n < 8; ++n) acc[m][n] = MFMA16(bb[n], a[m], acc[m][n]); }
    const float sc = 0.044194173824159216f;
#pragma unroll
    for (int m = 0; m < 2; ++m) { float v = -3.0e38f;
#pragma unroll
        for (int n = 0; n < 8; ++n) { acc[m][n] = acc[m][n] * sc; v = fmaxf(v, fmaxf(fmaxf(acc[m][n][0], acc[m][n][1]), fmaxf(acc[m][n][2], acc[m][n][3]))); }
        v = fmaxf(v, __shfl_xor(v, 16)); v = fmaxf(v, __shfl_xor(v, 32));
        if (fq == 0) xm[wc * 128 + wr * 32 + m * 16 + fr] = v; }
    __syncthreads();
#pragma unroll
    for (int m = 0; m < 2; ++m) { const int row = wr * 32 + m * 16 + fr; const float mx = fmaxf(xm[row], xm[128 + row]); float s = 0.f;
#pragma unroll
        for (int n = 0; n < 8; ++n) { const float p0 = __expf(acc[m][n][0] - mx), p1 = __expf(acc[m][n][1] - mx), p2 = __expf(acc[m][n][2] - mx), p3 = __expf(acc[m][n][3] - mx);
            s += (p0 + p1) + (p2 + p3);
            u32x2 o; o.x = cvt_pk_bf16(p0, p1); o.y = cvt_pk_bf16(p2, p3);
            *(LAS u32x2*)(P + row * 528 + (wc * 128 + n * 16 + fq * 4) * 2) = o; }
        s += __shfl_xor(s, 16); s += __shfl_xor(s, 32);
        if (fq == 0) xs[wc * 128 + row] = s; }
    __syncthreads();
    float inv[2];
#pragma unroll
    for (int m = 0; m < 2; ++m) { const int row = wr * 32 + m * 16 + fr; inv[m] = 1.0f / (xs[row] + xs[128 + row]); }
    f32x4 o[2][16];
#pragma unroll
    for (int m = 0; m < 2; ++m)
#pragma unroll
        for (int n = 0; n < 16; ++n) o[m][n] = (f32x4){0.f, 0.f, 0.f, 0.f};
    const bf16_t* vp = VTM + (size_t)(h * 512 + wc * 256 + fr) * MM + b * NMEM + fq * 8;
    for (int ks = 0; ks < 8; ++ks) { bf16x8 a[2];
#pragma unroll
        for (int m = 0; m < 2; ++m) a[m] = *(const LAS bf16x8*)(P + (wr * 32 + m * 16 + fr) * 528 + (ks * 32 + fq * 8) * 2);
#pragma unroll
        for (int n = 0; n < 16; ++n) { const bf16x8 bv = *(const bf16x8*)(vp + (size_t)n * 16 * MM + ks * 32);
#pragma unroll
            for (int m = 0; m < 2; ++m) o[m][n] = MFMA16(bv, a[m], o[m][n]); } }
#pragma unroll
    for (int m = 0; m < 2; ++m) { const size_t rowoff = (size_t)(R0 + wr * 32 + m * 16 + fr) * D + h * 512 + wc * 256 + fq * 4;
#pragma unroll
        for (int n = 0; n < 16; ++n) { const f32x4 v = o[m][n] * inv[m]; u32x2 w; w.x = cvt_pk_bf16(v[0], v[1]); w.y = cvt_pk_bf16(v[2], v[3]); *(u32x2*)(O + rowoff + n * 16) = w; } }
    __syncthreads();
}

#ifndef REP_P0
#define REP_P0 1
#endif
#ifndef REP_P0N
#define REP_P0N 1
#endif
#ifndef REP_P1
#define REP_P1 1
#endif
#ifndef REP_P3
#define REP_P3 1
#endif
#ifndef REP_P7
#define REP_P7 1
#endif
#ifndef TS_K
#define TS_K -1
#endif
#ifndef ABSORB
#define ABSORB 1
#endif
#ifndef OLD_ATTN
#define OLD_ATTN 0
#endif
#ifndef REP_P2
#define REP_P2 1
#endif
#ifndef REP_P5
#define REP_P5 1
#endif
#ifndef REP_SYNC
#define REP_SYNC 1
#endif
#ifndef REP_P4
#define REP_P4 1
#endif
struct Args { const float* in[21]; float* out; unsigned char* ws; };
#define GEMM_PHASE(EPI, g, S, E) pg8::gemm_phase<EPI, pg8::StaticOrder, true, true>(lds, g, S, E)
__global__ void __launch_bounds__(NTHR, 2) mk_fwd(Args a) {
    extern __shared__ __attribute__((aligned(16))) unsigned char lds_raw[];
    LAS unsigned char* lds = (LAS unsigned char*)lds_raw;
    cg::grid_group grid = cg::this_grid();
    const int G = gridDim.x, bx = blockIdx.x;
    volatile LAS unsigned* bar_st = (volatile LAS unsigned*)(lds + LDS_BYTES - 64);
    if (threadIdx.x < 2) bar_st[threadIdx.x] = 0u;
    __syncthreads();
    const XcdBarrier xbar = xcd_barrier_post((unsigned*)(a.ws + WS_BAR), bar_st);
    volatile LAS unsigned* ts_lds = (volatile LAS unsigned*)(lds + LDS_BYTES - 32);
    if (TS_K >= 0 && bx == 0 && threadIdx.x == 0) ts_lds[0] = (unsigned)__builtin_amdgcn_s_memrealtime();
#define STAMP(k) do { if (TS_K == (k) && bx == 0 && threadIdx.x == 0) ts_lds[1] = (unsigned)__builtin_amdgcn_s_memrealtime(); } while (0)
#define TID_FRESH() ({ int t_ = threadIdx.x; asm volatile("" : "+v"(t_)); t_; })
    const float *x = a.in[0], *mem = a.in[1], *norm_mix_g = a.in[2], *w_in = a.in[3], *pool_w = a.in[4], *pool_scale = a.in[5], *sgu_norm_g = a.in[6], *w_spatial = a.in[7], *b_spatial = a.in[8],
                *w_out = a.in[9], *norm_xattn_g = a.in[10], *norm_mem_g = a.in[11], *w_q = a.in[12], *w_k = a.in[13], *w_v = a.in[14], *w_o = a.in[15], *norm_ffn_g = a.in[16],
                *w_gate = a.in[17], *w_up = a.in[18], *w_down = a.in[19], *final_norm_g = a.in[20];
    float* out = a.out; unsigned char* ws = a.ws;
    float *SS1 = (float*)(ws + WS_SS1), *SS2 = (float*)(ws + WS_SS2), *SS3 = (float*)(ws + WS_SS3);
    bf16_t *Win_t = (bf16_t*)(ws + WS_WIN), *Wout_t = (bf16_t*)(ws + WS_WOUT), *Wq_t = (bf16_t*)(ws + WS_WQ), *Wk_t = (bf16_t*)(ws + WS_WK), *Wv_t = (bf16_t*)(ws + WS_WV), *Wo_t = (bf16_t*)(ws + WS_WO),
           *Wgu_t = (bf16_t*)(ws + WS_WGU), *Wd_t = (bf16_t*)(ws + WS_WD), *PWt = (bf16_t*)(ws + WS_PW), *WSb = (bf16_t*)(ws + WS_WSP), *MN = (bf16_t*)(ws + WS_MN), *KB = (bf16_t*)(ws + WS_KB),
           *VTM = (bf16_t*)(ws + WS_VTM), *XB = (bf16_t*)(ws + WS_XB), *HG = (bf16_t*)(ws + WS_HG), *PAU = (bf16_t*)(ws + WS_PAU), *Qb = (bf16_t*)(ws + WS_Q), *VT = (bf16_t*)(ws + WS_VT),
           *Yb = (bf16_t*)(ws + WS_Y), *Ob = (bf16_t*)(ws + WS_O);

    {
        const int tid = TID_FRESH(), lane = tid & 63, wave = __builtin_amdgcn_readfirstlane(tid >> 6);
        LAS float* scr = (LAS float*)(lds + wave * 16640);
        const int gw = bx * NWAVES + wave, NGW = G * NWAVES;
        constexpr int I_IN = 32 * 48, I_SQ = 32 * 32, I_PW = 4 * 16;
        constexpr int NITEMS = I_IN + 4 * I_SQ + I_PW;
        { float* RS0 = (float*)(ws + WS_RS0); for (int m = gw; m < M; m += 2 * NGW) raw_row2_bf16(x + (size_t)m * D, x + (size_t)(m + NGW) * D, m + NGW < M, XB + (size_t)m * D, XB + (size_t)(m + NGW) * D, RS0 + m, RS0 + m + NGW, lane); }
        for (int m = gw; m < MM; m += NGW) norm_row_bf16(mem + (size_t)m * D, norm_mem_g, MN + (size_t)m * D, lane);
        for (int it = gw; it < NITEMS * REP_P0; it += NGW) {
            int r = it % NITEMS;
            if (r < I_IN) { tr_item(w_in, 3072, (r / 48) * 64, (r % 48) * 64, Win_t, D, (r % 48) * 64, norm_mix_g, nullptr, scr, lane); continue; } r -= I_IN;
            if (r < I_SQ) { tr_item(w_k, D, (r / 32) * 64, (r % 32) * 64, Wk_t, D, (r % 32) * 64, nullptr, nullptr, scr, lane); continue; } r -= I_SQ;
            if (r < I_SQ) { tr_item(w_v, D, (r / 32) * 64, (r % 32) * 64, Wv_t, D, (r % 32) * 64, nullptr, nullptr, scr, lane); continue; } r -= I_SQ;
            if (r < I_SQ) { tr_item(w_out, D, (r / 32) * 64, (r % 32) * 64, Wout_t, D, (r % 32) * 64, nullptr, nullptr, scr, lane); continue; } r -= I_SQ;
#if ABSORB
            if (r < I_SQ) continue; r -= I_SQ;
#else
            if (r < I_SQ) { tr_item(w_q, D, (r / 32) * 64, (r % 32) * 64, Wq_t, D, (r % 32) * 64, norm_xattn_g, nullptr, scr, lane); continue; } r -= I_SQ;
#endif
            {
              bf16_t* PWn = (bf16_t*)(ws + WS_PWN);
#pragma unroll 4
              for (int j = 0; j < 16; ++j) { const int gc = r * 16 + j, g = gc >> 8; const f32x4 v = *(const f32x4*)(pool_w + (size_t)gc * 256 + lane * 4) * *(const f32x4*)(pool_scale + g * 256 + lane * 4);
                  u32x2 o; o.x = cvt_pk_bf16(v[0], v[1]); o.y = cvt_pk_bf16(v[2], v[3]); *(u32x2*)(PWn + (size_t)gc * 2048 + lane * 4) = o; *(u32x2*)(PWn + (size_t)gc * 2048 + 256 + lane * 4) = (u32x2){0u, 0u}; } }
        }
        for (int i = bx * NTHR + tid; i < 8 * 128 * 128 / 4; i += G * NTHR) { const f32x4 v = *((const f32x4*)w_spatial + i); const int s = (i * 4) & 127, t = ((i * 4) >> 7) & 127;
            const bool keep = (s >> 6) <= (t >> 6); u32x2 o; o.x = keep ? cvt_pk_bf16(v[0], v[1]) : 0u; o.y = keep ? cvt_pk_bf16(v[2], v[3]) : 0u; *((u32x2*)WSb + i) = o; }
    }
    if (a.ws == nullptr) grid.sync();
    xcd_barrier(xbar);
    STAMP(0);
    for (int rep = 0; rep < REP_P1; ++rep) {
        { pg8::Gemm g{XB, Win_t, M, 2048, D, D}; pg8::InProjOrder S; S.init(G, bx, XB, Win_t, MN, Wk_t, Wv_t); pg8::EpiInProj E{PAU, VT, KB, VTM, (const float*)(ws + WS_RS0)};
          pg8::gemm_phase<pg8::EpiInProj, pg8::InProjOrder, true, true>(lds, g, S, E); }
        { pg8::Gemm g{KB, Wq_t, 4096, D, 512, D}; pg8::PreQKOrder S{G, bx + 128, 160, Wout_t, (const bf16_t*)(ws + WS_PWN)}; pg8::EpiPre E{(bf16_t*)(ws + WS_WQK), Wout_t};
          pg8::gemm_phase<pg8::EpiPre, pg8::PreQKOrder, true, true>(lds, g, S, E); }
        {
            const int f0q = G > 64 ? 64 : 0; const int cq = bx - f0q, ncu = G - f0q;
            if (cq >= 0) { const int tid = TID_FRESH(), lane = tid & 63, wave = __builtin_amdgcn_readfirstlane(tid >> 6);
                for (int it = cq * NWAVES + wave; it < 1024; it += ncu * NWAVES) { const int k = it * 2 + (lane >> 5);
                    const float gk = norm_xattn_g[k]; const f32x4* src = (const f32x4*)(w_q + (size_t)k * D); u32x2* dst = (u32x2*)(Wq_t + (size_t)k * D);
#pragma unroll 4
                    for (int j = 0; j < 16; ++j) { const int q = (lane & 31) + 32 * j; const f32x4 v = src[q] * gk; u32x2 o; o.x = cvt_pk_bf16(v[0], v[1]); o.y = cvt_pk_bf16(v[2], v[3]); dst[q] = o; } } } }
        const int f0 = G > 64 ? 64 : 0;
        if (bx >= f0) {
            const int tid = TID_FRESH(), lane = tid & 63, wave = __builtin_amdgcn_readfirstlane(tid >> 6);
            LAS float* scr = (LAS float*)(lds + wave * 16640);
            constexpr int I_SQ = 32 * 32, I_GU = 32 * 88, I_DN = 88 * 32, NIT = I_SQ + 2 * I_GU + I_DN;
            for (int it = (bx - f0) * NWAVES + wave; it < NIT; it += (G - f0) * NWAVES) {
                int r = it;
                if (r < I_SQ) { tr_item(w_o, D, (r / 32) * 64, (r % 32) * 64, Wo_t, D, (r % 32) * 64, nullptr, nullptr, scr, lane); continue; } r -= I_SQ;
                if (r < 2 * I_GU) { const int up = r >= I_GU; if (up) r -= I_GU; const int n0 = (r % 88) * 64;
                    tr_item(up ? w_up : w_gate, DFF, (r / 88) * 64, n0, Wgu_t, D, (n0 >> 7) * 256 + (n0 & 127) + up * 128, norm_ffn_g, nullptr, scr, lane); continue; } r -= 2 * I_GU;
                tr_item(w_down, D, (r / 32) * 64, (r % 32) * 64, Wd_t, DFF, (r % 32) * 64, nullptr, nullptr, scr, lane);
            }
        }
    }
    xcd_barrier(xbar);
    STAMP(101);
    for (int uu = bx; uu < 256 * REP_P2; uu += G) { const int u = uu & 255; sgu_unit(lds, u >> 1, (u & 1) * 4, VT, PAU, Yb, WSb, sgu_norm_g, b_spatial, (int)threadIdx.x); pool_half(u >> 1, u & 1, PAU, Yb, (int)threadIdx.x); }
#if ABSORB
    { pg8::Gemm g{KB, Wq_t, 4096, D, 512, D}; pg8::PreQKOrder S{G, bx, 128, Wout_t, (const bf16_t*)(ws + WS_PWN)}; pg8::EpiPre E{(bf16_t*)(ws + WS_WQK), Wout_t}; pg8::gemm_phase<pg8::EpiPre, pg8::PreQKOrder, true, true>(lds, g, S, E); }
    { pg8::Gemm g{Wo_t, VTM, 8192, 1024, 512, D}; pg8::PreVOOrder S{G, (bx + G - 128 % G) % G}; pg8::EpiPlain E{(bf16_t*)(ws + WS_VWO), 1024}; pg8::gemm_phase<pg8::EpiPlain, pg8::PreVOOrder, true, true>(lds, g, S, E); }
#endif
    xcd_barrier(xbar);
    STAMP(102);
    for (int rep = 0; rep < REP_P3; ++rep) { pg8::Gemm g{Yb, Wout_t, M, D, D, D}; pg8::StaticOrder S; S.init(M, D, G, bx); pg8::EpiResid<false> E{nullptr, XB, XB, SS1, D, (LAS float*)(lds + 131072)}; GEMM_PHASE(pg8::EpiResid<false>, g, S, E); }
    xcd_barrier(xbar);
    STAMP(103);
#if ABSORB
    { pg8::Gemm g{XB, (const bf16_t*)(ws + WS_WQK), M, 1024, D, D}; pg8::ScoreOrder S{G, bx}; pg8::EpiSoftmaxN E{(bf16_t*)(ws + WS_PM), SS1, 1.0f / D, (LAS float*)(lds + 131072), 0.044194173824159216f * 1.4426950408889634f};
      pg8::gemm_phase<pg8::EpiSoftmaxN, pg8::ScoreOrder, true, true>(lds, g, S, E); }
    xcd_barrier(xbar);
    STAMP(104);
    { pg8::Gemm g{(const bf16_t*)(ws + WS_PM), (const bf16_t*)(ws + WS_VWO), M, D, 1024, 1024}; pg8::AttnOutOrder S{G, bx}; pg8::EpiResid<false> E{nullptr, XB, XB, SS2, D, (LAS float*)(lds + 131072)};
      pg8::gemm_phase<pg8::EpiResid<false>, pg8::AttnOutOrder, true, true>(lds, g, S, E); }
    xcd_barrier(xbar);
    STAMP(108);
#else
    for (int rep = 0; rep < REP_P4; ++rep) { pg8::Gemm g{XB, Wq_t, M, D, D, D}; pg8::StaticOrder S; S.init(M, D, G, bx); pg8::EpiRowScale E{Qb, D, SS1, 1.0f / D}; GEMM_PHASE(pg8::EpiRowScale, g, S, E); }
    xcd_barrier(xbar);
    STAMP(104);
#if OLD_ATTN
    for (int u = bx; u < 512 * REP_P5; u += G) attn_unit(lds, u & 511, Qb, KB, VTM, Ob, (int)threadIdx.x);
    xcd_barrier(xbar);
    STAMP(105);
#else
    for (int rep = 0; rep < REP_P5; ++rep) {
    { pg8::Gemm g{Qb, KB, M, 1024, 512, D}; pg8::AttnSOrder S{G, bx}; pg8::EpiSoftmax E{(bf16_t*)(ws + WS_PM), (float*)(ws + WS_RSP), (LAS float*)(lds + 131072), 0.044194173824159216f * 1.4426950408889634f};
      pg8::gemm_phase<pg8::EpiSoftmax, pg8::AttnSOrder, true, true>(lds, g, S, E); }
    xcd_barrier(xbar);
    STAMP(106);
    { pg8::Gemm g{(const bf16_t*)(ws + WS_PM), VTM, M, 2048, 256, 1024}; pg8::AttnPVOrder S{G, bx}; pg8::EpiAttnOut E{Ob, (const float*)(ws + WS_RSP)};
      pg8::gemm_phase<pg8::EpiAttnOut, pg8::AttnPVOrder, true, true>(lds, g, S, E); }
    xcd_barrier(xbar);
    STAMP(107);
    }
#endif
    { pg8::Gemm g{Ob, Wo_t, M, D, D, D}; pg8::StaticOrder S; S.init(M, D, G, bx); pg8::EpiResid<false> E{nullptr, XB, XB, SS2, D, (LAS float*)(lds + 131072)}; GEMM_PHASE(pg8::EpiResid<false>, g, S, E); }
    xcd_barrier(xbar);
    STAMP(108);
#endif
    for (int rep = 0; rep < REP_P7; ++rep) { pg8::Gemm g{XB, Wgu_t, M, 2 * DFF, D, D}; pg8::StaticOrder S; S.init(M, 2 * DFF, G, bx); pg8::EpiSwiglu E{HG, DFF, SS2, 1.0f / D}; GEMM_PHASE(pg8::EpiSwiglu, g, S, E); }
    xcd_barrier(xbar);
    STAMP(109);
#ifndef FUSE_FINAL
#define FUSE_FINAL 1
#endif
    if (FUSE_FINAL && G == 256) {
        pg8::Gemm g{HG, Wd_t, M, D, DFF, DFF}; pg8::DownOrder S{bx}; pg8::EpiFinal E{XB, out, SS3, (unsigned*)(ws + WS_PCNT), final_norm_g, (LAS float*)(lds + 131072), D};
        pg8::gemm_phase<pg8::EpiFinal, pg8::DownOrder, true, true>(lds, g, S, E);
    } else {
    { pg8::Gemm g{HG, Wd_t, M, D, DFF, DFF}; pg8::StaticOrder S; S.init(M, D, G, bx); pg8::EpiResid<false> E{nullptr, XB, XB, SS3, D, (LAS float*)(lds + 131072)}; GEMM_PHASE(pg8::EpiResid<false>, g, S, E); }
    xcd_barrier(xbar);
    STAMP(110);
    { const int tid = TID_FRESH(), lane = tid & 63, wave = __builtin_amdgcn_readfirstlane(tid >> 6); const int gw = bx * NWAVES + wave, NGW = G * NWAVES;
      for (int m0 = gw; m0 < M; m0 += 4 * NGW) {
          u32x4 w[4][4]; f32x4 pa[4], pb[4];
#pragma unroll
          for (int q = 0; q < 4; ++q) { const int m = m0 + q * NGW; if (m < M) { pa[q] = *(const f32x4*)(SS3 + (size_t)m * 8); pb[q] = *(const f32x4*)(SS3 + (size_t)m * 8 + 4);
#pragma unroll
              for (int j = 0; j < 4; ++j) w[q][j] = *(const u32x4*)(XB + (size_t)m * D + (lane + 64 * j) * 8); } }
#pragma unroll
          for (int q = 0; q < 4; ++q) { const int m = m0 + q * NGW; if (m < M) {
              const float rstd = 1.0f / sqrtf((((pa[q][0] + pa[q][1]) + (pa[q][2] + pa[q][3])) + ((pb[q][0] + pb[q][1]) + (pb[q][2] + pb[q][3]))) * (1.0f / D) + RMS_EPS);
#pragma unroll
              for (int j = 0; j < 4; ++j) { const int c = (lane + 64 * j) * 8; const f32x4 g0 = *(const f32x4*)(final_norm_g + c), g1 = *(const f32x4*)(final_norm_g + c + 4); const u32x4 ww = w[q][j];
                  const f32x4 y0 = (f32x4){bf_lo(ww.x), bf_hi(ww.x), bf_lo(ww.y), bf_hi(ww.y)} * rstd * g0, y1 = (f32x4){bf_lo(ww.z), bf_hi(ww.z), bf_lo(ww.w), bf_hi(ww.w)} * rstd * g1;
                  *(f32x4*)(out + (size_t)m * D + c) = y0; *(f32x4*)(out + (size_t)m * D + c + 4) = y1; } } } } }
    }
    if (TS_K >= 0 && bx == 0 && threadIdx.x == 0) { const unsigned dt = ts_lds[1] - ts_lds[0]; const unsigned t0 = (unsigned)__builtin_amdgcn_s_memrealtime(); while ((unsigned)__builtin_amdgcn_s_memrealtime() - t0 < dt) __builtin_amdgcn_s_sleep(8); }
}

extern "C" void kernel_launch(void* const* d_in, const int* in_sizes, int n_in, void* d_out, int out_size, void* d_ws, size_t ws_size, hipStream_t stream) {
    static int grid = 0;
    if (grid == 0) {
        if (n_in != 21 || in_sizes[0] != M * D || out_size != M * D || ws_size < WS_END) { fprintf(stderr, "kernel_launch: unexpected shapes (n_in %d, in0 %d, out %d, ws %zu); nothing launched\n", n_in, n_in > 0 ? in_sizes[0] : -1, out_size, ws_size); grid = -1; return; }
        int dev = 0, cus = 0, per_cu = 0;
        if (hipGetDevice(&dev) != hipSuccess || hipDeviceGetAttribute(&cus, hipDeviceAttributeMultiprocessorCount, dev) != hipSuccess) { grid = -1; return; }
        if (hipFuncSetAttribute((const void*)mk_fwd, hipFuncAttributeMaxDynamicSharedMemorySize, LDS_BYTES) != hipSuccess) { fprintf(stderr, "kernel_launch: hipFuncSetAttribute failed\n"); grid = -1; return; }
        if (hipOccupancyMaxActiveBlocksPerMultiprocessor(&per_cu, (const void*)mk_fwd, NTHR, LDS_BYTES) != hipSuccess || per_cu < 1) { fprintf(stderr, "kernel_launch: occupancy query says %d blocks per CU\n", per_cu); (void)hipGetLastError(); grid = -1; return; }
        grid = cus * per_cu;
    }
    if (grid < 0) return;
    if (hipMemsetAsync(d_ws, 0, WS_ZERO_BYTES, stream) != hipSuccess) { fprintf(stderr, "kernel_launch: hipMemsetAsync failed\n"); return; }
    Args a{};
    for (int i = 0; i < 21; ++i) a.in[i] = (const float*)d_in[i];
    a.out = (float*)d_out; a.ws = (unsigned char*)d_ws;
    void* args[] = {&a};
    const hipError_t e = hipLaunchCooperativeKernel((const void*)mk_fwd, dim3(grid), dim3(NTHR), args, LDS_BYTES, stream);
    if (e != hipSuccess) fprintf(stderr, "kernel_launch: cooperative launch failed: %s (grid %d)\n", hipGetErrorString(e), grid);
}
```

```cpp
#include <hip/hip_runtime.h>
#include <hip/hip_cooperative_groups.h>
#include <cstdio>
#include <cstdint>
namespace cg = cooperative_groups;
namespace pg8 {
#define PG8_LAS __attribute__((address_space(3)))
typedef unsigned short bf16_t;
typedef short bf16x8 __attribute__((ext_vector_type(8)));
typedef float f32x4 __attribute__((ext_vector_type(4)));
typedef unsigned u32x4 __attribute__((ext_vector_type(4)));
constexpr int BM = 256, BK = 64, HALF = 128, HTB = HALF * BK * 2  , STAGE_BYTES = 8 * HTB, NXCD = 8, WGM = 4;

__host__ __device__ __forceinline__ int lds_byte(int r, int c) { const int st = (r >> 4) * 2 + (c >> 5), rr = r & 15, cc = c & 31, ob = rr * 64 + cc * 2; return st * 1024 + (ob ^ (((ob >> 9) & 1) << 5)); }
__host__ __device__ __forceinline__ void stage_rc(int b, int& R, int& C) { const int st = b / 1024, sb = b % 1024, swz = sb ^ (((sb >> 9) & 1) << 5); R = (st >> 1) * 16 + swz / 64; C = (st & 1) * 32 + (swz % 64) / 2; }
__host__ __device__ __forceinline__ int perm32(int rho) { const int n = rho >> 4, i = rho & 15; return 8 * (i >> 2) + 4 * n + (i & 3); }

__device__ __forceinline__ const bf16_t* sel_ptr(bool c, const bf16_t* a, const bf16_t* b) { const unsigned long long m = 0ull - (unsigned long long)c; return (const bf16_t*)((((unsigned long long)a) & m) | (((unsigned long long)b) & ~m)); }
struct Unit { int pm, pn; const char* a = nullptr; const char* b = nullptr; };
struct Gemm { const bf16_t* A; const bf16_t* Bt; int M, N, K, ld; };

struct StaticOrder {
    int nM, nN, nwg, G, c;
    __host__ __device__ void init(int M, int N, int G_, int c_) { nM = M / BM; nN = N / BM; nwg = nM * nN; G = G_; c = c_; }
    __host__ __device__ bool next(int i, Unit& u) const {
        const long L = (long)i * G + c; if (L >= nwg) return false;
        int wgid = (int)L; { const int q = nwg / NXCD, r = nwg % NXCD, xcd = wgid % NXCD, off = wgid / NXCD; wgid = (xcd < r ? xcd * (q + 1) : r * (q + 1) + (xcd - r) * q) + off; }
        const int nig = WGM * nN, gid = wgid / nig, fm = gid * WGM, gsz = (nM - fm) < WGM ? (nM - fm) : WGM;
        u.pm = fm + ((wgid % nig) % gsz); u.pn = (wgid % nig) / gsz; return true;
    }
    __device__ __forceinline__ void a_ready(const Unit&) const {}
    __device__ __forceinline__ void done(const Unit&) const {}
    __device__ __forceinline__ const char* pA(const Gemm& g, const Unit& u) const { return (const char*)g.A + (size_t)u.pm * BM * g.ld * 2; }
    __device__ __forceinline__ const char* pB(const Gemm& g, const Unit& u) const { return (const char*)g.Bt + (size_t)u.pn * BM * g.ld * 2; }
};
struct DownOrder {
    int c;
    __device__ bool next(int i, Unit& u) const { if (i > 1) return false; const int xcd = c & 7, j = c >> 3; u.pm = i * 32 + xcd * 4 + (j >> 3); u.pn = j & 7; return true; }
    __device__ __forceinline__ void a_ready(const Unit&) const {}
    __device__ __forceinline__ void done(const Unit&) const {}
    __device__ __forceinline__ const char* pA(const Gemm& g, const Unit& u) const { return (const char*)g.A + (size_t)u.pm * BM * g.ld * 2; }
    __device__ __forceinline__ const char* pB(const Gemm& g, const Unit& u) const { return (const char*)g.Bt + (size_t)u.pn * BM * g.ld * 2; }
};
struct PreQKOrder {
    int G, c0, cmax; const bf16_t* Wout_t; const bf16_t* PWn;
    __device__ __forceinline__ bool next(int i, Unit& u) const { const int c = i * G + c0; if (c >= cmax) return false;
        if (c < 128) { u.pm = (c >> 5) * 4 + ((c >> 3) & 3); u.pn = c & 7; } else { const int q = c - 128; u.pm = 0x1000 | (q >> 2); u.pn = q & 3; } return true; }
    __device__ __forceinline__ void a_ready(const Unit&) const {}
    __device__ __forceinline__ void done(const Unit&) const {}
    __device__ __forceinline__ const char* pA(const Gemm& g, const Unit& u) const { const bool pw = (u.pm & 0x1000) != 0;
        const bf16_t* p = sel_ptr(pw, Wout_t + (size_t)(u.pm & 0xfff) * 256 * 2048 + u.pn * 256, g.A + (size_t)((u.pm & 0xfff) >> 2) * 256 * 2048 + (u.pm & 3) * 512); return (const char*)p; }
    __device__ __forceinline__ const char* pB(const Gemm& g, const Unit& u) const { const bool pw = (u.pm & 0x1000) != 0;
        const bf16_t* p = sel_ptr(pw, PWn + (size_t)u.pn * 256 * 2048, g.Bt + (size_t)u.pn * 256 * 2048 + (u.pm & 3) * 512); return (const char*)p; }
};
struct PreVOOrder {
    int G, c0;
    __device__ bool next(int i, Unit& u) const { const int c = i * G + c0; if (c >= 128) return false; u.pm = (c >> 5) * 8 + ((c >> 2) & 7); u.pn = c & 3; return true; }
    __device__ __forceinline__ void a_ready(const Unit&) const {}
    __device__ __forceinline__ void done(const Unit&) const {}
    __device__ __forceinline__ const char* pA(const Gemm& g, const Unit& u) const { return (const char*)(g.A + (size_t)(u.pm & 7) * 256 * 2048 + u.pn * 512); }
    __device__ __forceinline__ const char* pB(const Gemm& g, const Unit& u) const { return (const char*)(g.Bt + (size_t)(u.pm >> 3) * 256 * 2048 + u.pn * 512); }
};
struct ScoreOrder {
    int G, c;
    __device__ bool next(int i, Unit& u) const { if (G != 256) { const int L = i * G + c; if (L >= 256) return false; u.pm = L >> 2; u.pn = L & 3; return true; }
        if (i > 0) return false; const int xcd = c & 7, j = c >> 3; u.pm = xcd * 8 + (j >> 2); u.pn = j & 3; return true; }
    __device__ __forceinline__ void a_ready(const Unit&) const {}
    __device__ __forceinline__ void done(const Unit&) const {}
    __device__ __forceinline__ const char* pA(const Gemm& g, const Unit& u) const { return (const char*)(g.A + (size_t)u.pm * BM * 2048); }
    __device__ __forceinline__ const char* pB(const Gemm& g, const Unit& u) const { return (const char*)(g.Bt + (size_t)((u.pm >> 4) * 1024 + u.pn * 256) * 2048); }
};
struct AttnOutOrder {
    int G, c;
    __device__ bool next(int i, Unit& u) const { if (G != 256) { const int L = i * G + c; if (L >= 512) return false; u.pm = L >> 3; u.pn = L & 7; return true; }
        if (i > 1) return false; const int xcd = c & 7, j = c >> 3; u.pm = xcd * 8 + i * 4 + (j >> 3); u.pn = j & 7; return true; }
    __device__ __forceinline__ void a_ready(const Unit&) const {}
    __device__ __forceinline__ void done(const Unit&) const {}
    __device__ __forceinline__ const char* pA(const Gemm& g, const Unit& u) const { return (const char*)(g.A + (size_t)u.pm * BM * 1024); }
    __device__ __forceinline__ const char* pB(const Gemm& g, const Unit& u) const { return (const char*)(g.Bt + (size_t)((u.pm >> 4) * 2048 + u.pn * 256) * 1024); }
};
struct AttnSOrder {
    int G, c;
    __device__ bool next(int i, Unit& u) const { const int L = i * G + c; if (L >= 256) return false; u.pm = L >> 2; u.pn = L & 3; return true; }
    __device__ __forceinline__ void a_ready(const Unit&) const {}
    __device__ __forceinline__ void done(const Unit&) const {}
    __device__ __forceinline__ const char* pA(const Gemm& g, const Unit& u) const { return (const char*)(g.A + (size_t)u.pm * BM * 2048 + u.pn * 512); }
    __device__ __forceinline__ const char* pB(const Gemm& g, const Unit& u) const { return (const char*)(g.Bt + (size_t)(u.pm >> 4) * 256 * 2048 + u.pn * 512); }
};
struct AttnPVOrder {
    int G, c;
    __device__ bool next(int i, Unit& u) const { const int L = i * G + c; if (L >= 512) return false; u.pm = L >> 3; u.pn = L & 7; return true; }
    __device__ __forceinline__ void a_ready(const Unit&) const {}
    __device__ __forceinline__ void done(const Unit&) const {}
    __device__ __forceinline__ const char* pA(const Gemm& g, const Unit& u) const { return (const char*)(g.A + (size_t)u.pm * BM * 1024 + (u.pn >> 1) * 256); }
    __device__ __forceinline__ const char* pB(const Gemm& g, const Unit& u) const { return (const char*)(g.Bt + (size_t)u.pn * BM * 1024 + (u.pm >> 4) * 256); }
};

typedef __bf16 bf16x2v_ __attribute__((ext_vector_type(2)));
typedef float f32x2v_ __attribute__((ext_vector_type(2)));
__device__ __forceinline__ unsigned cvt_pk_bf16(float lo, float hi) { const f32x2v_ f = {lo, hi}; const bf16x2v_ b = __builtin_convertvector(f, bf16x2v_); return __builtin_bit_cast(unsigned, b); }
typedef unsigned u32x2 __attribute__((ext_vector_type(2)));
constexpr float RMS_EPS = 1e-6f;

struct EpiPlain {
    static constexpr bool PERM = true, AFTER_DRAIN = false;
    bf16_t* O; int ldc;
    __device__ __forceinline__ void operator()(const f32x4 (&acc)[2][2][4][2], const Unit& u, int wr, int wc, int fr, int fq) const {
        { const int l_ = (int)__builtin_amdgcn_mbcnt_hi(~0u, __builtin_amdgcn_mbcnt_lo(~0u, 0u)); fr = l_ & 15; fq = l_ >> 4; }
        const int row0 = u.pm * BM + wr * 64 + fr, col0 = u.pn * BM + wc * 32 + 8 * fq;
#pragma unroll
        for (int ai = 0; ai < 2; ++ai)
#pragma unroll
            for (int m = 0; m < 4; ++m) { bf16_t* rowp = O + (size_t)(row0 + ai * HALF + m * 16) * ldc + col0;
#pragma unroll
                for (int bj = 0; bj < 2; ++bj) { const f32x4 v0 = acc[ai][bj][m][0], v1 = acc[ai][bj][m][1];
                    u32x4 w; w.x = cvt_pk_bf16(v0[0], v0[1]); w.y = cvt_pk_bf16(v0[2], v0[3]); w.z = cvt_pk_bf16(v1[0], v1[1]); w.w = cvt_pk_bf16(v1[2], v1[3]);
                    *(u32x4*)(rowp + bj * HALF) = w; } }
    }
};
struct EpiPre {
    static constexpr bool PERM = true, AFTER_DRAIN = false;
    bf16_t* WQK; bf16_t* Wout_t;
    __device__ __forceinline__ void operator()(const f32x4 (&acc)[2][2][4][2], const Unit& u, int wr, int wc, int fr, int fq) const {
        const bool pw = (u.pm & 0x1000) != 0; Unit t; t.pm = u.pm & 0xfff; t.pn = u.pn; const EpiPlain E{(bf16_t*)sel_ptr(pw, Wout_t, WQK), 2048}; E(acc, t, wr, wc, fr, fq);
    }
};
struct EpiRowScale {
    static constexpr bool PERM = true, AFTER_DRAIN = false;
    bf16_t* O; int ldc; const float* SS; float inv_n;
    __device__ __forceinline__ void operator()(const f32x4 (&acc)[2][2][4][2], const Unit& u, int wr, int wc, int fr, int fq) const {
        const int row0 = u.pm * BM + wr * 64 + fr, col0 = u.pn * BM + wc * 32 + 8 * fq;
#pragma unroll
        for (int ai = 0; ai < 2; ++ai)
#pragma unroll
            for (int m = 0; m < 4; ++m) { const int row = row0 + ai * HALF + m * 16; bf16_t* rowp = O + (size_t)row * ldc + col0;
                const f32x4 pa = *(const f32x4*)(SS + (size_t)row * 8), pb = *(const f32x4*)(SS + (size_t)row * 8 + 4); const float rs = __builtin_amdgcn_rsqf((((pa[0] + pa[1]) + (pa[2] + pa[3])) + ((pb[0] + pb[1]) + (pb[2] + pb[3]))) * inv_n + RMS_EPS);
#pragma unroll
                for (int bj = 0; bj < 2; ++bj) { const f32x4 v0 = acc[ai][bj][m][0] * rs, v1 = acc[ai][bj][m][1] * rs;
                    u32x4 w; w.x = cvt_pk_bf16(v0[0], v0[1]); w.y = cvt_pk_bf16(v0[2], v0[3]); w.z = cvt_pk_bf16(v1[0], v1[1]); w.w = cvt_pk_bf16(v1[2], v1[3]);
                    *(u32x4*)(rowp + bj * HALF) = w; } }
    }
};
struct EpiRowScaleC {
    static constexpr bool PERM = true, AFTER_DRAIN = false;
    bf16_t* O; int ldc; const float* RS;
    __device__ __forceinline__ void operator()(const f32x4 (&acc)[2][2][4][2], const Unit& u, int wr, int wc, int fr, int fq) const {
        const int row0 = u.pm * BM + wr * 64 + fr, col0 = u.pn * BM + wc * 32 + 8 * fq;
#pragma unroll
        for (int ai = 0; ai < 2; ++ai)
#pragma unroll
            for (int m = 0; m < 4; ++m) { const int row = row0 + ai * HALF + m * 16; bf16_t* rowp = O + (size_t)row * ldc + col0; const float rs = RS[row];
#pragma unroll
                for (int bj = 0; bj < 2; ++bj) { const f32x4 v0 = acc[ai][bj][m][0] * rs, v1 = acc[ai][bj][m][1] * rs;
                    u32x4 w; w.x = cvt_pk_bf16(v0[0], v0[1]); w.y = cvt_pk_bf16(v0[2], v0[3]); w.z = cvt_pk_bf16(v1[0], v1[1]); w.w = cvt_pk_bf16(v1[2], v1[3]);
                    *(u32x4*)(rowp + bj * HALF) = w; } }
    }
};
struct EpiColScale {
    static constexpr bool PERM = true, AFTER_DRAIN = false;
    bf16_t* O; int ldc; const float* RS;
    __device__ __forceinline__ void operator()(const f32x4 (&acc)[2][2][4][2], const Unit& u, int wr, int wc, int fr, int fq) const {
        const int row0 = u.pm * BM + wr * 64 + fr, col0 = u.pn * BM + wc * 32 + 8 * fq;
        f32x4 c0[2], c1[2];
#pragma unroll
        for (int bj = 0; bj < 2; ++bj) { c0[bj] = *(const f32x4*)(RS + col0 + bj * HALF); c1[bj] = *(const f32x4*)(RS + col0 + bj * HALF + 4); }
#pragma unroll
        for (int ai = 0; ai < 2; ++ai)
#pragma unroll
            for (int m = 0; m < 4; ++m) { bf16_t* rowp = O + (size_t)(row0 + ai * HALF + m * 16) * ldc + col0;
#pragma unroll
                for (int bj = 0; bj < 2; ++bj) { const f32x4 v0 = acc[ai][bj][m][0] * c0[bj], v1 = acc[ai][bj][m][1] * c1[bj];
                    u32x4 w; w.x = cvt_pk_bf16(v0[0], v0[1]); w.y = cvt_pk_bf16(v0[2], v0[3]); w.z = cvt_pk_bf16(v1[0], v1[1]); w.w = cvt_pk_bf16(v1[2], v1[3]);
                    *(u32x4*)(rowp + bj * HALF) = w; } }
    }
};
struct InProjOrder {
    int G, c, cv, na, nb, nk, nv;
    const bf16_t *XB, *Win_t, *MN, *Wk_t, *Wv_t;
    static __device__ __forceinline__ int count(int nwg, int c, int G) { return c < nwg ? (nwg - c + G - 1) / G : 0; }
    __device__ __forceinline__ void init(int G_, int bx, const bf16_t* XB_, const bf16_t* Win_t_, const bf16_t* MN_, const bf16_t* Wk_t_, const bf16_t* Wv_t_) {
        G = G_; c = bx; cv = (bx + G_ - 32 % G_) % G_; na = count(512, c, G); nb = count(256, c, G); nk = count(32, c, G); nv = count(32, cv, G);
        XB = XB_; Win_t = Win_t_; MN = MN_; Wk_t = Wk_t_; Wv_t = Wv_t_; }
    __device__ __forceinline__ bool next(int i, Unit& u) const {
        StaticOrder t; t.G = G; bool ok;
        if (i < na) { t.nM = 64; t.nN = 8; t.nwg = 512; t.c = c; ok = t.next(i, u); u.a = (const char*)(XB + (size_t)u.pm * BM * 2048); u.b = (const char*)(Win_t + (size_t)u.pn * BM * 2048); }
        else if (i < na + nb) { t.nM = 4; t.nN = 64; t.nwg = 256; t.c = c; ok = t.next(i - na, u); u.a = (const char*)(Win_t + (size_t)(2048 + u.pm * BM) * 2048); u.b = (const char*)(XB + (size_t)u.pn * BM * 2048); u.pn |= 1 << 16; }
        else if (i < na + nb + nk) { t.nM = 4; t.nN = 8; t.nwg = 32; t.c = c; ok = t.next(i - na - nb, u); u.a = (const char*)(MN + (size_t)u.pm * BM * 2048); u.b = (const char*)(Wk_t + (size_t)u.pn * BM * 2048); u.pn |= 2 << 16; }
        else if (i < na + nb + nk + nv) { t.nM = 4; t.nN = 8; t.nwg = 32; t.c = cv; ok = t.next(i - na - nb - nk, u); u.a = (const char*)(MN + (size_t)u.pm * BM * 2048); u.b = (const char*)(Wv_t + (size_t)u.pn * BM * 2048); u.pn |= 3 << 16; }
        else return false;
        return ok; }
    __device__ __forceinline__ void a_ready(const Unit&) const {}
    __device__ __forceinline__ void done(const Unit&) const {}
    __device__ __forceinline__ const char* pA(const Gemm&, const Unit& u) const { return u.a; }
    __device__ __forceinline__ const char* pB(const Gemm&, const Unit& u) const { return u.b; }
};
struct EpiInProj {
    static constexpr bool PERM = true, AFTER_DRAIN = false;
    bf16_t *PAU, *VT, *KB, *VB; const float* RS0;
    __device__ __forceinline__ void operator()(const f32x4 (&acc)[2][2][4][2], const Unit& u, int wr, int wc, int fr, int fq) const {
        const int kind = u.pn >> 16; Unit t; t.pm = u.pm; t.pn = u.pn & 0xffff;
        if (kind == 0) { EpiRowScaleC E{PAU, 2048, RS0}; E(acc, t, wr, wc, fr, fq); }
        else if (kind == 1) { EpiColScale E{VT, 16384, RS0}; E(acc, t, wr, wc, fr, fq); }
        else { EpiPlain E{kind == 2 ? KB : VB, 2048}; E(acc, t, wr, wc, fr, fq); }
    }
};
__device__ __forceinline__ float silu_mul(float g, float u) { return g * u * __builtin_amdgcn_rcpf(1.0f + __expf(-g)); }
struct EpiSwiglu {
    static constexpr bool PERM = true, AFTER_DRAIN = false;
    bf16_t* O; int ldc; const float* SS; float inv_n;
    __device__ __forceinline__ void operator()(const f32x4 (&acc)[2][2][4][2], const Unit& u, int wr, int wc, int fr, int fq) const {
        const int row0 = u.pm * BM + wr * 64 + fr, col0 = u.pn * HALF + wc * 32 + 8 * fq;
#pragma unroll
        for (int ai = 0; ai < 2; ++ai)
#pragma unroll
            for (int m = 0; m < 4; ++m) { const int row = row0 + ai * HALF + m * 16;
                const f32x4 pa = *(const f32x4*)(SS + (size_t)row * 8), pb = *(const f32x4*)(SS + (size_t)row * 8 + 4); const float rs = __builtin_amdgcn_rsqf((((pa[0] + pa[1]) + (pa[2] + pa[3])) + ((pb[0] + pb[1]) + (pb[2] + pb[3]))) * inv_n + RMS_EPS);
                const f32x4 g0 = acc[ai][0][m][0] * rs, g1 = acc[ai][0][m][1] * rs, u0 = acc[ai][1][m][0] * rs, u1 = acc[ai][1][m][1] * rs;
                u32x4 w;
                w.x = cvt_pk_bf16(silu_mul(g0[0], u0[0]), silu_mul(g0[1], u0[1])); w.y = cvt_pk_bf16(silu_mul(g0[2], u0[2]), silu_mul(g0[3], u0[3]));
                w.z = cvt_pk_bf16(silu_mul(g1[0], u1[0]), silu_mul(g1[1], u1[1])); w.w = cvt_pk_bf16(silu_mul(g1[2], u1[2]), silu_mul(g1[3], u1[3]));
                *(u32x4*)(O + (size_t)row * ldc + col0) = w; }
    }
};
struct EpiSoftmax {
    static constexpr bool PERM = true, AFTER_DRAIN = false;
    bf16_t* P; float* RSP; __attribute__((address_space(3))) float* xm; float sl2;
    __device__ __forceinline__ void operator()(const f32x4 (&acc)[2][2][4][2], const Unit& u, int wr, int wc, int fr, int fq) const {
        const int h = u.pn;
#pragma unroll
        for (int ai = 0; ai < 2; ++ai)
#pragma unroll
            for (int m = 0; m < 4; ++m) { float v = -3.0e38f;
#pragma unroll
                for (int bj = 0; bj < 2; ++bj)
#pragma unroll
                    for (int n = 0; n < 2; ++n) { const f32x4 x = acc[ai][bj][m][n]; v = fmaxf(v, fmaxf(fmaxf(x[0], x[1]), fmaxf(x[2], x[3]))); }
                v = fmaxf(v, __shfl_xor(v, 16)); v = fmaxf(v, __shfl_xor(v, 32));
                if (fq == 0) xm[(ai * HALF + wr * 64 + m * 16 + fr) * 4 + wc] = v; }
        asm volatile("s_waitcnt lgkmcnt(0)" ::: "memory"); __builtin_amdgcn_s_barrier(); asm volatile("" ::: "memory");
#pragma unroll
        for (int ai = 0; ai < 2; ++ai)
#pragma unroll
            for (int m = 0; m < 4; ++m) { const int r = ai * HALF + wr * 64 + m * 16 + fr; const int row = u.pm * BM + r;
                const f32x4 mm = *(const __attribute__((address_space(3))) f32x4*)(xm + r * 4); const float mx = fmaxf(fmaxf(mm[0], mm[1]), fmaxf(mm[2], mm[3])) * sl2; float s = 0.f;
#pragma unroll
                for (int bj = 0; bj < 2; ++bj) { f32x4 p0, p1;
#pragma unroll
                    for (int j = 0; j < 4; ++j) { p0[j] = __builtin_amdgcn_exp2f(acc[ai][bj][m][0][j] * sl2 - mx); p1[j] = __builtin_amdgcn_exp2f(acc[ai][bj][m][1][j] * sl2 - mx); }
                    s += ((p0[0] + p0[1]) + (p0[2] + p0[3])) + ((p1[0] + p1[1]) + (p1[2] + p1[3]));
                    u32x4 w; w.x = cvt_pk_bf16(p0[0], p0[1]); w.y = cvt_pk_bf16(p0[2], p0[3]); w.z = cvt_pk_bf16(p1[0], p1[1]); w.w = cvt_pk_bf16(p1[2], p1[3]);
                    *(u32x4*)(P + (size_t)row * 1024 + h * 256 + bj * HALF + wc * 32 + 8 * fq) = w; }
                s += __shfl_xor(s, 16); s += __shfl_xor(s, 32);
                if (fq == 0) RSP[(size_t)row * 16 + h * 4 + wc] = s; }
    }
};
struct EpiSoftmaxN {
    static constexpr bool PERM = true, AFTER_DRAIN = false;
    bf16_t* P; const float* SS; float inv_n; __attribute__((address_space(3))) float* xm; float sl2;
    __device__ __forceinline__ void operator()(f32x4 (&acc)[2][2][4][2], const Unit& u, int wr, int wc, int fr, int fq) const {
        { const int l_ = (int)__builtin_amdgcn_mbcnt_hi(~0u, __builtin_amdgcn_mbcnt_lo(~0u, 0u)); fr = l_ & 15; fq = l_ >> 4; }
        const int h = u.pn; __attribute__((address_space(3))) float* xs = xm + 1024;
#pragma unroll
        for (int ai = 0; ai < 2; ++ai)
#pragma unroll
            for (int m = 0; m < 4; ++m) { float v = -3.0e38f;
#pragma unroll
                for (int bj = 0; bj < 2; ++bj)
#pragma unroll
                    for (int n = 0; n < 2; ++n) { const f32x4 x = acc[ai][bj][m][n]; v = fmaxf(v, fmaxf(fmaxf(x[0], x[1]), fmaxf(x[2], x[3]))); }
                v = fmaxf(v, __shfl_xor(v, 16)); v = fmaxf(v, __shfl_xor(v, 32));
                if (fq == 0) xm[(ai * HALF + wr * 64 + m * 16 + fr) * 4 + wc] = v; }
        asm volatile("s_waitcnt lgkmcnt(0)" ::: "memory"); __builtin_amdgcn_s_barrier(); asm volatile("" ::: "memory");
#pragma unroll
        for (int ai = 0; ai < 2; ++ai)
#pragma unroll
            for (int m = 0; m < 4; ++m) { const int r = ai * HALF + wr * 64 + m * 16 + fr; const int row = u.pm * BM + r;
                const f32x4 pa = *(const f32x4*)(SS + (size_t)row * 8), pb = *(const f32x4*)(SS + (size_t)row * 8 + 4);
                const float f = sl2 * __builtin_amdgcn_rsqf((((pa[0] + pa[1]) + (pa[2] + pa[3])) + ((pb[0] + pb[1]) + (pb[2] + pb[3]))) * inv_n + RMS_EPS);
                const f32x4 mm = *(const __attribute__((address_space(3))) f32x4*)(xm + r * 4); const float mx = fmaxf(fmaxf(mm[0], mm[1]), fmaxf(mm[2], mm[3])) * f; float s = 0.f;
#pragma unroll
                for (int bj = 0; bj < 2; ++bj)
#pragma unroll
                    for (int n = 0; n < 2; ++n) { f32x4 p;
#pragma unroll
                        for (int j = 0; j < 4; ++j) p[j] = __builtin_amdgcn_exp2f(acc[ai][bj][m][n][j] * f - mx);
                        acc[ai][bj][m][n] = p; s += (p[0] + p[1]) + (p[2] + p[3]); }
                s += __shfl_xor(s, 16); s += __shfl_xor(s, 32);
                if (fq == 0) xs[r * 4 + wc] = s; }
        asm volatile("s_waitcnt lgkmcnt(0)" ::: "memory"); __builtin_amdgcn_s_barrier(); asm volatile("" ::: "memory");
#pragma unroll
        for (int ai = 0; ai < 2; ++ai)
#pragma unroll
            for (int m = 0; m < 4; ++m) { const int r = ai * HALF + wr * 64 + m * 16 + fr; const int row = u.pm * BM + r;
                const f32x4 ps = *(const __attribute__((address_space(3))) f32x4*)(xs + r * 4); const float inv = 1.0f / ((ps[0] + ps[1]) + (ps[2] + ps[3]));
#pragma unroll
                for (int bj = 0; bj < 2; ++bj) { const f32x4 v0 = acc[ai][bj][m][0] * inv, v1 = acc[ai][bj][m][1] * inv;
                    u32x4 w; w.x = cvt_pk_bf16(v0[0], v0[1]); w.y = cvt_pk_bf16(v0[2], v0[3]); w.z = cvt_pk_bf16(v1[0], v1[1]); w.w = cvt_pk_bf16(v1[2], v1[3]);
                    *(u32x4*)(P + (size_t)row * 1024 + h * 256 + bj * HALF + wc * 32 + 8 * fq) = w; } }
    }
};
struct EpiFinal {
    static constexpr bool PERM = true, AFTER_DRAIN = false;
    const bf16_t* res16; float* out; float* SS; unsigned* cnt; const float* gfin; __attribute__((address_space(3))) float* xs; int ldc;
    __device__ __forceinline__ void operator()(f32x4 (&acc)[2][2][4][2], const Unit& u, int wr, int wc, int fr, int fq) const {
        const int lane = (int)__builtin_amdgcn_mbcnt_hi(~0u, __builtin_amdgcn_mbcnt_lo(~0u, 0u)); fr = lane & 15; fq = lane >> 4;
        __attribute__((address_space(3))) float* rsl = xs + 1024;
        const int col0 = u.pn * BM + wc * 32 + 8 * fq;
#pragma unroll
        for (int ai = 0; ai < 2; ++ai) { u32x4 rh[4][2];
#pragma unroll
            for (int m = 0; m < 4; ++m) { const size_t off = (size_t)(u.pm * BM + ai * HALF + wr * 64 + m * 16 + fr) * ldc + col0;
#pragma unroll
                for (int bj = 0; bj < 2; ++bj) rh[m][bj] = *(const u32x4*)(res16 + off + bj * HALF); }
#pragma unroll
            for (int m = 0; m < 4; ++m) { float s = 0.f;
#pragma unroll
                for (int bj = 0; bj < 2; ++bj) { const u32x4 rb = rh[m][bj];
                    const f32x4 r0 = (f32x4){__uint_as_float(rb.x << 16), __uint_as_float(rb.x & 0xffff0000u), __uint_as_float(rb.y << 16), __uint_as_float(rb.y & 0xffff0000u)};
                    const f32x4 r1 = (f32x4){__uint_as_float(rb.z << 16), __uint_as_float(rb.z & 0xffff0000u), __uint_as_float(rb.w << 16), __uint_as_float(rb.w & 0xffff0000u)};
                    const f32x4 v0 = r0 + acc[ai][bj][m][0], v1 = r1 + acc[ai][bj][m][1]; acc[ai][bj][m][0] = v0; acc[ai][bj][m][1] = v1;
                    s += ((v0[0] * v0[0] + v0[1] * v0[1]) + (v0[2] * v0[2] + v0[3] * v0[3])) + ((v1[0] * v1[0] + v1[1] * v1[1]) + (v1[2] * v1[2] + v1[3] * v1[3])); }
                s += __shfl_xor(s, 16); s += __shfl_xor(s, 32); if (fq == 0) xs[(ai * HALF + wr * 64 + m * 16 + fr) * 4 + wc] = s; }
            asm volatile("" ::: "memory"); }
        asm volatile("s_waitcnt lgkmcnt(0)" ::: "memory"); __builtin_amdgcn_s_barrier(); asm volatile("" ::: "memory");
        if (fq == 0) {
#pragma unroll
            for (int ai = 0; ai < 2; ++ai) { const int r = ai * HALF + wr * 64 + wc * 16 + fr; const f32x4 p = *(const __attribute__((address_space(3))) f32x4*)(xs + r * 4);
                __hip_atomic_store(SS + (size_t)(u.pm * BM + r) * 8 + u.pn, (p[0] + p[1]) + (p[2] + p[3]), __ATOMIC_RELAXED, __HIP_MEMORY_SCOPE_AGENT); } }
        asm volatile("s_waitcnt vmcnt(0)" ::: "memory");
        if (lane == 0) __hip_atomic_fetch_add(cnt + 64 * u.pm, 1u, __ATOMIC_RELAXED, __HIP_MEMORY_SCOPE_AGENT);
        if (wr == 0 && wc == 0) {
            unsigned sp = 0u;
            while ((unsigned)__builtin_amdgcn_readfirstlane((int)__hip_atomic_load(cnt + 64 * u.pm, __ATOMIC_RELAXED, __HIP_MEMORY_SCOPE_AGENT)) < 64u) { __builtin_amdgcn_s_sleep(2); if (++sp > (1u << 22)) break; }
            __builtin_amdgcn_fence(__ATOMIC_ACQUIRE, "agent"); }
        asm volatile("s_waitcnt vmcnt(0) lgkmcnt(0)" ::: "memory"); __builtin_amdgcn_s_barrier(); asm volatile("" ::: "memory");
        if (wr == 0) {
            const int r = wc * 64 + lane; const unsigned long long* sp = (const unsigned long long*)(SS + (size_t)(u.pm * BM + r) * 8); float t = 0.f;
#pragma unroll
            for (int q = 0; q < 4; ++q) { const unsigned long long w = __hip_atomic_load(sp + q, __ATOMIC_RELAXED, __HIP_MEMORY_SCOPE_AGENT); t += __uint_as_float((unsigned)w) + __uint_as_float((unsigned)(w >> 32)); }
            rsl[r] = __builtin_amdgcn_rsqf(t * (1.0f / 2048.0f) + RMS_EPS); }
        asm volatile("s_waitcnt vmcnt(0) lgkmcnt(0)" ::: "memory"); __builtin_amdgcn_s_barrier(); asm volatile("" ::: "memory");
        f32x4 g0[2], g1[2];
#pragma unroll
        for (int bj = 0; bj < 2; ++bj) { g0[bj] = *(const f32x4*)(gfin + col0 + bj * HALF); g1[bj] = *(const f32x4*)(gfin + col0 + bj * HALF + 4); }
#pragma unroll
        for (int ai = 0; ai < 2; ++ai)
#pragma unroll
            for (int m = 0; m < 4; ++m) { const int r = ai * HALF + wr * 64 + m * 16 + fr; const float rs = rsl[r]; float* op = out + (size_t)(u.pm * BM + r) * ldc + col0;
#pragma unroll
                for (int bj = 0; bj < 2; ++bj) { *(f32x4*)(op + bj * HALF) = acc[ai][bj][m][0] * rs * g0[bj]; *(f32x4*)(op + bj * HALF + 4) = acc[ai][bj][m][1] * rs * g1[bj]; } }
    }
};
struct EpiAttnOut {
    static constexpr bool PERM = true, AFTER_DRAIN = false;
    bf16_t* O; const float* RSP;
    __device__ __forceinline__ void operator()(const f32x4 (&acc)[2][2][4][2], const Unit& u, int wr, int wc, int fr, int fq) const {
        const int row0 = u.pm * BM + wr * 64 + fr, col0 = u.pn * BM + wc * 32 + 8 * fq, h = u.pn >> 1;
#pragma unroll
        for (int ai = 0; ai < 2; ++ai)
#pragma unroll
            for (int m = 0; m < 4; ++m) { const int row = row0 + ai * HALF + m * 16; bf16_t* rowp = O + (size_t)row * 2048 + col0;
                const f32x4 ps = *(const f32x4*)(RSP + (size_t)row * 16 + h * 4); const float rs = 1.0f / ((ps[0] + ps[1]) + (ps[2] + ps[3]));
#pragma unroll
                for (int bj = 0; bj < 2; ++bj) { const f32x4 v0 = acc[ai][bj][m][0] * rs, v1 = acc[ai][bj][m][1] * rs;
                    u32x4 w; w.x = cvt_pk_bf16(v0[0], v0[1]); w.y = cvt_pk_bf16(v0[2], v0[3]); w.z = cvt_pk_bf16(v1[0], v1[1]); w.w = cvt_pk_bf16(v1[2], v1[3]);
                    *(u32x4*)(rowp + bj * HALF) = w; } }
    }
};
template <bool RES_F32> struct EpiResid {
    static constexpr bool PERM = true, AFTER_DRAIN = false;
    const float* res32; const bf16_t* res16; bf16_t* xb; float* SS; int ldc; __attribute__((address_space(3))) float* xs;
    __device__ __forceinline__ void operator()(const f32x4 (&acc)[2][2][4][2], const Unit& u, int wr, int wc, int fr, int fq) const {
        const int col0 = u.pn * BM + wc * 32 + 8 * fq;
#pragma unroll
        for (int ai = 0; ai < 2; ++ai) {
            f32x4 rf[RES_F32 ? 4 : 1][2][2]; u32x4 rh[RES_F32 ? 1 : 4][2];
#pragma unroll
            for (int m = 0; m < 4; ++m) { const size_t off = (size_t)(u.pm * BM + ai * HALF + wr * 64 + m * 16 + fr) * ldc + col0;
#pragma unroll
                for (int bj = 0; bj < 2; ++bj) {
                    if constexpr (RES_F32) { rf[m][bj][0] = *(const f32x4*)(res32 + off + bj * HALF); rf[m][bj][1] = *(const f32x4*)(res32 + off + bj * HALF + 4); }
                    else rh[m][bj] = *(const u32x4*)(res16 + off + bj * HALF); } }
#pragma unroll
            for (int m = 0; m < 4; ++m) { const int row = u.pm * BM + ai * HALF + wr * 64 + m * 16 + fr; const size_t off = (size_t)row * ldc + col0; float s = 0.f;
#pragma unroll
                for (int bj = 0; bj < 2; ++bj) { f32x4 r0, r1;
                    if constexpr (RES_F32) { r0 = rf[m][bj][0]; r1 = rf[m][bj][1]; }
                    else { const u32x4 rb = rh[m][bj];
                        r0 = (f32x4){__uint_as_float(rb.x << 16), __uint_as_float(rb.x & 0xffff0000u), __uint_as_float(rb.y << 16), __uint_as_float(rb.y & 0xffff0000u)};
                        r1 = (f32x4){__uint_as_float(rb.z << 16), __uint_as_float(rb.z & 0xffff0000u), __uint_as_float(rb.w << 16), __uint_as_float(rb.w & 0xffff0000u)}; }
                    const f32x4 v0 = r0 + acc[ai][bj][m][0], v1 = r1 + acc[ai][bj][m][1];
                    u32x4 w; w.x = cvt_pk_bf16(v0[0], v0[1]); w.y = cvt_pk_bf16(v0[2], v0[3]); w.z = cvt_pk_bf16(v1[0], v1[1]); w.w = cvt_pk_bf16(v1[2], v1[3]);
                    *(u32x4*)(xb + off + bj * HALF) = w;
                    s += ((v0[0] * v0[0] + v0[1] * v0[1]) + (v0[2] * v0[2] + v0[3] * v0[3])) + ((v1[0] * v1[0] + v1[1] * v1[1]) + (v1[2] * v1[2] + v1[3] * v1[3])); }
                s += __shfl_xor(s, 16); s += __shfl_xor(s, 32); if (fq == 0) xs[(ai * HALF + wr * 64 + m * 16 + fr) * 4 + wc] = s; }
            asm volatile("" ::: "memory"); }
        asm volatile("s_waitcnt lgkmcnt(0)" ::: "memory"); __builtin_amdgcn_s_barrier(); asm volatile("" ::: "memory");
        if (fq == 0) {
#pragma unroll
            for (int ai = 0; ai < 2; ++ai) { const int r = ai * HALF + wr * 64 + wc * 16 + fr; const f32x4 p = *(const __attribute__((address_space(3))) f32x4*)(xs + r * 4);
                SS[(size_t)(u.pm * BM + r) * 8 + u.pn] = (p[0] + p[1]) + (p[2] + p[3]); } }
    }
};
template <class Epi, class Sched, bool ALIGN_EPI = false, bool SP2 = false>
__device__ __forceinline__ void gemm_phase(PG8_LAS unsigned char* lds, const Gemm g, const Sched& S, const Epi& E) {
    int tid_ = threadIdx.x; asm volatile("" : "+v"(tid_));
    const int tid = tid_, wid = __builtin_amdgcn_readfirstlane(tid >> 6), lane = tid & 63, wr = wid >> 2, wc = wid & 3, fr = lane & 15, fq = lane >> 4;
    const int K = g.ld, nt = g.K / BK;
    unsigned voffA[2], voffB[2];
#pragma unroll
    for (int i = 0; i < 2; ++i) { int R, C; stage_rc(tid * 16 + i * 8192, R, C); const int Rb = Epi::PERM ? ((R & ~31) + perm32(R & 31)) : R;
        voffA[i] = (unsigned)(R * K + C) * 2u; voffB[i] = (unsigned)(Rb * K + C) * 2u; }
    const size_t kstep = (size_t)(BK * 2);
    const size_t hstep = (size_t)HALF * K * 2;
    const unsigned ldsw = (unsigned)wid * 1024u;
    const int aoff = lds_byte(wr * 64 + fr, fq * 8), boff = lds_byte(wc * 32 + fr, fq * 8);
#define PG8_SA(b, h) (((b) * 2 + (h)) * HTB)
#define PG8_SB(b, h) ((4 + (b) * 2 + (h)) * HTB)
#define PG8_STAGE(bufoff, gbase, voff) do { _Pragma("unroll") for (int _i = 0; _i < 2; ++_i) \
        __builtin_amdgcn_global_load_lds((const unsigned*)((const char*)(gbase) + (voff)[_i]), (PG8_LAS unsigned*)(lds + (bufoff) + ldsw + _i * 8192), 16, 0, 0); } while (0)
#define PG8_LDA(dst, b, h) do { _Pragma("unroll") for (int m = 0; m < 4; ++m) _Pragma("unroll") for (int k = 0; k < 2; ++k) dst[m][k] = *(const PG8_LAS bf16x8*)(lds + PG8_SA(b, h) + aoff + m * 2048 + k * 1024); } while (0)
#define PG8_LDB(dst, b, h) do { _Pragma("unroll") for (int n = 0; n < 2; ++n) _Pragma("unroll") for (int k = 0; k < 2; ++k) dst[n][k] = *(const PG8_LAS bf16x8*)(lds + PG8_SB(b, h) + boff + n * 2048 + k * 1024); } while (0)
#define PG8_MMA(ai, bj, At, Bt) do { __builtin_amdgcn_s_setprio(1); _Pragma("unroll") for (int m = 0; m < 4; ++m) _Pragma("unroll") for (int n = 0; n < 2; ++n) _Pragma("unroll") for (int k = 0; k < 2; ++k) \
        acc[ai][bj][m][n] = __builtin_amdgcn_mfma_f32_16x16x32_bf16(Bt[n][k], At[m][k], acc[ai][bj][m][n], 0, 0, 0); __builtin_amdgcn_s_setprio(0); } while (0)
#define PG8_WAIT_V(n) asm volatile("s_waitcnt vmcnt(" #n ")" ::: "memory")
#define PG8_WAIT_L(n) asm volatile("s_waitcnt lgkmcnt(" #n ")" ::: "memory")
#define PG8_BAR __builtin_amdgcn_s_barrier()
#define PG8_SCHED __builtin_amdgcn_sched_barrier(0)
    Unit cur, nxt; int ui = 0;
    if (!S.next(0, cur)) return;
    f32x4 acc[2][2][4][2];
#pragma unroll
    for (int a = 0; a < 2; ++a)
#pragma unroll
        for (int b = 0; b < 2; ++b)
#pragma unroll
            for (int m = 0; m < 4; ++m)
#pragma unroll
                for (int n = 0; n < 2; ++n) acc[a][b][m][n] = (f32x4){0.f, 0.f, 0.f, 0.f};
    bf16x8 At[4][2], B0[2][2], B1[2][2];
    const char* cA = S.pA(g, cur); const char* cB = S.pB(g, cur);
    S.a_ready(cur);
    if constexpr (SP2) {
        PG8_STAGE(PG8_SB(0, 0), cB, voffB); PG8_STAGE(PG8_SB(0, 1), cB + hstep, voffB); PG8_STAGE(PG8_SA(0, 0), cA, voffA); PG8_STAGE(PG8_SA(0, 1), cA + hstep, voffA);
        if (wr == 1) PG8_BAR;
        PG8_WAIT_V(2); PG8_BAR;
        PG8_STAGE(PG8_SB(1, 0), cB + kstep, voffB); PG8_STAGE(PG8_SA(1, 0), cA + kstep, voffA); PG8_STAGE(PG8_SB(1, 1), cB + hstep + kstep, voffB);
        PG8_WAIT_V(6); PG8_BAR;
    } else {
        PG8_STAGE(PG8_SB(0, 0), cB, voffB); PG8_STAGE(PG8_SA(0, 0), cA, voffA); PG8_STAGE(PG8_SB(0, 1), cB + hstep, voffB); PG8_STAGE(PG8_SA(0, 1), cA + hstep, voffA);
        if (wr == 1) PG8_BAR;
        PG8_WAIT_V(4); PG8_BAR;
        PG8_STAGE(PG8_SB(1, 0), cB + kstep, voffB); PG8_STAGE(PG8_SA(1, 0), cA + kstep, voffA); PG8_STAGE(PG8_SB(1, 1), cB + hstep + kstep, voffB);
        PG8_WAIT_V(6); PG8_BAR;
    }
    for (;;) {
        const bool has_next = S.next(ui + 1, nxt);
        const char* nA = has_next ? S.pA(g, nxt) : cA; const char* nB = has_next ? S.pB(g, nxt) : cB;
        for (int t = 0; t < nt; t += 2) {
            const bool last = (t == nt - 2);
            const char* a1 = cA + (size_t)(t + 1) * kstep;
            const char* a2 = last ? nA : cA + (size_t)(t + 2) * kstep; const char* b2 = last ? nB : cB + (size_t)(t + 2) * kstep;
            const char* a3 = a2 + kstep; const char* b3 = b2 + kstep;
            if (last && has_next) S.a_ready(nxt);
            if constexpr (SP2) {
            PG8_LDB(B0, 0, 0); PG8_LDB(B1, 0, 1); PG8_SCHED; PG8_LDA(At, 0, 0); PG8_STAGE(PG8_SA(1, 1), a1 + hstep, voffA);
            PG8_WAIT_V(8); PG8_WAIT_L(0); PG8_BAR; PG8_MMA(0, 0, At, B0); PG8_MMA(0, 1, At, B1); PG8_BAR; PG8_SCHED;
            PG8_LDA(At, 0, 1); PG8_STAGE(PG8_SB(0, 0), b2, voffB); PG8_STAGE(PG8_SB(0, 1), b2 + hstep, voffB); PG8_STAGE(PG8_SA(0, 0), a2, voffA);
            PG8_WAIT_V(8); PG8_WAIT_L(0); PG8_BAR; PG8_MMA(1, 0, At, B0); PG8_MMA(1, 1, At, B1); PG8_BAR; PG8_SCHED;
            PG8_LDB(B0, 1, 0); PG8_LDB(B1, 1, 1); PG8_SCHED; PG8_LDA(At, 1, 0); PG8_STAGE(PG8_SA(0, 1), a2 + hstep, voffA);
            PG8_WAIT_V(8); PG8_WAIT_L(0); PG8_BAR; PG8_MMA(0, 0, At, B0); PG8_MMA(0, 1, At, B1); PG8_BAR; PG8_SCHED;
            PG8_LDA(At, 1, 1); PG8_STAGE(PG8_SB(1, 0), b3, voffB); PG8_STAGE(PG8_SB(1, 1), b3 + hstep, voffB); PG8_STAGE(PG8_SA(1, 0), a3, voffA);
            PG8_WAIT_V(8); PG8_WAIT_L(0); PG8_BAR; PG8_MMA(1, 0, At, B0); PG8_MMA(1, 1, At, B1); PG8_BAR; PG8_SCHED;
            } else {
            PG8_LDB(B0, 0, 0); PG8_SCHED; PG8_LDA(At, 0, 0); PG8_STAGE(PG8_SA(1, 1), a1 + hstep, voffA);
            PG8_WAIT_L(8); PG8_BAR; PG8_WAIT_L(0); PG8_MMA(0, 0, At, B0); PG8_BAR; PG8_SCHED;
            PG8_LDB(B1, 0, 1); PG8_STAGE(PG8_SB(0, 0), b2, voffB);
            PG8_BAR; PG8_WAIT_L(0); PG8_MMA(0, 1, At, B1); PG8_BAR;
            PG8_LDA(At, 0, 1); PG8_STAGE(PG8_SA(0, 0), a2, voffA);
            PG8_BAR; PG8_WAIT_L(0); PG8_MMA(1, 0, At, B0); PG8_BAR; PG8_SCHED;
            PG8_STAGE(PG8_SB(0, 1), b2 + hstep, voffB);
            PG8_WAIT_V(6); PG8_BAR; PG8_MMA(1, 1, At, B1); PG8_BAR;
            PG8_LDB(B0, 1, 0); PG8_SCHED; PG8_LDA(At, 1, 0); PG8_STAGE(PG8_SA(0, 1), a2 + hstep, voffA);
            PG8_WAIT_L(8); PG8_BAR; PG8_WAIT_L(0); PG8_MMA(0, 0, At, B0); PG8_BAR; PG8_SCHED;
            PG8_LDB(B1, 1, 1); PG8_STAGE(PG8_SB(1, 0), b3, voffB);
            PG8_BAR; PG8_WAIT_L(0); PG8_MMA(0, 1, At, B1); PG8_BAR;
            PG8_LDA(At, 1, 1); PG8_STAGE(PG8_SA(1, 0), a3, voffA);
            PG8_BAR; PG8_WAIT_L(0); PG8_MMA(1, 0, At, B0); PG8_BAR; PG8_SCHED;
            PG8_STAGE(PG8_SB(1, 1), b3 + hstep, voffB);
            PG8_WAIT_V(6); PG8_BAR; PG8_MMA(1, 1, At, B1); PG8_BAR;
            }
        }
        if constexpr (ALIGN_EPI) { if (wr == 0) PG8_BAR; }
        if constexpr (!Epi::AFTER_DRAIN) { E(acc, cur, wr, wc, fr, fq); S.done(cur); }
        if (!has_next) break;
#pragma unroll
        for (int a = 0; a < 2; ++a)
#pragma unroll
            for (int b = 0; b < 2; ++b)
#pragma unroll
                for (int m = 0; m < 4; ++m)
#pragma unroll
                    for (int n = 0; n < 2; ++n) acc[a][b][m][n] = (f32x4){0.f, 0.f, 0.f, 0.f};
        cur = nxt; cA = nA; cB = nB; ++ui;
        if constexpr (ALIGN_EPI) { if (wr == 1) PG8_BAR; }
    }
    PG8_WAIT_V(0);
    if constexpr (!ALIGN_EPI) { if (wr == 0) PG8_BAR; }
    PG8_BAR;
    if constexpr (Epi::AFTER_DRAIN) { E.fused(acc, cur, wr, wc, fr, fq, lds, wid, lane); S.done(cur); }
#undef PG8_SA
#undef PG8_SB
#undef PG8_STAGE
#undef PG8_LDA
#undef PG8_LDB
#undef PG8_MMA
#undef PG8_WAIT_V
#undef PG8_WAIT_L
#undef PG8_BAR
#undef PG8_SCHED
}
}
#define LAS __attribute__((address_space(3)))
using pg8::bf16_t; using pg8::bf16x8; using pg8::f32x4; using pg8::u32x4; using pg8::u32x2; using pg8::cvt_pk_bf16; using pg8::RMS_EPS;
constexpr int BATCH = 4, SEQ = 4096, D = 2048, M = BATCH * SEQ, NMEM = 256, MM = BATCH * NMEM, DFF = 5632, DPOOL = 1024, DSGU = 1024;
constexpr int NWAVES = 8, NTHR = NWAVES * 64;
constexpr int LDS_BYTES = 147456;
constexpr size_t MiB = 1u << 20;
constexpr size_t WS_BAR = 0, WS_PCNT = 16384, WS_ZERO_BYTES = 65536;
constexpr size_t WS_WIN = 1 * MiB, WS_WOUT = 13 * MiB, WS_WQ = 21 * MiB, WS_WK = 29 * MiB, WS_WV = 37 * MiB, WS_WO = 45 * MiB, WS_WGU = 53 * MiB, WS_WD = 97 * MiB;
constexpr size_t WS_PW = 119 * MiB, WS_WSP = 119 * MiB + 512 * 1024;
constexpr size_t WS_MN = 120 * MiB, WS_KB = 124 * MiB, WS_VTM = 128 * MiB;
constexpr size_t WS_XB = 132 * MiB;
constexpr size_t WS_HG = 196 * MiB;
constexpr size_t WS_PAU = 196 * MiB, WS_Q = 196 * MiB, WS_VT = 260 * MiB, WS_Y = 292 * MiB, WS_O = 292 * MiB;
constexpr size_t WS_PM = 260 * MiB;
constexpr size_t WS_RSP = 356 * MiB;
constexpr size_t WS_SS1 = 372 * MiB, WS_SS2 = WS_SS1 + 512 * 1024, WS_SS3 = WS_SS2 + 512 * 1024;
constexpr size_t WS_RS0 = 375 * MiB;
constexpr size_t WS_WQK = 356 * MiB;
constexpr size_t WS_VWO = 376 * MiB;
constexpr size_t WS_PWN = 392 * MiB;
constexpr size_t WS_END = 396 * MiB;

__device__ __forceinline__ float bf_lo(unsigned w) { return __uint_as_float(w << 16); }
__device__ __forceinline__ float bf_hi(unsigned w) { return __uint_as_float(w & 0xffff0000u); }
__device__ __forceinline__ float wave_sum(float v) {
#pragma unroll
    for (int o = 1; o < 64; o <<= 1) v += __shfl_xor(v, o);
    return v;
}
#define LDS_WAIT() asm volatile("s_waitcnt lgkmcnt(0)" ::: "memory")
#define MFMA16(a, b, c) __builtin_amdgcn_mfma_f32_16x16x32_bf16((a), (b), (c), 0, 0, 0)

#define XB_TMO      128
#define XB_XCNT(j)  (256  + 64 * (j))
#define XB_XSUB(j)  (1280 + 64 * (j))
#define XB_XGEN(j)  (2304 + 64 * (j))
#define XB_TOP      3328
#define XB_TOPGEN   3392
#define XCD_BAR_WORDS 3456
#define XB_SPIN_CAP (1u << 18)

__device__ __forceinline__ unsigned xb_ld(unsigned* p)              { return __hip_atomic_load(p, __ATOMIC_RELAXED, __HIP_MEMORY_SCOPE_AGENT); }
__device__ __forceinline__ unsigned xb_add(unsigned* p, unsigned v) { return __hip_atomic_fetch_add(p, v, __ATOMIC_RELAXED, __HIP_MEMORY_SCOPE_AGENT); }
__device__ __forceinline__ unsigned xb_xcc_id() { return (unsigned)__builtin_amdgcn_s_getreg((3 << 11) | 20) & 0xFu; }
#define XB_SPIN(cond, bar) do { unsigned _sp = 0; while (cond) { __builtin_amdgcn_s_sleep(1); \
    if ((++_sp & 255u) == 0u) { if (xb_ld(&(bar)[XB_TMO])) break; if (_sp > XB_SPIN_CAP) { atomicAdd(&(bar)[XB_TMO], 1u); break; } } } } while (0)

struct XcdBarrier {
    unsigned* bar; unsigned x;
    volatile LAS unsigned* st;
};

__device__ __forceinline__ XcdBarrier xcd_barrier_post(unsigned* bar, volatile LAS unsigned* st) {
    XcdBarrier b; b.bar = bar; b.x = xb_xcc_id(); b.st = st;
    if (threadIdx.x == 0) (void)xb_add(&bar[XB_XCNT(b.x)], 1u);
    return b;
}
__device__ __forceinline__ void xcd_barrier_complete(unsigned* bar, unsigned x, unsigned& nloc, unsigned& nx) {
    const unsigned G = gridDim.x * gridDim.y * gridDim.z;
    unsigned sum, cnt, mine, sp = 0u;
    for (;;) {
        sum = 0u; cnt = 0u; mine = 0u;
#pragma unroll
        for (unsigned j = 0; j < 16; ++j) { const unsigned c = xb_ld(&bar[XB_XCNT(j)]); sum += c; cnt += (c > 0u) ? 1u : 0u; mine = (j == x) ? c : mine; }
        if (sum == G) break;
        __builtin_amdgcn_s_sleep(1);
        if ((++sp & 255u) == 0u) { if (xb_ld(&bar[XB_TMO])) break; if (sp > XB_SPIN_CAP) { atomicAdd(&bar[XB_TMO], 1u); break; } }
    }
    nloc = mine > 0u ? mine : 1u; nx = cnt > 0u ? cnt : 1u;
}

__device__ __forceinline__ void xcd_barrier(const XcdBarrier& b) {
    asm volatile("s_waitcnt vmcnt(0)" ::: "memory");
    __syncthreads();
    if (threadIdx.x == 0) {
        unsigned* bar = b.bar;
        __builtin_amdgcn_s_waitcnt(0);
        unsigned nloc = b.st[0], nx = b.st[1];
        if (nloc == 0u) { xcd_barrier_complete(bar, b.x, nloc, nx); b.st[0] = nloc; b.st[1] = nx; }
        const unsigned old = xb_add(&bar[XB_XSUB(b.x)], 1u);
        const unsigned gen = old / nloc;
        if (old + 1u == (gen + 1u) * nloc) {
            __builtin_amdgcn_fence(__ATOMIC_RELEASE, "agent");
            asm volatile("s_waitcnt vmcnt(0)" ::: "memory");
            const unsigned og = xb_add(&bar[XB_TOP], 1u);
            const unsigned tg = og / nx;
            if (og + 1u == (tg + 1u) * nx) xb_add(&bar[XB_TOPGEN], 1u);
            else XB_SPIN(xb_ld(&bar[XB_TOPGEN]) == tg, bar);
            __builtin_amdgcn_fence(__ATOMIC_ACQUIRE, "agent");
            xb_add(&bar[XB_XGEN(b.x)], 1u);
            asm volatile("s_waitcnt vmcnt(0)" ::: "memory");
        } else {
            XB_SPIN(xb_ld(&bar[XB_XGEN(b.x)]) == gen, bar);
            __builtin_amdgcn_fence(__ATOMIC_ACQUIRE, "agent");
            asm volatile("s_waitcnt vmcnt(0)" ::: "memory");
        }
    }
    __syncthreads();
}

__device__ __forceinline__ void tr_item(const float* W, int ldw, int k0, int n0, bf16_t* WT, int ldt, int orow0, const float* kgain, const float* nscale, LAS float* scr, int lane) {
    f32x4 v[16];
#pragma unroll
    for (int i = 0; i < 16; ++i) { const int kk = 4 * i + (lane >> 4), nn = (lane & 15) * 4; v[i] = __builtin_nontemporal_load((const f32x4*)(W + (size_t)(k0 + kk) * ldw + n0 + nn)); }
#pragma unroll
    for (int i = 0; i < 16; ++i) { const int kk = 4 * i + (lane >> 4), nn = (lane & 15) * 4;
        if (kgain) v[i] = v[i] * kgain[k0 + kk];
        LAS float* s = scr + kk * 65 + nn; s[0] = v[i][0]; s[1] = v[i][1]; s[2] = v[i][2]; s[3] = v[i][3]; }
    LDS_WAIT();
    const int c = lane & 7;
#pragma unroll
    for (int j = 0; j < 8; ++j) { const int n = (lane >> 3) + 8 * j; const LAS float* s = scr + (8 * c) * 65 + n;
        const float sc = nscale ? nscale[n] : 1.0f;
        u32x4 o; o.x = cvt_pk_bf16(s[0 * 65] * sc, s[1 * 65] * sc); o.y = cvt_pk_bf16(s[2 * 65] * sc, s[3 * 65] * sc); o.z = cvt_pk_bf16(s[4 * 65] * sc, s[5 * 65] * sc); o.w = cvt_pk_bf16(s[6 * 65] * sc, s[7 * 65] * sc);
        *(u32x4*)(WT + (size_t)(orow0 + n) * ldt + k0 + 8 * c) = o; }
    LDS_WAIT();
}
__device__ __forceinline__ void norm_row_bf16(const float* xrow, const float* g, bf16_t* orow, int lane) {
    const f32x4* xr = (const f32x4*)xrow + lane; f32x4 v[8]; float s = 0.f;
#pragma unroll
    for (int j = 0; j < 8; ++j) { v[j] = xr[64 * j]; s += (v[j][0] * v[j][0] + v[j][1] * v[j][1]) + (v[j][2] * v[j][2] + v[j][3] * v[j][3]); }
    const float rstd = 1.0f / sqrtf(wave_sum(s) * (1.0f / D) + RMS_EPS);
    const f32x4* gr = (const f32x4*)g + lane; u32x2* o = (u32x2*)orow + lane;
#pragma unroll
    for (int j = 0; j < 8; ++j) { const f32x4 gg = gr[64 * j]; const f32x4 y = v[j] * rstd * gg; u32x2 w; w.x = cvt_pk_bf16(y[0], y[1]); w.y = cvt_pk_bf16(y[2], y[3]); o[64 * j] = w; }
}
__device__ __forceinline__ void norm_row2_bf16(const float* xa, const float* xb_, bool has2, const float* g, bf16_t* oa, bf16_t* ob, int lane) {
    const f32x4* ra = (const f32x4*)xa + lane; const f32x4* rb = (const f32x4*)(has2 ? xb_ : xa) + lane; f32x4 va[8], vb[8]; float sa = 0.f, sb = 0.f;
#pragma unroll
    for (int j = 0; j < 8; ++j) { va[j] = ra[64 * j]; vb[j] = rb[64 * j]; }
#pragma unroll
    for (int j = 0; j < 8; ++j) { sa += (va[j][0] * va[j][0] + va[j][1] * va[j][1]) + (va[j][2] * va[j][2] + va[j][3] * va[j][3]); sb += (vb[j][0] * vb[j][0] + vb[j][1] * vb[j][1]) + (vb[j][2] * vb[j][2] + vb[j][3] * vb[j][3]); }
    const float ka = 1.0f / sqrtf(wave_sum(sa) * (1.0f / D) + RMS_EPS), kb = 1.0f / sqrtf(wave_sum(sb) * (1.0f / D) + RMS_EPS);
    const f32x4* gr = (const f32x4*)g + lane; u32x2* pa = (u32x2*)oa + lane; u32x2* pb = (u32x2*)ob + lane;
#pragma unroll
    for (int j = 0; j < 8; ++j) { const f32x4 gg = gr[64 * j]; const f32x4 ya = va[j] * ka * gg, yb = vb[j] * kb * gg; u32x2 w; w.x = cvt_pk_bf16(ya[0], ya[1]); w.y = cvt_pk_bf16(ya[2], ya[3]); pa[64 * j] = w;
        if (has2) { u32x2 w2; w2.x = cvt_pk_bf16(yb[0], yb[1]); w2.y = cvt_pk_bf16(yb[2], yb[3]); pb[64 * j] = w2; } }
}
__device__ __forceinline__ void raw_row2_bf16(const float* xa, const float* xb_, bool has2, bf16_t* oa, bf16_t* ob, float* rsa, float* rsb, int lane) {
    const f32x4* ra = (const f32x4*)xa + lane; const f32x4* rb = (const f32x4*)(has2 ? xb_ : xa) + lane; f32x4 va[8], vb[8]; float sa = 0.f, sb = 0.f;
#pragma unroll
    for (int j = 0; j < 8; ++j) { va[j] = __builtin_nontemporal_load(ra + 64 * j); vb[j] = __builtin_nontemporal_load(rb + 64 * j); }
    u32x2* pa = (u32x2*)oa + lane; u32x2* pb = (u32x2*)ob + lane;
#pragma unroll
    for (int j = 0; j < 8; ++j) { sa += (va[j][0] * va[j][0] + va[j][1] * va[j][1]) + (va[j][2] * va[j][2] + va[j][3] * va[j][3]); sb += (vb[j][0] * vb[j][0] + vb[j][1] * vb[j][1]) + (vb[j][2] * vb[j][2] + vb[j][3] * vb[j][3]);
        u32x2 w; w.x = cvt_pk_bf16(va[j][0], va[j][1]); w.y = cvt_pk_bf16(va[j][2], va[j][3]); pa[64 * j] = w;
        if (has2) { u32x2 w2; w2.x = cvt_pk_bf16(vb[j][0], vb[j][1]); w2.y = cvt_pk_bf16(vb[j][2], vb[j][3]); pb[64 * j] = w2; } }
    const float ka = 1.0f / sqrtf(wave_sum(sa) * (1.0f / D) + RMS_EPS), kb = 1.0f / sqrtf(wave_sum(sb) * (1.0f / D) + RMS_EPS);
    if (lane == 0) { *rsa = ka; if (has2) *rsb = kb; }
}
__device__ __forceinline__ void norm_row_out(const bf16_t* xrow, float ss, const float* g, float* orow, int lane) {
    const float rstd = 1.0f / sqrtf(ss * (1.0f / D) + RMS_EPS);
#pragma unroll
    for (int j = 0; j < 4; ++j) { const int c = (lane + 64 * j) * 8; const u32x4 w = *(const u32x4*)(xrow + c);
        const f32x4 g0 = *(const f32x4*)(g + c), g1 = *(const f32x4*)(g + c + 4);
        const f32x4 y0 = (f32x4){bf_lo(w.x), bf_hi(w.x), bf_lo(w.y), bf_hi(w.y)} * rstd * g0, y1 = (f32x4){bf_lo(w.z), bf_hi(w.z), bf_lo(w.w), bf_hi(w.w)} * rstd * g1;
        *(f32x4*)(orow + c) = y0; *(f32x4*)(orow + c + 4) = y1; }
}

__device__ __forceinline__ void sgu_unit(LAS unsigned char* lds, int nb, int h0, const bf16_t* VT, const bf16_t* PAU, bf16_t* Y, const bf16_t* WSb, const float* sg, const float* bsp, int tid) {
    asm volatile("" : "+v"(tid));
    const int lane = tid & 63, wave = tid >> 6, fr = lane & 15, fq = lane >> 4;
    const int T0 = nb * 128;
    LAS float* red = (LAS float*)lds;
    LAS float* rstd = (LAS float*)(lds + 4096);
    LAS unsigned char* Bb = lds + 8192;
    {
        const int tg = tid & 15, rl = tid >> 4;
        float s[8];
#pragma unroll
        for (int e = 0; e < 8; ++e) s[e] = 0.f;
#pragma unroll 4
        for (int i = 0; i < 32; ++i) { const int c = rl + 32 * i; const u32x4 w = *(const u32x4*)(VT + (size_t)c * M + T0 + tg * 8);
#pragma unroll
            for (int e = 0; e < 4; ++e) { const float lo = bf_lo(w[e]), hi = bf_hi(w[e]); s[2 * e] += lo * lo; s[2 * e + 1] += hi * hi; } }
#pragma unroll
        for (int e = 0; e < 8; ++e) { s[e] += __shfl_xor(s[e], 16); s[e] += __shfl_xor(s[e], 32); }
        if (fq == 0) {
#pragma unroll
            for (int e = 0; e < 8; ++e) red[wave * 128 + tg * 8 + e] = s[e]; }
    }
    __syncthreads();
    if (tid < 128) { float t = 0.f;
#pragma unroll
        for (int w = 0; w < 8; ++w) t += red[w * 128 + tid];
        rstd[tid] = 1.0f / sqrtf(t * (1.0f / DSGU) + RMS_EPS); }
    __syncthreads();
    const int wr = wave >> 1, wc = wave & 1;
    for (int h = h0; h < h0 + 4; ++h) {
        LAS unsigned char* B = Bb + (h & 1) * 34816;
#pragma unroll
        for (int i = 0; i < 4; ++i) { const int p = tid + 512 * i, c = p >> 4, sgp = p & 15;
            const u32x4 w = *(const u32x4*)(VT + (size_t)(h * 128 + c) * M + T0 + sgp * 8);
            const float g = sg[h * 128 + c];
            const f32x4 r0 = *(const LAS f32x4*)(rstd + sgp * 8) * g, r1 = *(const LAS f32x4*)(rstd + sgp * 8 + 4) * g;
            u32x4 o; o.x = cvt_pk_bf16(bf_lo(w.x) * r0[0], bf_hi(w.x) * r0[1]); o.y = cvt_pk_bf16(bf_lo(w.y) * r0[2], bf_hi(w.y) * r0[3]);
            o.z = cvt_pk_bf16(bf_lo(w.z) * r1[0], bf_hi(w.z) * r1[1]); o.w = cvt_pk_bf16(bf_lo(w.w) * r1[2], bf_hi(w.w) * r1[3]);
            const int rho = (c & ~31) + ((c >> 2) & 1) * 16 + ((c >> 3) & 3) * 4 + (c & 3);
            *(LAS u32x4*)(B + rho * 272 + sgp * 16) = o; }
        __syncthreads();
        f32x4 acc[2][4];
#pragma unroll
        for (int m = 0; m < 2; ++m)
#pragma unroll
            for (int n = 0; n < 4; ++n) acc[m][n] = (f32x4){0.f, 0.f, 0.f, 0.f};
#pragma unroll
        for (int ks = 0; ks < 4; ++ks) { bf16x8 a[2], b[4];
#pragma unroll
            for (int m = 0; m < 2; ++m) a[m] = *(const bf16x8*)(WSb + (size_t)((h * 128 + wr * 32 + m * 16 + fr) * 128 + ks * 32 + fq * 8));
#pragma unroll
            for (int n = 0; n < 4; ++n) b[n] = *(const LAS bf16x8*)(B + (wc * 64 + n * 16 + fr) * 272 + (ks * 32 + fq * 8) * 2);
#pragma unroll
            for (int m = 0; m < 2; ++m)
#pragma unroll
                for (int n = 0; n < 4; ++n) acc[m][n] = MFMA16(b[n], a[m], acc[m][n]); }
#pragma unroll
        for (int m = 0; m < 2; ++m) { const int t = wr * 32 + m * 16 + fr; const float bias = bsp[h * 128 + t];
#pragma unroll
            for (int gq = 0; gq < 2; ++gq) { const size_t off = (size_t)(T0 + t) * D + DPOOL + h * 128 + wc * 64 + gq * 32 + fq * 8;
                const u32x4 uu = *(const u32x4*)(PAU + off); const f32x4 m0 = acc[m][2 * gq] + bias, m1 = acc[m][2 * gq + 1] + bias;
                u32x4 o; o.x = cvt_pk_bf16(bf_lo(uu.x) * m0[0], bf_hi(uu.x) * m0[1]); o.y = cvt_pk_bf16(bf_lo(uu.y) * m0[2], bf_hi(uu.y) * m0[3]);
                o.z = cvt_pk_bf16(bf_lo(uu.z) * m1[0], bf_hi(uu.z) * m1[1]); o.w = cvt_pk_bf16(bf_lo(uu.w) * m1[2], bf_hi(uu.w) * m1[3]);
                *(u32x4*)(Y + off) = o; } }
    }
    __syncthreads();
}
template <int W> __device__ __forceinline__ void pool_p(const bf16_t* base, bf16_t* ybase, int ts, int tp0) {
    u32x4 arr[W + 7];
#pragma unroll
    for (int j = 0; j < W + 7; ++j) { const int t = ts - (W - 1) + j, tc = t < -tp0 ? -tp0 : t; arr[j] = *(const u32x4*)(base + (ptrdiff_t)tc * D); }
#pragma unroll
    for (int j = 0; j < W - 1; ++j) { const int t = ts - (W - 1) + j; if (tp0 + t < 0) arr[j] = (u32x4){0u, 0u, 0u, 0u}; }
    float S[8];
#pragma unroll
    for (int e = 0; e < 8; ++e) S[e] = 0.f;
#pragma unroll
    for (int j = 0; j < W - 1; ++j)
#pragma unroll
        for (int e = 0; e < 4; ++e) { S[2 * e] += bf_lo(arr[j][e]); S[2 * e + 1] += bf_hi(arr[j][e]); }
#pragma unroll
    for (int i = 0; i < 8; ++i) { const int t = ts + i, tp = tp0 + t; float cur[8], p[8];
#pragma unroll
        for (int e = 0; e < 4; ++e) { cur[2 * e] = bf_lo(arr[W - 1 + i][e]); cur[2 * e + 1] = bf_hi(arr[W - 1 + i][e]); }
        const float inv = 1.0f / (float)(tp + 1 < W ? tp + 1 : W);
#pragma unroll
        for (int e = 0; e < 8; ++e) { S[e] += cur[e]; p[e] = S[e] * inv - cur[e]; }
        u32x4 o; o.x = cvt_pk_bf16(p[0], p[1]); o.y = cvt_pk_bf16(p[2], p[3]); o.z = cvt_pk_bf16(p[4], p[5]); o.w = cvt_pk_bf16(p[6], p[7]);
        *(u32x4*)(ybase + (size_t)t * D) = o;
#pragma unroll
        for (int e = 0; e < 4; ++e) { S[2 * e] -= bf_lo(arr[i][e]); S[2 * e + 1] -= bf_hi(arr[i][e]); } }
}
__device__ __forceinline__ void pool_half(int nb, int gh, const bf16_t* PAU, bf16_t* Y, int tid) {
    asm volatile("" : "+v"(tid));
    const int T0 = nb * 128, tp0 = T0 & (SEQ - 1), cgp = tid & 31, ts = (tid >> 5) * 8;
    const bf16_t* src = PAU + (size_t)T0 * D + cgp * 8; bf16_t* dst = Y + (size_t)T0 * D + cgp * 8;
    if (gh == 0) { pool_p<2>(src, dst, ts, tp0); pool_p<16>(src + 768, dst + 768, ts, tp0); }
    else { pool_p<4>(src + 256, dst + 256, ts, tp0); pool_p<8>(src + 512, dst + 512, ts, tp0); }
}
__device__ __forceinline__ void attn_unit(LAS unsigned char* lds, int unit, const bf16_t* Q, const bf16_t* KB, const bf16_t* VTM, bf16_t* O, int tid) {
    asm volatile("" : "+v"(tid));
    const int lane = tid & 63, wave = tid >> 6, fr = lane & 15, fq = lane >> 4, wr = wave >> 1, wc = wave & 1;
    const int qt = unit & 31, h = (unit >> 5) & 3, b = unit >> 7;
    const int R0 = b * SEQ + qt * 128;
    LAS unsigned char* P = lds;
    LAS float* xm = (LAS float*)(lds + 67584);
    LAS float* xs = xm + 256;
    f32x4 acc[2][8];
#pragma unroll
    for (int m = 0; m < 2; ++m)
#pragma unroll
        for (int n = 0; n < 8; ++n) acc[m][n] = (f32x4){0.f, 0.f, 0.f, 0.f};
    const bf16_t* qp = Q + (size_t)(R0 + wr * 32 + fr) * D + h * 512 + fq * 8;
    const bf16_t* kp = KB + (size_t)(b * NMEM + wc * 128 + fr) * D + h * 512 + fq * 8;
#pragma unroll 2
    for (int ks = 0; ks < 16; ++ks) { bf16x8 a[2], bb[8];
#pragma unroll
        for (int m = 0; m < 2; ++m) a[m] = *(const bf16x8*)(qp + (size_t)m * 16 * D + ks * 32);
#pragma unroll
        for (int n = 0; n < 8; ++n) bb[n] = *(const bf16x8*)(kp + (size_t)n * 16 * D + ks * 32);
#pragma unroll
        for (int m = 0; m < 2; ++m)
#pragma unroll
            for (int n = 0; n < 8; ++n) acc[m][n] = MFMA16(bb[n], a[m], acc[m][n]); }
    const float sc = 0.044194173824159216f;
#pragma unroll
    for (int m = 0; m < 2; ++m) { float v = -3.0e38f;
#pragma unroll
        for (int n = 0; n < 8; ++n) { acc[m][n] = acc[m][n] * sc; v = fmaxf(v, fmaxf(fmaxf(acc[m][n][0], acc[m][n][1]), fmaxf(acc[m][n][2], acc[m][n][3]))); }
        v = fmaxf(v, __shfl_xor(v, 16)); v = fmaxf(v, __shfl_xor(v, 32));
        if (fq == 0) xm[wc * 128 + wr * 32 + m * 16 + fr] = v; }
    __syncthreads();
#pragma unroll
    for (int m = 0; m < 2; ++m) { const int row = wr * 32 + m * 16 + fr; const float mx = fmaxf(xm[row], xm[128 + row]); float s = 0.f;
#pragma unroll
        for (int n = 0; n < 8; ++n) { const float p0 = __expf(acc[m][n][0] - mx), p1 = __expf(acc[m][n][1] - mx), p2 = __expf(acc[m][n][2] - mx), p3 = __expf(acc[m][n][3] - mx);
            s += (p0 + p1) + (p2 + p3);
            u32x2 o; o.x = cvt_pk_bf16(p0, p1); o.y = cvt_pk_bf16(p2, p3);
            *(LAS u32x2*)(P + row * 528 + (wc * 128 + n * 16 + fq * 4) * 2) = o; }
        s += __shfl_xor(s, 16); s += __shfl_xor(s, 32);
        if (fq == 0) xs[wc * 128 + row] = s; }
    __syncthreads();
    float inv[2];
#pragma unroll
    for (int m = 0; m < 2; ++m) { const int row = wr * 32 + m * 16 + fr; inv[m] = 1.0f / (xs[row] + xs[128 + row]); }
    f32x4 o[2][16];
#pragma unroll
    for (int m = 0; m < 2; ++m)
#pragma unroll
        for (int n = 0; n < 16; ++n) o[m][n] = (f32x4){0.f, 0.f, 0.f, 0.f};
    const bf16_t* vp = VTM + (size_t)(h * 512 + wc * 256 + fr) * MM + b * NMEM + fq * 8;
    for (int ks = 0; ks < 8; ++ks) { bf16x8 a[2];
#pragma unroll
        for (int m = 0; m < 2; ++m) a[m] = *(const LAS bf16x8*)(P + (wr * 32 + m * 16 + fr) * 528 + (ks * 32 + fq * 8) * 2);
#pragma unroll
        for (int n = 0; n < 16; ++n) { const bf16x8 bv = *(const bf16x8*)(vp + (size_t)n * 16 * MM + ks * 32);
#pragma unroll
            for (int m = 0; m < 2; ++m) o[m][n] = MFMA16(bv, a[m], o[m][n]); } }
#pragma unroll
    for (int m = 0; m < 2; ++m) { const size_t rowoff = (size_t)(R0 + wr * 32 + m * 16 + fr) * D + h * 512 + wc * 256 + fq * 4;
#pragma unroll
        for (int n = 0; n < 16; ++n) { const f32x4 v = o[m][n] * inv[m]; u32x2 w; w.x = cvt_pk_bf16(v[0], v[1]); w.y = cvt_pk_bf16(v[2], v[3]); *(u32x2*)(O + rowoff + n * 16) = w; } }
    __syncthreads();
}

#ifndef REP_P0
#define REP_P0 1
#endif
#ifndef REP_P0N
#define REP_P0N 1
#endif
#ifndef REP_P1
#define REP_P1 1
#endif
#ifndef REP_P3
#define REP_P3 1
#endif
#ifndef REP_P7
#define REP_P7 1
#endif
#ifndef TS_K
#define TS_K -1
#endif
#ifndef ABSORB
#define ABSORB 1
#endif
#ifndef OLD_ATTN
#define OLD_ATTN 0
#endif
#ifndef REP_P2
#define REP_P2 1
#endif
#ifndef REP_P5
#define REP_P5 1
#endif
#ifndef REP_SYNC
#define REP_SYNC 1
#endif
#ifndef REP_P4
#define REP_P4 1
#endif
struct Args { const float* in[21]; float* out; unsigned char* ws; };
#define GEMM_PHASE(EPI, g, S, E) pg8::gemm_phase<EPI, pg8::StaticOrder, true, true>(lds, g, S, E)
__global__ void __launch_bounds__(NTHR, 2) mk_fwd(Args a) {
    extern __shared__ __attribute__((aligned(16))) unsigned char lds_raw[];
    LAS unsigned char* lds = (LAS unsigned char*)lds_raw;
    cg::grid_group grid = cg::this_grid();
    const int G = gridDim.x, bx = blockIdx.x;
    volatile LAS unsigned* bar_st = (volatile LAS unsigned*)(lds + LDS_BYTES - 64);
    if (threadIdx.x < 2) bar_st[threadIdx.x] = 0u;
    __syncthreads();
    const XcdBarrier xbar = xcd_barrier_post((unsigned*)(a.ws + WS_BAR), bar_st);
    volatile LAS unsigned* ts_lds = (volatile LAS unsigned*)(lds + LDS_BYTES - 32);
    if (TS_K >= 0 && bx == 0 && threadIdx.x == 0) ts_lds[0] = (unsigned)__builtin_amdgcn_s_memrealtime();
#define STAMP(k) do { if (TS_K == (k) && bx == 0 && threadIdx.x == 0) ts_lds[1] = (unsigned)__builtin_amdgcn_s_memrealtime(); } while (0)
#define TID_FRESH() ({ int t_ = threadIdx.x; asm volatile("" : "+v"(t_)); t_; })
    const float *x = a.in[0], *mem = a.in[1], *norm_mix_g = a.in[2], *w_in = a.in[3], *pool_w = a.in[4], *pool_scale = a.in[5], *sgu_norm_g = a.in[6], *w_spatial = a.in[7], *b_spatial = a.in[8],
                *w_out = a.in[9], *norm_xattn_g = a.in[10], *norm_mem_g = a.in[11], *w_q = a.in[12], *w_k = a.in[13], *w_v = a.in[14], *w_o = a.in[15], *norm_ffn_g = a.in[16],
                *w_gate = a.in[17], *w_up = a.in[18], *w_down = a.in[19], *final_norm_g = a.in[20];
    float* out = a.out; unsigned char* ws = a.ws;
    float *SS1 = (float*)(ws + WS_SS1), *SS2 = (float*)(ws + WS_SS2), *SS3 = (float*)(ws + WS_SS3);
    bf16_t *Win_t = (bf16_t*)(ws + WS_WIN), *Wout_t = (bf16_t*)(ws + WS_WOUT), *Wq_t = (bf16_t*)(ws + WS_WQ), *Wk_t = (bf16_t*)(ws + WS_WK), *Wv_t = (bf16_t*)(ws + WS_WV), *Wo_t = (bf16_t*)(ws + WS_WO),
           *Wgu_t = (bf16_t*)(ws + WS_WGU), *Wd_t = (bf16_t*)(ws + WS_WD), *PWt = (bf16_t*)(ws + WS_PW), *WSb = (bf16_t*)(ws + WS_WSP), *MN = (bf16_t*)(ws + WS_MN), *KB = (bf16_t*)(ws + WS_KB),
           *VTM = (bf16_t*)(ws + WS_VTM), *XB = (bf16_t*)(ws + WS_XB), *HG = (bf16_t*)(ws + WS_HG), *PAU = (bf16_t*)(ws + WS_PAU), *Qb = (bf16_t*)(ws + WS_Q), *VT = (bf16_t*)(ws + WS_VT),
           *Yb = (bf16_t*)(ws + WS_Y), *Ob = (bf16_t*)(ws + WS_O);

    {
        const int tid = TID_FRESH(), lane = tid & 63, wave = __builtin_amdgcn_readfirstlane(tid >> 6);
        LAS float* scr = (LAS float*)(lds + wave * 16640);
        const int gw = bx * NWAVES + wave, NGW = G * NWAVES;
        constexpr int I_IN = 32 * 48, I_SQ = 32 * 32, I_PW = 4 * 16;
        constexpr int NITEMS = I_IN + 4 * I_SQ + I_PW;
        { float* RS0 = (float*)(ws + WS_RS0); for (int m = gw; m < M; m += 2 * NGW) raw_row2_bf16(x + (size_t)m * D, x + (size_t)(m + NGW) * D, m + NGW < M, XB + (size_t)m * D, XB + (size_t)(m + NGW) * D, RS0 + m, RS0 + m + NGW, lane); }
        for (int m = gw; m < MM; m += NGW) norm_row_bf16(mem + (size_t)m * D, norm_mem_g, MN + (size_t)m * D, lane);
        for (int it = gw; it < NITEMS * REP_P0; it += NGW) {
            int r = it % NITEMS;
            if (r < I_IN) { tr_item(w_in, 3072, (r / 48) * 64, (r % 48) * 64, Win_t, D, (r % 48) * 64, norm_mix_g, nullptr, scr, lane); continue; } r -= I_IN;
            if (r < I_SQ) { tr_item(w_k, D, (r / 32) * 64, (r % 32) * 64, Wk_t, D, (r % 32) * 64, nullptr, nullptr, scr, lane); continue; } r -= I_SQ;
            if (r < I_SQ) { tr_item(w_v, D, (r / 32) * 64, (r % 32) * 64, Wv_t, D, (r % 32) * 64, nullptr, nullptr, scr, lane); continue; } r -= I_SQ;
            if (r < I_SQ) { tr_item(w_out, D, (r / 32) * 64, (r % 32) * 64, Wout_t, D, (r % 32) * 64, nullptr, nullptr, scr, lane); continue; } r -= I_SQ;
#if ABSORB
            if (r < I_SQ) continue; r -= I_SQ;
#else
            if (r < I_SQ) { tr_item(w_q, D, (r / 32) * 64, (r % 32) * 64, Wq_t, D, (r % 32) * 64, norm_xattn_g, nullptr, scr, lane); continue; } r -= I_SQ;
#endif
            {
              bf16_t* PWn = (bf16_t*)(ws + WS_PWN);
#pragma unroll 4
              for (int j = 0; j < 16; ++j) { const int gc = r * 16 + j, g = gc >> 8; const f32x4 v = *(const f32x4*)(pool_w + (size_t)gc * 256 + lane * 4) * *(const f32x4*)(pool_scale + g * 256 + lane * 4);
                  u32x2 o; o.x = cvt_pk_bf16(v[0], v[1]); o.y = cvt_pk_bf16(v[2], v[3]); *(u32x2*)(PWn + (size_t)gc * 2048 + lane * 4) = o; *(u32x2*)(PWn + (size_t)gc * 2048 + 256 + lane * 4) = (u32x2){0u, 0u}; } }
        }
        for (int i = bx * NTHR + tid; i < 8 * 128 * 128 / 4; i += G * NTHR) { const f32x4 v = *((const f32x4*)w_spatial + i); const int s = (i * 4) & 127, t = ((i * 4) >> 7) & 127;
            const bool keep = (s >> 6) <= (t >> 6); u32x2 o; o.x = keep ? cvt_pk_bf16(v[0], v[1]) : 0u; o.y = keep ? cvt_pk_bf16(v[2], v[3]) : 0u; *((u32x2*)WSb + i) = o; }
    }
    if (a.ws == nullptr) grid.sync();
    xcd_barrier(xbar);
    STAMP(0);
    for (int rep = 0; rep < REP_P1; ++rep) {
        { pg8::Gemm g{XB, Win_t, M, 2048, D, D}; pg8::InProjOrder S; S.init(G, bx, XB, Win_t, MN, Wk_t, Wv_t); pg8::EpiInProj E{PAU, VT, KB, VTM, (const float*)(ws + WS_RS0)};
          pg8::gemm_phase<pg8::EpiInProj, pg8::InProjOrder, true, true>(lds, g, S, E); }
        { pg8::Gemm g{KB, Wq_t, 4096, D, 512, D}; pg8::PreQKOrder S{G, bx + 128, 160, Wout_t, (const bf16_t*)(ws + WS_PWN)}; pg8::EpiPre E{(bf16_t*)(ws + WS_WQK), Wout_t};
          pg8::gemm_phase<pg8::EpiPre, pg8::PreQKOrder, true, true>(lds, g, S, E); }
        {
            const int f0q = G > 64 ? 64 : 0; const int cq = bx - f0q, ncu = G - f0q;
            if (cq >= 0) { const int tid = TID_FRESH(), lane = tid & 63, wave = __builtin_amdgcn_readfirstlane(tid >> 6);
                for (int it = cq * NWAVES + wave; it < 1024; it += ncu * NWAVES) { const int k = it * 2 + (lane >> 5);
                    const float gk = norm_xattn_g[k]; const f32x4* src = (const f32x4*)(w_q + (size_t)k * D); u32x2* dst = (u32x2*)(Wq_t + (size_t)k * D);
#pragma unroll 4
                    for (int j = 0; j < 16; ++j) { const int q = (lane & 31) + 32 * j; const f32x4 v = src[q] * gk; u32x2 o; o.x = cvt_pk_bf16(v[0], v[1]); o.y = cvt_pk_bf16(v[2], v[3]); dst[q] = o; } } } }
        const int f0 = G > 64 ? 64 : 0;
        if (bx >= f0) {
            const int tid = TID_FRESH(), lane = tid & 63, wave = __builtin_amdgcn_readfirstlane(tid >> 6);
            LAS float* scr = (LAS float*)(lds + wave * 16640);
            constexpr int I_SQ = 32 * 32, I_GU = 32 * 88, I_DN = 88 * 32, NIT = I_SQ + 2 * I_GU + I_DN;
            for (int it = (bx - f0) * NWAVES + wave; it < NIT; it += (G - f0) * NWAVES) {
                int r = it;
                if (r < I_SQ) { tr_item(w_o, D, (r / 32) * 64, (r % 32) * 64, Wo_t, D, (r % 32) * 64, nullptr, nullptr, scr, lane); continue; } r -= I_SQ;
                if (r < 2 * I_GU) { const int up = r >= I_GU; if (up) r -= I_GU; const int n0 = (r % 88) * 64;
                    tr_item(up ? w_up : w_gate, DFF, (r / 88) * 64, n0, Wgu_t, D, (n0 >> 7) * 256 + (n0 & 127) + up * 128, norm_ffn_g, nullptr, scr, lane); continue; } r -= 2 * I_GU;
                tr_item(w_down, D, (r / 32) * 64, (r % 32) * 64, Wd_t, DFF, (r % 32) * 64, nullptr, nullptr, scr, lane);
            }
        }
    }
    xcd_barrier(xbar);
    STAMP(101);
    for (int uu = bx; uu < 256 * REP_P2; uu += G) { const int u0 = uu & 255; const int u = (G == 256) ? ((((u0 & 7) * 16 + (u0 >> 4)) << 1) | ((u0 >> 3) & 1)) : u0;
        sgu_unit(lds, u >> 1, (u & 1) * 4, VT, PAU, Yb, WSb, sgu_norm_g, b_spatial, (int)threadIdx.x); pool_half(u >> 1, u & 1, PAU, Yb, (int)threadIdx.x); }
#if ABSORB
    { pg8::Gemm g{KB, Wq_t, 4096, D, 512, D}; pg8::PreQKOrder S{G, bx, 128, Wout_t, (const bf16_t*)(ws + WS_PWN)}; pg8::EpiPre E{(bf16_t*)(ws + WS_WQK), Wout_t}; pg8::gemm_phase<pg8::EpiPre, pg8::PreQKOrder, true, true>(lds, g, S, E); }
    { pg8::Gemm g{Wo_t, VTM, 8192, 1024, 512, D}; pg8::PreVOOrder S{G, (bx + G - 128 % G) % G}; pg8::EpiPlain E{(bf16_t*)(ws + WS_VWO), 1024}; pg8::gemm_phase<pg8::EpiPlain, pg8::PreVOOrder, true, true>(lds, g, S, E); }
#endif
    xcd_barrier(xbar);
    STAMP(102);
    for (int rep = 0; rep < REP_P3; ++rep) { pg8::Gemm g{Yb, Wout_t, M, D, D, D}; pg8::StaticOrder S; S.init(M, D, G, bx); pg8::EpiResid<false> E{nullptr, XB, XB, SS1, D, (LAS float*)(lds + 131072)}; GEMM_PHASE(pg8::EpiResid<false>, g, S, E); }
    xcd_barrier(xbar);
    STAMP(103);
#if ABSORB
    { pg8::Gemm g{XB, (const bf16_t*)(ws + WS_WQK), M, 1024, D, D}; pg8::ScoreOrder S{G, bx}; pg8::EpiSoftmaxN E{(bf16_t*)(ws + WS_PM), SS1, 1.0f / D, (LAS float*)(lds + 131072), 0.044194173824159216f * 1.4426950408889634f};
      pg8::gemm_phase<pg8::EpiSoftmaxN, pg8::ScoreOrder, true, true>(lds, g, S, E); }
    xcd_barrier(xbar);
    STAMP(104);
    { pg8::Gemm g{(const bf16_t*)(ws + WS_PM), (const bf16_t*)(ws + WS_VWO), M, D, 1024, 1024}; pg8::AttnOutOrder S{G, bx}; pg8::EpiResid<false> E{nullptr, XB, XB, SS2, D, (LAS float*)(lds + 131072)};
      pg8::gemm_phase<pg8::EpiResid<false>, pg8::AttnOutOrder, true, true>(lds, g, S, E); }
    xcd_barrier(xbar);
    STAMP(108);
#else
    for (int rep = 0; rep < REP_P4; ++rep) { pg8::Gemm g{XB, Wq_t, M, D, D, D}; pg8::StaticOrder S; S.init(M, D, G, bx); pg8::EpiRowScale E{Qb, D, SS1, 1.0f / D}; GEMM_PHASE(pg8::EpiRowScale, g, S, E); }
    xcd_barrier(xbar);
    STAMP(104);
#if OLD_ATTN
    for (int u = bx; u < 512 * REP_P5; u += G) attn_unit(lds, u & 511, Qb, KB, VTM, Ob, (int)threadIdx.x);
    xcd_barrier(xbar);
    STAMP(105);
#else
    for (int rep = 0; rep < REP_P5; ++rep) {
    { pg8::Gemm g{Qb, KB, M, 1024, 512, D}; pg8::AttnSOrder S{G, bx}; pg8::EpiSoftmax E{(bf16_t*)(ws + WS_PM), (float*)(ws + WS_RSP), (LAS float*)(lds + 131072), 0.044194173824159216f * 1.4426950408889634f};
      pg8::gemm_phase<pg8::EpiSoftmax, pg8::AttnSOrder, true, true>(lds, g, S, E); }
    xcd_barrier(xbar);
    STAMP(106);
    { pg8::Gemm g{(const bf16_t*)(ws + WS_PM), VTM, M, 2048, 256, 1024}; pg8::AttnPVOrder S{G, bx}; pg8::EpiAttnOut E{Ob, (const float*)(ws + WS_RSP)};
      pg8::gemm_phase<pg8::EpiAttnOut, pg8::AttnPVOrder, true, true>(lds, g, S, E); }
    xcd_barrier(xbar);
    STAMP(107);
    }
#endif
    { pg8::Gemm g{Ob, Wo_t, M, D, D, D}; pg8::StaticOrder S; S.init(M, D, G, bx); pg8::EpiResid<false> E{nullptr, XB, XB, SS2, D, (LAS float*)(lds + 131072)}; GEMM_PHASE(pg8::EpiResid<false>, g, S, E); }
    xcd_barrier(xbar);
    STAMP(108);
#endif
    for (int rep = 0; rep < REP_P7; ++rep) { pg8::Gemm g{XB, Wgu_t, M, 2 * DFF, D, D}; pg8::StaticOrder S; S.init(M, 2 * DFF, G, bx); pg8::EpiSwiglu E{HG, DFF, SS2, 1.0f / D}; GEMM_PHASE(pg8::EpiSwiglu, g, S, E); }
    xcd_barrier(xbar);
    STAMP(109);
#ifndef FUSE_FINAL
#define FUSE_FINAL 1
#endif
    if (FUSE_FINAL && G == 256) {
        pg8::Gemm g{HG, Wd_t, M, D, DFF, DFF}; pg8::DownOrder S{bx}; pg8::EpiFinal E{XB, out, SS3, (unsigned*)(ws + WS_PCNT), final_norm_g, (LAS float*)(lds + 131072), D};
        pg8::gemm_phase<pg8::EpiFinal, pg8::DownOrder, true, true>(lds, g, S, E);
    } else {
    { pg8::Gemm g{HG, Wd_t, M, D, DFF, DFF}; pg8::StaticOrder S; S.init(M, D, G, bx); pg8::EpiResid<false> E{nullptr, XB, XB, SS3, D, (LAS float*)(lds + 131072)}; GEMM_PHASE(pg8::EpiResid<false>, g, S, E); }
    xcd_barrier(xbar);
    STAMP(110);
    { const int tid = TID_FRESH(), lane = tid & 63, wave = __builtin_amdgcn_readfirstlane(tid >> 6); const int gw = bx * NWAVES + wave, NGW = G * NWAVES;
      for (int m0 = gw; m0 < M; m0 += 4 * NGW) {
          u32x4 w[4][4]; f32x4 pa[4], pb[4];
#pragma unroll
          for (int q = 0; q < 4; ++q) { const int m = m0 + q * NGW; if (m < M) { pa[q] = *(const f32x4*)(SS3 + (size_t)m * 8); pb[q] = *(const f32x4*)(SS3 + (size_t)m * 8 + 4);
#pragma unroll
              for (int j = 0; j < 4; ++j) w[q][j] = *(const u32x4*)(XB + (size_t)m * D + (lane + 64 * j) * 8); } }
#pragma unroll
          for (int q = 0; q < 4; ++q) { const int m = m0 + q * NGW; if (m < M) {
              const float rstd = 1.0f / sqrtf((((pa[q][0] + pa[q][1]) + (pa[q][2] + pa[q][3])) + ((pb[q][0] + pb[q][1]) + (pb[q][2] + pb[q][3]))) * (1.0f / D) + RMS_EPS);
#pragma unroll
              for (int j = 0; j < 4; ++j) { const int c = (lane + 64 * j) * 8; const f32x4 g0 = *(const f32x4*)(final_norm_g + c), g1 = *(const f32x4*)(final_norm_g + c + 4); const u32x4 ww = w[q][j];
                  const f32x4 y0 = (f32x4){bf_lo(ww.x), bf_hi(ww.x), bf_lo(ww.y), bf_hi(ww.y)} * rstd * g0, y1 = (f32x4){bf_lo(ww.z), bf_hi(ww.z), bf_lo(ww.w), bf_hi(ww.w)} * rstd * g1;
                  *(f32x4*)(out + (size_t)m * D + c) = y0; *(f32x4*)(out + (size_t)m * D + c + 4) = y1; } } } } }
    }
    if (TS_K >= 0 && bx == 0 && threadIdx.x == 0) { const unsigned dt = ts_lds[1] - ts_lds[0]; const unsigned t0 = (unsigned)__builtin_amdgcn_s_memrealtime(); while ((unsigned)__builtin_amdgcn_s_memrealtime() - t0 < dt) __builtin_amdgcn_s_sleep(8); }
}

extern "C" void kernel_launch(void* const* d_in, const int* in_sizes, int n_in, void* d_out, int out_size, void* d_ws, size_t ws_size, hipStream_t stream) {
    static int grid = 0;
    if (grid == 0) {
        if (n_in != 21 || in_sizes[0] != M * D || out_size != M * D || ws_size < WS_END) { fprintf(stderr, "kernel_launch: unexpected shapes (n_in %d, in0 %d, out %d, ws %zu); nothing launched\n", n_in, n_in > 0 ? in_sizes[0] : -1, out_size, ws_size); grid = -1; return; }
        int dev = 0, cus = 0, per_cu = 0;
        if (hipGetDevice(&dev) != hipSuccess || hipDeviceGetAttribute(&cus, hipDeviceAttributeMultiprocessorCount, dev) != hipSuccess) { grid = -1; return; }
        if (hipFuncSetAttribute((const void*)mk_fwd, hipFuncAttributeMaxDynamicSharedMemorySize, LDS_BYTES) != hipSuccess) { fprintf(stderr, "kernel_launch: hipFuncSetAttribute failed\n"); grid = -1; return; }
        if (hipOccupancyMaxActiveBlocksPerMultiprocessor(&per_cu, (const void*)mk_fwd, NTHR, LDS_BYTES) != hipSuccess || per_cu < 1) { fprintf(stderr, "kernel_launch: occupancy query says %d blocks per CU\n", per_cu); (void)hipGetLastError(); grid = -1; return; }
        grid = cus * per_cu;
    }
    if (grid < 0) return;
    if (hipMemsetAsync(d_ws, 0, WS_ZERO_BYTES, stream) != hipSuccess) { fprintf(stderr, "kernel_launch: hipMemsetAsync failed\n"); return; }
    Args a{};
    for (int i = 0; i < 21; ++i) a.in[i] = (const float*)d_in[i];
    a.out = (float*)d_out; a.ws = (unsigned char*)d_ws;
    void* args[] = {&a};
    const hipError_t e = hipLaunchCooperativeKernel((const void*)mk_fwd, dim3(grid), dim3(NTHR), args, LDS_BYTES, stream);
    if (e != hipSuccess) fprintf(stderr, "kernel_launch: cooperative launch failed: %s (grid %d)\n", hipGetErrorString(e), grid);
}
```
